# Optimizing an MI355X kernel written in HIP

```python
import math
import jax, jax.numpy as jnp
from jax import lax
import numpy as np


D_MODEL = 1024
BATCH = 8
SEQ = 4096
DEPTH = 2

EXPAND = 2
D_INNER = EXPAND * D_MODEL
N_MEM = 256
EPS = 1e-6
NEG = -1e30
BIG = 1e30

POOL_WINDOWS = (2, 4, 8, 16)
POOL_WIDTH = 3 * D_INNER // 8
POOL_GROUP = POOL_WIDTH // len(POOL_WINDOWS)

RET_HEADS = 4
RET_DK = 128
RET_DV = 192
RET_CHUNK = 128
ROPE_BASE = 10000.0

MEM_HEADS = 4
MEM_DH = 128
MEM_WIDTH = MEM_HEADS * MEM_DH

NSA_HEADS = 12
NSA_KV = 2
NSA_HPG = NSA_HEADS // NSA_KV
NSA_DH = 128
CMP_BLOCK = 32
CMP_STRIDE = 16
CMP_HIDDEN = 256
SLC_BLOCK = 64
SLC_TOPK = 8
WINDOW = 512
NSA_QBLOCK = 32

REL_BUCKETS = 32
REL_MAX_DIST = 128

EVEN_SPLITS = (POOL_WIDTH, RET_HEADS * RET_DK, RET_HEADS * RET_DK, RET_HEADS * RET_DV, MEM_WIDTH, D_INNER)
ODD_SPLITS = (NSA_HEADS * NSA_DH,) + (NSA_KV * NSA_DH,) * 6 + (3 * NSA_HEADS, MEM_WIDTH, D_INNER)
EVEN_COLS = sum(EVEN_SPLITS)
ODD_COLS = sum(ODD_SPLITS)

kernel_name = 'hybrid_pool_retention_nsa_memory'


def rmsnorm(x, g):
    xf = x.astype(jnp.float32)
    y = xf * lax.rsqrt(jnp.mean(xf * xf, axis=-1, keepdims=True) + EPS)
    return (y * g.astype(jnp.float32)).astype(x.dtype)


def split_cols(z, sizes):
    return jnp.split(z, np.cumsum(sizes)[:-1].tolist(), axis=-1)


def t5_bucket(rel):
    n = jnp.maximum(rel, 0)
    max_exact = REL_BUCKETS // 2
    nf = jnp.maximum(n, 1).astype(jnp.float32)
    large = max_exact + (jnp.log(nf / max_exact) / math.log(REL_MAX_DIST / max_exact)
                         * (REL_BUCKETS - max_exact)).astype(jnp.int32)
    large = jnp.minimum(large, REL_BUCKETS - 1)
    return jnp.where(n < max_exact, n, large)


def pool_mixer(u, w_grp, scale):
    B_, S, W = u.shape
    uf = u.astype(jnp.float32)
    cs = jnp.concatenate([jnp.zeros((B_, 1, W), jnp.float32), jnp.cumsum(uf, axis=1)], axis=1)
    t = jnp.arange(S)
    outs = []
    for gi, w in enumerate(POOL_WINDOWS):
        sl = slice(gi * POOL_GROUP, (gi + 1) * POOL_GROUP)
        lo = jnp.maximum(t + 1 - w, 0)
        cnt = (t + 1 - lo).astype(jnp.float32)[None, :, None]
        outs.append((cs[:, 1:, sl] - cs[:, lo, sl]) / cnt - uf[..., sl])
    pooled = jnp.stack(outs, axis=2)
    y = jnp.einsum('bsgc,gcd->bsgd', pooled, w_grp.astype(jnp.float32)).reshape(B_, S, W)
    return y * scale.astype(jnp.float32)


def rotary(x):
    S, Dh = x.shape[-2], x.shape[-1]
    half = Dh // 2
    inv = ROPE_BASE ** (-jnp.arange(half, dtype=jnp.float32) / half)
    ang = jnp.arange(S, dtype=jnp.float32)[:, None] * inv[None, :]
    cos, sin = jnp.cos(ang), jnp.sin(ang)
    x1 = x[..., :half].astype(jnp.float32)
    x2 = x[..., half:].astype(jnp.float32)
    return jnp.concatenate([x1 * cos - x2 * sin, x1 * sin + x2 * cos], axis=-1)


def retention(q, k, v):
    B_, S, _ = q.shape
    H, C = RET_HEADS, RET_CHUNK
    N = S // C
    qh = rotary(q.reshape(B_, S, H, RET_DK).transpose(0, 2, 1, 3)) * (RET_DK ** -0.5)
    kh = rotary(k.reshape(B_, S, H, RET_DK).transpose(0, 2, 1, 3))
    vh = v.reshape(B_, S, H, RET_DV).transpose(0, 2, 1, 3).astype(jnp.float32)
    log_g = jnp.log(1.0 - jnp.exp2(-5.0 - jnp.arange(H, dtype=jnp.float32)))
    n = jnp.arange(C, dtype=jnp.float32)
    diff = n[:, None] - n[None, :]
    decay_in = jnp.where(diff >= 0, jnp.exp(log_g[:, None, None] * jnp.maximum(diff, 0.0)), 0.0)
    xi = jnp.exp(log_g[:, None] * (n + 1.0))
    zeta = jnp.exp(log_g[:, None] * (C - 1.0 - n))
    g_chunk = jnp.exp(log_g * C)
    qc = qh.reshape(B_, H, N, C, RET_DK)
    kc = kh.reshape(B_, H, N, C, RET_DK)
    vc = vh.reshape(B_, H, N, C, RET_DV)
    att = jnp.einsum('bhncd,bhnmd->bhncm', qc, kc) * decay_in[None, :, None]
    o_inner = jnp.einsum('bhncm,bhnmv->bhncv', att, vc)
    kv = jnp.einsum('bhnmd,bhnmv->bhndv', kc * zeta[None, :, None, :, None], vc)

    def step(R, kv_n):
        return R * g_chunk[None, :, None, None] + kv_n, R

    _, R_prev = lax.scan(step, jnp.zeros((B_, H, RET_DK, RET_DV), jnp.float32), kv.transpose(2, 0, 1, 3, 4))
    R_prev = R_prev.transpose(1, 2, 0, 3, 4)
    o_cross = jnp.einsum('bhncd,bhndv->bhncv', qc * xi[None, :, None, :, None], R_prev)
    o = (o_inner + o_cross).reshape(B_, H, S, RET_DV)
    mu = jnp.mean(o, axis=-1, keepdims=True)
    var = jnp.mean((o - mu) ** 2, axis=-1, keepdims=True)
    o = (o - mu) * lax.rsqrt(var + EPS)
    return o.transpose(0, 2, 1, 3).reshape(B_, S, H * RET_DV)


def mem_attention(xq, mem_n, w_mem_kv):
    B_, S, _ = xq.shape
    M = mem_n.shape[1]
    mk, mv = jnp.split(mem_n @ w_mem_kv, 2, axis=-1)
    mk = mk.reshape(B_, M, MEM_HEADS, MEM_DH)
    mv = mv.reshape(B_, M, MEM_HEADS, MEM_DH)
    qh = xq.reshape(B_, S, MEM_HEADS, MEM_DH).astype(jnp.float32) * (MEM_DH ** -0.5)
    p = jax.nn.softmax(jnp.einsum('bshd,bmhd->bhsm', qh, mk), axis=-1)
    o = jnp.einsum('bhsm,bmhd->bshd', p, mv)
    return o.reshape(B_, S, MEM_WIDTH)


def compress(k, pe, w1, b1, w2):
    B_, S = k.shape[:2]
    n_cmp = (S - CMP_BLOCK) // CMP_STRIDE + 1
    idx = jnp.arange(n_cmp)[:, None] * CMP_STRIDE + jnp.arange(CMP_BLOCK)[None, :]
    blocks = k[:, idx] + pe[:, None, :]
    flat = blocks.transpose(0, 1, 3, 2, 4).reshape(B_, n_cmp, NSA_KV, CMP_BLOCK * NSA_DH)
    return jax.nn.silu(flat @ w1 + b1) @ w2


def cmp_to_slc_matrix(n_cmp, n_slc):
    cst = np.arange(n_cmp)[:, None] * CMP_STRIDE
    sst = np.arange(n_slc)[None, :] * SLC_BLOCK
    ov = np.clip(np.minimum(cst + CMP_BLOCK, sst + SLC_BLOCK) - np.maximum(cst, sst), 0, None)
    return jnp.asarray(ov / CMP_STRIDE, dtype=jnp.float32)


def nsa_attention(q, kc, vc, ks, vs, kw, vw, gate_logits, cmp_pe, cmp_w1, cmp_b1, cmp_w2, rel_bias):
    B_, S = q.shape[:2]
    QB = NSA_QBLOCK
    qh = q.reshape(B_, S, NSA_KV, NSA_HPG, NSA_DH).transpose(0, 2, 3, 1, 4).astype(jnp.float32) * (NSA_DH ** -0.5)

    def kv_heads(t):
        return t.reshape(B_, S, NSA_KV, NSA_DH)

    kcmp = compress(kv_heads(kc), cmp_pe[0], cmp_w1[0], cmp_b1[0], cmp_w2[0]).transpose(0, 2, 1, 3)
    vcmp = compress(kv_heads(vc), cmp_pe[1], cmp_w1[1], cmp_b1[1], cmp_w2[1]).transpose(0, 2, 1, 3)
    n_cmp = kcmp.shape[2]
    n_slc = S // SLC_BLOCK
    kslc = kv_heads(ks).reshape(B_, n_slc, SLC_BLOCK, NSA_KV, NSA_DH).transpose(0, 3, 1, 2, 4)
    vslc = kv_heads(vs).reshape(B_, n_slc, SLC_BLOCK, NSA_KV, NSA_DH).transpose(0, 3, 1, 2, 4)
    pad = ((0, 0), (0, 0), (WINDOW, 0), (0, 0))
    kwin = jnp.pad(kv_heads(kw).transpose(0, 2, 1, 3), pad)
    vwin = jnp.pad(kv_heads(vw).transpose(0, 2, 1, 3), pad)
    gates = jax.nn.sigmoid(gate_logits.astype(jnp.float32)).reshape(B_, S, 3, NSA_KV, NSA_HPG).transpose(0, 2, 3, 4, 1)
    overlap = cmp_to_slc_matrix(n_cmp, n_slc)
    cend = jnp.arange(n_cmp) * CMP_STRIDE + CMP_BLOCK - 1
    table = rel_bias.astype(jnp.float32)
    table_g = table.reshape(REL_BUCKETS, NSA_KV, NSA_HPG)
    k_sel = min(SLC_TOPK, n_slc)
    b_idx = jnp.arange(B_)[:, None, None, None]
    g_idx = jnp.arange(NSA_KV)[None, :, None, None]

    def head_bias(rel):
        return table[t5_bucket(rel)].transpose(2, 0, 1).reshape(NSA_KV, NSA_HPG, rel.shape[0], rel.shape[1])

    def masked_softmax(s, mask):
        return jax.nn.softmax(jnp.where(mask, s, NEG), axis=-1)

    def block(s0):
        tpos = s0 + jnp.arange(QB)
        qb = lax.dynamic_slice_in_dim(qh, s0, QB, axis=3)
        gb = lax.dynamic_slice_in_dim(gates, s0, QB, axis=4)
        rel_c = tpos[:, None] - cend[None, :]
        sc = jnp.einsum('bghqd,bgjd->bghqj', qb, kcmp) + head_bias(rel_c)
        pc = masked_softmax(sc, rel_c >= 0) * (tpos >= CMP_BLOCK - 1).astype(jnp.float32)[:, None]
        oc = jnp.einsum('bghqj,bgjd->bghqd', pc, vcmp)
        imp = jnp.einsum('bghqj,js->bgqs', pc, overlap)
        sblk = jnp.arange(n_slc)[None, :]
        cur = (tpos // SLC_BLOCK)[:, None]
        forced = (sblk == 0) | (sblk == cur) | (sblk == cur - 1)
        future = sblk * SLC_BLOCK > tpos[:, None]
        imp = jnp.where(forced, BIG, jnp.where(future, -BIG, imp))
        _, sel = lax.top_k(imp, k_sel)
        kg = kslc[b_idx, g_idx, sel].reshape(B_, NSA_KV, QB, k_sel * SLC_BLOCK, NSA_DH)
        vg = vslc[b_idx, g_idx, sel].reshape(B_, NSA_KV, QB, k_sel * SLC_BLOCK, NSA_DH)
        kpos_s = (sel[..., None] * SLC_BLOCK + jnp.arange(SLC_BLOCK)).reshape(B_, NSA_KV, QB, k_sel * SLC_BLOCK)
        rel_s = tpos[None, None, :, None] - kpos_s
        bias_s = table_g[t5_bucket(rel_s), g_idx].transpose(0, 1, 4, 2, 3)
        ss = jnp.einsum('bghqd,bgqkd->bghqk', qb, kg) + bias_s
        ps = masked_softmax(ss, (rel_s >= 0)[:, :, None])
        osel = jnp.einsum('bghqk,bgqkd->bghqd', ps, vg)
        kwb = lax.dynamic_slice_in_dim(kwin, s0, WINDOW + QB, axis=2)
        vwb = lax.dynamic_slice_in_dim(vwin, s0, WINDOW + QB, axis=2)
        kpos_w = s0 - WINDOW + jnp.arange(WINDOW + QB)
        rel_w = tpos[:, None] - kpos_w[None, :]
        mask_w = (rel_w >= 0) & (rel_w < WINDOW) & (kpos_w >= 0)[None, :]
        sw = jnp.einsum('bghqd,bgkd->bghqk', qb, kwb) + head_bias(rel_w)
        pw = masked_softmax(sw, mask_w)
        ow = jnp.einsum('bghqk,bgkd->bghqd', pw, vwb)
        return gb[:, 0, ..., None] * oc + gb[:, 1, ..., None] * osel + gb[:, 2, ..., None] * ow

    outs = lax.map(block, jnp.arange(S // QB) * QB)
    return outs.transpose(1, 0, 4, 2, 3, 5).reshape(B_, S, NSA_HEADS * NSA_DH)


def even_layer(h, mem_n, g, w_in, pool_w, pool_scale, w_mem_kv, w_out):
    u = rmsnorm(h, g)
    za, rq, rk, rv, xq, gate = split_cols(u @ w_in, EVEN_SPLITS)
    a = pool_mixer(za, pool_w, pool_scale)
    r = retention(rq, rk, rv)
    m = mem_attention(xq, mem_n, w_mem_kv)
    y = jnp.concatenate([a, r, m], axis=-1) * jax.nn.silu(gate.astype(jnp.float32))
    return h + (y @ w_out).astype(h.dtype)


def odd_layer(h, mem_n, g, w_in, cmp_pe, cmp_w1, cmp_b1, cmp_w2, w_mem_kv, w_out, rel_bias):
    u = rmsnorm(h, g)
    q, kc, vc, ks, vs, kw, vw, gl, xq, gate = split_cols(u @ w_in, ODD_SPLITS)
    c = nsa_attention(q, kc, vc, ks, vs, kw, vw, gl, cmp_pe, cmp_w1, cmp_b1, cmp_w2, rel_bias)
    m = mem_attention(xq, mem_n, w_mem_kv)
    y = jnp.concatenate([c, m], axis=-1) * jax.nn.silu(gate.astype(jnp.float32))
    return h + (y @ w_out).astype(h.dtype)


def setup_inputs(seed: int = 0) -> dict:
    key = jax.random.key(seed)
    ks = jax.random.split(key, 20)
    n_even = (DEPTH + 1) // 2
    n_odd = DEPTH // 2

    def nrm(k, shape, scale):
        return scale * jax.random.normal(k, shape, jnp.float32)

    return {
        'x': nrm(ks[0], (BATCH, SEQ, D_MODEL), 1.0),
        'mem': nrm(ks[1], (BATCH, N_MEM, D_MODEL), 1.0),
        'norm_g': 1.0 + nrm(ks[2], (DEPTH, D_MODEL), 0.05),
        'final_g': 1.0 + nrm(ks[3], (D_MODEL,), 0.05),
        'mem_norm_g': 1.0 + nrm(ks[4], (D_MODEL,), 0.05),
        'rel_bias': nrm(ks[5], (REL_BUCKETS, NSA_HEADS), 0.5),
        'ev_w_in': nrm(ks[6], (n_even, D_MODEL, EVEN_COLS), D_MODEL ** -0.5),
        'ev_pool_w': nrm(ks[7], (n_even, len(POOL_WINDOWS), POOL_GROUP, POOL_GROUP), POOL_GROUP ** -0.5),
        'ev_pool_scale': 1.0 + nrm(ks[8], (n_even, POOL_WIDTH), 0.1),
        'ev_w_mem_kv': nrm(ks[9], (n_even, D_MODEL, 2 * MEM_WIDTH), D_MODEL ** -0.5),
        'ev_w_out': nrm(ks[10], (n_even, D_INNER, D_MODEL), D_INNER ** -0.5),
        'od_w_in': nrm(ks[11], (n_odd, D_MODEL, ODD_COLS), D_MODEL ** -0.5),
        'od_cmp_pe': nrm(ks[12], (n_odd, 2, CMP_BLOCK, NSA_DH), 0.1),
        'od_cmp_w1': nrm(ks[13], (n_odd, 2, CMP_BLOCK * NSA_DH, CMP_HIDDEN), (CMP_BLOCK * NSA_DH) ** -0.5),
        'od_cmp_b1': nrm(ks[14], (n_odd, 2, CMP_HIDDEN), 0.01),
        'od_cmp_w2': nrm(ks[15], (n_odd, 2, CMP_HIDDEN, NSA_DH), CMP_HIDDEN ** -0.5),
        'od_w_mem_kv': nrm(ks[16], (n_odd, D_MODEL, 2 * MEM_WIDTH), D_MODEL ** -0.5),
        'od_w_out': nrm(ks[17], (n_odd, D_INNER, D_MODEL), D_INNER ** -0.5),
    }


def reference(x, mem, norm_g, final_g, mem_norm_g, rel_bias, ev_w_in, ev_pool_w, ev_pool_scale, ev_w_mem_kv, ev_w_out,
              od_w_in, od_cmp_pe, od_cmp_w1, od_cmp_b1, od_cmp_w2, od_w_mem_kv, od_w_out):
    mem_n = rmsnorm(mem, mem_norm_g)
    h = x
    for i in range(DEPTH):
        j = i // 2
        if i % 2 == 0:
            h = even_layer(h, mem_n, norm_g[i], ev_w_in[j], ev_pool_w[j], ev_pool_scale[j], ev_w_mem_kv[j], ev_w_out[j])
        else:
            h = odd_layer(h, mem_n, norm_g[i], od_w_in[j], od_cmp_pe[j], od_cmp_w1[j], od_cmp_b1[j], od_cmp_w2[j],
                          od_w_mem_kv[j], od_w_out[j], rel_bias)
    return rmsnorm(h, final_g)
```

```cpp
#include <hip/hip_runtime.h>
#include <hip/hip_cooperative_groups.h>
#include <cstdio>
#include <cstdint>
namespace cg = cooperative_groups;

#define LAS __attribute__((address_space(3)))
#define GAS __attribute__((address_space(1)))
typedef unsigned short bf16_t;
typedef short bf16x8 __attribute__((ext_vector_type(8)));
typedef short s16x4 __attribute__((ext_vector_type(4)));
typedef float f32x4 __attribute__((ext_vector_type(4)));
typedef float f32x16 __attribute__((ext_vector_type(16)));
typedef unsigned u32x4 __attribute__((ext_vector_type(4)));
typedef unsigned u32x2 __attribute__((ext_vector_type(2)));

constexpr int BATCH = 8, SEQ = 4096, DM = 1024, MTOK = BATCH * SEQ, NMEM = 256, DIN = 2048;
constexpr float EPS = 1e-6f;
constexpr float LOG2E = 1.4426950408889634f;
constexpr int EV_LD = 5120, EV_ZA = 0, EV_RQ = 768, EV_RK = 1280, EV_RV = 1792, EV_XQ = 2560, EV_G = 3072;
constexpr int OD_LD = 5632, OD_N = 5888, OD_COLS = 5668, OD_Q = 0, OD_KC = 1536, OD_VC = 1792, OD_KS = 2048, OD_VS = 2304, OD_KW = 2560, OD_VW = 2816, OD_XQ = 3072, OD_G = 3584;
constexpr int GATE_LD = 40;
constexpr size_t MiB = 1u << 20;
constexpr size_t WS_CTL = 0, CTL_BYTES = 1 * MiB;
constexpr size_t WS_W0 = 1 * MiB;
constexpr size_t WS_W1 = WS_W0 + (size_t)EV_LD * DM * 2;
constexpr size_t WS_WO0 = WS_W1 + (size_t)OD_N * DM * 2;
constexpr size_t WS_WO1 = WS_WO0 + (size_t)DM * DIN * 2;
constexpr size_t WS_WM0 = WS_WO1 + (size_t)DM * DIN * 2;
constexpr size_t WS_WM1 = WS_WM0 + (size_t)DM * DM * 2;
constexpr size_t WS_WC1 = WS_WM1 + (size_t)DM * DM * 2;
constexpr size_t WS_WC2 = WS_WC1 + (size_t)2 * 256 * 4096 * 2;
constexpr size_t WS_WP = WS_WC2 + (size_t)2 * 128 * 256 * 2;
constexpr size_t WS_WEND = WS_WP + (size_t)4 * 192 * 192 * 2;
static_assert(WS_WEND <= 41 * MiB, "weights");
constexpr size_t WS_MEMN = 41 * MiB, WS_MKV0 = 45 * MiB, WS_MKV1 = 49 * MiB;
constexpr size_t WS_ROPE = 53 * MiB;
constexpr size_t WS_PART = 55 * MiB;
constexpr size_t WS_MISC = 57 * MiB;
constexpr size_t WS_Z = 58 * MiB;
constexpr size_t WS_R = 410 * MiB;
constexpr size_t WS_GATES = WS_R + 64 * MiB;
constexpr size_t WS_KCMP = WS_R + 70 * MiB, WS_VCMP = WS_R + 71 * MiB;
constexpr size_t WS_END = 506 * MiB;

constexpr int RING_BYTES = 131072, RSTD_OFF = RING_BYTES, RSTD_BYTES = 12 * 1024, MISC_OFF = RSTD_OFF + RSTD_BYTES, LDS_BYTES = 147456;

__device__ __forceinline__ unsigned f2bf(float f) { unsigned u = __builtin_bit_cast(unsigned, f); return (u + 0x7fffu + ((u >> 16) & 1u)) >> 16; }
__device__ __forceinline__ unsigned pk2(float lo, float hi) { return f2bf(lo) | (f2bf(hi) << 16); }
__device__ __forceinline__ float bf2f(unsigned short b) { return __builtin_bit_cast(float, (unsigned)b << 16); }
__device__ __forceinline__ unsigned cvt_pk_bf16(float lo, float hi) { unsigned r; asm volatile("v_cvt_pk_bf16_f32 %0, %1, %2" : "=v"(r) : "v"(lo), "v"(hi)); return r; }
__device__ __forceinline__ float wave_sum(float v) {
#pragma unroll
    for (int o = 1; o < 64; o <<= 1) v += __shfl_xor(v, o);
    return v;
}
__device__ __forceinline__ float fast_sigmoid(float v) { return __builtin_amdgcn_rcpf(1.f + __builtin_amdgcn_exp2f(-v * LOG2E)); }
#define LDS_WAIT() asm volatile("s_waitcnt lgkmcnt(0)" ::: "memory")
#define VM_WAIT() asm volatile("s_waitcnt vmcnt(0)" ::: "memory")

namespace pg8 {
constexpr int BM = 256, BK = 64, HALF = 128, HTB = HALF * BK * 2, STAGE_BYTES = 8 * HTB, NXCD = 8, WGM = 8;
__host__ __device__ __forceinline__ int lds_byte(int r, int c) { const int st = (r >> 4) * 2 + (c >> 5), rr = r & 15, cc = c & 31, ob = rr * 64 + cc * 2; return st * 1024 + (ob ^ (((ob >> 9) & 1) << 5)); }
__host__ __device__ __forceinline__ void stage_rc(int b, int& R, int& C) { const int st = b / 1024, sb = b % 1024, swz = sb ^ (((sb >> 9) & 1) << 5); R = (st >> 1) * 16 + swz / 64; C = (st & 1) * 32 + (swz % 64) / 2; }
__host__ __device__ __forceinline__ int perm32(int rho) { const int n = rho >> 4, i = rho & 15; return 8 * (i >> 2) + 4 * n + (i & 3); }
struct Unit { int pm, pn, idx; };
struct Gemm { const bf16_t* A; const bf16_t* Bt; int M, N, K, lda; };
struct StaticOrder {
    int nM, nN, nwg, G, c;
    __device__ void init(int M, int N, int G_, int c_) { nM = M / BM; nN = N / BM; nwg = nM * nN; G = G_; c = c_; }
    __device__ bool next(int i, Unit& u) const {
        const long L = (long)i * G + c; if (L >= nwg) return false;
        int wgid = (int)L; { const int q = nwg / NXCD, r = nwg % NXCD, xcd = wgid % NXCD, off = wgid / NXCD; wgid = (xcd < r ? xcd * (q + 1) : r * (q + 1) + (xcd - r) * q) + off; }
        const int nig = WGM * nN, gid = wgid / nig, fm = gid * WGM, gsz = (nM - fm) < WGM ? (nM - fm) : WGM;
        u.pm = fm + ((wgid % nig) % gsz); u.pn = (wgid % nig) / gsz; u.idx = i; return true;
    }
};
template <class Epi>
__device__ __forceinline__ void gemm_phase(LAS unsigned char* lds, const Gemm g, const StaticOrder& S, const Epi& E) {
    const int tid = threadIdx.x, wid = __builtin_amdgcn_readfirstlane(tid >> 6), lane = tid & 63, wr = wid >> 2, wc = wid & 3, fr = lane & 15, fq = lane >> 4;
    const int K = g.K, nt = K / BK, lda = g.lda;
    unsigned voffA[2], voffB[2];
#pragma unroll
    for (int i = 0; i < 2; ++i) { int R, C; stage_rc(tid * 16 + i * 8192, R, C); const int Rb = (R & ~31) + perm32(R & 31);
        voffA[i] = (unsigned)(R * lda + C) * 2u; voffB[i] = (unsigned)(Rb * K + C) * 2u; }
    const size_t kstep = (size_t)(BK * 2);
    const size_t hstepA = (size_t)HALF * lda * 2, hstepB = (size_t)HALF * K * 2;
    const size_t tstepA = 2 * hstepA, tstepB = 2 * hstepB;
    const unsigned ldsw = (unsigned)wid * 1024u;
    const int aoff = lds_byte(wr * 64 + fr, fq * 8), boff = lds_byte(wc * 32 + fr, fq * 8);
#define PG8_SA(b, h) (((b) * 2 + (h)) * HTB)
#define PG8_SB(b, h) ((4 + (b) * 2 + (h)) * HTB)
#define PG8_STAGE(bufoff, gbase, voff) do { _Pragma("unroll") for (int _i = 0; _i < 2; ++_i) \
        __builtin_amdgcn_global_load_lds((const unsigned*)((const char*)(gbase) + (voff)[_i]), (LAS unsigned*)(lds + (bufoff) + ldsw + _i * 8192), 16, 0, 0); } while (0)
#define PG8_LDA(dst, b, h) do { _Pragma("unroll") for (int m = 0; m < 4; ++m) _Pragma("unroll") for (int k = 0; k < 2; ++k) dst[m][k] = *(const LAS bf16x8*)(lds + PG8_SA(b, h) + aoff + m * 2048 + k * 1024); } while (0)
#define PG8_LDB(dst, b, h) do { _Pragma("unroll") for (int n = 0; n < 2; ++n) _Pragma("unroll") for (int k = 0; k < 2; ++k) dst[n][k] = *(const LAS bf16x8*)(lds + PG8_SB(b, h) + boff + n * 2048 + k * 1024); } while (0)
#define PG8_MMA(ai, bj, At, Bt) do { __builtin_amdgcn_s_setprio(1); _Pragma("unroll") for (int m = 0; m < 4; ++m) _Pragma("unroll") for (int n = 0; n < 2; ++n) _Pragma("unroll") for (int k = 0; k < 2; ++k) \
        acc[ai][bj][m][n] = __builtin_amdgcn_mfma_f32_16x16x32_bf16(Bt[n][k], At[m][k], acc[ai][bj][m][n], 0, 0, 0); __builtin_amdgcn_s_setprio(0); } while (0)
#define PG8_WAIT_V(n) asm volatile("s_waitcnt vmcnt(" #n ")" ::: "memory")
#define PG8_WAIT_L(n) asm volatile("s_waitcnt lgkmcnt(" #n ")" ::: "memory")
#define PG8_BAR __builtin_amdgcn_s_barrier()
#define PG8_SCHED __builtin_amdgcn_sched_barrier(0)
    Unit cur, nxt; int ui = 0;
    if (!S.next(0, cur)) return;
    f32x4 acc[2][2][4][2];
#pragma unroll
    for (int a = 0; a < 2; ++a)
#pragma unroll
        for (int b = 0; b < 2; ++b)
#pragma unroll
            for (int m = 0; m < 4; ++m)
#pragma unroll
                for (int n = 0; n < 2; ++n) acc[a][b][m][n] = (f32x4){0.f, 0.f, 0.f, 0.f};
    bf16x8 At[4][2], B0[2][2], B1[2][2];
    const char* cA = (const char*)g.A + (size_t)cur.pm * tstepA; const char* cB = (const char*)g.Bt + (size_t)cur.pn * tstepB;
    PG8_STAGE(PG8_SB(0, 0), cB, voffB); PG8_STAGE(PG8_SB(0, 1), cB + hstepB, voffB); PG8_STAGE(PG8_SA(0, 0), cA, voffA); PG8_STAGE(PG8_SA(0, 1), cA + hstepA, voffA);
    if (wr == 1) PG8_BAR;
    PG8_WAIT_V(2); PG8_BAR;
    PG8_STAGE(PG8_SB(1, 0), cB + kstep, voffB); PG8_STAGE(PG8_SA(1, 0), cA + kstep, voffA); PG8_STAGE(PG8_SB(1, 1), cB + hstepB + kstep, voffB);
    PG8_WAIT_V(6); PG8_BAR;
    for (;;) {
        const bool has_next = S.next(ui + 1, nxt);
        const char* nA = has_next ? (const char*)g.A + (size_t)nxt.pm * tstepA : cA; const char* nB = has_next ? (const char*)g.Bt + (size_t)nxt.pn * tstepB : cB;
        for (int t = 0; t < nt; t += 2) {
            const bool last = (t == nt - 2);
            const char* a1 = cA + (size_t)(t + 1) * kstep;
            const char* a2 = last ? nA : cA + (size_t)(t + 2) * kstep; const char* b2 = last ? nB : cB + (size_t)(t + 2) * kstep;
            const char* a3 = a2 + kstep; const char* b3 = b2 + kstep;
            PG8_LDB(B0, 0, 0); PG8_LDB(B1, 0, 1); PG8_SCHED; PG8_LDA(At, 0, 0); PG8_STAGE(PG8_SA(1, 1), a1 + hstepA, voffA);
            PG8_WAIT_V(8); PG8_WAIT_L(0); PG8_BAR; PG8_MMA(0, 0, At, B0); PG8_MMA(0, 1, At, B1); PG8_BAR; PG8_SCHED;
            PG8_LDA(At, 0, 1); PG8_STAGE(PG8_SB(0, 0), b2, voffB); PG8_STAGE(PG8_SB(0, 1), b2 + hstepB, voffB); PG8_STAGE(PG8_SA(0, 0), a2, voffA);
            PG8_WAIT_V(8); PG8_WAIT_L(0); PG8_BAR; PG8_MMA(1, 0, At, B0); PG8_MMA(1, 1, At, B1); PG8_BAR; PG8_SCHED;
            PG8_LDB(B0, 1, 0); PG8_LDB(B1, 1, 1); PG8_SCHED; PG8_LDA(At, 1, 0); PG8_STAGE(PG8_SA(0, 1), a2 + hstepA, voffA);
            PG8_WAIT_V(8); PG8_WAIT_L(0); PG8_BAR; PG8_MMA(0, 0, At, B0); PG8_MMA(0, 1, At, B1); PG8_BAR; PG8_SCHED;
            PG8_LDA(At, 1, 1); PG8_STAGE(PG8_SB(1, 0), b3, voffB); PG8_STAGE(PG8_SB(1, 1), b3 + hstepB, voffB); PG8_STAGE(PG8_SA(1, 0), a3, voffA);
            PG8_WAIT_V(8); PG8_WAIT_L(0); PG8_BAR; PG8_MMA(1, 0, At, B0); PG8_MMA(1, 1, At, B1); PG8_BAR; PG8_SCHED;
        }
        if (wr == 0) PG8_BAR;
        E(acc, cur, wr, wc, fr, fq);
        if (!has_next) break;
#pragma unroll
        for (int a = 0; a < 2; ++a)
#pragma unroll
            for (int b = 0; b < 2; ++b)
#pragma unroll
                for (int m = 0; m < 4; ++m)
#pragma unroll
                    for (int n = 0; n < 2; ++n) acc[a][b][m][n] = (f32x4){0.f, 0.f, 0.f, 0.f};
        cur = nxt; cA = nA; cB = nB; ++ui;
        if (wr == 1) PG8_BAR;
    }
    PG8_WAIT_V(0);
    PG8_BAR;
#undef PG8_SA
#undef PG8_SB
#undef PG8_STAGE
#undef PG8_LDA
#undef PG8_LDB
#undef PG8_MMA
#undef PG8_WAIT_V
#undef PG8_WAIT_L
#undef PG8_BAR
#undef PG8_SCHED
}
}

struct EpiIn {
    bf16_t* Z; int ldz; const LAS float* rstd; int pn_silu, pn_gate; float* gates; int zlo, zhi;
    __device__ __forceinline__ void operator()(const f32x4 (&acc)[2][2][4][2], const pg8::Unit& u, int wr, int wc, int fr, int fq) const {
        const int rl0 = wr * 64 + fr, col0 = u.pn * 256 + wc * 32 + 8 * fq;
        const bool is_gate = (u.pn == pn_gate), is_silu = (u.pn >= pn_silu) && !is_gate;
#pragma unroll
        for (int ai = 0; ai < 2; ++ai)
#pragma unroll
            for (int m = 0; m < 4; ++m) {
                const int rl = rl0 + ai * 128 + m * 16; const float rs = rstd[u.idx * 256 + rl]; const size_t row = (size_t)u.pm * 256 + rl;
#pragma unroll
                for (int bj = 0; bj < 2; ++bj) {
                    f32x4 v0 = acc[ai][bj][m][0] * rs, v1 = acc[ai][bj][m][1] * rs;
                    if (is_gate) {
                        const int c = wc * 32 + 8 * fq + bj * 128;
                        if (c < 36) { float* gp = gates + row * GATE_LD + c;
#pragma unroll
                            for (int j = 0; j < 4; ++j) { gp[j] = fast_sigmoid(v0[j]); if (c + 4 + j < 36) gp[4 + j] = fast_sigmoid(v1[j]); } }
                    } else {
                        if (is_silu) {
#pragma unroll
                            for (int j = 0; j < 4; ++j) { v0[j] = v0[j] * fast_sigmoid(v0[j]); v1[j] = v1[j] * fast_sigmoid(v1[j]); }
                            if (u.pn >= zlo && u.pn < zhi) { v0 = (f32x4){0.f, 0.f, 0.f, 0.f}; v1 = v0; }
                        }
                        u32x4 w; w.x = cvt_pk_bf16(v0[0], v0[1]); w.y = cvt_pk_bf16(v0[2], v0[3]); w.z = cvt_pk_bf16(v1[0], v1[1]); w.w = cvt_pk_bf16(v1[2], v1[3]);
                        *(u32x4*)(Z + row * ldz + col0 + bj * 128) = w;
                    }
                }
            }
    }
};
struct EpiBf {
    bf16_t* O; int ldc;
    __device__ __forceinline__ void operator()(const f32x4 (&acc)[2][2][4][2], const pg8::Unit& u, int wr, int wc, int fr, int fq) const {
        const int row0 = u.pm * 256 + wr * 64 + fr, col0 = u.pn * 256 + wc * 32 + 8 * fq;
#pragma unroll
        for (int ai = 0; ai < 2; ++ai)
#pragma unroll
            for (int m = 0; m < 4; ++m)
#pragma unroll
                for (int bj = 0; bj < 2; ++bj) {
                    const f32x4 v0 = acc[ai][bj][m][0], v1 = acc[ai][bj][m][1];
                    u32x4 w; w.x = cvt_pk_bf16(v0[0], v0[1]); w.y = cvt_pk_bf16(v0[2], v0[3]); w.z = cvt_pk_bf16(v1[0], v1[1]); w.w = cvt_pk_bf16(v1[2], v1[3]);
                    *(u32x4*)(O + (size_t)(row0 + ai * 128 + m * 16) * ldc + col0 + bj * 128) = w;
                }
    }
};
struct EpiOut {
    const float* base; float* out; bf16_t* hb; float* part;
    __device__ __forceinline__ void operator()(const f32x4 (&acc)[2][2][4][2], const pg8::Unit& u, int wr, int wc, int fr, int fq) const {
        const int row0 = u.pm * 256 + wr * 64 + fr, col0 = u.pn * 256 + wc * 32 + 8 * fq;
#pragma unroll
        for (int ai = 0; ai < 2; ++ai)
#pragma unroll
            for (int m = 0; m < 4; ++m) {
                const size_t row = (size_t)(row0 + ai * 128 + m * 16); float ss = 0.f;
#pragma unroll
                for (int bj = 0; bj < 2; ++bj) {
                    const size_t off = row * DM + col0 + bj * 128;
                    const f32x4 b0 = *(const f32x4*)(base + off), b1 = *(const f32x4*)(base + off + 4);
                    const f32x4 v0 = acc[ai][bj][m][0] + b0, v1 = acc[ai][bj][m][1] + b1;
                    *(f32x4*)(out + off) = v0; *(f32x4*)(out + off + 4) = v1;
                    u32x4 w; w.x = cvt_pk_bf16(v0[0], v0[1]); w.y = cvt_pk_bf16(v0[2], v0[3]); w.z = cvt_pk_bf16(v1[0], v1[1]); w.w = cvt_pk_bf16(v1[2], v1[3]);
                    *(u32x4*)(hb + off) = w;
                    ss += (v0[0] * v0[0] + v0[1] * v0[1]) + (v0[2] * v0[2] + v0[3] * v0[3]) + (v1[0] * v1[0] + v1[1] * v1[1]) + (v1[2] * v1[2] + v1[3] * v1[3]);
                }
                ss += __shfl_xor(ss, 16); ss += __shfl_xor(ss, 32);
                if (fq == 0) part[row * 16 + u.pn * 4 + wc] = ss;
            }
    }
};

struct Args { const float* in[18]; float* out; unsigned char* ws; int ph_lo, ph_hi; };
struct Frame {
    LAS unsigned char* lds; int tid, lane, wave, G, bid;
    unsigned char* ws;
};
#define KSWZ(row, colB) ((row) * 256 + ((colB) ^ (((row) & 7) << 4)))
#define SBAR() __builtin_amdgcn_sched_barrier(0)
__device__ __forceinline__ int crow(int r, int hi) { return (r & 3) + 8 * (r >> 2) + 4 * hi; }
template <int NCB> __device__ __forceinline__ int v_st(int k, int c) { const int kk = (k & ~0xC) | ((k & 4) << 1) | ((k & 8) >> 1); return ((kk >> 3) * NCB + (c >> 5)) * 512 + ((kk & 7) * 32 + (c & 31)) * 2; }
__device__ __forceinline__ int v_rd_base(int lane) { return ((lane & 3) << 3) | (((lane >> 2) & 3) << 6) | (((lane >> 4) & 1) << 5) | (((lane >> 5) & 1) << 8); }
template <int OFF> __device__ __forceinline__ s16x4 tr_read(int vb) { s16x4 r; asm volatile("ds_read_b64_tr_b16 %0, %1 offset:%2" : "=&v"(r) : "v"(vb), "i"(OFF) : "memory"); return r; }
__device__ __forceinline__ int lds_addr(const LAS void* p) { return (int)(unsigned)(size_t)p; }
__device__ __forceinline__ void qkt(f32x16& p0, f32x16& p1, const LAS char* Ks, const bf16x8* qr, int r32, int hi) {
    p0 = f32x16{}; p1 = f32x16{};
#pragma unroll
    for (int d0 = 0; d0 < 8; ++d0) { const int cb = (d0 * 16 + hi * 8) * 2;
        const bf16x8 b0 = *(const LAS bf16x8*)(Ks + KSWZ(r32, cb));
        const bf16x8 b1 = *(const LAS bf16x8*)(Ks + KSWZ(32 + r32, cb));
        p0 = __builtin_amdgcn_mfma_f32_32x32x16_bf16(b0, qr[d0], p0, 0, 0, 0);
        p1 = __builtin_amdgcn_mfma_f32_32x32x16_bf16(b1, qr[d0], p1, 0, 0, 0); }
}
__device__ __forceinline__ void pack_p(const f32x16& p0, const f32x16& p1, bf16x8& pa0, bf16x8& pa1, bf16x8& pa2, bf16x8& pa3) {
#define PK4(P, BASE, OUT) do { unsigned a0 = cvt_pk_bf16(P[BASE + 0], P[BASE + 1]), a1 = cvt_pk_bf16(P[BASE + 2], P[BASE + 3]);   \
    unsigned b0 = cvt_pk_bf16(P[BASE + 4], P[BASE + 5]), b1 = cvt_pk_bf16(P[BASE + 6], P[BASE + 7]);                              \
    auto r0 = __builtin_amdgcn_permlane32_swap(a0, b0, false, false); auto r1 = __builtin_amdgcn_permlane32_swap(a1, b1, false, false); \
    u32x4 w = {r0[0], r1[0], r0[1], r1[1]}; OUT = __builtin_bit_cast(bf16x8, w); } while (0)
    PK4(p0, 0, pa0); PK4(p0, 8, pa1); PK4(p1, 0, pa2); PK4(p1, 8, pa3);
#undef PK4
}
__device__ __forceinline__ float xhalf_max(float v) { auto rr = __builtin_amdgcn_permlane32_swap(__float_as_uint(v), __float_as_uint(v), false, false); return fmaxf(__uint_as_float(rr[0]), __uint_as_float(rr[1])); }
__device__ __forceinline__ float xhalf_sum(float v) { auto rr = __builtin_amdgcn_permlane32_swap(__float_as_uint(v), __float_as_uint(v), false, false); return __uint_as_float(rr[0]) + __uint_as_float(rr[1]); }
template <int ND> __device__ __forceinline__ void softmax_step(f32x16& p0, f32x16& p1, float& m, float& l, f32x16 (&o)[ND]) {
    float pmax = p0[0];
#pragma unroll
    for (int r = 1; r < 16; ++r) pmax = fmaxf(pmax, p0[r]);
#pragma unroll
    for (int r = 0; r < 16; ++r) pmax = fmaxf(pmax, p1[r]);
    pmax = xhalf_max(pmax);
    const float mn = fmaxf(m, pmax);
    const float alpha = __builtin_amdgcn_exp2f(m - mn);
    m = mn;
    float ps = 0.f;
#pragma unroll
    for (int r = 0; r < 16; ++r) { p0[r] = __builtin_amdgcn_exp2f(p0[r] - mn); ps += p0[r]; }
#pragma unroll
    for (int r = 0; r < 16; ++r) { p1[r] = __builtin_amdgcn_exp2f(p1[r] - mn); ps += p1[r]; }
    ps = xhalf_sum(ps);
    l = l * alpha + ps;
    if (__any(alpha != 1.f)) {
#pragma unroll
        for (int d = 0; d < ND; ++d)
#pragma unroll
            for (int r = 0; r < 16; ++r) o[d][r] *= alpha;
    }
}
template <int NCB, int D0> __device__ __forceinline__ void pv_one(f32x16& od, int vb, bf16x8 pa0, bf16x8 pa1, bf16x8 pa2, bf16x8 pa3) {
    constexpr int KS = NCB * 1024, HF = NCB * 512, B0 = D0 * 512;
    const s16x4 l0 = tr_read<B0>(vb), h0 = tr_read<B0 + HF>(vb), l1 = tr_read<B0 + KS>(vb), h1 = tr_read<B0 + KS + HF>(vb);
    const s16x4 l2 = tr_read<B0 + 2 * KS>(vb), h2 = tr_read<B0 + 2 * KS + HF>(vb), l3 = tr_read<B0 + 3 * KS>(vb), h3 = tr_read<B0 + 3 * KS + HF>(vb);
    asm volatile("s_waitcnt lgkmcnt(0)" ::: "memory"); SBAR();
#define PKV(L, H) (bf16x8){L[0], L[1], L[2], L[3], H[0], H[1], H[2], H[3]}
    od = __builtin_amdgcn_mfma_f32_32x32x16_bf16(PKV(l0, h0), pa0, od, 0, 0, 0);
    od = __builtin_amdgcn_mfma_f32_32x32x16_bf16(PKV(l1, h1), pa1, od, 0, 0, 0);
    od = __builtin_amdgcn_mfma_f32_32x32x16_bf16(PKV(l2, h2), pa2, od, 0, 0, 0);
    od = __builtin_amdgcn_mfma_f32_32x32x16_bf16(PKV(l3, h3), pa3, od, 0, 0, 0);
#undef PKV
}
template <int NCB> __device__ __forceinline__ void pv_all(f32x16 (&o)[NCB], int vb, bf16x8 pa0, bf16x8 pa1, bf16x8 pa2, bf16x8 pa3) {
    pv_one<NCB, 0>(o[0], vb, pa0, pa1, pa2, pa3); pv_one<NCB, 1>(o[1], vb, pa0, pa1, pa2, pa3); pv_one<NCB, 2>(o[2], vb, pa0, pa1, pa2, pa3); pv_one<NCB, 3>(o[3], vb, pa0, pa1, pa2, pa3);
    if constexpr (NCB == 6) { pv_one<NCB, 4>(o[4], vb, pa0, pa1, pa2, pa3); pv_one<NCB, 5>(o[5], vb, pa0, pa1, pa2, pa3); }
}
struct KReg { bf16x8 a, b; };
template <int NCB> struct VReg { bf16x8 v[NCB == 4 ? 2 : 3]; };
__device__ __forceinline__ void k_load(KReg& s, const bf16_t* kp, size_t ld, int tid) { const int sr = tid >> 4, sc = (tid & 15) * 8;
    s.a = *(const bf16x8*)(kp + (size_t)sr * ld + sc); s.b = *(const bf16x8*)(kp + (size_t)(32 + sr) * ld + sc); }
__device__ __forceinline__ void k_write(LAS char* Kl, const KReg& s, int tid) { const int sr = tid >> 4, kc = (tid & 15) * 16;
    *(LAS bf16x8*)(Kl + KSWZ(sr, kc)) = s.a; *(LAS bf16x8*)(Kl + KSWZ(32 + sr, kc)) = s.b; }
template <int NCB> __device__ __forceinline__ void v_load(VReg<NCB>& s, const bf16_t* vp, size_t ld, int tid) {
    if constexpr (NCB == 4) { const int sr = tid >> 4, sc = (tid & 15) * 8; s.v[0] = *(const bf16x8*)(vp + (size_t)sr * ld + sc); s.v[1] = *(const bf16x8*)(vp + (size_t)(32 + sr) * ld + sc); }
    else {
#pragma unroll
        for (int i = 0; i < 3; ++i) { const int id = tid + 512 * i, row = id / 24, c = (id % 24) * 8; s.v[i] = *(const bf16x8*)(vp + (size_t)row * ld + c); } }
}
template <int NCB> __device__ __forceinline__ void v_write(LAS char* Vl, const VReg<NCB>& s, int tid) {
    if constexpr (NCB == 4) { const int sr = tid >> 4, sc = (tid & 15) * 8; *(LAS bf16x8*)(Vl + v_st<4>(sr, sc)) = s.v[0]; *(LAS bf16x8*)(Vl + v_st<4>(32 + sr, sc)) = s.v[1]; }
    else {
#pragma unroll
        for (int i = 0; i < 3; ++i) { const int id = tid + 512 * i, row = id / 24, c = (id % 24) * 8; *(LAS bf16x8*)(Vl + v_st<6>(row, c)) = s.v[i]; } }
}
__device__ __forceinline__ void q_load(bf16x8 (&qr)[8], const bf16_t* qrow  , int hi) {
#pragma unroll
    for (int d0 = 0; d0 < 8; ++d0) qr[d0] = *(const bf16x8*)(qrow + d0 * 16 + hi * 8);
}
template <int ND> __device__ __forceinline__ void store_y(bf16_t* yrow, const f32x16 (&o)[ND], float sc, int hi) {
#pragma unroll
    for (int d0 = 0; d0 < ND; ++d0)
#pragma unroll
        for (int rg = 0; rg < 4; ++rg) { u32x2* p = (u32x2*)(yrow + 32 * d0 + 8 * rg + 4 * hi); const u32x2 g = *p;
            const float g0 = __builtin_bit_cast(float, g.x << 16), g1 = __builtin_bit_cast(float, g.x & 0xffff0000u), g2 = __builtin_bit_cast(float, g.y << 16), g3 = __builtin_bit_cast(float, g.y & 0xffff0000u);
            u32x2 w; w.x = cvt_pk_bf16(o[d0][4 * rg] * sc * g0, o[d0][4 * rg + 1] * sc * g1); w.y = cvt_pk_bf16(o[d0][4 * rg + 2] * sc * g2, o[d0][4 * rg + 3] * sc * g3); *p = w; }
}

__device__ __forceinline__ void mem_attn_phase(const Frame& F, bf16_t* Z, int ldz, int xq_col, int y_col, const bf16_t* mkv, int unit_lo, int unit_step) {
    const int tid = F.tid, lane = F.lane, r32 = lane & 31, hi = lane >> 5, wave = F.wave;
    LAS char* Kl = (LAS char*)F.lds; LAS char* Vl = Kl + 32768;
    constexpr float C = 0.08838834764831845f * LOG2E;
    for (int u = unit_lo; u < BATCH * 4 * 16; u += unit_step) {
        const int b = u >> 6, head = (u >> 4) & 3, tb = u & 15;
        const size_t t = (size_t)b * SEQ + tb * 256 + wave * 32 + r32;
        bf16x8 qr[8]; q_load(qr, Z + t * ldz + xq_col + head * 128, hi);
        const bf16_t* kp = mkv + (size_t)b * NMEM * DM + head * 128; const bf16_t* vp = kp + 512;
        float m = -1e30f, l = 0.f; f32x16 o[4] = {};
        KReg ks; VReg<4> vs;
        k_load(ks, kp, DM, tid); v_load<4>(vs, vp, DM, tid); k_write(Kl, ks, tid); v_write<4>(Vl, vs, tid); __syncthreads();
        for (int j = 0; j < 4; ++j) {
            const int bo = (j & 1) * 16384;
            if (j + 1 < 4) { k_load(ks, kp + (size_t)(j + 1) * 64 * DM, DM, tid); v_load<4>(vs, vp + (size_t)(j + 1) * 64 * DM, DM, tid); }
            f32x16 p0, p1; qkt(p0, p1, Kl + bo, qr, r32, hi);
#pragma unroll
            for (int r = 0; r < 16; ++r) { p0[r] *= C; p1[r] *= C; }
            softmax_step<4>(p0, p1, m, l, o);
            bf16x8 pa0, pa1, pa2, pa3; pack_p(p0, p1, pa0, pa1, pa2, pa3);
            pv_all<4>(o, lds_addr(Vl + bo) + v_rd_base(lane), pa0, pa1, pa2, pa3);
            if (j + 1 < 4) { k_write(Kl + (bo ^ 16384), ks, tid); v_write<4>(Vl + (bo ^ 16384), vs, tid); }
            __syncthreads();
        }
        store_y<4>(Z + t * ldz + y_col + head * 128, o, 1.f / l, hi);
    }
}

__device__ __forceinline__ void pool_phase(const Frame& F, bf16_t* Z, const bf16_t* WP, const float* scale, int unit_lo, int unit_step) {
    const int tid = F.tid, lane = F.lane, r32 = lane & 31, hi = lane >> 5, wave = F.wave;
    LAS char* Wl = (LAS char*)F.lds;
    for (int u = unit_lo; u < BATCH * 16 * 4; u += unit_step) {
        const int g = u & 3, tb = (u >> 2) & 15, b = u >> 6;
        const int win = 2 << g;
        { const bf16_t* wsrc = WP + (size_t)g * 192 * 192;
#pragma unroll
          for (int i = 0; i < 9; ++i) { const int id = tid + 512 * i, row = id / 24, c = id % 24; *(LAS bf16x8*)(Wl + row * 400 + c * 16) = *(const bf16x8*)(wsrc + row * 192 + c * 8); } }
        __syncthreads();
        const int tloc = tb * 256 + wave * 32 + r32;
        const bf16_t* zrow = Z + ((size_t)b * SEQ + tloc) * EV_LD + EV_ZA + g * 192;
        const int cnt = (tloc + 1 < win) ? tloc + 1 : win; const float icnt = 1.0f / (float)cnt;
        f32x16 o[6] = {};
#pragma unroll 1
        for (int s = 0; s < 12; ++s) {
            const bf16_t* p = zrow + 16 * s + 8 * hi;
            float accv[8]; float cur[8];
            { const bf16x8 v = *(const bf16x8*)p;
#pragma unroll
              for (int j = 0; j < 8; ++j) { cur[j] = bf2f((unsigned short)v[j]); accv[j] = cur[j]; } }
            for (int i = 1; i < cnt; ++i) { const bf16x8 v = *(const bf16x8*)(p - (size_t)i * EV_LD);
#pragma unroll
              for (int j = 0; j < 8; ++j) accv[j] += bf2f((unsigned short)v[j]); }
            u32x4 w; w.x = cvt_pk_bf16(accv[0] * icnt - cur[0], accv[1] * icnt - cur[1]); w.y = cvt_pk_bf16(accv[2] * icnt - cur[2], accv[3] * icnt - cur[3]);
            w.z = cvt_pk_bf16(accv[4] * icnt - cur[4], accv[5] * icnt - cur[5]); w.w = cvt_pk_bf16(accv[6] * icnt - cur[6], accv[7] * icnt - cur[7]);
            const bf16x8 bfrag = __builtin_bit_cast(bf16x8, w);
#pragma unroll
            for (int ob = 0; ob < 6; ++ob) { const bf16x8 afrag = *(const LAS bf16x8*)(Wl + (32 * ob + r32) * 400 + (16 * s + 8 * hi) * 2);
                o[ob] = __builtin_amdgcn_mfma_f32_32x32x16_bf16(afrag, bfrag, o[ob], 0, 0, 0); }
        }
        bf16_t* yrow = Z + ((size_t)b * SEQ + tloc) * EV_LD + EV_G + g * 192; const float* sc = scale + g * 192;
#pragma unroll
        for (int ob = 0; ob < 6; ++ob)
#pragma unroll
            for (int rg = 0; rg < 4; ++rg) { const int c = 32 * ob + 8 * rg + 4 * hi; const f32x4 s4 = *(const f32x4*)(sc + c); u32x2* p = (u32x2*)(yrow + c); const u32x2 gg = *p;
                const float g0 = __builtin_bit_cast(float, gg.x << 16), g1 = __builtin_bit_cast(float, gg.x & 0xffff0000u), g2 = __builtin_bit_cast(float, gg.y << 16), g3 = __builtin_bit_cast(float, gg.y & 0xffff0000u);
                u32x2 w; w.x = cvt_pk_bf16(o[ob][4 * rg] * s4.x * g0, o[ob][4 * rg + 1] * s4.y * g1); w.y = cvt_pk_bf16(o[ob][4 * rg + 2] * s4.z * g2, o[ob][4 * rg + 3] * s4.w * g3); *p = w; }
        __syncthreads();
    }
}


constexpr int RET_KV_ELEMS = 192 * 128;
__device__ __forceinline__ float ret_log2_gamma(int h) { return log2f(1.0f - exp2f(-5.0f - (float)h)); }
__device__ __forceinline__ void ret_a_phase(const Frame& F, bf16_t* Z, const float* ropec, const float* ropes, float* kvT, int unit_lo, int unit_step) {
    const int tid = F.tid, lane = F.lane, wave = F.wave;
    LAS char* Kimg = (LAS char*)F.lds; LAS char* Vimg = Kimg + 32768;
    for (int u = unit_lo; u < BATCH * 4 * 32; u += unit_step) {
        const int b = u >> 7, h = (u >> 5) & 3, n = u & 31, c0 = n * 128;
        const float lgam = ret_log2_gamma(h);
#pragma unroll
        for (int i = 0; i < 2; ++i) {
            const int id = tid + 512 * i, m = id >> 3, c = id & 7, pos = c0 + m;
            bf16_t* row = Z + ((size_t)b * SEQ + pos) * EV_LD;
            const f32x4 ca = *(const f32x4*)(ropec + pos * 64 + 8 * c), cb = *(const f32x4*)(ropec + pos * 64 + 8 * c + 4);
            const f32x4 sa = *(const f32x4*)(ropes + pos * 64 + 8 * c), sb = *(const f32x4*)(ropes + pos * 64 + 8 * c + 4);
            float cs[8] = {ca.x, ca.y, ca.z, ca.w, cb.x, cb.y, cb.z, cb.w}, sn[8] = {sa.x, sa.y, sa.z, sa.w, sb.x, sb.y, sb.z, sb.w};
            const float zeta = exp2f((float)(127 - m) * lgam);
            { bf16_t* kp = row + EV_RK + h * 128 + 8 * c; const bf16x8 x1 = *(const bf16x8*)kp, x2 = *(const bf16x8*)(kp + 64);
              float o1[8], o2[8];
#pragma unroll
              for (int j = 0; j < 8; ++j) { const float a = bf2f((unsigned short)x1[j]), bb = bf2f((unsigned short)x2[j]); o1[j] = a * cs[j] - bb * sn[j]; o2[j] = a * sn[j] + bb * cs[j]; }
              u32x4 w1 = {cvt_pk_bf16(o1[0], o1[1]), cvt_pk_bf16(o1[2], o1[3]), cvt_pk_bf16(o1[4], o1[5]), cvt_pk_bf16(o1[6], o1[7])};
              u32x4 w2 = {cvt_pk_bf16(o2[0], o2[1]), cvt_pk_bf16(o2[2], o2[3]), cvt_pk_bf16(o2[4], o2[5]), cvt_pk_bf16(o2[6], o2[7])};
              *(u32x4*)kp = w1; *(u32x4*)(kp + 64) = w2;
              u32x4 z1 = {cvt_pk_bf16(o1[0] * zeta, o1[1] * zeta), cvt_pk_bf16(o1[2] * zeta, o1[3] * zeta), cvt_pk_bf16(o1[4] * zeta, o1[5] * zeta), cvt_pk_bf16(o1[6] * zeta, o1[7] * zeta)};
              u32x4 z2 = {cvt_pk_bf16(o2[0] * zeta, o2[1] * zeta), cvt_pk_bf16(o2[2] * zeta, o2[3] * zeta), cvt_pk_bf16(o2[4] * zeta, o2[5] * zeta), cvt_pk_bf16(o2[6] * zeta, o2[7] * zeta)};
              LAS char* img = Kimg + (m >> 6) * 16384;
              *(LAS u32x4*)(img + v_st<4>(m & 63, 8 * c)) = z1; *(LAS u32x4*)(img + v_st<4>(m & 63, 64 + 8 * c)) = z2; }
            { bf16_t* qp = row + EV_RQ + h * 128 + 8 * c; const bf16x8 x1 = *(const bf16x8*)qp, x2 = *(const bf16x8*)(qp + 64);
              float o1[8], o2[8];
#pragma unroll
              for (int j = 0; j < 8; ++j) { const float a = bf2f((unsigned short)x1[j]), bb = bf2f((unsigned short)x2[j]); o1[j] = (a * cs[j] - bb * sn[j]) * 0.08838834764831845f; o2[j] = (a * sn[j] + bb * cs[j]) * 0.08838834764831845f; }
              u32x4 w1 = {cvt_pk_bf16(o1[0], o1[1]), cvt_pk_bf16(o1[2], o1[3]), cvt_pk_bf16(o1[4], o1[5]), cvt_pk_bf16(o1[6], o1[7])};
              u32x4 w2 = {cvt_pk_bf16(o2[0], o2[1]), cvt_pk_bf16(o2[2], o2[3]), cvt_pk_bf16(o2[4], o2[5]), cvt_pk_bf16(o2[6], o2[7])};
              *(u32x4*)qp = w1; *(u32x4*)(qp + 64) = w2; }
        }
#pragma unroll
        for (int i = 0; i < 6; ++i) { const int id = tid + 512 * i, m = id / 24, c = id % 24;
            const bf16x8 v = *(const bf16x8*)(Z + ((size_t)b * SEQ + c0 + m) * EV_LD + EV_RV + h * 192 + 8 * c);
            *(LAS bf16x8*)(Vimg + (m >> 6) * 24576 + v_st<6>(m & 63, 8 * c)) = v; }
        __syncthreads();
        const int kbk = wave & 3, dvb0 = (wave >> 2) * 3;
        const int vbK = lds_addr(Kimg) + v_rd_base(lane) + kbk * 512, vbV = lds_addr(Vimg) + v_rd_base(lane) + dvb0 * 512;
        f32x16 acc[3] = {};
#pragma unroll
        for (int T = 0; T < 2; ++T)
#pragma unroll
            for (int ks = 0; ks < 4; ++ks) {
                const s16x4 bl = tr_read<0>(vbK + T * 16384 + ks * 4096), bh = tr_read<0>(vbK + T * 16384 + ks * 4096 + 2048);
                s16x4 al[3], ah[3];
#pragma unroll
                for (int i = 0; i < 3; ++i) { al[i] = tr_read<0>(vbV + T * 24576 + ks * 6144 + i * 512); ah[i] = tr_read<0>(vbV + T * 24576 + ks * 6144 + 3072 + i * 512); }
                asm volatile("s_waitcnt lgkmcnt(0)" ::: "memory"); SBAR();
                const bf16x8 bf = (bf16x8){bl[0], bl[1], bl[2], bl[3], bh[0], bh[1], bh[2], bh[3]};
#pragma unroll
                for (int i = 0; i < 3; ++i) { const bf16x8 af = (bf16x8){al[i][0], al[i][1], al[i][2], al[i][3], ah[i][0], ah[i][1], ah[i][2], ah[i][3]};
                    acc[i] = __builtin_amdgcn_mfma_f32_32x32x16_bf16(af, bf, acc[i], 0, 0, 0); }
            }
        float* dst = kvT + (size_t)u * RET_KV_ELEMS;
        const int r32 = lane & 31, hi = lane >> 5;
#pragma unroll
        for (int i = 0; i < 3; ++i)
#pragma unroll
            for (int r = 0; r < 16; ++r) dst[(size_t)(32 * (dvb0 + i) + crow(r, hi)) * 128 + 32 * kbk + r32] = acc[i][r];
        __syncthreads();
    }
}
__device__ __forceinline__ void ret_scan_phase(const Frame& F, float* kvT) {
    for (int idx = F.bid * 512 + F.tid; idx < 32 * (RET_KV_ELEMS / 4); idx += F.G * 512) {
        const int bh = idx / (RET_KV_ELEMS / 4), e = idx % (RET_KV_ELEMS / 4), h = bh & 3;
        const float gch = exp2f(128.0f * ret_log2_gamma(h));
        f32x4* p = (f32x4*)(kvT + (size_t)bh * 32 * RET_KV_ELEMS) + e;
        f32x4 R = {0.f, 0.f, 0.f, 0.f};
#pragma unroll 4
        for (int n = 0; n < 32; ++n) { const f32x4 t = p[(size_t)n * (RET_KV_ELEMS / 4)]; p[(size_t)n * (RET_KV_ELEMS / 4)] = R; R = R * gch + t; }
    }
}
__device__ __forceinline__ void ret_c_phase(const Frame& F, bf16_t* Z, const float* kvT, int unit_lo, int unit_step) {
    const int tid = F.tid, lane = F.lane, wave = F.wave, r32 = lane & 31, hi = lane >> 5;
    LAS char* Kl = (LAS char*)F.lds; LAS char* Vl = Kl + 32768; LAS float* st = (LAS float*)(Kl + 32768 + 49152);
    for (int u = unit_lo; u < BATCH * 4 * 32; u += unit_step) {
        const int b = u >> 7, h = (u >> 5) & 3, n = u & 31, c0 = n * 128;
        const float lgam = ret_log2_gamma(h);
        const bf16_t* zb = Z + ((size_t)b * SEQ + c0) * EV_LD;
        { KReg k0, k1; VReg<6> v0, v1;
          k_load(k0, zb + EV_RK + h * 128, EV_LD, tid); k_load(k1, zb + (size_t)64 * EV_LD + EV_RK + h * 128, EV_LD, tid);
          v_load<6>(v0, zb + EV_RV + h * 192, EV_LD, tid); v_load<6>(v1, zb + (size_t)64 * EV_LD + EV_RV + h * 192, EV_LD, tid);
          k_write(Kl, k0, tid); k_write(Kl + 16384, k1, tid); v_write<6>(Vl, v0, tid); v_write<6>(Vl + 24576, v1, tid); }
        const int q4 = wave & 3, dvb0 = (wave >> 2) * 3, ti = 32 * q4 + r32;
        bf16x8 qr[8]; q_load(qr, zb + (size_t)ti * EV_LD + EV_RQ + h * 128, hi);
        __syncthreads();
        f32x16 o[3] = {};
        const int ntile = (q4 >> 1) + 1;
        for (int j = 0; j < ntile; ++j) {
            f32x16 p0, p1; qkt(p0, p1, Kl + j * 16384, qr, r32, hi);
#pragma unroll
            for (int r = 0; r < 16; ++r) { const int d0 = ti - (64 * j + crow(r, hi)), d1 = d0 - 32;
                p0[r] = d0 >= 0 ? p0[r] * exp2f((float)d0 * lgam) : 0.f; p1[r] = d1 >= 0 ? p1[r] * exp2f((float)d1 * lgam) : 0.f; }
            bf16x8 pa0, pa1, pa2, pa3; pack_p(p0, p1, pa0, pa1, pa2, pa3);
            const int vb = lds_addr(Vl + j * 24576) + v_rd_base(lane) + dvb0 * 512;
            pv_one<6, 0>(o[0], vb, pa0, pa1, pa2, pa3); pv_one<6, 0>(o[1], vb + 512, pa0, pa1, pa2, pa3); pv_one<6, 0>(o[2], vb + 1024, pa0, pa1, pa2, pa3);
        }
        { const float xi = exp2f((float)(ti + 1) * lgam);
#pragma unroll
          for (int s = 0; s < 8; ++s) { u32x4 w = __builtin_bit_cast(u32x4, qr[s]);
              w.x = cvt_pk_bf16(__builtin_bit_cast(float, w.x << 16) * xi, __builtin_bit_cast(float, w.x & 0xffff0000u) * xi); w.y = cvt_pk_bf16(__builtin_bit_cast(float, w.y << 16) * xi, __builtin_bit_cast(float, w.y & 0xffff0000u) * xi);
              w.z = cvt_pk_bf16(__builtin_bit_cast(float, w.z << 16) * xi, __builtin_bit_cast(float, w.z & 0xffff0000u) * xi); w.w = cvt_pk_bf16(__builtin_bit_cast(float, w.w << 16) * xi, __builtin_bit_cast(float, w.w & 0xffff0000u) * xi);
              qr[s] = __builtin_bit_cast(bf16x8, w); }
          const float* rp = kvT + (size_t)u * RET_KV_ELEMS;
#pragma unroll
          for (int i = 0; i < 3; ++i)
#pragma unroll
              for (int s = 0; s < 8; ++s) { const float* a = rp + (size_t)(32 * (dvb0 + i) + r32) * 128 + 16 * s + 8 * hi; const f32x4 a0 = *(const f32x4*)a, a1 = *(const f32x4*)(a + 4);
                  u32x4 w = {cvt_pk_bf16(a0.x, a0.y), cvt_pk_bf16(a0.z, a0.w), cvt_pk_bf16(a1.x, a1.y), cvt_pk_bf16(a1.z, a1.w)};
                  o[i] = __builtin_amdgcn_mfma_f32_32x32x16_bf16(__builtin_bit_cast(bf16x8, w), qr[s], o[i], 0, 0, 0); } }
        float s1 = 0.f, s2 = 0.f;
#pragma unroll
        for (int i = 0; i < 3; ++i)
#pragma unroll
            for (int r = 0; r < 16; ++r) { s1 += o[i][r]; s2 += o[i][r] * o[i][r]; }
        s1 = xhalf_sum(s1); s2 = xhalf_sum(s2);
        if (hi == 0) { st[(wave * 32 + r32) * 2] = s1; st[(wave * 32 + r32) * 2 + 1] = s2; }
        __syncthreads();
        const float t1 = s1 + st[((wave ^ 4) * 32 + r32) * 2], t2 = s2 + st[((wave ^ 4) * 32 + r32) * 2 + 1];
        const float mu = t1 * (1.f / 192.f), var = fmaxf(t2 * (1.f / 192.f) - mu * mu, 0.f), rs = 1.0f / sqrtf(var + EPS);
#pragma unroll
        for (int i = 0; i < 3; ++i)
#pragma unroll
            for (int r = 0; r < 16; ++r) o[i][r] = (o[i][r] - mu) * rs;
        store_y<3>(Z + ((size_t)b * SEQ + c0 + ti) * EV_LD + EV_G + 768 + h * 192 + 32 * dvb0, o, 1.f, hi);
        __syncthreads();
    }
}

__device__ __forceinline__ void compress_phase(const Frame& F, const bf16_t* Z, const bf16_t* W1t, const bf16_t* W2t, const float* b1, const float* b1part, bf16_t* kcmp, bf16_t* vcmp, int unit_lo, int unit_step) {
    const int tid = F.tid, lane = F.lane, wave = F.wave, r32 = lane & 31, hi = lane >> 5;
    LAS char* Al = (LAS char*)F.lds; LAS char* Hs = Al + 32768;
    for (int u = unit_lo; u < 128; u += unit_step) {
        const int kv = u >> 6, rt = u & 63;
        const bf16_t* w1 = W1t + (size_t)kv * 256 * 4096; const bf16_t* w2 = W2t + (size_t)kv * 128 * 256;
        bf16_t* dstc = kv ? vcmp : kcmp; const int zc = kv ? OD_VC : OD_KC;
        if (rt == 0 && tid < 256) { const int bg = tid >> 4, c = tid & 15; *(u32x4*)(dstc + ((size_t)bg * 256 + 255) * 128 + c * 8) = (u32x4){0u, 0u, 0u, 0u}; }
        const int sr = tid >> 4, sc = (tid & 15) * 8;
        const bf16_t* rp[2];
#pragma unroll
        for (int i = 0; i < 2; ++i) { int r = rt * 64 + sr + 32 * i; if (r > 4079) r = 4079; const int g = r & 1, bj = r >> 1, b = bj / 255, j = bj % 255;
            rp[i] = Z + ((size_t)b * SEQ + 16 * j) * OD_LD + zc + g * 128 + sc; }
        KReg a; a.a = *(const bf16x8*)rp[0]; a.b = *(const bf16x8*)rp[1];
        k_write(Al, a, tid);
        const bf16_t* wrow = w1 + (size_t)(32 * wave + r32) * 4096 + 8 * hi;
        bf16x8 bcur[8], bnxt[8];
#pragma unroll
        for (int s = 0; s < 8; ++s) bcur[s] = *(const bf16x8*)(wrow + 16 * s);
        f32x16 acc[2] = {};
        __syncthreads();
#pragma unroll 1
        for (int l = 0; l < 32; ++l) {
            const int bo = (l & 1) * 16384;
            if (l + 1 < 32) { a.a = *(const bf16x8*)(rp[0] + (size_t)(l + 1) * OD_LD); a.b = *(const bf16x8*)(rp[1] + (size_t)(l + 1) * OD_LD);
#pragma unroll
                for (int s = 0; s < 8; ++s) bnxt[s] = *(const bf16x8*)(wrow + (l + 1) * 128 + 16 * s); }
#pragma unroll
            for (int s = 0; s < 8; ++s) { const int cb = (16 * s + 8 * hi) * 2;
                const bf16x8 a0 = *(const LAS bf16x8*)(Al + bo + KSWZ(r32, cb)), a1 = *(const LAS bf16x8*)(Al + bo + KSWZ(32 + r32, cb));
                acc[0] = __builtin_amdgcn_mfma_f32_32x32x16_bf16(a0, bcur[s], acc[0], 0, 0, 0);
                acc[1] = __builtin_amdgcn_mfma_f32_32x32x16_bf16(a1, bcur[s], acc[1], 0, 0, 0); }
            if (l + 1 < 32) { k_write(Al + (bo ^ 16384), a, tid);
#pragma unroll
                for (int s = 0; s < 8; ++s) bcur[s] = bnxt[s]; }
            __syncthreads();
        }
        { const int col = 32 * wave + r32; float bb = b1[kv * 256 + col];
          for (int j = 0; j < 32; ++j) bb += b1part[(kv * 32 + j) * 256 + col];
#pragma unroll
          for (int rb = 0; rb < 2; ++rb)
#pragma unroll
              for (int r = 0; r < 16; ++r) { const float v = acc[rb][r] + bb; const float sv = v * fast_sigmoid(v);
                  *(LAS unsigned short*)(Hs + (32 * rb + crow(r, hi)) * 528 + col * 2) = (unsigned short)f2bf(sv); } }
        __syncthreads();
        { const int rb = wave & 1, cbk = wave >> 1; f32x16 o2 = {};
#pragma unroll
          for (int s = 0; s < 16; ++s) { const bf16x8 af = *(const LAS bf16x8*)(Hs + (32 * rb + r32) * 528 + (16 * s + 8 * hi) * 2);
              const bf16x8 bf = *(const bf16x8*)(w2 + (size_t)(32 * cbk + r32) * 256 + 16 * s + 8 * hi);
              o2 = __builtin_amdgcn_mfma_f32_32x32x16_bf16(af, bf, o2, 0, 0, 0); }
#pragma unroll
          for (int r = 0; r < 16; ++r) { const int row = rt * 64 + 32 * rb + crow(r, hi);
              if (row < 4080) { const int g = row & 1, bj = row >> 1, b = bj / 255, j = bj % 255;
                  dstc[(((size_t)b * 2 + g) * 256 + j) * 128 + 32 * cbk + r32] = (bf16_t)f2bf(o2[r]); } } }
        __syncthreads();
    }
}

__device__ __forceinline__ void nsa_post(f32x16& p0, f32x16& p1, int t, int kbase, int kstride, int limit, bool sel, int kvalid, const LAS float* tbl, int hi, bool fast) {
    constexpr float C = 0.08838834764831845f * LOG2E;
    const float NEGINF = -__builtin_inff();
    if (fast) { const float b128 = tbl[128];
#pragma unroll
        for (int r = 0; r < 16; ++r) { p0[r] = sel ? p0[r] * C + b128 : NEGINF; p1[r] = sel ? p1[r] * C + b128 : NEGINF; }
        return; }
#pragma unroll
    for (int r = 0; r < 16; ++r) {
        { const int k = crow(r, hi); const int rel = t - (kbase + kstride * k); const bool ok = sel && rel >= 0 && rel < limit && k < kvalid; const int idx = rel < 0 ? 0 : (rel > 128 ? 128 : rel);
          p0[r] = ok ? p0[r] * C + tbl[idx] : NEGINF; }
        { const int k = 32 + crow(r, hi); const int rel = t - (kbase + kstride * k); const bool ok = sel && rel >= 0 && rel < limit && k < kvalid; const int idx = rel < 0 ? 0 : (rel > 128 ? 128 : rel);
          p1[r] = ok ? p1[r] * C + tbl[idx] : NEGINF; }
    }
}
constexpr int NSA_FIN_OFF = 32768, NSA_IMP_OFF = 32768, NSA_SEL_OFF = 131072, NSA_TB_OFF = NSA_SEL_OFF + 256;
static_assert(NSA_TB_OFF + 6 * 132 * 4 <= RSTD_OFF + RSTD_BYTES, "nsa lds");
struct LdRegs { bf16x8 k[8], v[8]; };
__device__ __forceinline__ void ld_load(LdRegs& r, const bf16_t* kp, size_t ldk, const bf16_t* vp, size_t ldv, int lt, bool with_v) {
    asm volatile("" : "+v"(lt));
#pragma unroll
    for (int i = 0; i < 8; ++i) { const int c = lt + 128 * i, row = c >> 4, cc = (c & 15) * 8; r.k[i] = *(const bf16x8*)(kp + (size_t)row * ldk + cc); }
    if (with_v) {
#pragma unroll
        for (int i = 0; i < 8; ++i) { const int c = lt + 128 * i, row = c >> 4, cc = (c & 15) * 8; r.v[i] = *(const bf16x8*)(vp + (size_t)row * ldv + cc); } }
}
__device__ __forceinline__ void ld_write(LAS char* Kl, LAS char* Vl, const LdRegs& r, int lt, bool with_v) {
    asm volatile("" : "+v"(lt));
#pragma unroll
    for (int i = 0; i < 8; ++i) { const int c = lt + 128 * i, row = c >> 4, cc = (c & 15); *(LAS bf16x8*)(Kl + KSWZ(row, cc * 16)) = r.k[i]; }
    if (with_v) {
#pragma unroll
        for (int i = 0; i < 8; ++i) { const int c = lt + 128 * i, row = c >> 4, cc = (c & 15); *(LAS bf16x8*)(Vl + v_st<4>(row, cc * 8)) = r.v[i]; } }
}
__device__ __forceinline__ void nsa_phase(const Frame& F, bf16_t* Z, const float* gates, const bf16_t* kcmp, const bf16_t* vcmp, const float* tbias) {
    const int tid = F.tid, lane = F.lane, wave = F.wave, r32 = lane & 31, hi = lane >> 5, lt = tid - 384;
    LAS char* Kl = (LAS char*)F.lds; LAS char* Vl = Kl + 16384;
    LAS float* imp = (LAS float*)(Kl + NSA_IMP_OFF); LAS unsigned long long* selm = (LAS unsigned long long*)(Kl + NSA_SEL_OFF); LAS float* tb = (LAS float*)(Kl + NSA_TB_OFF);
    const bool cw = wave < 6;
    LAS float* finw = (LAS float*)(Kl + NSA_FIN_OFF) + wave * 4096 + lane;
    const int vb = lds_addr(Vl) + v_rd_base(lane);
    for (int round = 0; round < 8; ++round) {
        const int rank = round * 256 + ((round & 1) ? (255 - F.bid) : F.bid);
        if (F.bid >= 256) break;
        const int qt = 127 - (rank >> 4), bg = rank & 15, b = bg >> 1, g = bg & 1, s0 = qt * 32, t = s0 + r32;
        const int head = cw ? wave : 0, hg = g * 6 + head;
        const bf16_t* zb = Z + (size_t)b * SEQ * OD_LD;
        const bf16_t* kc = kcmp + (size_t)bg * 256 * 128; const bf16_t* vc = vcmp + (size_t)bg * 256 * 128;
        const int jmax = (s0 >> 4) > 254 ? 254 : (s0 >> 4), ntc = (jmax >> 6) + 1, cur = s0 >> 6;
        for (int i = tid; i < 6 * 32 * 65; i += 512) imp[i] = 0.f;
        for (int i = tid; i < 6 * 132; i += 512) tb[i] = tbias[g * 6 * 132 + i];
        const LAS float* tbl = tb + head * 132;
        const float* gp = gates + ((size_t)b * SEQ + t) * GATE_LD + hg;
        bf16x8 qr[8]; f32x16 o[4] = {};
        if (cw) {
            q_load(qr, zb + (size_t)t * OD_LD + OD_Q + hg * 128, hi);
            float m = -1e30f, l = 0.f;
            for (int j = 0; j < ntc; ++j) {
                __syncthreads();
                { f32x16 p0, p1; qkt(p0, p1, Kl, qr, r32, hi);
                  nsa_post(p0, p1, t, 16 * 64 * j + 31, 16, 1 << 30, true, 255 - 64 * j, tbl, hi, false);
                  float pmax = p0[0];
#pragma unroll
                  for (int r = 1; r < 16; ++r) pmax = fmaxf(pmax, p0[r]);
#pragma unroll
                  for (int r = 0; r < 16; ++r) pmax = fmaxf(pmax, p1[r]);
                  pmax = xhalf_max(pmax); const float mn = fmaxf(m, pmax); float ps = 0.f;
#pragma unroll
                  for (int r = 0; r < 16; ++r) ps += __builtin_amdgcn_exp2f(p0[r] - mn) + __builtin_amdgcn_exp2f(p1[r] - mn);
                  ps = xhalf_sum(ps); l = l * __builtin_amdgcn_exp2f(m - mn) + ps; m = mn; }
                __syncthreads(); }
            const float inv_l = (l > 0.f && t >= 31) ? 1.0f / l : 0.f;
            for (int j = 0; j < ntc; ++j) {
                __syncthreads();
                { f32x16 p0, p1; qkt(p0, p1, Kl, qr, r32, hi);
                  nsa_post(p0, p1, t, 16 * 64 * j + 31, 16, 1 << 30, true, 255 - 64 * j, tbl, hi, false);
#pragma unroll
                  for (int r = 0; r < 16; ++r) { p0[r] = __builtin_amdgcn_exp2f(p0[r] - m) * inv_l; p1[r] = __builtin_amdgcn_exp2f(p1[r] - m) * inv_l; }
                  LAS float* ip = imp + (head * 32 + r32) * 65 + 16 * j + hi;
#pragma unroll
                  for (int gq = 0; gq < 4; ++gq) {
                      { const float own = 2.f * (p0[4 * gq] + p0[4 * gq + 1] + p0[4 * gq + 2]) + p0[4 * gq + 3]; const int J = 2 * gq;
                        __hip_atomic_fetch_add(ip + J, own, __ATOMIC_RELAXED, __HIP_MEMORY_SCOPE_WORKGROUP); __hip_atomic_fetch_add(ip + J + 1, p0[4 * gq + 3], __ATOMIC_RELAXED, __HIP_MEMORY_SCOPE_WORKGROUP); }
                      { const float own = 2.f * (p1[4 * gq] + p1[4 * gq + 1] + p1[4 * gq + 2]) + p1[4 * gq + 3]; const int J = 8 + 2 * gq;
                        __hip_atomic_fetch_add(ip + J, own, __ATOMIC_RELAXED, __HIP_MEMORY_SCOPE_WORKGROUP); __hip_atomic_fetch_add(ip + J + 1, p1[4 * gq + 3], __ATOMIC_RELAXED, __HIP_MEMORY_SCOPE_WORKGROUP); }
                  }
                  bf16x8 pa0, pa1, pa2, pa3; pack_p(p0, p1, pa0, pa1, pa2, pa3);
                  pv_all<4>(o, vb, pa0, pa1, pa2, pa3); }
                __syncthreads(); }
        } else {
            LdRegs lr;
            ld_load(lr, kc, 128, vc, 128, lt, false);
            for (int j = 0; j < ntc; ++j) { ld_write(Kl, Vl, lr, lt, false); __syncthreads();
                if (j + 1 < ntc) ld_load(lr, kc + (size_t)(j + 1) * 64 * 128, 128, vc, 128, lt, false);
                __syncthreads(); }
            ld_load(lr, kc, 128, vc, 128, lt, true);
            for (int j = 0; j < ntc; ++j) { ld_write(Kl, Vl, lr, lt, true); __syncthreads();
                if (j + 1 < ntc) ld_load(lr, kc + (size_t)(j + 1) * 64 * 128, 128, vc + (size_t)(j + 1) * 64 * 128, 128, lt, true);
                __syncthreads(); }
        }
        for (int i = 0; i < 4; ++i) { const int tt = wave * 4 + i, tq = s0 + tt;
            float v = 0.f;
#pragma unroll
            for (int h = 0; h < 6; ++h) v += imp[(h * 32 + tt) * 65 + lane];
            const bool forced = (lane == 0) || (lane == cur) || (lane == cur - 1), future = lane * 64 > tq;
            v = forced ? 1e30f : (future ? -1e30f : v);
            unsigned long long msk = 0ull;
            for (int k = 0; k < 8; ++k) { float bv = v; int bi = lane;
#pragma unroll
                for (int off = 1; off < 64; off <<= 1) { const float ov = __shfl_xor(bv, off); const int oi = __shfl_xor(bi, off); if (ov > bv || (ov == bv && oi < bi)) { bv = ov; bi = oi; } }
                msk |= 1ull << bi; if (lane == bi) v = -__builtin_inff(); }
            msk &= (2ull << cur) - 1ull;
            if (lane == 0) selm[tt] = msk; }
        __syncthreads();
        const unsigned long long mymask = selm[r32]; unsigned long long uni;
        { unsigned lo = (unsigned)mymask, hi32 = (unsigned)(mymask >> 32);
#pragma unroll
          for (int off = 1; off < 32; off <<= 1) { lo |= __shfl_xor(lo, off); hi32 |= __shfl_xor(hi32, off); }
          uni = ((unsigned long long)(unsigned)__builtin_amdgcn_readfirstlane(hi32) << 32) | (unsigned)__builtin_amdgcn_readfirstlane(lo); }
        const int jt0 = (s0 - 511) < 0 ? 0 : (s0 - 511) >> 6, ntw = cur - jt0 + 1;
        if (cw) {
            { const float g_cmp = gp[0];
#pragma unroll
              for (int d = 0; d < 4; ++d)
#pragma unroll
                  for (int r = 0; r < 16; ++r) finw[(d * 16 + r) * 64] = g_cmp * o[d][r]; }
            { float ms = -1e30f, ls = 0.f;
#pragma unroll
              for (int d = 0; d < 4; ++d) o[d] = f32x16{};
              unsigned long long rem = uni;
              while (rem != 0ull) { const int J = __builtin_ctzll(rem); rem &= rem - 1;
                  __syncthreads();
                  const bool sel = (mymask >> J) & 1ull;
                  if (__any(sel)) { f32x16 p0, p1; qkt(p0, p1, Kl, qr, r32, hi);
                      nsa_post(p0, p1, t, 64 * J, 1, 1 << 30, sel, 64, tbl, hi, s0 - (64 * J + 63) >= 128);
                      softmax_step<4>(p0, p1, ms, ls, o);
                      bf16x8 pa0, pa1, pa2, pa3; pack_p(p0, p1, pa0, pa1, pa2, pa3);
                      pv_all<4>(o, vb, pa0, pa1, pa2, pa3); }
                  __syncthreads(); }
              const float sc = gp[12] / ls;
#pragma unroll
              for (int d = 0; d < 4; ++d)
#pragma unroll
                  for (int r = 0; r < 16; ++r) finw[(d * 16 + r) * 64] += sc * o[d][r]; }
            { float mw = -1e30f, lw = 0.f;
#pragma unroll
              for (int d = 0; d < 4; ++d) o[d] = f32x16{};
              for (int j = 0; j < ntw; ++j) { const int kb0 = (jt0 + j) * 64;
                  __syncthreads();
                  { f32x16 p0, p1; qkt(p0, p1, Kl, qr, r32, hi);
                    nsa_post(p0, p1, t, kb0, 1, 512, true, 64, tbl, hi, (s0 - (kb0 + 63) >= 128) && (s0 + 31 - kb0 < 512));
                    softmax_step<4>(p0, p1, mw, lw, o);
                    bf16x8 pa0, pa1, pa2, pa3; pack_p(p0, p1, pa0, pa1, pa2, pa3);
                    pv_all<4>(o, vb, pa0, pa1, pa2, pa3); }
                  __syncthreads(); }
              const float sc = gp[24] / lw;
#pragma unroll
              for (int d = 0; d < 4; ++d)
#pragma unroll
                  for (int r = 0; r < 16; ++r) o[d][r] = finw[(d * 16 + r) * 64] + sc * o[d][r];
              store_y<4>(Z + ((size_t)b * SEQ + t) * OD_LD + OD_G + hg * 128, o, 1.f, hi); }
        } else {
            LdRegs lr;
            { unsigned long long rem = uni; int J = __builtin_ctzll(rem); rem &= rem - 1;
              ld_load(lr, zb + (size_t)J * 64 * OD_LD + OD_KS + g * 128, OD_LD, zb + (size_t)J * 64 * OD_LD + OD_VS + g * 128, OD_LD, lt, true);
              for (;;) { ld_write(Kl, Vl, lr, lt, true); __syncthreads();
                  const bool more = rem != 0ull;
                  if (more) { J = __builtin_ctzll(rem); rem &= rem - 1;
                      ld_load(lr, zb + (size_t)J * 64 * OD_LD + OD_KS + g * 128, OD_LD, zb + (size_t)J * 64 * OD_LD + OD_VS + g * 128, OD_LD, lt, true); }
                  __syncthreads();
                  if (!more) break; } }
            ld_load(lr, zb + (size_t)jt0 * 64 * OD_LD + OD_KW + g * 128, OD_LD, zb + (size_t)jt0 * 64 * OD_LD + OD_VW + g * 128, OD_LD, lt, true);
            for (int j = 0; j < ntw; ++j) { const int kb0 = (jt0 + j) * 64;
                ld_write(Kl, Vl, lr, lt, true); __syncthreads();
                if (j + 1 < ntw) ld_load(lr, zb + (size_t)(kb0 + 64) * OD_LD + OD_KW + g * 128, OD_LD, zb + (size_t)(kb0 + 64) * OD_LD + OD_VW + g * 128, OD_LD, lt, true);
                __syncthreads(); }
        }
        __syncthreads();
    }
}

template <int MAP>
__device__ __forceinline__ void transpose_item(const float* W, int K, int N, bf16_t* WT, const float* kscale, LAS float* scr, int item, int lane) {
    const int nblk = (N + 31) / 32, kb = item / nblk, nb = item % nblk, k0 = 64 * kb, n0 = 32 * nb;
    const int nl = n0 + (lane & 31);
#pragma unroll 8
    for (int i = 0; i < 32; ++i) { const int kk = 2 * i + (lane >> 5); float v = 0.f; if (nl < N) v = W[(size_t)(k0 + kk) * N + nl]; if (kscale) v *= kscale[k0 + kk]; scr[kk * 33 + (lane & 31)] = v; }
    LDS_WAIT(); asm volatile("" ::: "memory");
    const int c = lane & 7;
#pragma unroll
    for (int j = 0; j < 4; ++j) { const int n = (lane >> 3) + 8 * j; const LAS float* s = scr + (8 * c) * 33 + n;
        u32x4 o; o.x = pk2(s[0 * 33], s[1 * 33]); o.y = pk2(s[2 * 33], s[3 * 33]); o.z = pk2(s[4 * 33], s[5 * 33]); o.w = pk2(s[6 * 33], s[7 * 33]);
        const int ncol = n0 + n;
        if (ncol < N) {
            int drow = ncol;
            if (MAP == 1) { if (ncol >= 3620) drow = OD_G + (ncol - 3620); else if (ncol >= 3108) drow = OD_XQ + (ncol - 3108); else if (ncol >= 3072) drow = OD_LD + (ncol - 3072); }
            *(u32x4*)(WT + (size_t)drow * K + k0 + 8 * c) = o; } }
    LDS_WAIT(); asm volatile("" ::: "memory");
}
__device__ __forceinline__ int t5_bucket(int n) {
    if (n < 16) return n;
    int l = 16 + (int)(__logf((float)n * (1.f / 16.f)) / 2.0794415416798357f * 16.f);
    return l < 31 ? l : 31;
}
__device__ __forceinline__ void prologue(const Frame& F, const Args& a) {
    LAS float* scr = (LAS float*)(F.lds + F.wave * 16384);
    const int gw = F.bid * 8 + F.wave, NGW = F.G * 8, lane = F.lane;
    unsigned char* ws = F.ws;
    const float* norm_g = a.in[2];
    constexpr int I0 = 16 * 160, I1 = 16 * 178, IO = 32 * 32, IM = 16 * 32, IC1 = 64 * 8, IC2 = 4 * 4, IP = 3 * 6;
    constexpr int NITEMS = I0 + I1 + 2 * IO + 2 * IM + 2 * IC1 + 2 * IC2 + 4 * IP;
    for (int it = gw; it < NITEMS; it += NGW) {
        int r = it;
        if (r < I0) { transpose_item<0>(a.in[6], DM, EV_LD, (bf16_t*)(ws + WS_W0), norm_g, scr, r, lane); continue; } r -= I0;
        if (r < I1) { transpose_item<1>(a.in[11], DM, OD_COLS, (bf16_t*)(ws + WS_W1), norm_g + DM, scr, r, lane); continue; } r -= I1;
        if (r < IO) { transpose_item<0>(a.in[10], DIN, DM, (bf16_t*)(ws + WS_WO0), nullptr, scr, r, lane); continue; } r -= IO;
        if (r < IO) { transpose_item<0>(a.in[17], DIN, DM, (bf16_t*)(ws + WS_WO1), nullptr, scr, r, lane); continue; } r -= IO;
        if (r < IM) { transpose_item<0>(a.in[9], DM, DM, (bf16_t*)(ws + WS_WM0), nullptr, scr, r, lane); continue; } r -= IM;
        if (r < IM) { transpose_item<0>(a.in[16], DM, DM, (bf16_t*)(ws + WS_WM1), nullptr, scr, r, lane); continue; } r -= IM;
        if (r < 2 * IC1) { const int kv = r / IC1; transpose_item<0>(a.in[13] + (size_t)kv * 4096 * 256, 4096, 256, (bf16_t*)(ws + WS_WC1) + (size_t)kv * 256 * 4096, nullptr, scr, r % IC1, lane); continue; } r -= 2 * IC1;
        if (r < 2 * IC2) { const int kv = r / IC2; transpose_item<0>(a.in[15] + (size_t)kv * 256 * 128, 256, 128, (bf16_t*)(ws + WS_WC2) + (size_t)kv * 128 * 256, nullptr, scr, r % IC2, lane); continue; } r -= 2 * IC2;
        { const int gi = r / IP; transpose_item<0>(a.in[7] + (size_t)gi * 192 * 192, 192, 192, (bf16_t*)(ws + WS_WP) + (size_t)gi * 192 * 192, nullptr, scr, r % IP, lane); }
    }
    { u32x4* p = (u32x4*)((bf16_t*)(ws + WS_W1) + (size_t)OD_COLS * DM); const int n16 = (OD_N - OD_COLS) * DM * 2 / 16;
      for (int i = F.bid * 512 + F.tid; i < n16; i += F.G * 512) p[i] = (u32x4){0u, 0u, 0u, 0u}; }
    { const float* x = a.in[0]; bf16_t* xb = (bf16_t*)(ws + WS_R); float* part = (float*)(ws + WS_PART);
      for (int m = gw; m < MTOK; m += NGW) {
          const f32x4* xr = (const f32x4*)(x + (size_t)m * DM) + lane; f32x4 v[4]; float s = 0.f;
#pragma unroll
          for (int j = 0; j < 4; ++j) { v[j] = xr[64 * j]; s += (v[j].x * v[j].x + v[j].y * v[j].y) + (v[j].z * v[j].z + v[j].w * v[j].w); }
          s = wave_sum(s);
          u32x2* o8 = (u32x2*)(xb + (size_t)m * DM) + lane;
#pragma unroll
          for (int j = 0; j < 4; ++j) o8[64 * j] = (u32x2){pk2(v[j].x, v[j].y), pk2(v[j].z, v[j].w)};
          if (lane < 16) part[(size_t)m * 16 + lane] = (lane == 0) ? s : 0.f;
      } }
    { const float* mem = a.in[1]; const float* mg = a.in[4]; bf16_t* mn = (bf16_t*)(ws + WS_MEMN);
      for (int m = gw; m < BATCH * NMEM; m += NGW) {
          const f32x4* xr = (const f32x4*)(mem + (size_t)m * DM) + lane; const f32x4* gr = (const f32x4*)mg + lane; f32x4 v[4]; float s = 0.f;
#pragma unroll
          for (int j = 0; j < 4; ++j) { v[j] = xr[64 * j]; s += (v[j].x * v[j].x + v[j].y * v[j].y) + (v[j].z * v[j].z + v[j].w * v[j].w); }
          const float rs = 1.0f / sqrtf(wave_sum(s) * (1.f / DM) + EPS);
          u32x2* o8 = (u32x2*)(mn + (size_t)m * DM) + lane;
#pragma unroll
          for (int j = 0; j < 4; ++j) { const f32x4 g = gr[64 * j]; o8[64 * j] = (u32x2){pk2(v[j].x * rs * g.x, v[j].y * rs * g.y), pk2(v[j].z * rs * g.z, v[j].w * rs * g.w)}; }
      } }
    { float* ct = (float*)(ws + WS_ROPE); float* st = ct + SEQ * 64;
      for (int i = F.bid * 512 + F.tid; i < SEQ * 64; i += F.G * 512) {
          const int s = i >> 6, f = i & 63;
          const float inv = exp2f(-((float)f * (1.f / 64.f)) * 13.287712379549449f);
          const float ang = (float)s * inv;
          const double x = (double)ang; const double kq = rint(x * 0.6366197723675814);
          double r = fma(-kq, 1.5707963267948966, x); r = fma(-kq, 6.123233995736766e-17, r);
          const double r2 = r * r;
          const double sn = r * (1.0 + r2 * (-1.0 / 6 + r2 * (1.0 / 120 + r2 * (-1.0 / 5040 + r2 * (1.0 / 362880 - r2 * (1.0 / 39916800))))));
          const double cs = 1.0 + r2 * (-0.5 + r2 * (1.0 / 24 + r2 * (-1.0 / 720 + r2 * (1.0 / 40320 - r2 * (1.0 / 3628800)))));
          const int q = ((int)kq) & 3;
          double c_, s_;
          if (q == 0) { c_ = cs; s_ = sn; } else if (q == 1) { c_ = -sn; s_ = cs; } else if (q == 2) { c_ = -cs; s_ = -sn; } else { c_ = sn; s_ = -cs; }
          ct[i] = (float)c_; st[i] = (float)s_;
      } }
    if (F.bid == 0) { float* tb = (float*)(ws + WS_MISC); const float* rb = a.in[5];
        for (int i = F.tid; i < 12 * 132; i += 512) { const int h = i / 132, r = i % 132; const int bk = r >= 128 ? 31 : t5_bucket(r); tb[i] = rb[bk * 12 + h] * LOG2E; } }
    if (F.bid < 64 && F.tid < 256) { const int kv = F.bid >> 5, j = F.bid & 31, c = F.tid; const float* pe = a.in[12] + (size_t)kv * 4096; const float* w1 = a.in[13] + (size_t)kv * 4096 * 256;
        float s = 0.f;
        for (int k = 128 * j; k < 128 * j + 128; ++k) s += pe[k] * w1[(size_t)k * 256 + c];
        ((float*)(ws + WS_MISC + 65536))[(kv * 32 + j) * 256 + c] = s; }
}

__device__ __forceinline__ void final_norm(const Frame& F, float* out, const float* part, const float* fg) {
    const int gw = F.bid * 8 + F.wave, NGW = F.G * 8, lane = F.lane;
    for (int m = gw; m < MTOK; m += NGW) {
        float ps = (lane < 16) ? part[(size_t)m * 16 + lane] : 0.f;
        float tot = 0.f;
#pragma unroll
        for (int j = 0; j < 16; ++j) tot += __shfl(ps, j);
        const float rs = 1.0f / sqrtf(tot * (1.f / DM) + EPS);
        f32x4* xr = (f32x4*)(out + (size_t)m * DM) + lane; const f32x4* gr = (const f32x4*)fg + lane;
#pragma unroll
        for (int j = 0; j < 4; ++j) { f32x4 v = xr[64 * j]; const f32x4 g = gr[64 * j]; v.x = v.x * rs * g.x; v.y = v.y * rs * g.y; v.z = v.z * rs * g.z; v.w = v.w * rs * g.w; xr[64 * j] = v; }
    }
}
__device__ __forceinline__ void fill_rstd(const Frame& F, const pg8::StaticOrder& S, const float* part) {
    LAS float* rl = (LAS float*)(F.lds + RSTD_OFF); pg8::Unit u;
    for (int i = 0; i < 12 && S.next(i, u); ++i) {
        if (F.tid < 256) { const f32x4* p = (const f32x4*)(part + ((size_t)u.pm * 256 + F.tid) * 16);
            const f32x4 a = p[0], b = p[1], c = p[2], d = p[3];
            float tot = 0.f; tot += a.x; tot += a.y; tot += a.z; tot += a.w; tot += b.x; tot += b.y; tot += b.z; tot += b.w; tot += c.x; tot += c.y; tot += c.z; tot += c.w; tot += d.x; tot += d.y; tot += d.z; tot += d.w;
            rl[i * 256 + F.tid] = 1.0f / sqrtf(tot * (1.f / DM) + EPS); }
    }
    __syncthreads();
}

constexpr int NPHASE = 12;
__global__ void __launch_bounds__(512, 2) fwd_kernel(Args args) {
    extern __shared__ __attribute__((aligned(16))) unsigned char lds_raw[];
    cg::grid_group grid = cg::this_grid();
    Frame F; F.lds = (LAS unsigned char*)lds_raw; F.tid = threadIdx.x; F.lane = F.tid & 63; F.wave = __builtin_amdgcn_readfirstlane(F.tid >> 6);
    F.G = gridDim.x; F.bid = blockIdx.x; F.ws = args.ws;
    unsigned char* ws = args.ws;
    const int lo = args.ph_lo, hi = args.ph_hi;
#define IN(k) (lo <= (k) && (k) < hi)
#define SEAM(k) do { if (IN(k) && IN((k) + 1)) grid.sync(); } while (0)
    float* part = (float*)(ws + WS_PART);
    bf16_t* Z = (bf16_t*)(ws + WS_Z);
    bf16_t* HB = (bf16_t*)(ws + WS_R);

    if (IN(0)) { prologue(F, args); }
    SEAM(0);
    if (IN(1)) {
        { pg8::StaticOrder S; S.init(MTOK, EV_LD, F.G, F.bid); fill_rstd(F, S, part);
          pg8::Gemm g{HB, (const bf16_t*)(ws + WS_W0), MTOK, EV_LD, DM, DM};
          EpiIn E{Z, EV_LD, (const LAS float*)(F.lds + RSTD_OFF), EV_G / 256, -1, nullptr, 0, 0};
          pg8::gemm_phase(F.lds, g, S, E); }
        { pg8::StaticOrder S; S.init(BATCH * NMEM, DM, F.G, F.bid);
          pg8::Gemm g{(const bf16_t*)(ws + WS_MEMN), (const bf16_t*)(ws + WS_WM0), BATCH * NMEM, DM, DM, DM};
          EpiBf E{(bf16_t*)(ws + WS_MKV0), DM};
          pg8::gemm_phase(F.lds, g, S, E); }
        { pg8::StaticOrder S; S.init(BATCH * NMEM, DM, F.G, (F.bid + 128) % F.G);
          pg8::Gemm g{(const bf16_t*)(ws + WS_MEMN), (const bf16_t*)(ws + WS_WM1), BATCH * NMEM, DM, DM, DM};
          EpiBf E{(bf16_t*)(ws + WS_MKV1), DM};
          pg8::gemm_phase(F.lds, g, S, E); }
    }
    SEAM(1);
    if (IN(2)) {
        ret_a_phase(F, Z, (const float*)(ws + WS_ROPE), (const float*)(ws + WS_ROPE) + SEQ * 64, (float*)(ws + WS_R), F.bid, F.G);
        pool_phase(F, Z, (const bf16_t*)(ws + WS_WP), args.in[8], F.bid, F.G);
        mem_attn_phase(F, Z, EV_LD, EV_XQ, EV_G + 1536, (const bf16_t*)(ws + WS_MKV0), F.bid, F.G);
    }
    SEAM(2);
    if (IN(3)) ret_scan_phase(F, (float*)(ws + WS_R));
    SEAM(3);
    if (IN(4)) ret_c_phase(F, Z, (const float*)(ws + WS_R), F.bid, F.G);
    SEAM(4);
    if (IN(5)) {
        pg8::StaticOrder S; S.init(MTOK, DM, F.G, F.bid);
        pg8::Gemm g{Z + EV_G, (const bf16_t*)(ws + WS_WO0), MTOK, DM, DIN, EV_LD};
        EpiOut E{args.in[0], args.out, HB, part};
        pg8::gemm_phase(F.lds, g, S, E);
    }
    SEAM(5);
    if (IN(6)) {
        pg8::StaticOrder S; S.init(MTOK, OD_N, F.G, F.bid); fill_rstd(F, S, part);
        pg8::Gemm g{HB, (const bf16_t*)(ws + WS_W1), MTOK, OD_N, DM, DM};
        EpiIn E{Z, OD_LD, (const LAS float*)(F.lds + RSTD_OFF), OD_G / 256, OD_LD / 256, (float*)(ws + WS_GATES), 0, 0};
        pg8::gemm_phase(F.lds, g, S, E);
    }
    SEAM(6);
    if (IN(7)) {
        if (F.bid < 128) compress_phase(F, Z, (const bf16_t*)(ws + WS_WC1), (const bf16_t*)(ws + WS_WC2), args.in[14], (const float*)(ws + WS_MISC + 65536), (bf16_t*)(ws + WS_KCMP), (bf16_t*)(ws + WS_VCMP), F.bid, 128);
        else mem_attn_phase(F, Z, OD_LD, OD_XQ, OD_G + 1536, (const bf16_t*)(ws + WS_MKV1), F.bid - 128, F.G - 128);
    }
    SEAM(7);
    if (IN(8)) nsa_phase(F, Z, (const float*)(ws + WS_GATES), (const bf16_t*)(ws + WS_KCMP), (const bf16_t*)(ws + WS_VCMP), (const float*)(ws + WS_MISC));
    SEAM(8); SEAM(9);
    if (IN(10)) {
        pg8::StaticOrder S; S.init(MTOK, DM, F.G, F.bid);
        pg8::Gemm g{Z + OD_G, (const bf16_t*)(ws + WS_WO1), MTOK, DM, DIN, OD_LD};
        EpiOut E{args.out, args.out, HB, part};
        pg8::gemm_phase(F.lds, g, S, E);
    }
    SEAM(10);
    if (IN(11)) final_norm(F, args.out, part, args.in[3]);
#undef IN
#undef SEAM
}

extern "C" void kernel_launch(void* const* d_in, const int* in_sizes, int n_in, void* d_out, int out_size, void* d_ws, size_t ws_size, hipStream_t stream) {
    static int grid = 0;
    if (grid == 0) {
        if (n_in != 18 || out_size != MTOK * DM || ws_size < WS_END) { fprintf(stderr, "kernel_launch: unexpected shapes: n_in %d out %d ws %zu (need %zu)\n", n_in, out_size, ws_size, (size_t)WS_END); grid = -1; return; }
        int dev = 0, cus = 0, per_cu = 0;
        hipGetDevice(&dev); hipDeviceGetAttribute(&cus, hipDeviceAttributeMultiprocessorCount, dev);
        if (hipFuncSetAttribute((const void*)fwd_kernel, hipFuncAttributeMaxDynamicSharedMemorySize, LDS_BYTES) != hipSuccess) { fprintf(stderr, "kernel_launch: hipFuncSetAttribute failed\n"); grid = -1; return; }
        if (hipOccupancyMaxActiveBlocksPerMultiprocessor(&per_cu, (const void*)fwd_kernel, 512, LDS_BYTES) != hipSuccess || per_cu < 1) { fprintf(stderr, "kernel_launch: occupancy query says %d\n", per_cu); per_cu = 1; }
        (void)hipGetLastError();
        grid = cus;
    }
    if (grid < 0) return;
    Args a{};
    for (int i = 0; i < 18; ++i) a.in[i] = (const float*)d_in[i];
    a.out = (float*)d_out; a.ws = (unsigned char*)d_ws; a.ph_lo = 0; a.ph_hi = NPHASE;
    void* kargs[] = {&a};
    hipError_t e = hipLaunchCooperativeKernel((const void*)fwd_kernel, dim3(grid), dim3(512), kargs, LDS_BYTES, stream);
    if (e != hipSuccess) fprintf(stderr, "kernel_launch: cooperative launch failed: %s (grid %d)\n", hipGetErrorString(e), grid);
}
```

```cpp
#include <hip/hip_runtime.h>
#include <hip/hip_cooperative_groups.h>
#include <cstdio>
#include <cstdint>
namespace cg = cooperative_groups;

#define LAS __attribute__((address_space(3)))
#define GAS __attribute__((address_space(1)))
typedef unsigned short bf16_t;
typedef short bf16x8 __attribute__((ext_vector_type(8)));
typedef short s16x4 __attribute__((ext_vector_type(4)));
typedef float f32x4 __attribute__((ext_vector_type(4)));
typedef float f32x16 __attribute__((ext_vector_type(16)));
typedef unsigned u32x4 __attribute__((ext_vector_type(4)));
typedef unsigned u32x2 __attribute__((ext_vector_type(2)));

constexpr int BATCH = 8, SEQ = 4096, DM = 1024, MTOK = BATCH * SEQ, NMEM = 256, DIN = 2048;
constexpr float EPS = 1e-6f;
constexpr float LOG2E = 1.4426950408889634f;
constexpr int EV_LD = 5120, EV_ZA = 0, EV_RQ = 768, EV_RK = 1280, EV_RV = 1792, EV_XQ = 2560, EV_G = 3072;
constexpr int OD_LD = 5632, OD_N = 5888, OD_COLS = 5668, OD_Q = 0, OD_KC = 1536, OD_VC = 1792, OD_KS = 2048, OD_VS = 2304, OD_KW = 2560, OD_VW = 2816, OD_XQ = 3072, OD_G = 3584;
constexpr int GATE_LD = 40;
constexpr size_t MiB = 1u << 20;
constexpr size_t WS_CTL = 0, CTL_BYTES = 1 * MiB;
constexpr size_t WS_W0 = 1 * MiB;
constexpr size_t WS_W1 = WS_W0 + (size_t)EV_LD * DM * 2;
constexpr size_t WS_WO0 = WS_W1 + (size_t)OD_N * DM * 2;
constexpr size_t WS_WO1 = WS_WO0 + (size_t)DM * DIN * 2;
constexpr size_t WS_WM0 = WS_WO1 + (size_t)DM * DIN * 2;
constexpr size_t WS_WM1 = WS_WM0 + (size_t)DM * DM * 2;
constexpr size_t WS_WC1 = WS_WM1 + (size_t)DM * DM * 2;
constexpr size_t WS_WC2 = WS_WC1 + (size_t)2 * 256 * 4096 * 2;
constexpr size_t WS_WP = WS_WC2 + (size_t)2 * 128 * 256 * 2;
constexpr size_t WS_WEND = WS_WP + (size_t)4 * 192 * 192 * 2;
static_assert(WS_WEND <= 41 * MiB, "weights");
constexpr size_t WS_MEMN = 41 * MiB, WS_MKV0 = 45 * MiB, WS_MKV1 = 49 * MiB;
constexpr size_t WS_ROPE = 53 * MiB;
constexpr size_t WS_PART = 55 * MiB;
constexpr size_t WS_MISC = 57 * MiB;
constexpr size_t WS_Z = 58 * MiB;
constexpr size_t WS_R = 410 * MiB;
constexpr size_t WS_GATES = WS_R + 64 * MiB;
constexpr size_t WS_KCMP = WS_R + 70 * MiB, WS_VCMP = WS_R + 71 * MiB;
constexpr size_t WS_END = 506 * MiB;

constexpr int RING_BYTES = 131072, RSTD_OFF = RING_BYTES, RSTD_BYTES = 12 * 1024, MISC_OFF = RSTD_OFF + RSTD_BYTES, LDS_BYTES = 147456;

__device__ __forceinline__ unsigned f2bf(float f) { unsigned u = __builtin_bit_cast(unsigned, f); return (u + 0x7fffu + ((u >> 16) & 1u)) >> 16; }
__device__ __forceinline__ unsigned pk2(float lo, float hi) { return f2bf(lo) | (f2bf(hi) << 16); }
__device__ __forceinline__ float bf2f(unsigned short b) { return __builtin_bit_cast(float, (unsigned)b << 16); }
__device__ __forceinline__ unsigned cvt_pk_bf16(float lo, float hi) { unsigned r; asm volatile("v_cvt_pk_bf16_f32 %0, %1, %2" : "=v"(r) : "v"(lo), "v"(hi)); return r; }
__device__ __forceinline__ float wave_sum(float v) {
#pragma unroll
    for (int o = 1; o < 64; o <<= 1) v += __shfl_xor(v, o);
    return v;
}
__device__ __forceinline__ float fast_sigmoid(float v) { return __builtin_amdgcn_rcpf(1.f + __builtin_amdgcn_exp2f(-v * LOG2E)); }
#define LDS_WAIT() asm volatile("s_waitcnt lgkmcnt(0)" ::: "memory")
#define VM_WAIT() asm volatile("s_waitcnt vmcnt(0)" ::: "memory")

#define XB_TMO      128
#define XB_XCNT(j)  (256  + 64 * (j))
#define XB_XSUB(j)  (1280 + 64 * (j))
#define XB_XGEN(j)  (2304 + 64 * (j))
#define XB_TOP      3328
#define XB_TOPGEN   3392
#define XCD_BAR_WORDS 3456
#define XB_SPIN_CAP (1u << 18)
__device__ __forceinline__ unsigned xb_ld(unsigned* p)              { return __hip_atomic_load(p, __ATOMIC_RELAXED, __HIP_MEMORY_SCOPE_AGENT); }
__device__ __forceinline__ unsigned xb_add(unsigned* p, unsigned v) { return __hip_atomic_fetch_add(p, v, __ATOMIC_RELAXED, __HIP_MEMORY_SCOPE_AGENT); }
__device__ __forceinline__ unsigned xb_xcc_id() { return (unsigned)__builtin_amdgcn_s_getreg((3 << 11) | 20) & 0xFu; }
#define XB_SPIN(cond, bar) do { unsigned _sp = 0; while (cond) { __builtin_amdgcn_s_sleep(1); \
    if ((++_sp & 255u) == 0u) { if (xb_ld(&(bar)[XB_TMO])) break; if (_sp > XB_SPIN_CAP) { atomicAdd(&(bar)[XB_TMO], 1u); break; } } } } while (0)
struct XcdBarrier { unsigned* bar; unsigned x; volatile LAS unsigned* st; };
__device__ __forceinline__ XcdBarrier xcd_barrier_post(unsigned* bar, volatile LAS unsigned* st) {
    XcdBarrier b; b.bar = bar; b.x = xb_xcc_id(); b.st = st;
    if (threadIdx.x == 0) (void)xb_add(&bar[XB_XCNT(b.x)], 1u);
    return b;
}
__device__ __forceinline__ void xcd_barrier_complete(unsigned* bar, unsigned x, unsigned& nloc, unsigned& nx) {
    const unsigned G = gridDim.x * gridDim.y * gridDim.z;
    unsigned sum, cnt, mine, sp = 0u;
    for (;;) {
        sum = 0u; cnt = 0u; mine = 0u;
#pragma unroll
        for (unsigned j = 0; j < 16; ++j) { const unsigned c = xb_ld(&bar[XB_XCNT(j)]); sum += c; cnt += (c > 0u) ? 1u : 0u; mine = (j == x) ? c : mine; }
        if (sum == G) break;
        __builtin_amdgcn_s_sleep(1);
        if ((++sp & 255u) == 0u) { if (xb_ld(&bar[XB_TMO])) break; if (sp > XB_SPIN_CAP) { atomicAdd(&bar[XB_TMO], 1u); break; } }
    }
    nloc = mine > 0u ? mine : 1u; nx = cnt > 0u ? cnt : 1u;
}
__device__ __forceinline__ void xcd_barrier(const XcdBarrier& b) {
    asm volatile("s_waitcnt vmcnt(0)" ::: "memory");
    __syncthreads();
    if (threadIdx.x == 0) {
        unsigned* bar = b.bar;
        __builtin_amdgcn_s_waitcnt(0);
        unsigned nloc = b.st[0], nx = b.st[1];
        if (nloc == 0u) { xcd_barrier_complete(bar, b.x, nloc, nx); b.st[0] = nloc; b.st[1] = nx; }
        const unsigned old = xb_add(&bar[XB_XSUB(b.x)], 1u);
        const unsigned gen = old / nloc;
        if (old + 1u == (gen + 1u) * nloc) {
            __builtin_amdgcn_fence(__ATOMIC_RELEASE, "agent");
            asm volatile("s_waitcnt vmcnt(0)" ::: "memory");
            const unsigned og = xb_add(&bar[XB_TOP], 1u);
            const unsigned tg = og / nx;
            if (og + 1u == (tg + 1u) * nx) xb_add(&bar[XB_TOPGEN], 1u);
            else XB_SPIN(xb_ld(&bar[XB_TOPGEN]) == tg, bar);
            __builtin_amdgcn_fence(__ATOMIC_ACQUIRE, "agent");
            xb_add(&bar[XB_XGEN(b.x)], 1u);
            asm volatile("s_waitcnt vmcnt(0)" ::: "memory");
        } else {
            XB_SPIN(xb_ld(&bar[XB_XGEN(b.x)]) == gen, bar);
            __builtin_amdgcn_fence(__ATOMIC_ACQUIRE, "agent");
            asm volatile("s_waitcnt vmcnt(0)" ::: "memory");
        }
    }
    __syncthreads();
}

namespace pg8 {
constexpr int BM = 256, BK = 64, HALF = 128, HTB = HALF * BK * 2, STAGE_BYTES = 8 * HTB, NXCD = 8, WGM = 8;
__host__ __device__ __forceinline__ int lds_byte(int r, int c) { const int st = (r >> 4) * 2 + (c >> 5), rr = r & 15, cc = c & 31, ob = rr * 64 + cc * 2; return st * 1024 + (ob ^ (((ob >> 9) & 1) << 5)); }
__host__ __device__ __forceinline__ void stage_rc(int b, int& R, int& C) { const int st = b / 1024, sb = b % 1024, swz = sb ^ (((sb >> 9) & 1) << 5); R = (st >> 1) * 16 + swz / 64; C = (st & 1) * 32 + (swz % 64) / 2; }
__host__ __device__ __forceinline__ int perm32(int rho) { const int n = rho >> 4, i = rho & 15; return 8 * (i >> 2) + 4 * n + (i & 3); }
struct Unit { int pm, pn, idx; };
struct Gemm { const bf16_t* A; const bf16_t* Bt; int M, N, K, lda; };
struct StaticOrder {
    int nM, nN, nwg, G, c;
    __device__ void init(int M, int N, int G_, int c_) { nM = M / BM; nN = N / BM; nwg = nM * nN; G = G_; c = c_; }
    __device__ bool next(int i, Unit& u) const {
        const long L = (long)i * G + c; if (L >= nwg) return false;
        int wgid = (int)L; { const int q = nwg / NXCD, r = nwg % NXCD, xcd = wgid % NXCD, off = wgid / NXCD; wgid = (xcd < r ? xcd * (q + 1) : r * (q + 1) + (xcd - r) * q) + off; }
        const int nig = WGM * nN, gid = wgid / nig, fm = gid * WGM, gsz = (nM - fm) < WGM ? (nM - fm) : WGM;
        u.pm = fm + ((wgid % nig) % gsz); u.pn = (wgid % nig) / gsz; u.idx = i; return true;
    }
};
template <class Epi>
__device__ __forceinline__ void gemm_phase(LAS unsigned char* lds, const Gemm g, const StaticOrder& S, const Epi& E) {
    const int tid = threadIdx.x, wid = __builtin_amdgcn_readfirstlane(tid >> 6), lane = tid & 63, wr = wid >> 2, wc = wid & 3, fr = lane & 15, fq = lane >> 4;
    const int K = g.K, nt = K / BK, lda = g.lda;
    unsigned voffA[2], voffB[2];
#pragma unroll
    for (int i = 0; i < 2; ++i) { int R, C; stage_rc(tid * 16 + i * 8192, R, C); const int Rb = (R & ~31) + perm32(R & 31);
        voffA[i] = (unsigned)(R * lda + C) * 2u; voffB[i] = (unsigned)(Rb * K + C) * 2u; }
    const size_t kstep = (size_t)(BK * 2);
    const size_t hstepA = (size_t)HALF * lda * 2, hstepB = (size_t)HALF * K * 2;
    const size_t tstepA = 2 * hstepA, tstepB = 2 * hstepB;
    const unsigned ldsw = (unsigned)wid * 1024u;
    const int aoff = lds_byte(wr * 64 + fr, fq * 8), boff = lds_byte(wc * 32 + fr, fq * 8);
#define PG8_SA(b, h) (((b) * 2 + (h)) * HTB)
#define PG8_SB(b, h) ((4 + (b) * 2 + (h)) * HTB)
#define PG8_STAGE(bufoff, gbase, voff) do { _Pragma("unroll") for (int _i = 0; _i < 2; ++_i) \
        __builtin_amdgcn_global_load_lds((const unsigned*)((const char*)(gbase) + (voff)[_i]), (LAS unsigned*)(lds + (bufoff) + ldsw + _i * 8192), 16, 0, 0); } while (0)
#define PG8_LDA(dst, b, h) do { _Pragma("unroll") for (int m = 0; m < 4; ++m) _Pragma("unroll") for (int k = 0; k < 2; ++k) dst[m][k] = *(const LAS bf16x8*)(lds + PG8_SA(b, h) + aoff + m * 2048 + k * 1024); } while (0)
#define PG8_LDB(dst, b, h) do { _Pragma("unroll") for (int n = 0; n < 2; ++n) _Pragma("unroll") for (int k = 0; k < 2; ++k) dst[n][k] = *(const LAS bf16x8*)(lds + PG8_SB(b, h) + boff + n * 2048 + k * 1024); } while (0)
#define PG8_MMA(ai, bj, At, Bt) do { __builtin_amdgcn_s_setprio(1); _Pragma("unroll") for (int m = 0; m < 4; ++m) _Pragma("unroll") for (int n = 0; n < 2; ++n) _Pragma("unroll") for (int k = 0; k < 2; ++k) \
        acc[ai][bj][m][n] = __builtin_amdgcn_mfma_f32_16x16x32_bf16(Bt[n][k], At[m][k], acc[ai][bj][m][n], 0, 0, 0); __builtin_amdgcn_s_setprio(0); } while (0)
#define PG8_WAIT_V(n) asm volatile("s_waitcnt vmcnt(" #n ")" ::: "memory")
#define PG8_WAIT_L(n) asm volatile("s_waitcnt lgkmcnt(" #n ")" ::: "memory")
#define PG8_BAR __builtin_amdgcn_s_barrier()
#define PG8_SCHED __builtin_amdgcn_sched_barrier(0)
    Unit cur, nxt; int ui = 0;
    if (!S.next(0, cur)) return;
    f32x4 acc[2][2][4][2];
#pragma unroll
    for (int a = 0; a < 2; ++a)
#pragma unroll
        for (int b = 0; b < 2; ++b)
#pragma unroll
            for (int m = 0; m < 4; ++m)
#pragma unroll
                for (int n = 0; n < 2; ++n) acc[a][b][m][n] = (f32x4){0.f, 0.f, 0.f, 0.f};
    bf16x8 At[4][2], B0[2][2], B1[2][2];
    const char* cA = (const char*)g.A + (size_t)cur.pm * tstepA; const char* cB = (const char*)g.Bt + (size_t)cur.pn * tstepB;
    PG8_STAGE(PG8_SB(0, 0), cB, voffB); PG8_STAGE(PG8_SB(0, 1), cB + hstepB, voffB); PG8_STAGE(PG8_SA(0, 0), cA, voffA); PG8_STAGE(PG8_SA(0, 1), cA + hstepA, voffA);
    if (wr == 1) PG8_BAR;
    PG8_WAIT_V(2); PG8_BAR;
    PG8_STAGE(PG8_SB(1, 0), cB + kstep, voffB); PG8_STAGE(PG8_SA(1, 0), cA + kstep, voffA); PG8_STAGE(PG8_SB(1, 1), cB + hstepB + kstep, voffB);
    PG8_WAIT_V(6); PG8_BAR;
    for (;;) {
        const bool has_next = S.next(ui + 1, nxt);
        const char* nA = has_next ? (const char*)g.A + (size_t)nxt.pm * tstepA : cA; const char* nB = has_next ? (const char*)g.Bt + (size_t)nxt.pn * tstepB : cB;
        for (int t = 0; t < nt; t += 2) {
            const bool last = (t == nt - 2);
            const char* a1 = cA + (size_t)(t + 1) * kstep;
            const char* a2 = last ? nA : cA + (size_t)(t + 2) * kstep; const char* b2 = last ? nB : cB + (size_t)(t + 2) * kstep;
            const char* a3 = a2 + kstep; const char* b3 = b2 + kstep;
            PG8_LDB(B0, 0, 0); PG8_LDB(B1, 0, 1); PG8_SCHED; PG8_LDA(At, 0, 0); PG8_STAGE(PG8_SA(1, 1), a1 + hstepA, voffA);
            PG8_WAIT_V(8); PG8_WAIT_L(0); PG8_BAR; PG8_MMA(0, 0, At, B0); PG8_MMA(0, 1, At, B1); PG8_BAR; PG8_SCHED;
            PG8_LDA(At, 0, 1); PG8_STAGE(PG8_SB(0, 0), b2, voffB); PG8_STAGE(PG8_SB(0, 1), b2 + hstepB, voffB); PG8_STAGE(PG8_SA(0, 0), a2, voffA);
            PG8_WAIT_V(8); PG8_WAIT_L(0); PG8_BAR; PG8_MMA(1, 0, At, B0); PG8_MMA(1, 1, At, B1); PG8_BAR; PG8_SCHED;
            PG8_LDB(B0, 1, 0); PG8_LDB(B1, 1, 1); PG8_SCHED; PG8_LDA(At, 1, 0); PG8_STAGE(PG8_SA(0, 1), a2 + hstepA, voffA);
            PG8_WAIT_V(8); PG8_WAIT_L(0); PG8_BAR; PG8_MMA(0, 0, At, B0); PG8_MMA(0, 1, At, B1); PG8_BAR; PG8_SCHED;
            PG8_LDA(At, 1, 1); PG8_STAGE(PG8_SB(1, 0), b3, voffB); PG8_STAGE(PG8_SB(1, 1), b3 + hstepB, voffB); PG8_STAGE(PG8_SA(1, 0), a3, voffA);
            PG8_WAIT_V(8); PG8_WAIT_L(0); PG8_BAR; PG8_MMA(1, 0, At, B0); PG8_MMA(1, 1, At, B1); PG8_BAR; PG8_SCHED;
        }
        if (wr == 0) PG8_BAR;
        E(acc, cur, wr, wc, fr, fq);
        if (!has_next) break;
#pragma unroll
        for (int a = 0; a < 2; ++a)
#pragma unroll
            for (int b = 0; b < 2; ++b)
#pragma unroll
                for (int m = 0; m < 4; ++m)
#pragma unroll
                    for (int n = 0; n < 2; ++n) acc[a][b][m][n] = (f32x4){0.f, 0.f, 0.f, 0.f};
        cur = nxt; cA = nA; cB = nB; ++ui;
        if (wr == 1) PG8_BAR;
    }
    PG8_WAIT_V(0);
    PG8_BAR;
#undef PG8_SA
#undef PG8_SB
#undef PG8_STAGE
#undef PG8_LDA
#undef PG8_LDB
#undef PG8_MMA
#undef PG8_WAIT_V
#undef PG8_WAIT_L
#undef PG8_BAR
#undef PG8_SCHED
}
}

struct EpiIn {
    bf16_t* Z; int ldz; const LAS float* rstd; int pn_silu, pn_gate; float* gates; int zlo, zhi;
    __device__ __forceinline__ void operator()(const f32x4 (&acc)[2][2][4][2], const pg8::Unit& u, int wr, int wc, int fr, int fq) const {
        const int rl0 = wr * 64 + fr, col0 = u.pn * 256 + wc * 32 + 8 * fq;
        const bool is_gate = (u.pn == pn_gate), is_silu = (u.pn >= pn_silu) && !is_gate;
#pragma unroll
        for (int ai = 0; ai < 2; ++ai)
#pragma unroll
            for (int m = 0; m < 4; ++m) {
                const int rl = rl0 + ai * 128 + m * 16; const float rs = rstd[u.idx * 256 + rl]; const size_t row = (size_t)u.pm * 256 + rl;
#pragma unroll
                for (int bj = 0; bj < 2; ++bj) {
                    f32x4 v0 = acc[ai][bj][m][0] * rs, v1 = acc[ai][bj][m][1] * rs;
                    if (is_gate) {
                        const int c = wc * 32 + 8 * fq + bj * 128;
                        if (c < 36) { float* gp = gates + row * GATE_LD + c;
#pragma unroll
                            for (int j = 0; j < 4; ++j) { gp[j] = fast_sigmoid(v0[j]); if (c + 4 + j < 36) gp[4 + j] = fast_sigmoid(v1[j]); } }
                    } else {
                        if (is_silu) {
#pragma unroll
                            for (int j = 0; j < 4; ++j) { v0[j] = v0[j] * fast_sigmoid(v0[j]); v1[j] = v1[j] * fast_sigmoid(v1[j]); }
                            if (u.pn >= zlo && u.pn < zhi) { v0 = (f32x4){0.f, 0.f, 0.f, 0.f}; v1 = v0; }
                        }
                        u32x4 w; w.x = cvt_pk_bf16(v0[0], v0[1]); w.y = cvt_pk_bf16(v0[2], v0[3]); w.z = cvt_pk_bf16(v1[0], v1[1]); w.w = cvt_pk_bf16(v1[2], v1[3]);
                        *(u32x4*)(Z + row * ldz + col0 + bj * 128) = w;
                    }
                }
            }
    }
};
struct EpiBf {
    bf16_t* O; int ldc;
    __device__ __forceinline__ void operator()(const f32x4 (&acc)[2][2][4][2], const pg8::Unit& u, int wr, int wc, int fr, int fq) const {
        const int row0 = u.pm * 256 + wr * 64 + fr, col0 = u.pn * 256 + wc * 32 + 8 * fq;
#pragma unroll
        for (int ai = 0; ai < 2; ++ai)
#pragma unroll
            for (int m = 0; m < 4; ++m)
#pragma unroll
                for (int bj = 0; bj < 2; ++bj) {
                    const f32x4 v0 = acc[ai][bj][m][0], v1 = acc[ai][bj][m][1];
                    u32x4 w; w.x = cvt_pk_bf16(v0[0], v0[1]); w.y = cvt_pk_bf16(v0[2], v0[3]); w.z = cvt_pk_bf16(v1[0], v1[1]); w.w = cvt_pk_bf16(v1[2], v1[3]);
                    *(u32x4*)(O + (size_t)(row0 + ai * 128 + m * 16) * ldc + col0 + bj * 128) = w;
                }
    }
};
struct EpiOut {
    const float* base; float* out; bf16_t* hb; float* part;
    __device__ __forceinline__ void operator()(const f32x4 (&acc)[2][2][4][2], const pg8::Unit& u, int wr, int wc, int fr, int fq) const {
        const int row0 = u.pm * 256 + wr * 64 + fr, col0 = u.pn * 256 + wc * 32 + 8 * fq;
#pragma unroll
        for (int ai = 0; ai < 2; ++ai)
#pragma unroll
            for (int m = 0; m < 4; ++m) {
                const size_t row = (size_t)(row0 + ai * 128 + m * 16); float ss = 0.f;
#pragma unroll
                for (int bj = 0; bj < 2; ++bj) {
                    const size_t off = row * DM + col0 + bj * 128;
                    const f32x4 b0 = *(const f32x4*)(base + off), b1 = *(const f32x4*)(base + off + 4);
                    const f32x4 v0 = acc[ai][bj][m][0] + b0, v1 = acc[ai][bj][m][1] + b1;
                    *(f32x4*)(out + off) = v0; *(f32x4*)(out + off + 4) = v1;
                    u32x4 w; w.x = cvt_pk_bf16(v0[0], v0[1]); w.y = cvt_pk_bf16(v0[2], v0[3]); w.z = cvt_pk_bf16(v1[0], v1[1]); w.w = cvt_pk_bf16(v1[2], v1[3]);
                    *(u32x4*)(hb + off) = w;
                    ss += (v0[0] * v0[0] + v0[1] * v0[1]) + (v0[2] * v0[2] + v0[3] * v0[3]) + (v1[0] * v1[0] + v1[1] * v1[1]) + (v1[2] * v1[2] + v1[3] * v1[3]);
                }
                ss += __shfl_xor(ss, 16); ss += __shfl_xor(ss, 32);
                if (fq == 0) part[row * 16 + u.pn * 4 + wc] = ss;
            }
    }
};

struct Args { const float* in[18]; float* out; unsigned char* ws; int ph_lo, ph_hi; };
struct Frame {
    LAS unsigned char* lds; int tid, lane, wave, G, bid;
    unsigned char* ws;
};
#define KSWZ(row, colB) ((row) * 256 + ((colB) ^ (((row) & 7) << 4)))
#define SBAR() __builtin_amdgcn_sched_barrier(0)
__device__ __forceinline__ int crow(int r, int hi) { return (r & 3) + 8 * (r >> 2) + 4 * hi; }
template <int NCB> __device__ __forceinline__ int v_st(int k, int c) { const int kk = (k & ~0xC) | ((k & 4) << 1) | ((k & 8) >> 1); return ((kk >> 3) * NCB + (c >> 5)) * 512 + ((kk & 7) * 32 + (c & 31)) * 2; }
__device__ __forceinline__ int v_rd_base(int lane) { return ((lane & 3) << 3) | (((lane >> 2) & 3) << 6) | (((lane >> 4) & 1) << 5) | (((lane >> 5) & 1) << 8); }
template <int OFF> __device__ __forceinline__ s16x4 tr_read(int vb) { s16x4 r; asm volatile("ds_read_b64_tr_b16 %0, %1 offset:%2" : "=&v"(r) : "v"(vb), "i"(OFF) : "memory"); return r; }
__device__ __forceinline__ int lds_addr(const LAS void* p) { return (int)(unsigned)(size_t)p; }
__device__ __forceinline__ void qkt(f32x16& p0, f32x16& p1, const LAS char* Ks, const bf16x8* qr, int r32, int hi) {
    p0 = f32x16{}; p1 = f32x16{};
#pragma unroll
    for (int d0 = 0; d0 < 8; ++d0) { const int cb = (d0 * 16 + hi * 8) * 2;
        const bf16x8 b0 = *(const LAS bf16x8*)(Ks + KSWZ(r32, cb));
        const bf16x8 b1 = *(const LAS bf16x8*)(Ks + KSWZ(32 + r32, cb));
        p0 = __builtin_amdgcn_mfma_f32_32x32x16_bf16(b0, qr[d0], p0, 0, 0, 0);
        p1 = __builtin_amdgcn_mfma_f32_32x32x16_bf16(b1, qr[d0], p1, 0, 0, 0); }
}
__device__ __forceinline__ void pack_p(const f32x16& p0, const f32x16& p1, bf16x8& pa0, bf16x8& pa1, bf16x8& pa2, bf16x8& pa3) {
#define PK4(P, BASE, OUT) do { unsigned a0 = cvt_pk_bf16(P[BASE + 0], P[BASE + 1]), a1 = cvt_pk_bf16(P[BASE + 2], P[BASE + 3]);   \
    unsigned b0 = cvt_pk_bf16(P[BASE + 4], P[BASE + 5]), b1 = cvt_pk_bf16(P[BASE + 6], P[BASE + 7]);                              \
    auto r0 = __builtin_amdgcn_permlane32_swap(a0, b0, false, false); auto r1 = __builtin_amdgcn_permlane32_swap(a1, b1, false, false); \
    u32x4 w = {r0[0], r1[0], r0[1], r1[1]}; OUT = __builtin_bit_cast(bf16x8, w); } while (0)
    PK4(p0, 0, pa0); PK4(p0, 8, pa1); PK4(p1, 0, pa2); PK4(p1, 8, pa3);
#undef PK4
}
__device__ __forceinline__ float xhalf_max(float v) { auto rr = __builtin_amdgcn_permlane32_swap(__float_as_uint(v), __float_as_uint(v), false, false); return fmaxf(__uint_as_float(rr[0]), __uint_as_float(rr[1])); }
__device__ __forceinline__ float xhalf_sum(float v) { auto rr = __builtin_amdgcn_permlane32_swap(__float_as_uint(v), __float_as_uint(v), false, false); return __uint_as_float(rr[0]) + __uint_as_float(rr[1]); }
template <int ND> __device__ __forceinline__ void softmax_step(f32x16& p0, f32x16& p1, float& m, float& l, f32x16 (&o)[ND]) {
    float pmax = p0[0];
#pragma unroll
    for (int r = 1; r < 16; ++r) pmax = fmaxf(pmax, p0[r]);
#pragma unroll
    for (int r = 0; r < 16; ++r) pmax = fmaxf(pmax, p1[r]);
    pmax = xhalf_max(pmax);
    const float mn = fmaxf(m, pmax);
    const float alpha = __builtin_amdgcn_exp2f(m - mn);
    m = mn;
    float ps = 0.f;
#pragma unroll
    for (int r = 0; r < 16; ++r) { p0[r] = __builtin_amdgcn_exp2f(p0[r] - mn); ps += p0[r]; }
#pragma unroll
    for (int r = 0; r < 16; ++r) { p1[r] = __builtin_amdgcn_exp2f(p1[r] - mn); ps += p1[r]; }
    ps = xhalf_sum(ps);
    l = l * alpha + ps;
    if (__any(alpha != 1.f)) {
#pragma unroll
        for (int d = 0; d < ND; ++d)
#pragma unroll
            for (int r = 0; r < 16; ++r) o[d][r] *= alpha;
    }
}
template <int NCB, int D0> __device__ __forceinline__ void pv_one(f32x16& od, int vb, bf16x8 pa0, bf16x8 pa1, bf16x8 pa2, bf16x8 pa3) {
    constexpr int KS = NCB * 1024, HF = NCB * 512, B0 = D0 * 512;
    const s16x4 l0 = tr_read<B0>(vb), h0 = tr_read<B0 + HF>(vb), l1 = tr_read<B0 + KS>(vb), h1 = tr_read<B0 + KS + HF>(vb);
    const s16x4 l2 = tr_read<B0 + 2 * KS>(vb), h2 = tr_read<B0 + 2 * KS + HF>(vb), l3 = tr_read<B0 + 3 * KS>(vb), h3 = tr_read<B0 + 3 * KS + HF>(vb);
    asm volatile("s_waitcnt lgkmcnt(0)" ::: "memory"); SBAR();
#define PKV(L, H) (bf16x8){L[0], L[1], L[2], L[3], H[0], H[1], H[2], H[3]}
    od = __builtin_amdgcn_mfma_f32_32x32x16_bf16(PKV(l0, h0), pa0, od, 0, 0, 0);
    od = __builtin_amdgcn_mfma_f32_32x32x16_bf16(PKV(l1, h1), pa1, od, 0, 0, 0);
    od = __builtin_amdgcn_mfma_f32_32x32x16_bf16(PKV(l2, h2), pa2, od, 0, 0, 0);
    od = __builtin_amdgcn_mfma_f32_32x32x16_bf16(PKV(l3, h3), pa3, od, 0, 0, 0);
#undef PKV
}
template <int NCB> __device__ __forceinline__ void pv_all(f32x16 (&o)[NCB], int vb, bf16x8 pa0, bf16x8 pa1, bf16x8 pa2, bf16x8 pa3) {
    pv_one<NCB, 0>(o[0], vb, pa0, pa1, pa2, pa3); pv_one<NCB, 1>(o[1], vb, pa0, pa1, pa2, pa3); pv_one<NCB, 2>(o[2], vb, pa0, pa1, pa2, pa3); pv_one<NCB, 3>(o[3], vb, pa0, pa1, pa2, pa3);
    if constexpr (NCB == 6) { pv_one<NCB, 4>(o[4], vb, pa0, pa1, pa2, pa3); pv_one<NCB, 5>(o[5], vb, pa0, pa1, pa2, pa3); }
}
struct KReg { bf16x8 a, b; };
template <int NCB> struct VReg { bf16x8 v[NCB == 4 ? 2 : 3]; };
__device__ __forceinline__ void k_load(KReg& s, const bf16_t* kp, size_t ld, int tid) { const int sr = tid >> 4, sc = (tid & 15) * 8;
    s.a = *(const bf16x8*)(kp + (size_t)sr * ld + sc); s.b = *(const bf16x8*)(kp + (size_t)(32 + sr) * ld + sc); }
__device__ __forceinline__ void k_write(LAS char* Kl, const KReg& s, int tid) { const int sr = tid >> 4, kc = (tid & 15) * 16;
    *(LAS bf16x8*)(Kl + KSWZ(sr, kc)) = s.a; *(LAS bf16x8*)(Kl + KSWZ(32 + sr, kc)) = s.b; }
template <int NCB> __device__ __forceinline__ void v_load(VReg<NCB>& s, const bf16_t* vp, size_t ld, int tid) {
    if constexpr (NCB == 4) { const int sr = tid >> 4, sc = (tid & 15) * 8; s.v[0] = *(const bf16x8*)(vp + (size_t)sr * ld + sc); s.v[1] = *(const bf16x8*)(vp + (size_t)(32 + sr) * ld + sc); }
    else {
#pragma unroll
        for (int i = 0; i < 3; ++i) { const int id = tid + 512 * i, row = id / 24, c = (id % 24) * 8; s.v[i] = *(const bf16x8*)(vp + (size_t)row * ld + c); } }
}
template <int NCB> __device__ __forceinline__ void v_write(LAS char* Vl, const VReg<NCB>& s, int tid) {
    if constexpr (NCB == 4) { const int sr = tid >> 4, sc = (tid & 15) * 8; *(LAS bf16x8*)(Vl + v_st<4>(sr, sc)) = s.v[0]; *(LAS bf16x8*)(Vl + v_st<4>(32 + sr, sc)) = s.v[1]; }
    else {
#pragma unroll
        for (int i = 0; i < 3; ++i) { const int id = tid + 512 * i, row = id / 24, c = (id % 24) * 8; *(LAS bf16x8*)(Vl + v_st<6>(row, c)) = s.v[i]; } }
}
__device__ __forceinline__ void q_load(bf16x8 (&qr)[8], const bf16_t* qrow  , int hi) {
#pragma unroll
    for (int d0 = 0; d0 < 8; ++d0) qr[d0] = *(const bf16x8*)(qrow + d0 * 16 + hi * 8);
}
template <int ND> __device__ __forceinline__ void store_y(bf16_t* yrow, const f32x16 (&o)[ND], float sc, int hi) {
#pragma unroll
    for (int d0 = 0; d0 < ND; ++d0)
#pragma unroll
        for (int rg = 0; rg < 4; ++rg) { u32x2* p = (u32x2*)(yrow + 32 * d0 + 8 * rg + 4 * hi); const u32x2 g = *p;
            const float g0 = __builtin_bit_cast(float, g.x << 16), g1 = __builtin_bit_cast(float, g.x & 0xffff0000u), g2 = __builtin_bit_cast(float, g.y << 16), g3 = __builtin_bit_cast(float, g.y & 0xffff0000u);
            u32x2 w; w.x = cvt_pk_bf16(o[d0][4 * rg] * sc * g0, o[d0][4 * rg + 1] * sc * g1); w.y = cvt_pk_bf16(o[d0][4 * rg + 2] * sc * g2, o[d0][4 * rg + 3] * sc * g3); *p = w; }
}

__device__ __forceinline__ void mem_attn_phase(const Frame& F, bf16_t* Z, int ldz, int xq_col, int y_col, const bf16_t* mkv, int unit_lo, int unit_step) {
    const int tid = F.tid, lane = F.lane, r32 = lane & 31, hi = lane >> 5, wave = F.wave;
    LAS char* Kl = (LAS char*)F.lds; LAS char* Vl = Kl + 32768;
    constexpr float C = 0.08838834764831845f * LOG2E;
    for (int u = unit_lo; u < BATCH * 4 * 16; u += unit_step) {
        const int b = u >> 6, head = (u >> 4) & 3, tb = u & 15;
        const size_t t = (size_t)b * SEQ + tb * 256 + wave * 32 + r32;
        bf16x8 qr[8]; q_load(qr, Z + t * ldz + xq_col + head * 128, hi);
        const bf16_t* kp = mkv + (size_t)b * NMEM * DM + head * 128; const bf16_t* vp = kp + 512;
        float m = -1e30f, l = 0.f; f32x16 o[4] = {};
        KReg ks; VReg<4> vs;
        k_load(ks, kp, DM, tid); v_load<4>(vs, vp, DM, tid); k_write(Kl, ks, tid); v_write<4>(Vl, vs, tid); __syncthreads();
        for (int j = 0; j < 4; ++j) {
            const int bo = (j & 1) * 16384;
            if (j + 1 < 4) { k_load(ks, kp + (size_t)(j + 1) * 64 * DM, DM, tid); v_load<4>(vs, vp + (size_t)(j + 1) * 64 * DM, DM, tid); }
            f32x16 p0, p1; qkt(p0, p1, Kl + bo, qr, r32, hi);
#pragma unroll
            for (int r = 0; r < 16; ++r) { p0[r] *= C; p1[r] *= C; }
            softmax_step<4>(p0, p1, m, l, o);
            bf16x8 pa0, pa1, pa2, pa3; pack_p(p0, p1, pa0, pa1, pa2, pa3);
            pv_all<4>(o, lds_addr(Vl + bo) + v_rd_base(lane), pa0, pa1, pa2, pa3);
            if (j + 1 < 4) { k_write(Kl + (bo ^ 16384), ks, tid); v_write<4>(Vl + (bo ^ 16384), vs, tid); }
            __syncthreads();
        }
        store_y<4>(Z + t * ldz + y_col + head * 128, o, 1.f / l, hi);
    }
}

__device__ __forceinline__ void pool_phase(const Frame& F, bf16_t* Z, const bf16_t* WP, const float* scale, int unit_lo, int unit_step) {
    const int tid = F.tid, lane = F.lane, r32 = lane & 31, hi = lane >> 5, wave = F.wave;
    LAS char* Wl = (LAS char*)F.lds;
    for (int u = unit_lo; u < BATCH * 16 * 4; u += unit_step) {
        const int g = u & 3, tb = (u >> 2) & 15, b = u >> 6;
        const int win = 2 << g;
        { const bf16_t* wsrc = WP + (size_t)g * 192 * 192;
#pragma unroll
          for (int i = 0; i < 9; ++i) { const int id = tid + 512 * i, row = id / 24, c = id % 24; *(LAS bf16x8*)(Wl + row * 400 + c * 16) = *(const bf16x8*)(wsrc + row * 192 + c * 8); } }
        __syncthreads();
        const int tloc = tb * 256 + wave * 32 + r32;
        const bf16_t* zrow = Z + ((size_t)b * SEQ + tloc) * EV_LD + EV_ZA + g * 192;
        const int cnt = (tloc + 1 < win) ? tloc + 1 : win; const float icnt = 1.0f / (float)cnt;
        f32x16 o[6] = {};
#pragma unroll 1
        for (int s = 0; s < 12; ++s) {
            const bf16_t* p = zrow + 16 * s + 8 * hi;
            float accv[8]; float cur[8];
            { const bf16x8 v = *(const bf16x8*)p;
#pragma unroll
              for (int j = 0; j < 8; ++j) { cur[j] = bf2f((unsigned short)v[j]); accv[j] = cur[j]; } }
            for (int i = 1; i < cnt; ++i) { const bf16x8 v = *(const bf16x8*)(p - (size_t)i * EV_LD);
#pragma unroll
              for (int j = 0; j < 8; ++j) accv[j] += bf2f((unsigned short)v[j]); }
            u32x4 w; w.x = cvt_pk_bf16(accv[0] * icnt - cur[0], accv[1] * icnt - cur[1]); w.y = cvt_pk_bf16(accv[2] * icnt - cur[2], accv[3] * icnt - cur[3]);
            w.z = cvt_pk_bf16(accv[4] * icnt - cur[4], accv[5] * icnt - cur[5]); w.w = cvt_pk_bf16(accv[6] * icnt - cur[6], accv[7] * icnt - cur[7]);
            const bf16x8 bfrag = __builtin_bit_cast(bf16x8, w);
#pragma unroll
            for (int ob = 0; ob < 6; ++ob) { const bf16x8 afrag = *(const LAS bf16x8*)(Wl + (32 * ob + r32) * 400 + (16 * s + 8 * hi) * 2);
                o[ob] = __builtin_amdgcn_mfma_f32_32x32x16_bf16(afrag, bfrag, o[ob], 0, 0, 0); }
        }
        bf16_t* yrow = Z + ((size_t)b * SEQ + tloc) * EV_LD + EV_G + g * 192; const float* sc = scale + g * 192;
#pragma unroll
        for (int ob = 0; ob < 6; ++ob)
#pragma unroll
            for (int rg = 0; rg < 4; ++rg) { const int c = 32 * ob + 8 * rg + 4 * hi; const f32x4 s4 = *(const f32x4*)(sc + c); u32x2* p = (u32x2*)(yrow + c); const u32x2 gg = *p;
                const float g0 = __builtin_bit_cast(float, gg.x << 16), g1 = __builtin_bit_cast(float, gg.x & 0xffff0000u), g2 = __builtin_bit_cast(float, gg.y << 16), g3 = __builtin_bit_cast(float, gg.y & 0xffff0000u);
                u32x2 w; w.x = cvt_pk_bf16(o[ob][4 * rg] * s4.x * g0, o[ob][4 * rg + 1] * s4.y * g1); w.y = cvt_pk_bf16(o[ob][4 * rg + 2] * s4.z * g2, o[ob][4 * rg + 3] * s4.w * g3); *p = w; }
        __syncthreads();
    }
}


constexpr int RET_KV_ELEMS = 192 * 128;
__device__ __forceinline__ float ret_log2_gamma(int h) { return log2f(1.0f - exp2f(-5.0f - (float)h)); }
__device__ __forceinline__ void ret_a_phase(const Frame& F, bf16_t* Z, const float* ropec, const float* ropes, float* kvT, int unit_lo, int unit_step) {
    const int tid = F.tid, lane = F.lane, wave = F.wave;
    LAS char* Kimg = (LAS char*)F.lds; LAS char* Vimg = Kimg + 32768;
    for (int u = unit_lo; u < BATCH * 4 * 32; u += unit_step) {
        const int b = u >> 7, h = (u >> 5) & 3, n = u & 31, c0 = n * 128;
        const float lgam = ret_log2_gamma(h);
#pragma unroll
        for (int i = 0; i < 2; ++i) {
            const int id = tid + 512 * i, m = id >> 3, c = id & 7, pos = c0 + m;
            bf16_t* row = Z + ((size_t)b * SEQ + pos) * EV_LD;
            const f32x4 ca = *(const f32x4*)(ropec + pos * 64 + 8 * c), cb = *(const f32x4*)(ropec + pos * 64 + 8 * c + 4);
            const f32x4 sa = *(const f32x4*)(ropes + pos * 64 + 8 * c), sb = *(const f32x4*)(ropes + pos * 64 + 8 * c + 4);
            float cs[8] = {ca.x, ca.y, ca.z, ca.w, cb.x, cb.y, cb.z, cb.w}, sn[8] = {sa.x, sa.y, sa.z, sa.w, sb.x, sb.y, sb.z, sb.w};
            const float zeta = exp2f((float)(127 - m) * lgam);
            { bf16_t* kp = row + EV_RK + h * 128 + 8 * c; const bf16x8 x1 = *(const bf16x8*)kp, x2 = *(const bf16x8*)(kp + 64);
              float o1[8], o2[8];
#pragma unroll
              for (int j = 0; j < 8; ++j) { const float a = bf2f((unsigned short)x1[j]), bb = bf2f((unsigned short)x2[j]); o1[j] = a * cs[j] - bb * sn[j]; o2[j] = a * sn[j] + bb * cs[j]; }
              u32x4 w1 = {cvt_pk_bf16(o1[0], o1[1]), cvt_pk_bf16(o1[2], o1[3]), cvt_pk_bf16(o1[4], o1[5]), cvt_pk_bf16(o1[6], o1[7])};
              u32x4 w2 = {cvt_pk_bf16(o2[0], o2[1]), cvt_pk_bf16(o2[2], o2[3]), cvt_pk_bf16(o2[4], o2[5]), cvt_pk_bf16(o2[6], o2[7])};
              *(u32x4*)kp = w1; *(u32x4*)(kp + 64) = w2;
              u32x4 z1 = {cvt_pk_bf16(o1[0] * zeta, o1[1] * zeta), cvt_pk_bf16(o1[2] * zeta, o1[3] * zeta), cvt_pk_bf16(o1[4] * zeta, o1[5] * zeta), cvt_pk_bf16(o1[6] * zeta, o1[7] * zeta)};
              u32x4 z2 = {cvt_pk_bf16(o2[0] * zeta, o2[1] * zeta), cvt_pk_bf16(o2[2] * zeta, o2[3] * zeta), cvt_pk_bf16(o2[4] * zeta, o2[5] * zeta), cvt_pk_bf16(o2[6] * zeta, o2[7] * zeta)};
              LAS char* img = Kimg + (m >> 6) * 16384;
              *(LAS u32x4*)(img + v_st<4>(m & 63, 8 * c)) = z1; *(LAS u32x4*)(img + v_st<4>(m & 63, 64 + 8 * c)) = z2; }
            { bf16_t* qp = row + EV_RQ + h * 128 + 8 * c; const bf16x8 x1 = *(const bf16x8*)qp, x2 = *(const bf16x8*)(qp + 64);
              float o1[8], o2[8];
#pragma unroll
              for (int j = 0; j < 8; ++j) { const float a = bf2f((unsigned short)x1[j]), bb = bf2f((unsigned short)x2[j]); o1[j] = (a * cs[j] - bb * sn[j]) * 0.08838834764831845f; o2[j] = (a * sn[j] + bb * cs[j]) * 0.08838834764831845f; }
              u32x4 w1 = {cvt_pk_bf16(o1[0], o1[1]), cvt_pk_bf16(o1[2], o1[3]), cvt_pk_bf16(o1[4], o1[5]), cvt_pk_bf16(o1[6], o1[7])};
              u32x4 w2 = {cvt_pk_bf16(o2[0], o2[1]), cvt_pk_bf16(o2[2], o2[3]), cvt_pk_bf16(o2[4], o2[5]), cvt_pk_bf16(o2[6], o2[7])};
              *(u32x4*)qp = w1; *(u32x4*)(qp + 64) = w2; }
        }
#pragma unroll
        for (int i = 0; i < 6; ++i) { const int id = tid + 512 * i, m = id / 24, c = id % 24;
            const bf16x8 v = *(const bf16x8*)(Z + ((size_t)b * SEQ + c0 + m) * EV_LD + EV_RV + h * 192 + 8 * c);
            *(LAS bf16x8*)(Vimg + (m >> 6) * 24576 + v_st<6>(m & 63, 8 * c)) = v; }
        __syncthreads();
        const int kbk = wave & 3, dvb0 = (wave >> 2) * 3;
        const int vbK = lds_addr(Kimg) + v_rd_base(lane) + kbk * 512, vbV = lds_addr(Vimg) + v_rd_base(lane) + dvb0 * 512;
        f32x16 acc[3] = {};
#pragma unroll
        for (int T = 0; T < 2; ++T)
#pragma unroll
            for (int ks = 0; ks < 4; ++ks) {
                const s16x4 bl = tr_read<0>(vbK + T * 16384 + ks * 4096), bh = tr_read<0>(vbK + T * 16384 + ks * 4096 + 2048);
                s16x4 al[3], ah[3];
#pragma unroll
                for (int i = 0; i < 3; ++i) { al[i] = tr_read<0>(vbV + T * 24576 + ks * 6144 + i * 512); ah[i] = tr_read<0>(vbV + T * 24576 + ks * 6144 + 3072 + i * 512); }
                asm volatile("s_waitcnt lgkmcnt(0)" ::: "memory"); SBAR();
                const bf16x8 bf = (bf16x8){bl[0], bl[1], bl[2], bl[3], bh[0], bh[1], bh[2], bh[3]};
#pragma unroll
                for (int i = 0; i < 3; ++i) { const bf16x8 af = (bf16x8){al[i][0], al[i][1], al[i][2], al[i][3], ah[i][0], ah[i][1], ah[i][2], ah[i][3]};
                    acc[i] = __builtin_amdgcn_mfma_f32_32x32x16_bf16(af, bf, acc[i], 0, 0, 0); }
            }
        float* dst = kvT + (size_t)u * RET_KV_ELEMS;
        const int r32 = lane & 31, hi = lane >> 5;
#pragma unroll
        for (int i = 0; i < 3; ++i)
#pragma unroll
            for (int r = 0; r < 16; ++r) dst[(size_t)(32 * (dvb0 + i) + crow(r, hi)) * 128 + 32 * kbk + r32] = acc[i][r];
        __syncthreads();
    }
}
__device__ __forceinline__ void ret_scan_phase(const Frame& F, float* kvT) {
    for (int idx = F.bid * 512 + F.tid; idx < 32 * (RET_KV_ELEMS / 4); idx += F.G * 512) {
        const int bh = idx / (RET_KV_ELEMS / 4), e = idx % (RET_KV_ELEMS / 4), h = bh & 3;
        const float gch = exp2f(128.0f * ret_log2_gamma(h));
        f32x4* p = (f32x4*)(kvT + (size_t)bh * 32 * RET_KV_ELEMS) + e;
        f32x4 R = {0.f, 0.f, 0.f, 0.f};
#pragma unroll 4
        for (int n = 0; n < 32; ++n) { const f32x4 t = p[(size_t)n * (RET_KV_ELEMS / 4)]; p[(size_t)n * (RET_KV_ELEMS / 4)] = R; R = R * gch + t; }
    }
}
__device__ __forceinline__ void ret_c_phase(const Frame& F, bf16_t* Z, const float* kvT, int unit_lo, int unit_step) {
    const int tid = F.tid, lane = F.lane, wave = F.wave, r32 = lane & 31, hi = lane >> 5;
    LAS char* Kl = (LAS char*)F.lds; LAS char* Vl = Kl + 32768; LAS float* st = (LAS float*)(Kl + 32768 + 49152);
    for (int u = unit_lo; u < BATCH * 4 * 32; u += unit_step) {
        const int b = u >> 7, h = (u >> 5) & 3, n = u & 31, c0 = n * 128;
        const float lgam = ret_log2_gamma(h);
        const bf16_t* zb = Z + ((size_t)b * SEQ + c0) * EV_LD;
        { KReg k0, k1; VReg<6> v0, v1;
          k_load(k0, zb + EV_RK + h * 128, EV_LD, tid); k_load(k1, zb + (size_t)64 * EV_LD + EV_RK + h * 128, EV_LD, tid);
          v_load<6>(v0, zb + EV_RV + h * 192, EV_LD, tid); v_load<6>(v1, zb + (size_t)64 * EV_LD + EV_RV + h * 192, EV_LD, tid);
          k_write(Kl, k0, tid); k_write(Kl + 16384, k1, tid); v_write<6>(Vl, v0, tid); v_write<6>(Vl + 24576, v1, tid); }
        const int q4 = wave & 3, dvb0 = (wave >> 2) * 3, ti = 32 * q4 + r32;
        bf16x8 qr[8]; q_load(qr, zb + (size_t)ti * EV_LD + EV_RQ + h * 128, hi);
        __syncthreads();
        f32x16 o[3] = {};
        const int ntile = (q4 >> 1) + 1;
        for (int j = 0; j < ntile; ++j) {
            f32x16 p0, p1; qkt(p0, p1, Kl + j * 16384, qr, r32, hi);
#pragma unroll
            for (int r = 0; r < 16; ++r) { const int d0 = ti - (64 * j + crow(r, hi)), d1 = d0 - 32;
                p0[r] = d0 >= 0 ? p0[r] * exp2f((float)d0 * lgam) : 0.f; p1[r] = d1 >= 0 ? p1[r] * exp2f((float)d1 * lgam) : 0.f; }
            bf16x8 pa0, pa1, pa2, pa3; pack_p(p0, p1, pa0, pa1, pa2, pa3);
            const int vb = lds_addr(Vl + j * 24576) + v_rd_base(lane) + dvb0 * 512;
            pv_one<6, 0>(o[0], vb, pa0, pa1, pa2, pa3); pv_one<6, 0>(o[1], vb + 512, pa0, pa1, pa2, pa3); pv_one<6, 0>(o[2], vb + 1024, pa0, pa1, pa2, pa3);
        }
        { const float xi = exp2f((float)(ti + 1) * lgam);
#pragma unroll
          for (int s = 0; s < 8; ++s) { u32x4 w = __builtin_bit_cast(u32x4, qr[s]);
              w.x = cvt_pk_bf16(__builtin_bit_cast(float, w.x << 16) * xi, __builtin_bit_cast(float, w.x & 0xffff0000u) * xi); w.y = cvt_pk_bf16(__builtin_bit_cast(float, w.y << 16) * xi, __builtin_bit_cast(float, w.y & 0xffff0000u) * xi);
              w.z = cvt_pk_bf16(__builtin_bit_cast(float, w.z << 16) * xi, __builtin_bit_cast(float, w.z & 0xffff0000u) * xi); w.w = cvt_pk_bf16(__builtin_bit_cast(float, w.w << 16) * xi, __builtin_bit_cast(float, w.w & 0xffff0000u) * xi);
              qr[s] = __builtin_bit_cast(bf16x8, w); }
          const float* rp = kvT + (size_t)u * RET_KV_ELEMS;
#pragma unroll
          for (int i = 0; i < 3; ++i)
#pragma unroll
              for (int s = 0; s < 8; ++s) { const float* a = rp + (size_t)(32 * (dvb0 + i) + r32) * 128 + 16 * s + 8 * hi; const f32x4 a0 = *(const f32x4*)a, a1 = *(const f32x4*)(a + 4);
                  u32x4 w = {cvt_pk_bf16(a0.x, a0.y), cvt_pk_bf16(a0.z, a0.w), cvt_pk_bf16(a1.x, a1.y), cvt_pk_bf16(a1.z, a1.w)};
                  o[i] = __builtin_amdgcn_mfma_f32_32x32x16_bf16(__builtin_bit_cast(bf16x8, w), qr[s], o[i], 0, 0, 0); } }
        float s1 = 0.f, s2 = 0.f;
#pragma unroll
        for (int i = 0; i < 3; ++i)
#pragma unroll
            for (int r = 0; r < 16; ++r) { s1 += o[i][r]; s2 += o[i][r] * o[i][r]; }
        s1 = xhalf_sum(s1); s2 = xhalf_sum(s2);
        if (hi == 0) { st[(wave * 32 + r32) * 2] = s1; st[(wave * 32 + r32) * 2 + 1] = s2; }
        __syncthreads();
        const float t1 = s1 + st[((wave ^ 4) * 32 + r32) * 2], t2 = s2 + st[((wave ^ 4) * 32 + r32) * 2 + 1];
        const float mu = t1 * (1.f / 192.f), var = fmaxf(t2 * (1.f / 192.f) - mu * mu, 0.f), rs = 1.0f / sqrtf(var + EPS);
#pragma unroll
        for (int i = 0; i < 3; ++i)
#pragma unroll
            for (int r = 0; r < 16; ++r) o[i][r] = (o[i][r] - mu) * rs;
        store_y<3>(Z + ((size_t)b * SEQ + c0 + ti) * EV_LD + EV_G + 768 + h * 192 + 32 * dvb0, o, 1.f, hi);
        __syncthreads();
    }
}

__device__ __forceinline__ void compress_phase(const Frame& F, const bf16_t* Z, const bf16_t* W1t, const bf16_t* W2t, const float* b1, const float* b1part, bf16_t* kcmp, bf16_t* vcmp, int unit_lo, int unit_step) {
    const int tid = F.tid, lane = F.lane, wave = F.wave, r32 = lane & 31, hi = lane >> 5;
    LAS char* Al = (LAS char*)F.lds; LAS char* Hs = Al + 32768;
    for (int u = unit_lo; u < 128; u += unit_step) {
        const int kv = u >> 6, rt = u & 63;
        const bf16_t* w1 = W1t + (size_t)kv * 256 * 4096; const bf16_t* w2 = W2t + (size_t)kv * 128 * 256;
        bf16_t* dstc = kv ? vcmp : kcmp; const int zc = kv ? OD_VC : OD_KC;
        if (rt == 0 && tid < 256) { const int bg = tid >> 4, c = tid & 15; *(u32x4*)(dstc + ((size_t)bg * 256 + 255) * 128 + c * 8) = (u32x4){0u, 0u, 0u, 0u}; }
        const int sr = tid >> 4, sc = (tid & 15) * 8;
        const bf16_t* rp[2];
#pragma unroll
        for (int i = 0; i < 2; ++i) { int r = rt * 64 + sr + 32 * i; if (r > 4079) r = 4079; const int g = r & 1, bj = r >> 1, b = bj / 255, j = bj % 255;
            rp[i] = Z + ((size_t)b * SEQ + 16 * j) * OD_LD + zc + g * 128 + sc; }
        KReg a; a.a = *(const bf16x8*)rp[0]; a.b = *(const bf16x8*)rp[1];
        k_write(Al, a, tid);
        const bf16_t* wrow = w1 + (size_t)(32 * wave + r32) * 4096 + 8 * hi;
        bf16x8 bcur[8], bnxt[8];
#pragma unroll
        for (int s = 0; s < 8; ++s) bcur[s] = *(const bf16x8*)(wrow + 16 * s);
        f32x16 acc[2] = {};
        __syncthreads();
#pragma unroll 1
        for (int l = 0; l < 32; ++l) {
            const int bo = (l & 1) * 16384;
            if (l + 1 < 32) { a.a = *(const bf16x8*)(rp[0] + (size_t)(l + 1) * OD_LD); a.b = *(const bf16x8*)(rp[1] + (size_t)(l + 1) * OD_LD);
#pragma unroll
                for (int s = 0; s < 8; ++s) bnxt[s] = *(const bf16x8*)(wrow + (l + 1) * 128 + 16 * s); }
#pragma unroll
            for (int s = 0; s < 8; ++s) { const int cb = (16 * s + 8 * hi) * 2;
                const bf16x8 a0 = *(const LAS bf16x8*)(Al + bo + KSWZ(r32, cb)), a1 = *(const LAS bf16x8*)(Al + bo + KSWZ(32 + r32, cb));
                acc[0] = __builtin_amdgcn_mfma_f32_32x32x16_bf16(a0, bcur[s], acc[0], 0, 0, 0);
                acc[1] = __builtin_amdgcn_mfma_f32_32x32x16_bf16(a1, bcur[s], acc[1], 0, 0, 0); }
            if (l + 1 < 32) { k_write(Al + (bo ^ 16384), a, tid);
#pragma unroll
                for (int s = 0; s < 8; ++s) bcur[s] = bnxt[s]; }
            __syncthreads();
        }
        { const int col = 32 * wave + r32; float bb = b1[kv * 256 + col];
          for (int j = 0; j < 32; ++j) bb += b1part[(kv * 32 + j) * 256 + col];
#pragma unroll
          for (int rb = 0; rb < 2; ++rb)
#pragma unroll
              for (int r = 0; r < 16; ++r) { const float v = acc[rb][r] + bb; const float sv = v * fast_sigmoid(v);
                  *(LAS unsigned short*)(Hs + (32 * rb + crow(r, hi)) * 528 + col * 2) = (unsigned short)f2bf(sv); } }
        __syncthreads();
        { const int rb = wave & 1, cbk = wave >> 1; f32x16 o2 = {};
#pragma unroll
          for (int s = 0; s < 16; ++s) { const bf16x8 af = *(const LAS bf16x8*)(Hs + (32 * rb + r32) * 528 + (16 * s + 8 * hi) * 2);
              const bf16x8 bf = *(const bf16x8*)(w2 + (size_t)(32 * cbk + r32) * 256 + 16 * s + 8 * hi);
              o2 = __builtin_amdgcn_mfma_f32_32x32x16_bf16(af, bf, o2, 0, 0, 0); }
#pragma unroll
          for (int r = 0; r < 16; ++r) { const int row = rt * 64 + 32 * rb + crow(r, hi);
              if (row < 4080) { const int g = row & 1, bj = row >> 1, b = bj / 255, j = bj % 255;
                  dstc[(((size_t)b * 2 + g) * 256 + j) * 128 + 32 * cbk + r32] = (bf16_t)f2bf(o2[r]); } } }
        __syncthreads();
    }
}

__device__ __forceinline__ void nsa_post(f32x16& p0, f32x16& p1, int t, int kbase, int kstride, int limit, bool sel, int kvalid, const LAS float* tbl, int hi, bool fast) {
    constexpr float C = 0.08838834764831845f * LOG2E;
    const float NEGINF = -__builtin_inff();
    if (fast) { const float b128 = tbl[128];
#pragma unroll
        for (int r = 0; r < 16; ++r) { p0[r] = sel ? p0[r] * C + b128 : NEGINF; p1[r] = sel ? p1[r] * C + b128 : NEGINF; }
        return; }
#pragma unroll
    for (int r = 0; r < 16; ++r) {
        { const int k = crow(r, hi); const int rel = t - (kbase + kstride * k); const bool ok = sel && rel >= 0 && rel < limit && k < kvalid; const int idx = rel < 0 ? 0 : (rel > 128 ? 128 : rel);
          p0[r] = ok ? p0[r] * C + tbl[idx] : NEGINF; }
        { const int k = 32 + crow(r, hi); const int rel = t - (kbase + kstride * k); const bool ok = sel && rel >= 0 && rel < limit && k < kvalid; const int idx = rel < 0 ? 0 : (rel > 128 ? 128 : rel);
          p1[r] = ok ? p1[r] * C + tbl[idx] : NEGINF; }
    }
}
constexpr int NSA_FIN_OFF = 32768, NSA_IMP_OFF = 32768, NSA_SEL_OFF = 131072, NSA_TB_OFF = NSA_SEL_OFF + 256;
static_assert(NSA_TB_OFF + 6 * 132 * 4 <= RSTD_OFF + RSTD_BYTES, "nsa lds");
struct LdRegs { bf16x8 k[8], v[8]; };
__device__ __forceinline__ void ld_load(LdRegs& r, const bf16_t* kp, size_t ldk, const bf16_t* vp, size_t ldv, int lt, bool with_v) {
    asm volatile("" : "+v"(lt));
#pragma unroll
    for (int i = 0; i < 8; ++i) { const int c = lt + 128 * i, row = c >> 4, cc = (c & 15) * 8; r.k[i] = *(const bf16x8*)(kp + (size_t)row * ldk + cc); }
    if (with_v) {
#pragma unroll
        for (int i = 0; i < 8; ++i) { const int c = lt + 128 * i, row = c >> 4, cc = (c & 15) * 8; r.v[i] = *(const bf16x8*)(vp + (size_t)row * ldv + cc); } }
}
__device__ __forceinline__ void ld_write(LAS char* Kl, LAS char* Vl, const LdRegs& r, int lt, bool with_v) {
    asm volatile("" : "+v"(lt));
#pragma unroll
    for (int i = 0; i < 8; ++i) { const int c = lt + 128 * i, row = c >> 4, cc = (c & 15); *(LAS bf16x8*)(Kl + KSWZ(row, cc * 16)) = r.k[i]; }
    if (with_v) {
#pragma unroll
        for (int i = 0; i < 8; ++i) { const int c = lt + 128 * i, row = c >> 4, cc = (c & 15); *(LAS bf16x8*)(Vl + v_st<4>(row, cc * 8)) = r.v[i]; } }
}
__device__ __forceinline__ void nsa_phase(const Frame& F, bf16_t* Z, const float* gates, const bf16_t* kcmp, const bf16_t* vcmp, const float* tbias) {
    const int tid = F.tid, lane = F.lane, wave = F.wave, r32 = lane & 31, hi = lane >> 5, lt = tid - 384;
    LAS char* Kl = (LAS char*)F.lds; LAS char* Vl = Kl + 16384;
    LAS float* imp = (LAS float*)(Kl + NSA_IMP_OFF); LAS unsigned long long* selm = (LAS unsigned long long*)(Kl + NSA_SEL_OFF); LAS float* tb = (LAS float*)(Kl + NSA_TB_OFF);
    const bool cw = wave < 6;
    LAS float* finw = (LAS float*)(Kl + NSA_FIN_OFF) + wave * 4096 + lane;
    const int vb = lds_addr(Vl) + v_rd_base(lane);
    for (int round = 0; round < 8; ++round) {
        const int rank = round * 256 + ((round & 1) ? (255 - F.bid) : F.bid);
        if (F.bid >= 256) break;
        const int qt = 127 - (rank >> 4), bg = rank & 15, b = bg >> 1, g = bg & 1, s0 = qt * 32, t = s0 + r32;
        const int head = cw ? wave : 0, hg = g * 6 + head;
        const bf16_t* zb = Z + (size_t)b * SEQ * OD_LD;
        const bf16_t* kc = kcmp + (size_t)bg * 256 * 128; const bf16_t* vc = vcmp + (size_t)bg * 256 * 128;
        const int jmax = (s0 >> 4) > 254 ? 254 : (s0 >> 4), ntc = (jmax >> 6) + 1, cur = s0 >> 6;
        for (int i = tid; i < 6 * 32 * 65; i += 512) imp[i] = 0.f;
        for (int i = tid; i < 6 * 132; i += 512) tb[i] = tbias[g * 6 * 132 + i];
        const LAS float* tbl = tb + head * 132;
        const float* gp = gates + ((size_t)b * SEQ + t) * GATE_LD + hg;
        bf16x8 qr[8]; f32x16 o[4] = {};
        if (cw) {
            q_load(qr, zb + (size_t)t * OD_LD + OD_Q + hg * 128, hi);
            float m = -1e30f, l = 0.f;
            for (int j = 0; j < ntc; ++j) {
                __syncthreads();
                { f32x16 p0, p1; qkt(p0, p1, Kl, qr, r32, hi);
                  nsa_post(p0, p1, t, 16 * 64 * j + 31, 16, 1 << 30, true, 255 - 64 * j, tbl, hi, false);
                  float pmax = p0[0];
#pragma unroll
                  for (int r = 1; r < 16; ++r) pmax = fmaxf(pmax, p0[r]);
#pragma unroll
                  for (int r = 0; r < 16; ++r) pmax = fmaxf(pmax, p1[r]);
                  pmax = xhalf_max(pmax); const float mn = fmaxf(m, pmax); float ps = 0.f;
#pragma unroll
                  for (int r = 0; r < 16; ++r) ps += __builtin_amdgcn_exp2f(p0[r] - mn) + __builtin_amdgcn_exp2f(p1[r] - mn);
                  ps = xhalf_sum(ps); l = l * __builtin_amdgcn_exp2f(m - mn) + ps; m = mn; }
                __syncthreads(); }
            const float inv_l = (l > 0.f && t >= 31) ? 1.0f / l : 0.f;
            for (int j = 0; j < ntc; ++j) {
                __syncthreads();
                { f32x16 p0, p1; qkt(p0, p1, Kl, qr, r32, hi);
                  nsa_post(p0, p1, t, 16 * 64 * j + 31, 16, 1 << 30, true, 255 - 64 * j, tbl, hi, false);
#pragma unroll
                  for (int r = 0; r < 16; ++r) { p0[r] = __builtin_amdgcn_exp2f(p0[r] - m) * inv_l; p1[r] = __builtin_amdgcn_exp2f(p1[r] - m) * inv_l; }
                  LAS float* ip = imp + (head * 32 + r32) * 65 + 16 * j + hi;
#pragma unroll
                  for (int gq = 0; gq < 4; ++gq) {
                      { const float own = 2.f * (p0[4 * gq] + p0[4 * gq + 1] + p0[4 * gq + 2]) + p0[4 * gq + 3]; const int J = 2 * gq;
                        __hip_atomic_fetch_add(ip + J, own, __ATOMIC_RELAXED, __HIP_MEMORY_SCOPE_WORKGROUP); __hip_atomic_fetch_add(ip + J + 1, p0[4 * gq + 3], __ATOMIC_RELAXED, __HIP_MEMORY_SCOPE_WORKGROUP); }
                      { const float own = 2.f * (p1[4 * gq] + p1[4 * gq + 1] + p1[4 * gq + 2]) + p1[4 * gq + 3]; const int J = 8 + 2 * gq;
                        __hip_atomic_fetch_add(ip + J, own, __ATOMIC_RELAXED, __HIP_MEMORY_SCOPE_WORKGROUP); __hip_atomic_fetch_add(ip + J + 1, p1[4 * gq + 3], __ATOMIC_RELAXED, __HIP_MEMORY_SCOPE_WORKGROUP); }
                  }
                  bf16x8 pa0, pa1, pa2, pa3; pack_p(p0, p1, pa0, pa1, pa2, pa3);
                  pv_all<4>(o, vb, pa0, pa1, pa2, pa3); }
                __syncthreads(); }
        } else {
            LdRegs lr;
            ld_load(lr, kc, 128, vc, 128, lt, false);
            for (int j = 0; j < ntc; ++j) { ld_write(Kl, Vl, lr, lt, false); __syncthreads();
                if (j + 1 < ntc) ld_load(lr, kc + (size_t)(j + 1) * 64 * 128, 128, vc, 128, lt, false);
                __syncthreads(); }
            ld_load(lr, kc, 128, vc, 128, lt, true);
            for (int j = 0; j < ntc; ++j) { ld_write(Kl, Vl, lr, lt, true); __syncthreads();
                if (j + 1 < ntc) ld_load(lr, kc + (size_t)(j + 1) * 64 * 128, 128, vc + (size_t)(j + 1) * 64 * 128, 128, lt, true);
                __syncthreads(); }
        }
        for (int i = 0; i < 4; ++i) { const int tt = wave * 4 + i, tq = s0 + tt;
            float v = 0.f;
#pragma unroll
            for (int h = 0; h < 6; ++h) v += imp[(h * 32 + tt) * 65 + lane];
            const bool forced = (lane == 0) || (lane == cur) || (lane == cur - 1), future = lane * 64 > tq;
            v = forced ? 1e30f : (future ? -1e30f : v);
            unsigned long long msk = 0ull;
            for (int k = 0; k < 8; ++k) { float bv = v; int bi = lane;
#pragma unroll
                for (int off = 1; off < 64; off <<= 1) { const float ov = __shfl_xor(bv, off); const int oi = __shfl_xor(bi, off); if (ov > bv || (ov == bv && oi < bi)) { bv = ov; bi = oi; } }
                msk |= 1ull << bi; if (lane == bi) v = -__builtin_inff(); }
            msk &= (2ull << cur) - 1ull;
            if (lane == 0) selm[tt] = msk; }
        __syncthreads();
        const unsigned long long mymask = selm[r32]; unsigned long long uni;
        { unsigned lo = (unsigned)mymask, hi32 = (unsigned)(mymask >> 32);
#pragma unroll
          for (int off = 1; off < 32; off <<= 1) { lo |= __shfl_xor(lo, off); hi32 |= __shfl_xor(hi32, off); }
          uni = ((unsigned long long)(unsigned)__builtin_amdgcn_readfirstlane(hi32) << 32) | (unsigned)__builtin_amdgcn_readfirstlane(lo); }
        const int jt0 = (s0 - 511) < 0 ? 0 : (s0 - 511) >> 6, ntw = cur - jt0 + 1;
        if (cw) {
            { const float g_cmp = gp[0];
#pragma unroll
              for (int d = 0; d < 4; ++d)
#pragma unroll
                  for (int r = 0; r < 16; ++r) finw[(d * 16 + r) * 64] = g_cmp * o[d][r]; }
            { float ms = -1e30f, ls = 0.f;
#pragma unroll
              for (int d = 0; d < 4; ++d) o[d] = f32x16{};
              unsigned long long rem = uni;
              while (rem != 0ull) { const int J = __builtin_ctzll(rem); rem &= rem - 1;
                  __syncthreads();
                  const bool sel = (mymask >> J) & 1ull;
                  if (__any(sel)) { f32x16 p0, p1; qkt(p0, p1, Kl, qr, r32, hi);
                      nsa_post(p0, p1, t, 64 * J, 1, 1 << 30, sel, 64, tbl, hi, s0 - (64 * J + 63) >= 128);
                      softmax_step<4>(p0, p1, ms, ls, o);
                      bf16x8 pa0, pa1, pa2, pa3; pack_p(p0, p1, pa0, pa1, pa2, pa3);
                      pv_all<4>(o, vb, pa0, pa1, pa2, pa3); }
                  __syncthreads(); }
              const float sc = gp[12] / ls;
#pragma unroll
              for (int d = 0; d < 4; ++d)
#pragma unroll
                  for (int r = 0; r < 16; ++r) finw[(d * 16 + r) * 64] += sc * o[d][r]; }
            { float mw = -1e30f, lw = 0.f;
#pragma unroll
              for (int d = 0; d < 4; ++d) o[d] = f32x16{};
              for (int j = 0; j < ntw; ++j) { const int kb0 = (jt0 + j) * 64;
                  __syncthreads();
                  { f32x16 p0, p1; qkt(p0, p1, Kl, qr, r32, hi);
                    nsa_post(p0, p1, t, kb0, 1, 512, true, 64, tbl, hi, (s0 - (kb0 + 63) >= 128) && (s0 + 31 - kb0 < 512));
                    softmax_step<4>(p0, p1, mw, lw, o);
                    bf16x8 pa0, pa1, pa2, pa3; pack_p(p0, p1, pa0, pa1, pa2, pa3);
                    pv_all<4>(o, vb, pa0, pa1, pa2, pa3); }
                  __syncthreads(); }
              const float sc = gp[24] / lw;
#pragma unroll
              for (int d = 0; d < 4; ++d)
#pragma unroll
                  for (int r = 0; r < 16; ++r) o[d][r] = finw[(d * 16 + r) * 64] + sc * o[d][r];
              store_y<4>(Z + ((size_t)b * SEQ + t) * OD_LD + OD_G + hg * 128, o, 1.f, hi); }
        } else {
            LdRegs lr;
            { unsigned long long rem = uni; int J = __builtin_ctzll(rem); rem &= rem - 1;
              ld_load(lr, zb + (size_t)J * 64 * OD_LD + OD_KS + g * 128, OD_LD, zb + (size_t)J * 64 * OD_LD + OD_VS + g * 128, OD_LD, lt, true);
              for (;;) { ld_write(Kl, Vl, lr, lt, true); __syncthreads();
                  const bool more = rem != 0ull;
                  if (more) { J = __builtin_ctzll(rem); rem &= rem - 1;
                      ld_load(lr, zb + (size_t)J * 64 * OD_LD + OD_KS + g * 128, OD_LD, zb + (size_t)J * 64 * OD_LD + OD_VS + g * 128, OD_LD, lt, true); }
                  __syncthreads();
                  if (!more) break; } }
            ld_load(lr, zb + (size_t)jt0 * 64 * OD_LD + OD_KW + g * 128, OD_LD, zb + (size_t)jt0 * 64 * OD_LD + OD_VW + g * 128, OD_LD, lt, true);
            for (int j = 0; j < ntw; ++j) { const int kb0 = (jt0 + j) * 64;
                ld_write(Kl, Vl, lr, lt, true); __syncthreads();
                if (j + 1 < ntw) ld_load(lr, zb + (size_t)(kb0 + 64) * OD_LD + OD_KW + g * 128, OD_LD, zb + (size_t)(kb0 + 64) * OD_LD + OD_VW + g * 128, OD_LD, lt, true);
                __syncthreads(); }
        }
        __syncthreads();
    }
}

template <int MAP>
__device__ __forceinline__ void transpose_item(const float* W, int K, int N, bf16_t* WT, const float* kscale, LAS float* scr, int item, int lane) {
    const int nblk = (N + 31) / 32, kb = item / nblk, nb = item % nblk, k0 = 64 * kb, n0 = 32 * nb;
    const int nl = n0 + (lane & 31);
#pragma unroll 8
    for (int i = 0; i < 32; ++i) { const int kk = 2 * i + (lane >> 5); float v = 0.f; if (nl < N) v = W[(size_t)(k0 + kk) * N + nl]; if (kscale) v *= kscale[k0 + kk]; scr[kk * 33 + (lane & 31)] = v; }
    LDS_WAIT(); asm volatile("" ::: "memory");
    const int c = lane & 7;
#pragma unroll
    for (int j = 0; j < 4; ++j) { const int n = (lane >> 3) + 8 * j; const LAS float* s = scr + (8 * c) * 33 + n;
        u32x4 o; o.x = pk2(s[0 * 33], s[1 * 33]); o.y = pk2(s[2 * 33], s[3 * 33]); o.z = pk2(s[4 * 33], s[5 * 33]); o.w = pk2(s[6 * 33], s[7 * 33]);
        const int ncol = n0 + n;
        if (ncol < N) {
            int drow = ncol;
            if (MAP == 1) { if (ncol >= 3620) drow = OD_G + (ncol - 3620); else if (ncol >= 3108) drow = OD_XQ + (ncol - 3108); else if (ncol >= 3072) drow = OD_LD + (ncol - 3072); }
            *(u32x4*)(WT + (size_t)drow * K + k0 + 8 * c) = o; } }
    LDS_WAIT(); asm volatile("" ::: "memory");
}
__device__ __forceinline__ int t5_bucket(int n) {
    if (n < 16) return n;
    int l = 16 + (int)(__logf((float)n * (1.f / 16.f)) / 2.0794415416798357f * 16.f);
    return l < 31 ? l : 31;
}
__device__ __forceinline__ void prologue(const Frame& F, const Args& a) {
    LAS float* scr = (LAS float*)(F.lds + F.wave * 16384);
    const int gw = F.bid * 8 + F.wave, NGW = F.G * 8, lane = F.lane;
    unsigned char* ws = F.ws;
    const float* norm_g = a.in[2];
    constexpr int I0 = 16 * 160, I1 = 16 * 178, IO = 32 * 32, IM = 16 * 32, IC1 = 64 * 8, IC2 = 4 * 4, IP = 3 * 6;
    constexpr int NITEMS = I0 + I1 + 2 * IO + 2 * IM + 2 * IC1 + 2 * IC2 + 4 * IP;
    for (int it = gw; it < NITEMS; it += NGW) {
        int r = it;
        if (r < I0) { transpose_item<0>(a.in[6], DM, EV_LD, (bf16_t*)(ws + WS_W0), norm_g, scr, r, lane); continue; } r -= I0;
        if (r < I1) { transpose_item<1>(a.in[11], DM, OD_COLS, (bf16_t*)(ws + WS_W1), norm_g + DM, scr, r, lane); continue; } r -= I1;
        if (r < IO) { transpose_item<0>(a.in[10], DIN, DM, (bf16_t*)(ws + WS_WO0), nullptr, scr, r, lane); continue; } r -= IO;
        if (r < IO) { transpose_item<0>(a.in[17], DIN, DM, (bf16_t*)(ws + WS_WO1), nullptr, scr, r, lane); continue; } r -= IO;
        if (r < IM) { transpose_item<0>(a.in[9], DM, DM, (bf16_t*)(ws + WS_WM0), nullptr, scr, r, lane); continue; } r -= IM;
        if (r < IM) { transpose_item<0>(a.in[16], DM, DM, (bf16_t*)(ws + WS_WM1), nullptr, scr, r, lane); continue; } r -= IM;
        if (r < 2 * IC1) { const int kv = r / IC1; transpose_item<0>(a.in[13] + (size_t)kv * 4096 * 256, 4096, 256, (bf16_t*)(ws + WS_WC1) + (size_t)kv * 256 * 4096, nullptr, scr, r % IC1, lane); continue; } r -= 2 * IC1;
        if (r < 2 * IC2) { const int kv = r / IC2; transpose_item<0>(a.in[15] + (size_t)kv * 256 * 128, 256, 128, (bf16_t*)(ws + WS_WC2) + (size_t)kv * 128 * 256, nullptr, scr, r % IC2, lane); continue; } r -= 2 * IC2;
        { const int gi = r / IP; transpose_item<0>(a.in[7] + (size_t)gi * 192 * 192, 192, 192, (bf16_t*)(ws + WS_WP) + (size_t)gi * 192 * 192, nullptr, scr, r % IP, lane); }
    }
    { u32x4* p = (u32x4*)((bf16_t*)(ws + WS_W1) + (size_t)OD_COLS * DM); const int n16 = (OD_N - OD_COLS) * DM * 2 / 16;
      for (int i = F.bid * 512 + F.tid; i < n16; i += F.G * 512) p[i] = (u32x4){0u, 0u, 0u, 0u}; }
    { const float* x = a.in[0]; bf16_t* xb = (bf16_t*)(ws + WS_R); float* part = (float*)(ws + WS_PART);
      for (int m = gw; m < MTOK; m += NGW) {
          const f32x4* xr = (const f32x4*)(x + (size_t)m * DM) + lane; f32x4 v[4]; float s = 0.f;
#pragma unroll
          for (int j = 0; j < 4; ++j) { v[j] = xr[64 * j]; s += (v[j].x * v[j].x + v[j].y * v[j].y) + (v[j].z * v[j].z + v[j].w * v[j].w); }
          s = wave_sum(s);
          u32x2* o8 = (u32x2*)(xb + (size_t)m * DM) + lane;
#pragma unroll
          for (int j = 0; j < 4; ++j) o8[64 * j] = (u32x2){pk2(v[j].x, v[j].y), pk2(v[j].z, v[j].w)};
          if (lane < 16) part[(size_t)m * 16 + lane] = (lane == 0) ? s : 0.f;
      } }
    { const float* mem = a.in[1]; const float* mg = a.in[4]; bf16_t* mn = (bf16_t*)(ws + WS_MEMN);
      for (int m = gw; m < BATCH * NMEM; m += NGW) {
          const f32x4* xr = (const f32x4*)(mem + (size_t)m * DM) + lane; const f32x4* gr = (const f32x4*)mg + lane; f32x4 v[4]; float s = 0.f;
#pragma unroll
          for (int j = 0; j < 4; ++j) { v[j] = xr[64 * j]; s += (v[j].x * v[j].x + v[j].y * v[j].y) + (v[j].z * v[j].z + v[j].w * v[j].w); }
          const float rs = 1.0f / sqrtf(wave_sum(s) * (1.f / DM) + EPS);
          u32x2* o8 = (u32x2*)(mn + (size_t)m * DM) + lane;
#pragma unroll
          for (int j = 0; j < 4; ++j) { const f32x4 g = gr[64 * j]; o8[64 * j] = (u32x2){pk2(v[j].x * rs * g.x, v[j].y * rs * g.y), pk2(v[j].z * rs * g.z, v[j].w * rs * g.w)}; }
      } }
    { float* ct = (float*)(ws + WS_ROPE); float* st = ct + SEQ * 64;
      for (int i = F.bid * 512 + F.tid; i < SEQ * 64; i += F.G * 512) {
          const int s = i >> 6, f = i & 63;
          const float inv = exp2f(-((float)f * (1.f / 64.f)) * 13.287712379549449f);
          const float ang = (float)s * inv;
          const double x = (double)ang; const double kq = rint(x * 0.6366197723675814);
          double r = fma(-kq, 1.5707963267948966, x); r = fma(-kq, 6.123233995736766e-17, r);
          const double r2 = r * r;
          const double sn = r * (1.0 + r2 * (-1.0 / 6 + r2 * (1.0 / 120 + r2 * (-1.0 / 5040 + r2 * (1.0 / 362880 - r2 * (1.0 / 39916800))))));
          const double cs = 1.0 + r2 * (-0.5 + r2 * (1.0 / 24 + r2 * (-1.0 / 720 + r2 * (1.0 / 40320 - r2 * (1.0 / 3628800)))));
          const int q = ((int)kq) & 3;
          double c_, s_;
          if (q == 0) { c_ = cs; s_ = sn; } else if (q == 1) { c_ = -sn; s_ = cs; } else if (q == 2) { c_ = -cs; s_ = -sn; } else { c_ = sn; s_ = -cs; }
          ct[i] = (float)c_; st[i] = (float)s_;
      } }
    if (F.bid == 0) { float* tb = (float*)(ws + WS_MISC); const float* rb = a.in[5];
        for (int i = F.tid; i < 12 * 132; i += 512) { const int h = i / 132, r = i % 132; const int bk = r >= 128 ? 31 : t5_bucket(r); tb[i] = rb[bk * 12 + h] * LOG2E; } }
    if (F.bid < 64 && F.tid < 256) { const int kv = F.bid >> 5, j = F.bid & 31, c = F.tid; const float* pe = a.in[12] + (size_t)kv * 4096; const float* w1 = a.in[13] + (size_t)kv * 4096 * 256;
        float s = 0.f;
        for (int k = 128 * j; k < 128 * j + 128; ++k) s += pe[k] * w1[(size_t)k * 256 + c];
        ((float*)(ws + WS_MISC + 65536))[(kv * 32 + j) * 256 + c] = s; }
}

__device__ __forceinline__ void final_norm(const Frame& F, float* out, const float* part, const float* fg) {
    const int gw = F.bid * 8 + F.wave, NGW = F.G * 8, lane = F.lane;
    for (int m = gw; m < MTOK; m += NGW) {
        float ps = (lane < 16) ? part[(size_t)m * 16 + lane] : 0.f;
        float tot = 0.f;
#pragma unroll
        for (int j = 0; j < 16; ++j) tot += __shfl(ps, j);
        const float rs = 1.0f / sqrtf(tot * (1.f / DM) + EPS);
        f32x4* xr = (f32x4*)(out + (size_t)m * DM) + lane; const f32x4* gr = (const f32x4*)fg + lane;
#pragma unroll
        for (int j = 0; j < 4; ++j) { f32x4 v = xr[64 * j]; const f32x4 g = gr[64 * j]; v.x = v.x * rs * g.x; v.y = v.y * rs * g.y; v.z = v.z * rs * g.z; v.w = v.w * rs * g.w; xr[64 * j] = v; }
    }
}
__device__ __forceinline__ void fill_rstd(const Frame& F, const pg8::StaticOrder& S, const float* part) {
    LAS float* rl = (LAS float*)(F.lds + RSTD_OFF); pg8::Unit u;
    for (int i = 0; i < 12 && S.next(i, u); ++i) {
        if (F.tid < 256) { const f32x4* p = (const f32x4*)(part + ((size_t)u.pm * 256 + F.tid) * 16);
            const f32x4 a = p[0], b = p[1], c = p[2], d = p[3];
            float tot = 0.f; tot += a.x; tot += a.y; tot += a.z; tot += a.w; tot += b.x; tot += b.y; tot += b.z; tot += b.w; tot += c.x; tot += c.y; tot += c.z; tot += c.w; tot += d.x; tot += d.y; tot += d.z; tot += d.w;
            rl[i * 256 + F.tid] = 1.0f / sqrtf(tot * (1.f / DM) + EPS); }
    }
    __syncthreads();
}

constexpr int NPHASE = 12;
__global__ void __launch_bounds__(512, 2) fwd_kernel(Args args) {
    extern __shared__ __attribute__((aligned(16))) unsigned char lds_raw[];
    Frame F; F.lds = (LAS unsigned char*)lds_raw; F.tid = threadIdx.x; F.lane = F.tid & 63; F.wave = __builtin_amdgcn_readfirstlane(F.tid >> 6);
    F.G = gridDim.x; F.bid = blockIdx.x; F.ws = args.ws;
    unsigned char* ws = args.ws;
    const int lo = args.ph_lo, hi = args.ph_hi;
#define IN(k) (lo <= (k) && (k) < hi)
    { volatile LAS unsigned* mw = (volatile LAS unsigned*)(F.lds + MISC_OFF); if (F.tid < 16) mw[F.tid] = 0u; }
    __syncthreads();
    const XcdBarrier xbar = xcd_barrier_post((unsigned*)(ws + WS_CTL) + 4096, (volatile LAS unsigned*)(F.lds + MISC_OFF));
#define SEAM(k) do { if (IN(k) && IN((k) + 1)) xcd_barrier(xbar); } while (0)
    float* part = (float*)(ws + WS_PART);
    bf16_t* Z = (bf16_t*)(ws + WS_Z);
    bf16_t* HB = (bf16_t*)(ws + WS_R);

    if (IN(0)) { prologue(F, args); }
    SEAM(0);
    if (IN(1)) {
        { pg8::StaticOrder S; S.init(MTOK, EV_LD, F.G, F.bid); fill_rstd(F, S, part);
          pg8::Gemm g{HB, (const bf16_t*)(ws + WS_W0), MTOK, EV_LD, DM, DM};
          EpiIn E{Z, EV_LD, (const LAS float*)(F.lds + RSTD_OFF), EV_G / 256, -1, nullptr, 0, 0};
          pg8::gemm_phase(F.lds, g, S, E); }
        { pg8::StaticOrder S; S.init(BATCH * NMEM, DM, F.G, F.bid);
          pg8::Gemm g{(const bf16_t*)(ws + WS_MEMN), (const bf16_t*)(ws + WS_WM0), BATCH * NMEM, DM, DM, DM};
          EpiBf E{(bf16_t*)(ws + WS_MKV0), DM};
          pg8::gemm_phase(F.lds, g, S, E); }
        { pg8::StaticOrder S; S.init(BATCH * NMEM, DM, F.G, (F.bid + 128) % F.G);
          pg8::Gemm g{(const bf16_t*)(ws + WS_MEMN), (const bf16_t*)(ws + WS_WM1), BATCH * NMEM, DM, DM, DM};
          EpiBf E{(bf16_t*)(ws + WS_MKV1), DM};
          pg8::gemm_phase(F.lds, g, S, E); }
    }
    SEAM(1);
    if (IN(2)) {
        ret_a_phase(F, Z, (const float*)(ws + WS_ROPE), (const float*)(ws + WS_ROPE) + SEQ * 64, (float*)(ws + WS_R), F.bid, F.G);
        pool_phase(F, Z, (const bf16_t*)(ws + WS_WP), args.in[8], F.bid, F.G);
        mem_attn_phase(F, Z, EV_LD, EV_XQ, EV_G + 1536, (const bf16_t*)(ws + WS_MKV0), F.bid, F.G);
    }
    SEAM(2);
    if (IN(3)) ret_scan_phase(F, (float*)(ws + WS_R));
    SEAM(3);
    if (IN(4)) ret_c_phase(F, Z, (const float*)(ws + WS_R), F.bid, F.G);
    SEAM(4);
    if (IN(5)) {
        pg8::StaticOrder S; S.init(MTOK, DM, F.G, F.bid);
        pg8::Gemm g{Z + EV_G, (const bf16_t*)(ws + WS_WO0), MTOK, DM, DIN, EV_LD};
        EpiOut E{args.in[0], args.out, HB, part};
        pg8::gemm_phase(F.lds, g, S, E);
    }
    SEAM(5);
    if (IN(6)) {
        pg8::StaticOrder S; S.init(MTOK, OD_N, F.G, F.bid); fill_rstd(F, S, part);
        pg8::Gemm g{HB, (const bf16_t*)(ws + WS_W1), MTOK, OD_N, DM, DM};
        EpiIn E{Z, OD_LD, (const LAS float*)(F.lds + RSTD_OFF), OD_G / 256, OD_LD / 256, (float*)(ws + WS_GATES), 0, 0};
        pg8::gemm_phase(F.lds, g, S, E);
    }
    SEAM(6);
    if (IN(7)) {
        if (F.bid < 128) compress_phase(F, Z, (const bf16_t*)(ws + WS_WC1), (const bf16_t*)(ws + WS_WC2), args.in[14], (const float*)(ws + WS_MISC + 65536), (bf16_t*)(ws + WS_KCMP), (bf16_t*)(ws + WS_VCMP), F.bid, 128);
        else mem_attn_phase(F, Z, OD_LD, OD_XQ, OD_G + 1536, (const bf16_t*)(ws + WS_MKV1), F.bid - 128, F.G - 128);
    }
    SEAM(7);
    if (IN(8)) nsa_phase(F, Z, (const float*)(ws + WS_GATES), (const bf16_t*)(ws + WS_KCMP), (const bf16_t*)(ws + WS_VCMP), (const float*)(ws + WS_MISC));
    SEAM(8); SEAM(9);
    if (IN(10)) {
        pg8::StaticOrder S; S.init(MTOK, DM, F.G, F.bid);
        pg8::Gemm g{Z + OD_G, (const bf16_t*)(ws + WS_WO1), MTOK, DM, DIN, OD_LD};
        EpiOut E{args.out, args.out, HB, part};
        pg8::gemm_phase(F.lds, g, S, E);
    }
    SEAM(10);
    if (IN(11)) final_norm(F, args.out, part, args.in[3]);
#undef IN
#undef SEAM
}

extern "C" void kernel_launch(void* const* d_in, const int* in_sizes, int n_in, void* d_out, int out_size, void* d_ws, size_t ws_size, hipStream_t stream) {
    static int grid = 0;
    if (grid == 0) {
        if (n_in != 18 || out_size != MTOK * DM || ws_size < WS_END) { fprintf(stderr, "kernel_launch: unexpected shapes: n_in %d out %d ws %zu (need %zu)\n", n_in, out_size, ws_size, (size_t)WS_END); grid = -1; return; }
        int dev = 0, cus = 0, per_cu = 0;
        hipGetDevice(&dev); hipDeviceGetAttribute(&cus, hipDeviceAttributeMultiprocessorCount, dev);
        if (hipFuncSetAttribute((const void*)fwd_kernel, hipFuncAttributeMaxDynamicSharedMemorySize, LDS_BYTES) != hipSuccess) { fprintf(stderr, "kernel_launch: hipFuncSetAttribute failed\n"); grid = -1; return; }
        if (hipOccupancyMaxActiveBlocksPerMultiprocessor(&per_cu, (const void*)fwd_kernel, 512, LDS_BYTES) != hipSuccess || per_cu < 1) { fprintf(stderr, "kernel_launch: occupancy query says %d\n", per_cu); per_cu = 1; }
        (void)hipGetLastError();
        grid = cus;
    }
    if (grid < 0) return;
    if (hipMemsetAsync((char*)d_ws + WS_CTL, 0, CTL_BYTES, stream) != hipSuccess) { fprintf(stderr, "kernel_launch: memset failed\n"); return; }
    Args a{};
    for (int i = 0; i < 18; ++i) a.in[i] = (const float*)d_in[i];
    a.out = (float*)d_out; a.ws = (unsigned char*)d_ws; a.ph_lo = 0; a.ph_hi = NPHASE;
    void* kargs[] = {&a};
    hipError_t e = hipLaunchCooperativeKernel((const void*)fwd_kernel, dim3(grid), dim3(512), kargs, LDS_BYTES, stream);
    if (e != hipSuccess) fprintf(stderr, "kernel_launch: cooperative launch failed: %s (grid %d)\n", hipGetErrorString(e), grid);
}
```

```cpp
#include <hip/hip_runtime.h>
#include <hip/hip_cooperative_groups.h>
#include <cstdio>
#include <cstdint>
namespace cg = cooperative_groups;

#define LAS __attribute__((address_space(3)))
#define GAS __attribute__((address_space(1)))
typedef unsigned short bf16_t;
typedef short bf16x8 __attribute__((ext_vector_type(8)));
typedef short s16x4 __attribute__((ext_vector_type(4)));
typedef float f32x4 __attribute__((ext_vector_type(4)));
typedef float f32x16 __attribute__((ext_vector_type(16)));
typedef unsigned u32x4 __attribute__((ext_vector_type(4)));
typedef unsigned u32x2 __attribute__((ext_vector_type(2)));

#ifndef PROBE_REP
#define PROBE_REP 0
#endif
#ifndef PROBE_VARIANT
#define PROBE_VARIANT 0
#endif
constexpr int BATCH = 8, SEQ = 4096, DM = 1024, MTOK = BATCH * SEQ, NMEM = 256, DIN = 2048;
constexpr float EPS = 1e-6f;
constexpr float LOG2E = 1.4426950408889634f;
constexpr int EV_LD = 5120, EV_ZA = 0, EV_RQ = 768, EV_RK = 1280, EV_RV = 1792, EV_XQ = 2560, EV_G = 3072;
constexpr int OD_LD = 5632, OD_N = 5888, OD_COLS = 5668, OD_Q = 0, OD_KC = 1536, OD_VC = 1792, OD_KS = 2048, OD_VS = 2304, OD_KW = 2560, OD_VW = 2816, OD_XQ = 3072, OD_G = 3584;
constexpr int GATE_LD = 40;
constexpr size_t MiB = 1u << 20;
constexpr size_t WS_CTL = 0, CTL_BYTES = 1 * MiB;
constexpr size_t WS_W0 = 1 * MiB;
constexpr size_t WS_W1 = WS_W0 + (size_t)EV_LD * DM * 2;
constexpr size_t WS_WO0 = WS_W1 + (size_t)OD_N * DM * 2;
constexpr size_t WS_WO1 = WS_WO0 + (size_t)DM * DIN * 2;
constexpr size_t WS_WM0 = WS_WO1 + (size_t)DM * DIN * 2;
constexpr size_t WS_WM1 = WS_WM0 + (size_t)DM * DM * 2;
constexpr size_t WS_WC1 = WS_WM1 + (size_t)DM * DM * 2;
constexpr size_t WS_WC2 = WS_WC1 + (size_t)2 * 256 * 4096 * 2;
constexpr size_t WS_WP = WS_WC2 + (size_t)2 * 128 * 256 * 2;
constexpr size_t WS_WEND = WS_WP + (size_t)4 * 192 * 192 * 2;
static_assert(WS_WEND <= 41 * MiB, "weights");
constexpr size_t WS_MEMN = 41 * MiB, WS_MKV0 = 45 * MiB, WS_MKV1 = 49 * MiB;
constexpr size_t WS_ROPE = 53 * MiB;
constexpr size_t WS_PART = 55 * MiB;
constexpr size_t WS_MISC = 57 * MiB;
constexpr size_t WS_Z = 58 * MiB;
constexpr size_t WS_R = 410 * MiB;
constexpr size_t WS_GATES = WS_R + 64 * MiB;
constexpr size_t WS_KCMP = WS_R + 70 * MiB, WS_VCMP = WS_R + 71 * MiB;
constexpr size_t WS_END = 506 * MiB;

constexpr int RING_BYTES = 131072, RSTD_OFF = RING_BYTES, RSTD_BYTES = 12 * 1024, MISC_OFF = RSTD_OFF + RSTD_BYTES, LDS_BYTES = 147456;

__device__ __forceinline__ unsigned f2bf(float f) { unsigned u = __builtin_bit_cast(unsigned, f); return (u + 0x7fffu + ((u >> 16) & 1u)) >> 16; }
__device__ __forceinline__ unsigned pk2(float lo, float hi) { return f2bf(lo) | (f2bf(hi) << 16); }
__device__ __forceinline__ float bf2f(unsigned short b) { return __builtin_bit_cast(float, (unsigned)b << 16); }
__device__ __forceinline__ unsigned cvt_pk_bf16(float lo, float hi) { unsigned r; asm volatile("v_cvt_pk_bf16_f32 %0, %1, %2" : "=v"(r) : "v"(lo), "v"(hi)); return r; }
__device__ __forceinline__ float wave_sum(float v) {
#pragma unroll
    for (int o = 1; o < 64; o <<= 1) v += __shfl_xor(v, o);
    return v;
}
__device__ __forceinline__ float fast_sigmoid(float v) { return __builtin_amdgcn_rcpf(1.f + __builtin_amdgcn_exp2f(-v * LOG2E)); }
#define LDS_WAIT() asm volatile("s_waitcnt lgkmcnt(0)" ::: "memory")
#define VM_WAIT() asm volatile("s_waitcnt vmcnt(0)" ::: "memory")

#define XB_TMO      128
#define XB_XCNT(j)  (256  + 64 * (j))
#define XB_XSUB(j)  (1280 + 64 * (j))
#define XB_XGEN(j)  (2304 + 64 * (j))
#define XB_TOP      3328
#define XB_TOPGEN   3392
#define XCD_BAR_WORDS 3456
#define XB_SPIN_CAP (1u << 18)
__device__ __forceinline__ unsigned xb_ld(unsigned* p)              { return __hip_atomic_load(p, __ATOMIC_RELAXED, __HIP_MEMORY_SCOPE_AGENT); }
__device__ __forceinline__ unsigned xb_add(unsigned* p, unsigned v) { return __hip_atomic_fetch_add(p, v, __ATOMIC_RELAXED, __HIP_MEMORY_SCOPE_AGENT); }
__device__ __forceinline__ unsigned xb_xcc_id() { return (unsigned)__builtin_amdgcn_s_getreg((3 << 11) | 20) & 0xFu; }
#define XB_SPIN(cond, bar) do { unsigned _sp = 0; while (cond) { __builtin_amdgcn_s_sleep(1); \
    if ((++_sp & 255u) == 0u) { if (xb_ld(&(bar)[XB_TMO])) break; if (_sp > XB_SPIN_CAP) { atomicAdd(&(bar)[XB_TMO], 1u); break; } } } } while (0)
struct XcdBarrier { unsigned* bar; unsigned x; volatile LAS unsigned* st; };
__device__ __forceinline__ XcdBarrier xcd_barrier_post(unsigned* bar, volatile LAS unsigned* st) {
    XcdBarrier b; b.bar = bar; b.x = xb_xcc_id(); b.st = st;
    if (threadIdx.x == 0) (void)xb_add(&bar[XB_XCNT(b.x)], 1u);
    return b;
}
__device__ __forceinline__ void xcd_barrier_complete(unsigned* bar, unsigned x, unsigned& nloc, unsigned& nx) {
    const unsigned G = gridDim.x * gridDim.y * gridDim.z;
    unsigned sum, cnt, mine, sp = 0u;
    for (;;) {
        sum = 0u; cnt = 0u; mine = 0u;
#pragma unroll
        for (unsigned j = 0; j < 16; ++j) { const unsigned c = xb_ld(&bar[XB_XCNT(j)]); sum += c; cnt += (c > 0u) ? 1u : 0u; mine = (j == x) ? c : mine; }
        if (sum == G) break;
        __builtin_amdgcn_s_sleep(1);
        if ((++sp & 255u) == 0u) { if (xb_ld(&bar[XB_TMO])) break; if (sp > XB_SPIN_CAP) { atomicAdd(&bar[XB_TMO], 1u); break; } }
    }
    nloc = mine > 0u ? mine : 1u; nx = cnt > 0u ? cnt : 1u;
}
__device__ __forceinline__ void xcd_barrier(const XcdBarrier& b) {
    asm volatile("s_waitcnt vmcnt(0)" ::: "memory");
    __syncthreads();
    if (threadIdx.x == 0) {
        unsigned* bar = b.bar;
        __builtin_amdgcn_s_waitcnt(0);
        unsigned nloc = b.st[0], nx = b.st[1];
        if (nloc == 0u) { xcd_barrier_complete(bar, b.x, nloc, nx); b.st[0] = nloc; b.st[1] = nx; }
        const unsigned old = xb_add(&bar[XB_XSUB(b.x)], 1u);
        const unsigned gen = old / nloc;
        if (old + 1u == (gen + 1u) * nloc) {
            __builtin_amdgcn_fence(__ATOMIC_RELEASE, "agent");
            asm volatile("s_waitcnt vmcnt(0)" ::: "memory");
            const unsigned og = xb_add(&bar[XB_TOP], 1u);
            const unsigned tg = og / nx;
            if (og + 1u == (tg + 1u) * nx) xb_add(&bar[XB_TOPGEN], 1u);
            else XB_SPIN(xb_ld(&bar[XB_TOPGEN]) == tg, bar);
            __builtin_amdgcn_fence(__ATOMIC_ACQUIRE, "agent");
            xb_add(&bar[XB_XGEN(b.x)], 1u);
            asm volatile("s_waitcnt vmcnt(0)" ::: "memory");
        } else {
            XB_SPIN(xb_ld(&bar[XB_XGEN(b.x)]) == gen, bar);
            __builtin_amdgcn_fence(__ATOMIC_ACQUIRE, "agent");
            asm volatile("s_waitcnt vmcnt(0)" ::: "memory");
        }
    }
    __syncthreads();
}

namespace pg8 {
constexpr int BM = 256, BK = 64, HALF = 128, HTB = HALF * BK * 2, STAGE_BYTES = 8 * HTB, NXCD = 8, WGM = 8;
__host__ __device__ __forceinline__ int lds_byte(int r, int c) { const int st = (r >> 4) * 2 + (c >> 5), rr = r & 15, cc = c & 31, ob = rr * 64 + cc * 2; return st * 1024 + (ob ^ (((ob >> 9) & 1) << 5)); }
__host__ __device__ __forceinline__ void stage_rc(int b, int& R, int& C) { const int st = b / 1024, sb = b % 1024, swz = sb ^ (((sb >> 9) & 1) << 5); R = (st >> 1) * 16 + swz / 64; C = (st & 1) * 32 + (swz % 64) / 2; }
__host__ __device__ __forceinline__ int perm32(int rho) { const int n = rho >> 4, i = rho & 15; return 8 * (i >> 2) + 4 * n + (i & 3); }
struct Unit { int pm, pn, idx; };
struct Gemm { const bf16_t* A; const bf16_t* Bt; int M, N, K, lda; };
struct StaticOrder {
    int nM, nN, nwg, G, c;
    __device__ void init(int M, int N, int G_, int c_) { nM = M / BM; nN = N / BM; nwg = nM * nN; G = G_; c = c_; }
    __device__ bool next(int i, Unit& u) const {
        const long L = (long)i * G + c; if (L >= nwg) return false;
        int wgid = (int)L; { const int q = nwg / NXCD, r = nwg % NXCD, xcd = wgid % NXCD, off = wgid / NXCD; wgid = (xcd < r ? xcd * (q + 1) : r * (q + 1) + (xcd - r) * q) + off; }
        const int nig = WGM * nN, gid = wgid / nig, fm = gid * WGM, gsz = (nM - fm) < WGM ? (nM - fm) : WGM;
        u.pm = fm + ((wgid % nig) % gsz); u.pn = (wgid % nig) / gsz; u.idx = i; return true;
    }
};
template <class Epi>
__device__ __forceinline__ void gemm_phase(LAS unsigned char* lds, const Gemm g, const StaticOrder& S, const Epi& E) {
    const int tid = threadIdx.x, wid = __builtin_amdgcn_readfirstlane(tid >> 6), lane = tid & 63, wr = wid >> 2, wc = wid & 3, fr = lane & 15, fq = lane >> 4;
    const int K = g.K, nt = K / BK, lda = g.lda;
    unsigned voffA[2], voffB[2];
#pragma unroll
    for (int i = 0; i < 2; ++i) { int R, C; stage_rc(tid * 16 + i * 8192, R, C); const int Rb = (R & ~31) + perm32(R & 31);
        voffA[i] = (unsigned)(R * lda + C) * 2u; voffB[i] = (unsigned)(Rb * K + C) * 2u; }
    const size_t kstep = (size_t)(BK * 2);
    const size_t hstepA = (size_t)HALF * lda * 2, hstepB = (size_t)HALF * K * 2;
    const size_t tstepA = 2 * hstepA, tstepB = 2 * hstepB;
    const unsigned ldsw = (unsigned)wid * 1024u;
    const int aoff = lds_byte(wr * 64 + fr, fq * 8), boff = lds_byte(wc * 32 + fr, fq * 8);
#define PG8_SA(b, h) (((b) * 2 + (h)) * HTB)
#define PG8_SB(b, h) ((4 + (b) * 2 + (h)) * HTB)
#define PG8_STAGE(bufoff, gbase, voff) do { _Pragma("unroll") for (int _i = 0; _i < 2; ++_i) \
        __builtin_amdgcn_global_load_lds((const unsigned*)((const char*)(gbase) + (voff)[_i]), (LAS unsigned*)(lds + (bufoff) + ldsw + _i * 8192), 16, 0, 0); } while (0)
#define PG8_LDA(dst, b, h) do { _Pragma("unroll") for (int m = 0; m < 4; ++m) _Pragma("unroll") for (int k = 0; k < 2; ++k) dst[m][k] = *(const LAS bf16x8*)(lds + PG8_SA(b, h) + aoff + m * 2048 + k * 1024); } while (0)
#define PG8_LDB(dst, b, h) do { _Pragma("unroll") for (int n = 0; n < 2; ++n) _Pragma("unroll") for (int k = 0; k < 2; ++k) dst[n][k] = *(const LAS bf16x8*)(lds + PG8_SB(b, h) + boff + n * 2048 + k * 1024); } while (0)
#define PG8_MMA(ai, bj, At, Bt) do { __builtin_amdgcn_s_setprio(1); _Pragma("unroll") for (int m = 0; m < 4; ++m) _Pragma("unroll") for (int n = 0; n < 2; ++n) _Pragma("unroll") for (int k = 0; k < 2; ++k) \
        acc[ai][bj][m][n] = __builtin_amdgcn_mfma_f32_16x16x32_bf16(Bt[n][k], At[m][k], acc[ai][bj][m][n], 0, 0, 0); __builtin_amdgcn_s_setprio(0); } while (0)
#define PG8_WAIT_V(n) asm volatile("s_waitcnt vmcnt(" #n ")" ::: "memory")
#define PG8_WAIT_L(n) asm volatile("s_waitcnt lgkmcnt(" #n ")" ::: "memory")
#define PG8_BAR __builtin_amdgcn_s_barrier()
#define PG8_SCHED __builtin_amdgcn_sched_barrier(0)
    Unit cur, nxt; int ui = 0;
    if (!S.next(0, cur)) return;
    f32x4 acc[2][2][4][2];
#pragma unroll
    for (int a = 0; a < 2; ++a)
#pragma unroll
        for (int b = 0; b < 2; ++b)
#pragma unroll
            for (int m = 0; m < 4; ++m)
#pragma unroll
                for (int n = 0; n < 2; ++n) acc[a][b][m][n] = (f32x4){0.f, 0.f, 0.f, 0.f};
    bf16x8 At[4][2], B0[2][2], B1[2][2];
    const char* cA = (const char*)g.A + (size_t)cur.pm * tstepA; const char* cB = (const char*)g.Bt + (size_t)cur.pn * tstepB;
    PG8_STAGE(PG8_SB(0, 0), cB, voffB); PG8_STAGE(PG8_SB(0, 1), cB + hstepB, voffB); PG8_STAGE(PG8_SA(0, 0), cA, voffA); PG8_STAGE(PG8_SA(0, 1), cA + hstepA, voffA);
    if (wr == 1) PG8_BAR;
    PG8_WAIT_V(2); PG8_BAR;
    PG8_STAGE(PG8_SB(1, 0), cB + kstep, voffB); PG8_STAGE(PG8_SA(1, 0), cA + kstep, voffA); PG8_STAGE(PG8_SB(1, 1), cB + hstepB + kstep, voffB);
    PG8_WAIT_V(6); PG8_BAR;
    for (;;) {
        const bool has_next = S.next(ui + 1, nxt);
        const char* nA = has_next ? (const char*)g.A + (size_t)nxt.pm * tstepA : cA; const char* nB = has_next ? (const char*)g.Bt + (size_t)nxt.pn * tstepB : cB;
        for (int t = 0; t < nt; t += 2) {
            const bool last = (t == nt - 2);
            const char* a1 = cA + (size_t)(t + 1) * kstep;
            const char* a2 = last ? nA : cA + (size_t)(t + 2) * kstep; const char* b2 = last ? nB : cB + (size_t)(t + 2) * kstep;
            const char* a3 = a2 + kstep; const char* b3 = b2 + kstep;
            PG8_LDB(B0, 0, 0); PG8_LDB(B1, 0, 1); PG8_SCHED; PG8_LDA(At, 0, 0); PG8_STAGE(PG8_SA(1, 1), a1 + hstepA, voffA);
            PG8_WAIT_V(8); PG8_WAIT_L(0); PG8_BAR; PG8_MMA(0, 0, At, B0); PG8_MMA(0, 1, At, B1); PG8_BAR; PG8_SCHED;
            PG8_LDA(At, 0, 1); PG8_STAGE(PG8_SB(0, 0), b2, voffB); PG8_STAGE(PG8_SB(0, 1), b2 + hstepB, voffB); PG8_STAGE(PG8_SA(0, 0), a2, voffA);
            PG8_WAIT_V(8); PG8_WAIT_L(0); PG8_BAR; PG8_MMA(1, 0, At, B0); PG8_MMA(1, 1, At, B1); PG8_BAR; PG8_SCHED;
            PG8_LDB(B0, 1, 0); PG8_LDB(B1, 1, 1); PG8_SCHED; PG8_LDA(At, 1, 0); PG8_STAGE(PG8_SA(0, 1), a2 + hstepA, voffA);
            PG8_WAIT_V(8); PG8_WAIT_L(0); PG8_BAR; PG8_MMA(0, 0, At, B0); PG8_MMA(0, 1, At, B1); PG8_BAR; PG8_SCHED;
            PG8_LDA(At, 1, 1); PG8_STAGE(PG8_SB(1, 0), b3, voffB); PG8_STAGE(PG8_SB(1, 1), b3 + hstepB, voffB); PG8_STAGE(PG8_SA(1, 0), a3, voffA);
            PG8_WAIT_V(8); PG8_WAIT_L(0); PG8_BAR; PG8_MMA(1, 0, At, B0); PG8_MMA(1, 1, At, B1); PG8_BAR; PG8_SCHED;
        }
        if (wr == 0) PG8_BAR;
        E(acc, cur, wr, wc, fr, fq);
        if (!has_next) break;
#pragma unroll
        for (int a = 0; a < 2; ++a)
#pragma unroll
            for (int b = 0; b < 2; ++b)
#pragma unroll
                for (int m = 0; m < 4; ++m)
#pragma unroll
                    for (int n = 0; n < 2; ++n) acc[a][b][m][n] = (f32x4){0.f, 0.f, 0.f, 0.f};
        cur = nxt; cA = nA; cB = nB; ++ui;
        if (wr == 1) PG8_BAR;
    }
    PG8_WAIT_V(0);
    PG8_BAR;
#undef PG8_SA
#undef PG8_SB
#undef PG8_STAGE
#undef PG8_LDA
#undef PG8_LDB
#undef PG8_MMA
#undef PG8_WAIT_V
#undef PG8_WAIT_L
#undef PG8_BAR
#undef PG8_SCHED
}
}

struct EpiIn {
    bf16_t* Z; int ldz; const LAS float* rstd; int pn_silu, pn_gate; float* gates; int zlo, zhi;
    __device__ __forceinline__ void operator()(const f32x4 (&acc)[2][2][4][2], const pg8::Unit& u, int wr, int wc, int fr, int fq) const {
        const int rl0 = wr * 64 + fr, col0 = u.pn * 256 + wc * 32 + 8 * fq;
        const bool is_gate = (u.pn == pn_gate), is_silu = (u.pn >= pn_silu) && !is_gate;
#pragma unroll
        for (int ai = 0; ai < 2; ++ai)
#pragma unroll
            for (int m = 0; m < 4; ++m) {
                const int rl = rl0 + ai * 128 + m * 16; const float rs = rstd[u.idx * 256 + rl]; const size_t row = (size_t)u.pm * 256 + rl;
#pragma unroll
                for (int bj = 0; bj < 2; ++bj) {
                    f32x4 v0 = acc[ai][bj][m][0] * rs, v1 = acc[ai][bj][m][1] * rs;
                    if (is_gate) {
                        const int c = wc * 32 + 8 * fq + bj * 128;
                        if (c < 36) { float* gp = gates + row * GATE_LD + c;
#pragma unroll
                            for (int j = 0; j < 4; ++j) { gp[j] = fast_sigmoid(v0[j]); if (c + 4 + j < 36) gp[4 + j] = fast_sigmoid(v1[j]); } }
                    } else {
                        if (is_silu) {
#pragma unroll
                            for (int j = 0; j < 4; ++j) { v0[j] = v0[j] * fast_sigmoid(v0[j]); v1[j] = v1[j] * fast_sigmoid(v1[j]); }
                            if (u.pn >= zlo && u.pn < zhi) { v0 = (f32x4){0.f, 0.f, 0.f, 0.f}; v1 = v0; }
                        }
                        u32x4 w; w.x = cvt_pk_bf16(v0[0], v0[1]); w.y = cvt_pk_bf16(v0[2], v0[3]); w.z = cvt_pk_bf16(v1[0], v1[1]); w.w = cvt_pk_bf16(v1[2], v1[3]);
                        *(u32x4*)(Z + row * ldz + col0 + bj * 128) = w;
                    }
                }
            }
    }
};
struct EpiBf {
    bf16_t* O; int ldc;
    __device__ __forceinline__ void operator()(const f32x4 (&acc)[2][2][4][2], const pg8::Unit& u, int wr, int wc, int fr, int fq) const {
        const int row0 = u.pm * 256 + wr * 64 + fr, col0 = u.pn * 256 + wc * 32 + 8 * fq;
#pragma unroll
        for (int ai = 0; ai < 2; ++ai)
#pragma unroll
            for (int m = 0; m < 4; ++m)
#pragma unroll
                for (int bj = 0; bj < 2; ++bj) {
                    const f32x4 v0 = acc[ai][bj][m][0], v1 = acc[ai][bj][m][1];
                    u32x4 w; w.x = cvt_pk_bf16(v0[0], v0[1]); w.y = cvt_pk_bf16(v0[2], v0[3]); w.z = cvt_pk_bf16(v1[0], v1[1]); w.w = cvt_pk_bf16(v1[2], v1[3]);
                    *(u32x4*)(O + (size_t)(row0 + ai * 128 + m * 16) * ldc + col0 + bj * 128) = w;
                }
    }
};
struct EpiOut {
    const float* base; float* out; bf16_t* hb; float* part; int dry;
    __device__ __forceinline__ void operator()(const f32x4 (&acc)[2][2][4][2], const pg8::Unit& u, int wr, int wc, int fr, int fq) const {
        const int row0 = u.pm * 256 + wr * 64 + fr, col0 = u.pn * 256 + wc * 32 + 8 * fq;
#pragma unroll
        for (int ai = 0; ai < 2; ++ai)
#pragma unroll
            for (int m = 0; m < 4; ++m) {
                const size_t row = (size_t)(row0 + ai * 128 + m * 16); float ss = 0.f;
#pragma unroll
                for (int bj = 0; bj < 2; ++bj) {
                    const size_t off = row * DM + col0 + bj * 128;
                    const f32x4 b0 = *(const f32x4*)(base + off), b1 = *(const f32x4*)(base + off + 4);
                    const f32x4 v0 = acc[ai][bj][m][0] + b0, v1 = acc[ai][bj][m][1] + b1;
                    if (!dry) { *(f32x4*)(out + off) = v0; *(f32x4*)(out + off + 4) = v1; }
                    u32x4 w; w.x = cvt_pk_bf16(v0[0], v0[1]); w.y = cvt_pk_bf16(v0[2], v0[3]); w.z = cvt_pk_bf16(v1[0], v1[1]); w.w = cvt_pk_bf16(v1[2], v1[3]);
                    if (!dry) *(u32x4*)(hb + off) = w;
                    ss += (v0[0] * v0[0] + v0[1] * v0[1]) + (v0[2] * v0[2] + v0[3] * v0[3]) + (v1[0] * v1[0] + v1[1] * v1[1]) + (v1[2] * v1[2] + v1[3] * v1[3]);
                }
                ss += __shfl_xor(ss, 16); ss += __shfl_xor(ss, 32);
                if (fq == 0 && !dry) part[row * 16 + u.pn * 4 + wc] = ss;
            }
    }
};

struct Args { const float* in[18]; float* out; unsigned char* ws; int ph_lo, ph_hi; };
struct Frame {
    LAS unsigned char* lds; int tid, lane, wave, G, bid;
    unsigned char* ws; int dry;
};
#define KSWZ(row, colB) ((row) * 256 + ((colB) ^ (((row) & 7) << 4)))
#define SBAR() __builtin_amdgcn_sched_barrier(0)
__device__ __forceinline__ int crow(int r, int hi) { return (r & 3) + 8 * (r >> 2) + 4 * hi; }
template <int NCB> __device__ __forceinline__ int v_st(int k, int c) { const int kk = (k & ~0xC) | ((k & 4) << 1) | ((k & 8) >> 1); return ((kk >> 3) * NCB + (c >> 5)) * 512 + ((kk & 7) * 32 + (c & 31)) * 2; }
__device__ __forceinline__ int v_rd_base(int lane) { return ((lane & 3) << 3) | (((lane >> 2) & 3) << 6) | (((lane >> 4) & 1) << 5) | (((lane >> 5) & 1) << 8); }
template <int OFF> __device__ __forceinline__ s16x4 tr_read(int vb) { s16x4 r; asm volatile("ds_read_b64_tr_b16 %0, %1 offset:%2" : "=&v"(r) : "v"(vb), "i"(OFF) : "memory"); return r; }
__device__ __forceinline__ int lds_addr(const LAS void* p) { return (int)(unsigned)(size_t)p; }
__device__ __forceinline__ void qkt(f32x16& p0, f32x16& p1, const LAS char* Ks, const bf16x8* qr, int r32, int hi) {
    p0 = f32x16{}; p1 = f32x16{};
#pragma unroll
    for (int d0 = 0; d0 < 8; ++d0) { const int cb = (d0 * 16 + hi * 8) * 2;
        const bf16x8 b0 = *(const LAS bf16x8*)(Ks + KSWZ(r32, cb));
        const bf16x8 b1 = *(const LAS bf16x8*)(Ks + KSWZ(32 + r32, cb));
        p0 = __builtin_amdgcn_mfma_f32_32x32x16_bf16(b0, qr[d0], p0, 0, 0, 0);
        p1 = __builtin_amdgcn_mfma_f32_32x32x16_bf16(b1, qr[d0], p1, 0, 0, 0); }
}
__device__ __forceinline__ void qkt_lq(f32x16& p0, f32x16& p1, const LAS char* Ks, const LAS char* ql, int r32, int hi) {
    p0 = f32x16{}; p1 = f32x16{};
#pragma unroll
    for (int d0 = 0; d0 < 8; ++d0) { const int cb = (d0 * 16 + hi * 8) * 2;
        const bf16x8 q = *(const LAS bf16x8*)(ql + d0 * 1024);
        const bf16x8 b0 = *(const LAS bf16x8*)(Ks + KSWZ(r32, cb));
        const bf16x8 b1 = *(const LAS bf16x8*)(Ks + KSWZ(32 + r32, cb));
        p0 = __builtin_amdgcn_mfma_f32_32x32x16_bf16(b0, q, p0, 0, 0, 0);
        p1 = __builtin_amdgcn_mfma_f32_32x32x16_bf16(b1, q, p1, 0, 0, 0); }
}
__device__ __forceinline__ void pack_p(const f32x16& p0, const f32x16& p1, bf16x8& pa0, bf16x8& pa1, bf16x8& pa2, bf16x8& pa3) {
#define PK4(P, BASE, OUT) do { unsigned a0 = cvt_pk_bf16(P[BASE + 0], P[BASE + 1]), a1 = cvt_pk_bf16(P[BASE + 2], P[BASE + 3]);   \
    unsigned b0 = cvt_pk_bf16(P[BASE + 4], P[BASE + 5]), b1 = cvt_pk_bf16(P[BASE + 6], P[BASE + 7]);                              \
    auto r0 = __builtin_amdgcn_permlane32_swap(a0, b0, false, false); auto r1 = __builtin_amdgcn_permlane32_swap(a1, b1, false, false); \
    u32x4 w = {r0[0], r1[0], r0[1], r1[1]}; OUT = __builtin_bit_cast(bf16x8, w); } while (0)
    PK4(p0, 0, pa0); PK4(p0, 8, pa1); PK4(p1, 0, pa2); PK4(p1, 8, pa3);
#undef PK4
}
__device__ __forceinline__ float xhalf_max(float v) { auto rr = __builtin_amdgcn_permlane32_swap(__float_as_uint(v), __float_as_uint(v), false, false); return fmaxf(__uint_as_float(rr[0]), __uint_as_float(rr[1])); }
__device__ __forceinline__ float xhalf_sum(float v) { auto rr = __builtin_amdgcn_permlane32_swap(__float_as_uint(v), __float_as_uint(v), false, false); return __uint_as_float(rr[0]) + __uint_as_float(rr[1]); }
template <int ND> __device__ __forceinline__ void softmax_step(f32x16& p0, f32x16& p1, float& m, float& l, f32x16 (&o)[ND]) {
    float pmax = p0[0];
#pragma unroll
    for (int r = 1; r < 16; ++r) pmax = fmaxf(pmax, p0[r]);
#pragma unroll
    for (int r = 0; r < 16; ++r) pmax = fmaxf(pmax, p1[r]);
    pmax = xhalf_max(pmax);
    const float mn = fmaxf(m, pmax);
    const float alpha = __builtin_amdgcn_exp2f(m - mn);
    m = mn;
    float ps = 0.f;
#pragma unroll
    for (int r = 0; r < 16; ++r) { p0[r] = __builtin_amdgcn_exp2f(p0[r] - mn); ps += p0[r]; }
#pragma unroll
    for (int r = 0; r < 16; ++r) { p1[r] = __builtin_amdgcn_exp2f(p1[r] - mn); ps += p1[r]; }
    ps = xhalf_sum(ps);
    l = l * alpha + ps;
    if (__any(alpha != 1.f)) {
#pragma unroll
        for (int d = 0; d < ND; ++d)
#pragma unroll
            for (int r = 0; r < 16; ++r) o[d][r] *= alpha;
    }
}
template <int NCB, int D0> __device__ __forceinline__ void pv_one(f32x16& od, int vb, bf16x8 pa0, bf16x8 pa1, bf16x8 pa2, bf16x8 pa3) {
    constexpr int KS = NCB * 1024, HF = NCB * 512, B0 = D0 * 512;
    const s16x4 l0 = tr_read<B0>(vb), h0 = tr_read<B0 + HF>(vb), l1 = tr_read<B0 + KS>(vb), h1 = tr_read<B0 + KS + HF>(vb);
    const s16x4 l2 = tr_read<B0 + 2 * KS>(vb), h2 = tr_read<B0 + 2 * KS + HF>(vb), l3 = tr_read<B0 + 3 * KS>(vb), h3 = tr_read<B0 + 3 * KS + HF>(vb);
    asm volatile("s_waitcnt lgkmcnt(0)" ::: "memory"); SBAR();
#define PKV(L, H) (bf16x8){L[0], L[1], L[2], L[3], H[0], H[1], H[2], H[3]}
    od = __builtin_amdgcn_mfma_f32_32x32x16_bf16(PKV(l0, h0), pa0, od, 0, 0, 0);
    od = __builtin_amdgcn_mfma_f32_32x32x16_bf16(PKV(l1, h1), pa1, od, 0, 0, 0);
    od = __builtin_amdgcn_mfma_f32_32x32x16_bf16(PKV(l2, h2), pa2, od, 0, 0, 0);
    od = __builtin_amdgcn_mfma_f32_32x32x16_bf16(PKV(l3, h3), pa3, od, 0, 0, 0);
#undef PKV
}
template <int NCB> __device__ __forceinline__ void pv_all(f32x16 (&o)[NCB], int vb, bf16x8 pa0, bf16x8 pa1, bf16x8 pa2, bf16x8 pa3) {
    pv_one<NCB, 0>(o[0], vb, pa0, pa1, pa2, pa3); pv_one<NCB, 1>(o[1], vb, pa0, pa1, pa2, pa3); pv_one<NCB, 2>(o[2], vb, pa0, pa1, pa2, pa3); pv_one<NCB, 3>(o[3], vb, pa0, pa1, pa2, pa3);
    if constexpr (NCB == 6) { pv_one<NCB, 4>(o[4], vb, pa0, pa1, pa2, pa3); pv_one<NCB, 5>(o[5], vb, pa0, pa1, pa2, pa3); }
}
struct KReg { bf16x8 a, b; };
template <int NCB> struct VReg { bf16x8 v[NCB == 4 ? 2 : 3]; };
__device__ __forceinline__ void k_load(KReg& s, const bf16_t* kp, size_t ld, int tid) { const int sr = tid >> 4, sc = (tid & 15) * 8;
    s.a = *(const bf16x8*)(kp + (size_t)sr * ld + sc); s.b = *(const bf16x8*)(kp + (size_t)(32 + sr) * ld + sc); }
__device__ __forceinline__ void k_write(LAS char* Kl, const KReg& s, int tid) { const int sr = tid >> 4, kc = (tid & 15) * 16;
    *(LAS bf16x8*)(Kl + KSWZ(sr, kc)) = s.a; *(LAS bf16x8*)(Kl + KSWZ(32 + sr, kc)) = s.b; }
template <int NCB> __device__ __forceinline__ void v_load(VReg<NCB>& s, const bf16_t* vp, size_t ld, int tid) {
    if constexpr (NCB == 4) { const int sr = tid >> 4, sc = (tid & 15) * 8; s.v[0] = *(const bf16x8*)(vp + (size_t)sr * ld + sc); s.v[1] = *(const bf16x8*)(vp + (size_t)(32 + sr) * ld + sc); }
    else {
#pragma unroll
        for (int i = 0; i < 3; ++i) { const int id = tid + 512 * i, row = id / 24, c = (id % 24) * 8; s.v[i] = *(const bf16x8*)(vp + (size_t)row * ld + c); } }
}
template <int NCB> __device__ __forceinline__ void v_write(LAS char* Vl, const VReg<NCB>& s, int tid) {
    if constexpr (NCB == 4) { const int sr = tid >> 4, sc = (tid & 15) * 8; *(LAS bf16x8*)(Vl + v_st<4>(sr, sc)) = s.v[0]; *(LAS bf16x8*)(Vl + v_st<4>(32 + sr, sc)) = s.v[1]; }
    else {
#pragma unroll
        for (int i = 0; i < 3; ++i) { const int id = tid + 512 * i, row = id / 24, c = (id % 24) * 8; *(LAS bf16x8*)(Vl + v_st<6>(row, c)) = s.v[i]; } }
}
__device__ __forceinline__ void q_load(bf16x8 (&qr)[8], const bf16_t* qrow  , int hi) {
#pragma unroll
    for (int d0 = 0; d0 < 8; ++d0) qr[d0] = *(const bf16x8*)(qrow + d0 * 16 + hi * 8);
}
template <int ND> __device__ __forceinline__ void store_y(bf16_t* yrow, const f32x16 (&o)[ND], float sc, int hi) {
#pragma unroll
    for (int d0 = 0; d0 < ND; ++d0)
#pragma unroll
        for (int rg = 0; rg < 4; ++rg) { u32x2* p = (u32x2*)(yrow + 32 * d0 + 8 * rg + 4 * hi); const u32x2 g = *p;
            const float g0 = __builtin_bit_cast(float, g.x << 16), g1 = __builtin_bit_cast(float, g.x & 0xffff0000u), g2 = __builtin_bit_cast(float, g.y << 16), g3 = __builtin_bit_cast(float, g.y & 0xffff0000u);
            u32x2 w; w.x = cvt_pk_bf16(o[d0][4 * rg] * sc * g0, o[d0][4 * rg + 1] * sc * g1); w.y = cvt_pk_bf16(o[d0][4 * rg + 2] * sc * g2, o[d0][4 * rg + 3] * sc * g3); *p = w; }
}

__device__ __forceinline__ void mem_attn_phase(const Frame& F, bf16_t* Z, int ldz, int xq_col, int y_col, const bf16_t* mkv, int unit_lo, int unit_step) {
    const int tid = F.tid, lane = F.lane, r32 = lane & 31, hi = lane >> 5, wave = F.wave;
    LAS char* Kl = (LAS char*)F.lds; LAS char* Vl = Kl + 32768;
    constexpr float C = 0.08838834764831845f * LOG2E;
    for (int u = unit_lo; u < BATCH * 4 * 16; u += unit_step) {
        const int b = u >> 6, head = (u >> 4) & 3, tb = u & 15;
        const size_t t = (size_t)b * SEQ + tb * 256 + wave * 32 + r32;
        bf16x8 qr[8]; q_load(qr, Z + t * ldz + xq_col + head * 128, hi);
        const bf16_t* kp = mkv + (size_t)b * NMEM * DM + head * 128; const bf16_t* vp = kp + 512;
        float m = -1e30f, l = 0.f; f32x16 o[4] = {};
        KReg ks; VReg<4> vs;
        k_load(ks, kp, DM, tid); v_load<4>(vs, vp, DM, tid); k_write(Kl, ks, tid); v_write<4>(Vl, vs, tid); __syncthreads();
        for (int j = 0; j < 4; ++j) {
            const int bo = (j & 1) * 16384;
            if (j + 1 < 4) { k_load(ks, kp + (size_t)(j + 1) * 64 * DM, DM, tid); v_load<4>(vs, vp + (size_t)(j + 1) * 64 * DM, DM, tid); }
            f32x16 p0, p1; qkt(p0, p1, Kl + bo, qr, r32, hi);
#pragma unroll
            for (int r = 0; r < 16; ++r) { p0[r] *= C; p1[r] *= C; }
            softmax_step<4>(p0, p1, m, l, o);
            bf16x8 pa0, pa1, pa2, pa3; pack_p(p0, p1, pa0, pa1, pa2, pa3);
            pv_all<4>(o, lds_addr(Vl + bo) + v_rd_base(lane), pa0, pa1, pa2, pa3);
            if (j + 1 < 4) { k_write(Kl + (bo ^ 16384), ks, tid); v_write<4>(Vl + (bo ^ 16384), vs, tid); }
            __syncthreads();
        }
        if (!F.dry) store_y<4>(Z + t * ldz + y_col + head * 128, o, 1.f / l, hi);
    }
}

__device__ __forceinline__ void pool_phase(const Frame& F, bf16_t* Z, const bf16_t* WP, const float* scale, int unit_lo, int unit_step) {
    const int tid = F.tid, lane = F.lane, r32 = lane & 31, hi = lane >> 5, wave = F.wave;
    LAS char* Wl = (LAS char*)F.lds;
    for (int u = unit_lo; u < BATCH * 16 * 4; u += unit_step) {
        const int g = u & 3, tb = (u >> 2) & 15, b = u >> 6;
        const int win = 2 << g;
        { const bf16_t* wsrc = WP + (size_t)g * 192 * 192;
#pragma unroll
          for (int i = 0; i < 9; ++i) { const int id = tid + 512 * i, row = id / 24, c = id % 24; *(LAS bf16x8*)(Wl + row * 400 + c * 16) = *(const bf16x8*)(wsrc + row * 192 + c * 8); } }
        __syncthreads();
        const int tloc = tb * 256 + wave * 32 + r32;
        const bf16_t* zrow = Z + ((size_t)b * SEQ + tloc) * EV_LD + EV_ZA + g * 192;
        const int cnt = (tloc + 1 < win) ? tloc + 1 : win; const float icnt = 1.0f / (float)cnt;
        f32x16 o[6] = {};
#pragma unroll 1
        for (int s = 0; s < 12; ++s) {
            const bf16_t* p = zrow + 16 * s + 8 * hi;
            float accv[8]; float cur[8];
            { const bf16x8 v = *(const bf16x8*)p;
#pragma unroll
              for (int j = 0; j < 8; ++j) { cur[j] = bf2f((unsigned short)v[j]); accv[j] = cur[j]; } }
            for (int i = 1; i < cnt; ++i) { const bf16x8 v = *(const bf16x8*)(p - (size_t)i * EV_LD);
#pragma unroll
              for (int j = 0; j < 8; ++j) accv[j] += bf2f((unsigned short)v[j]); }
            u32x4 w; w.x = cvt_pk_bf16(accv[0] * icnt - cur[0], accv[1] * icnt - cur[1]); w.y = cvt_pk_bf16(accv[2] * icnt - cur[2], accv[3] * icnt - cur[3]);
            w.z = cvt_pk_bf16(accv[4] * icnt - cur[4], accv[5] * icnt - cur[5]); w.w = cvt_pk_bf16(accv[6] * icnt - cur[6], accv[7] * icnt - cur[7]);
            const bf16x8 bfrag = __builtin_bit_cast(bf16x8, w);
#pragma unroll
            for (int ob = 0; ob < 6; ++ob) { const bf16x8 afrag = *(const LAS bf16x8*)(Wl + (32 * ob + r32) * 400 + (16 * s + 8 * hi) * 2);
                o[ob] = __builtin_amdgcn_mfma_f32_32x32x16_bf16(afrag, bfrag, o[ob], 0, 0, 0); }
        }
        bf16_t* yrow = Z + ((size_t)b * SEQ + tloc) * EV_LD + EV_G + g * 192; const float* sc = scale + g * 192;
        if (!F.dry)
#pragma unroll
        for (int ob = 0; ob < 6; ++ob)
#pragma unroll
            for (int rg = 0; rg < 4; ++rg) { const int c = 32 * ob + 8 * rg + 4 * hi; const f32x4 s4 = *(const f32x4*)(sc + c); u32x2* p = (u32x2*)(yrow + c); const u32x2 gg = *p;
                const float g0 = __builtin_bit_cast(float, gg.x << 16), g1 = __builtin_bit_cast(float, gg.x & 0xffff0000u), g2 = __builtin_bit_cast(float, gg.y << 16), g3 = __builtin_bit_cast(float, gg.y & 0xffff0000u);
                u32x2 w; w.x = cvt_pk_bf16(o[ob][4 * rg] * s4.x * g0, o[ob][4 * rg + 1] * s4.y * g1); w.y = cvt_pk_bf16(o[ob][4 * rg + 2] * s4.z * g2, o[ob][4 * rg + 3] * s4.w * g3); *p = w; }
        __syncthreads();
    }
}


constexpr int RET_KV_ELEMS = 192 * 128;
__device__ __forceinline__ float ret_log2_gamma(int h) { return log2f(1.0f - exp2f(-5.0f - (float)h)); }
__device__ __forceinline__ void ret_a_phase(const Frame& F, bf16_t* Z, const float* ropec, const float* ropes, float* kvT, int unit_lo, int unit_step) {
    const int tid = F.tid, lane = F.lane, wave = F.wave;
    LAS char* Kimg = (LAS char*)F.lds; LAS char* Vimg = Kimg + 32768;
    for (int u = unit_lo; u < BATCH * 4 * 32; u += unit_step) {
        const int b = u >> 7, h = (u >> 5) & 3, n = u & 31, c0 = n * 128;
        const float lgam = ret_log2_gamma(h);
#pragma unroll
        for (int i = 0; i < 2; ++i) {
            const int id = tid + 512 * i, m = id >> 3, c = id & 7, pos = c0 + m;
            bf16_t* row = Z + ((size_t)b * SEQ + pos) * EV_LD;
            const f32x4 ca = *(const f32x4*)(ropec + pos * 64 + 8 * c), cb = *(const f32x4*)(ropec + pos * 64 + 8 * c + 4);
            const f32x4 sa = *(const f32x4*)(ropes + pos * 64 + 8 * c), sb = *(const f32x4*)(ropes + pos * 64 + 8 * c + 4);
            float cs[8] = {ca.x, ca.y, ca.z, ca.w, cb.x, cb.y, cb.z, cb.w}, sn[8] = {sa.x, sa.y, sa.z, sa.w, sb.x, sb.y, sb.z, sb.w};
            const float zeta = exp2f((float)(127 - m) * lgam);
            { bf16_t* kp = row + EV_RK + h * 128 + 8 * c; const bf16x8 x1 = *(const bf16x8*)kp, x2 = *(const bf16x8*)(kp + 64);
              float o1[8], o2[8];
#pragma unroll
              for (int j = 0; j < 8; ++j) { const float a = bf2f((unsigned short)x1[j]), bb = bf2f((unsigned short)x2[j]); o1[j] = a * cs[j] - bb * sn[j]; o2[j] = a * sn[j] + bb * cs[j]; }
              u32x4 w1 = {cvt_pk_bf16(o1[0], o1[1]), cvt_pk_bf16(o1[2], o1[3]), cvt_pk_bf16(o1[4], o1[5]), cvt_pk_bf16(o1[6], o1[7])};
              u32x4 w2 = {cvt_pk_bf16(o2[0], o2[1]), cvt_pk_bf16(o2[2], o2[3]), cvt_pk_bf16(o2[4], o2[5]), cvt_pk_bf16(o2[6], o2[7])};
              if (!F.dry) { *(u32x4*)kp = w1; *(u32x4*)(kp + 64) = w2; }
              u32x4 z1 = {cvt_pk_bf16(o1[0] * zeta, o1[1] * zeta), cvt_pk_bf16(o1[2] * zeta, o1[3] * zeta), cvt_pk_bf16(o1[4] * zeta, o1[5] * zeta), cvt_pk_bf16(o1[6] * zeta, o1[7] * zeta)};
              u32x4 z2 = {cvt_pk_bf16(o2[0] * zeta, o2[1] * zeta), cvt_pk_bf16(o2[2] * zeta, o2[3] * zeta), cvt_pk_bf16(o2[4] * zeta, o2[5] * zeta), cvt_pk_bf16(o2[6] * zeta, o2[7] * zeta)};
              LAS char* img = Kimg + (m >> 6) * 16384;
              *(LAS u32x4*)(img + v_st<4>(m & 63, 8 * c)) = z1; *(LAS u32x4*)(img + v_st<4>(m & 63, 64 + 8 * c)) = z2; }
            { bf16_t* qp = row + EV_RQ + h * 128 + 8 * c; const bf16x8 x1 = *(const bf16x8*)qp, x2 = *(const bf16x8*)(qp + 64);
              float o1[8], o2[8];
#pragma unroll
              for (int j = 0; j < 8; ++j) { const float a = bf2f((unsigned short)x1[j]), bb = bf2f((unsigned short)x2[j]); o1[j] = (a * cs[j] - bb * sn[j]) * 0.08838834764831845f; o2[j] = (a * sn[j] + bb * cs[j]) * 0.08838834764831845f; }
              u32x4 w1 = {cvt_pk_bf16(o1[0], o1[1]), cvt_pk_bf16(o1[2], o1[3]), cvt_pk_bf16(o1[4], o1[5]), cvt_pk_bf16(o1[6], o1[7])};
              u32x4 w2 = {cvt_pk_bf16(o2[0], o2[1]), cvt_pk_bf16(o2[2], o2[3]), cvt_pk_bf16(o2[4], o2[5]), cvt_pk_bf16(o2[6], o2[7])};
              if (!F.dry) { *(u32x4*)qp = w1; *(u32x4*)(qp + 64) = w2; } }
        }
#pragma unroll
        for (int i = 0; i < 6; ++i) { const int id = tid + 512 * i, m = id / 24, c = id % 24;
            const bf16x8 v = *(const bf16x8*)(Z + ((size_t)b * SEQ + c0 + m) * EV_LD + EV_RV + h * 192 + 8 * c);
            *(LAS bf16x8*)(Vimg + (m >> 6) * 24576 + v_st<6>(m & 63, 8 * c)) = v; }
        __syncthreads();
        const int kbk = wave & 3, dvb0 = (wave >> 2) * 3;
        const int vbK = lds_addr(Kimg) + v_rd_base(lane) + kbk * 512, vbV = lds_addr(Vimg) + v_rd_base(lane) + dvb0 * 512;
        f32x16 acc[3] = {};
#pragma unroll
        for (int T = 0; T < 2; ++T)
#pragma unroll
            for (int ks = 0; ks < 4; ++ks) {
                const s16x4 bl = tr_read<0>(vbK + T * 16384 + ks * 4096), bh = tr_read<0>(vbK + T * 16384 + ks * 4096 + 2048);
                s16x4 al[3], ah[3];
#pragma unroll
                for (int i = 0; i < 3; ++i) { al[i] = tr_read<0>(vbV + T * 24576 + ks * 6144 + i * 512); ah[i] = tr_read<0>(vbV + T * 24576 + ks * 6144 + 3072 + i * 512); }
                asm volatile("s_waitcnt lgkmcnt(0)" ::: "memory"); SBAR();
                const bf16x8 bf = (bf16x8){bl[0], bl[1], bl[2], bl[3], bh[0], bh[1], bh[2], bh[3]};
#pragma unroll
                for (int i = 0; i < 3; ++i) { const bf16x8 af = (bf16x8){al[i][0], al[i][1], al[i][2], al[i][3], ah[i][0], ah[i][1], ah[i][2], ah[i][3]};
                    acc[i] = __builtin_amdgcn_mfma_f32_32x32x16_bf16(af, bf, acc[i], 0, 0, 0); }
            }
        float* dst = kvT + (size_t)u * RET_KV_ELEMS;
        const int r32 = lane & 31, hi = lane >> 5;
        if (!F.dry)
#pragma unroll
        for (int i = 0; i < 3; ++i)
#pragma unroll
            for (int r = 0; r < 16; ++r) dst[(size_t)(32 * (dvb0 + i) + crow(r, hi)) * 128 + 32 * kbk + r32] = acc[i][r];
        __syncthreads();
    }
}
__device__ __forceinline__ void ret_scan_phase(const Frame& F, float* kvT) {
    for (int idx = F.bid * 512 + F.tid; idx < 32 * (RET_KV_ELEMS / 4); idx += F.G * 512) {
        const int bh = idx / (RET_KV_ELEMS / 4), e = idx % (RET_KV_ELEMS / 4), h = bh & 3;
        const float gch = exp2f(128.0f * ret_log2_gamma(h));
        f32x4* p = (f32x4*)(kvT + (size_t)bh * 32 * RET_KV_ELEMS) + e;
        f32x4 R = {0.f, 0.f, 0.f, 0.f};
#pragma unroll 4
        for (int n = 0; n < 32; ++n) { const f32x4 t = p[(size_t)n * (RET_KV_ELEMS / 4)]; if (!F.dry) p[(size_t)n * (RET_KV_ELEMS / 4)] = R; R = R * gch + t; }
    }
}
__device__ __forceinline__ void ret_c_phase(const Frame& F, bf16_t* Z, const float* kvT, int unit_lo, int unit_step) {
    const int tid = F.tid, lane = F.lane, wave = F.wave, r32 = lane & 31, hi = lane >> 5;
    LAS char* Kl = (LAS char*)F.lds; LAS char* Vl = Kl + 32768; LAS float* st = (LAS float*)(Kl + 32768 + 49152);
    for (int u = unit_lo; u < BATCH * 4 * 32; u += unit_step) {
        const int b = u >> 7, h = (u >> 5) & 3, n = u & 31, c0 = n * 128;
        const float lgam = ret_log2_gamma(h);
        const bf16_t* zb = Z + ((size_t)b * SEQ + c0) * EV_LD;
        { KReg k0, k1; VReg<6> v0, v1;
          k_load(k0, zb + EV_RK + h * 128, EV_LD, tid); k_load(k1, zb + (size_t)64 * EV_LD + EV_RK + h * 128, EV_LD, tid);
          v_load<6>(v0, zb + EV_RV + h * 192, EV_LD, tid); v_load<6>(v1, zb + (size_t)64 * EV_LD + EV_RV + h * 192, EV_LD, tid);
          k_write(Kl, k0, tid); k_write(Kl + 16384, k1, tid); v_write<6>(Vl, v0, tid); v_write<6>(Vl + 24576, v1, tid); }
        const int q4 = wave & 3, dvb0 = (wave >> 2) * 3, ti = 32 * q4 + r32;
        bf16x8 qr[8]; q_load(qr, zb + (size_t)ti * EV_LD + EV_RQ + h * 128, hi);
        __syncthreads();
        f32x16 o[3] = {};
        const int ntile = (q4 >> 1) + 1;
        for (int j = 0; j < ntile; ++j) {
            f32x16 p0, p1; qkt(p0, p1, Kl + j * 16384, qr, r32, hi);
#pragma unroll
            for (int r = 0; r < 16; ++r) { const int d0 = ti - (64 * j + crow(r, hi)), d1 = d0 - 32;
                p0[r] = d0 >= 0 ? p0[r] * exp2f((float)d0 * lgam) : 0.f; p1[r] = d1 >= 0 ? p1[r] * exp2f((float)d1 * lgam) : 0.f; }
            bf16x8 pa0, pa1, pa2, pa3; pack_p(p0, p1, pa0, pa1, pa2, pa3);
            const int vb = lds_addr(Vl + j * 24576) + v_rd_base(lane) + dvb0 * 512;
            pv_one<6, 0>(o[0], vb, pa0, pa1, pa2, pa3); pv_one<6, 0>(o[1], vb + 512, pa0, pa1, pa2, pa3); pv_one<6, 0>(o[2], vb + 1024, pa0, pa1, pa2, pa3);
        }
        { const float xi = exp2f((float)(ti + 1) * lgam);
#pragma unroll
          for (int s = 0; s < 8; ++s) { u32x4 w = __builtin_bit_cast(u32x4, qr[s]);
              w.x = cvt_pk_bf16(__builtin_bit_cast(float, w.x << 16) * xi, __builtin_bit_cast(float, w.x & 0xffff0000u) * xi); w.y = cvt_pk_bf16(__builtin_bit_cast(float, w.y << 16) * xi, __builtin_bit_cast(float, w.y & 0xffff0000u) * xi);
              w.z = cvt_pk_bf16(__builtin_bit_cast(float, w.z << 16) * xi, __builtin_bit_cast(float, w.z & 0xffff0000u) * xi); w.w = cvt_pk_bf16(__builtin_bit_cast(float, w.w << 16) * xi, __builtin_bit_cast(float, w.w & 0xffff0000u) * xi);
              qr[s] = __builtin_bit_cast(bf16x8, w); }
          const float* rp = kvT + (size_t)u * RET_KV_ELEMS;
#pragma unroll
          for (int i = 0; i < 3; ++i)
#pragma unroll
              for (int s = 0; s < 8; ++s) { const float* a = rp + (size_t)(32 * (dvb0 + i) + r32) * 128 + 16 * s + 8 * hi; const f32x4 a0 = *(const f32x4*)a, a1 = *(const f32x4*)(a + 4);
                  u32x4 w = {cvt_pk_bf16(a0.x, a0.y), cvt_pk_bf16(a0.z, a0.w), cvt_pk_bf16(a1.x, a1.y), cvt_pk_bf16(a1.z, a1.w)};
                  o[i] = __builtin_amdgcn_mfma_f32_32x32x16_bf16(__builtin_bit_cast(bf16x8, w), qr[s], o[i], 0, 0, 0); } }
        float s1 = 0.f, s2 = 0.f;
#pragma unroll
        for (int i = 0; i < 3; ++i)
#pragma unroll
            for (int r = 0; r < 16; ++r) { s1 += o[i][r]; s2 += o[i][r] * o[i][r]; }
        s1 = xhalf_sum(s1); s2 = xhalf_sum(s2);
        if (hi == 0) { st[(wave * 32 + r32) * 2] = s1; st[(wave * 32 + r32) * 2 + 1] = s2; }
        __syncthreads();
        const float t1 = s1 + st[((wave ^ 4) * 32 + r32) * 2], t2 = s2 + st[((wave ^ 4) * 32 + r32) * 2 + 1];
        const float mu = t1 * (1.f / 192.f), var = fmaxf(t2 * (1.f / 192.f) - mu * mu, 0.f), rs = 1.0f / sqrtf(var + EPS);
#pragma unroll
        for (int i = 0; i < 3; ++i)
#pragma unroll
            for (int r = 0; r < 16; ++r) o[i][r] = (o[i][r] - mu) * rs;
        if (!F.dry) store_y<3>(Z + ((size_t)b * SEQ + c0 + ti) * EV_LD + EV_G + 768 + h * 192 + 32 * dvb0, o, 1.f, hi);
        __syncthreads();
    }
}

__device__ __forceinline__ void compress_phase(const Frame& F, const bf16_t* Z, const bf16_t* W1t, const bf16_t* W2t, const float* b1, const float* b1part, bf16_t* kcmp, bf16_t* vcmp, int unit_lo, int unit_step) {
    const int tid = F.tid, lane = F.lane, wave = F.wave, r32 = lane & 31, hi = lane >> 5;
    LAS char* Al = (LAS char*)F.lds; LAS char* Hs = Al + 32768;
    for (int u = unit_lo; u < 128; u += unit_step) {
        const int kv = u >> 6, rt = u & 63;
        const bf16_t* w1 = W1t + (size_t)kv * 256 * 4096; const bf16_t* w2 = W2t + (size_t)kv * 128 * 256;
        bf16_t* dstc = kv ? vcmp : kcmp; const int zc = kv ? OD_VC : OD_KC;
        if (rt == 0 && tid < 256) { const int bg = tid >> 4, c = tid & 15; *(u32x4*)(dstc + ((size_t)bg * 256 + 255) * 128 + c * 8) = (u32x4){0u, 0u, 0u, 0u}; }
        const int sr = tid >> 4, sc = (tid & 15) * 8;
        const bf16_t* rp[2];
#pragma unroll
        for (int i = 0; i < 2; ++i) { int r = rt * 64 + sr + 32 * i; if (r > 4079) r = 4079; const int g = r & 1, bj = r >> 1, b = bj / 255, j = bj % 255;
            rp[i] = Z + ((size_t)b * SEQ + 16 * j) * OD_LD + zc + g * 128 + sc; }
        KReg a; a.a = *(const bf16x8*)rp[0]; a.b = *(const bf16x8*)rp[1];
        k_write(Al, a, tid);
        const bf16_t* wrow = w1 + (size_t)(32 * wave + r32) * 4096 + 8 * hi;
        bf16x8 bcur[8], bnxt[8];
#pragma unroll
        for (int s = 0; s < 8; ++s) bcur[s] = *(const bf16x8*)(wrow + 16 * s);
        f32x16 acc[2] = {};
        __syncthreads();
#pragma unroll 1
        for (int l = 0; l < 32; ++l) {
            const int bo = (l & 1) * 16384;
            if (l + 1 < 32) { a.a = *(const bf16x8*)(rp[0] + (size_t)(l + 1) * OD_LD); a.b = *(const bf16x8*)(rp[1] + (size_t)(l + 1) * OD_LD);
#pragma unroll
                for (int s = 0; s < 8; ++s) bnxt[s] = *(const bf16x8*)(wrow + (l + 1) * 128 + 16 * s); }
#pragma unroll
            for (int s = 0; s < 8; ++s) { const int cb = (16 * s + 8 * hi) * 2;
                const bf16x8 a0 = *(const LAS bf16x8*)(Al + bo + KSWZ(r32, cb)), a1 = *(const LAS bf16x8*)(Al + bo + KSWZ(32 + r32, cb));
                acc[0] = __builtin_amdgcn_mfma_f32_32x32x16_bf16(a0, bcur[s], acc[0], 0, 0, 0);
                acc[1] = __builtin_amdgcn_mfma_f32_32x32x16_bf16(a1, bcur[s], acc[1], 0, 0, 0); }
            if (l + 1 < 32) { k_write(Al + (bo ^ 16384), a, tid);
#pragma unroll
                for (int s = 0; s < 8; ++s) bcur[s] = bnxt[s]; }
            __syncthreads();
        }
        { const int col = 32 * wave + r32; float bb = b1[kv * 256 + col];
          for (int j = 0; j < 32; ++j) bb += b1part[(kv * 32 + j) * 256 + col];
#pragma unroll
          for (int rb = 0; rb < 2; ++rb)
#pragma unroll
              for (int r = 0; r < 16; ++r) { const float v = acc[rb][r] + bb; const float sv = v * fast_sigmoid(v);
                  *(LAS unsigned short*)(Hs + (32 * rb + crow(r, hi)) * 528 + col * 2) = (unsigned short)f2bf(sv); } }
        __syncthreads();
        { const int rb = wave & 1, cbk = wave >> 1; f32x16 o2 = {};
#pragma unroll
          for (int s = 0; s < 16; ++s) { const bf16x8 af = *(const LAS bf16x8*)(Hs + (32 * rb + r32) * 528 + (16 * s + 8 * hi) * 2);
              const bf16x8 bf = *(const bf16x8*)(w2 + (size_t)(32 * cbk + r32) * 256 + 16 * s + 8 * hi);
              o2 = __builtin_amdgcn_mfma_f32_32x32x16_bf16(af, bf, o2, 0, 0, 0); }
#pragma unroll
          for (int r = 0; r < 16; ++r) { const int row = rt * 64 + 32 * rb + crow(r, hi);
              if (row < 4080) { const int g = row & 1, bj = row >> 1, b = bj / 255, j = bj % 255;
                  dstc[(((size_t)b * 2 + g) * 256 + j) * 128 + 32 * cbk + r32] = (bf16_t)f2bf(o2[r]); } } }
        __syncthreads();
    }
}

__device__ __forceinline__ void nsa_post(f32x16& p0, f32x16& p1, int t, int kbase, int kstride, int limit, bool sel, int kvalid, const LAS float* tbl, int hi, bool fast) {
    constexpr float C = 0.08838834764831845f * LOG2E;
    const float NEGINF = -__builtin_inff();
    if (fast) { const float b128 = tbl[128];
#pragma unroll
        for (int r = 0; r < 16; ++r) { p0[r] = sel ? p0[r] * C + b128 : NEGINF; p1[r] = sel ? p1[r] * C + b128 : NEGINF; }
        return; }
    asm volatile("" : "+v"(hi), "+v"(t));
#pragma unroll
    for (int r = 0; r < 16; ++r) {
        { const int k = crow(r, hi); const int rel = t - (kbase + kstride * k); const bool ok = sel && rel >= 0 && rel < limit && k < kvalid; const int idx = rel < 0 ? 0 : (rel > 128 ? 128 : rel);
          p0[r] = ok ? p0[r] * C + tbl[idx] : NEGINF; }
        { const int k = 32 + crow(r, hi); const int rel = t - (kbase + kstride * k); const bool ok = sel && rel >= 0 && rel < limit && k < kvalid; const int idx = rel < 0 ? 0 : (rel > 128 ? 128 : rel);
          p1[r] = ok ? p1[r] * C + tbl[idx] : NEGINF; }
    }
}
__device__ __forceinline__ void dma_k(LAS char* Kslot, const bf16_t* kp, size_t ld, int lw  , int lane) {
    asm volatile("" : "+v"(lane));
#pragma unroll
    for (int i = 0; i < 8; ++i) { const int pc = lw * 8 + i, row = pc * 4 + (lane >> 4), ch = (lane & 15) ^ (row & 7);
        __builtin_amdgcn_global_load_lds((const unsigned*)(kp + (size_t)row * ld + ch * 8), (LAS unsigned*)(Kslot + pc * 1024), 16, 0, 0); }
}
__device__ __forceinline__ void dma_v(LAS char* Vslot, const bf16_t* vp, size_t ld, int lw, int lane) {
    asm volatile("" : "+v"(lane));
#pragma unroll
    for (int i = 0; i < 8; ++i) { const int pc = lw * 8 + i, cblk = 2 * (pc & 1) + (lane >> 5), kk = (pc >> 1) * 8 + ((lane & 31) >> 2), k = (kk & ~0xC) | ((kk & 4) << 1) | ((kk & 8) >> 1), c = cblk * 32 + (lane & 3) * 8;
        __builtin_amdgcn_global_load_lds((const unsigned*)(vp + (size_t)k * ld + c), (LAS unsigned*)(Vslot + pc * 1024), 16, 0, 0); }
}
constexpr float NSA_THR = 6.0f;
template <int MODE>
__device__ __forceinline__ void acc_step(bf16_t* arow, bf16_t* yrow, const f32x16 (&o)[4], float sc, int hi, bool dry) {
#pragma unroll
    for (int d0 = 0; d0 < 4; ++d0)
#pragma unroll
        for (int rg = 0; rg < 4; ++rg) { const int c = 32 * d0 + 8 * rg + 4 * hi; u32x2* ap = (u32x2*)(arow + c);
            float v0 = o[d0][4 * rg] * sc, v1 = o[d0][4 * rg + 1] * sc, v2 = o[d0][4 * rg + 2] * sc, v3 = o[d0][4 * rg + 3] * sc;
            if (MODE >= 1) { const u32x2 a = *ap; v0 += __builtin_bit_cast(float, a.x << 16); v1 += __builtin_bit_cast(float, a.x & 0xffff0000u); v2 += __builtin_bit_cast(float, a.y << 16); v3 += __builtin_bit_cast(float, a.y & 0xffff0000u); }
            if (MODE == 2) { u32x2* yp = (u32x2*)(yrow + c); const u32x2 g = *yp;
                v0 *= __builtin_bit_cast(float, g.x << 16); v1 *= __builtin_bit_cast(float, g.x & 0xffff0000u); v2 *= __builtin_bit_cast(float, g.y << 16); v3 *= __builtin_bit_cast(float, g.y & 0xffff0000u);
                if (!dry) *yp = (u32x2){cvt_pk_bf16(v0, v1), cvt_pk_bf16(v2, v3)}; }
            else *ap = (u32x2){cvt_pk_bf16(v0, v1), cvt_pk_bf16(v2, v3)}; }
}
#define NSA_PK4(P, BASE, OUT) do { unsigned a0_ = cvt_pk_bf16(P[BASE + 0], P[BASE + 1]), a1_ = cvt_pk_bf16(P[BASE + 2], P[BASE + 3]);   \
    unsigned b0_ = cvt_pk_bf16(P[BASE + 4], P[BASE + 5]), b1_ = cvt_pk_bf16(P[BASE + 6], P[BASE + 7]);                              \
    auto r0_ = __builtin_amdgcn_permlane32_swap(a0_, b0_, false, false); auto r1_ = __builtin_amdgcn_permlane32_swap(a1_, b1_, false, false); \
    u32x4 w_ = {r0_[0], r1_[0], r0_[1], r1_[1]}; OUT = __builtin_bit_cast(bf16x8, w_); } while (0)
struct TileInfo { int blk; bool far; };
template <int TYPE> __device__ __forceinline__ TileInfo tile_info(int blk, int s0) {
    TileInfo ti; ti.blk = blk; const int kb = 64 * blk;
    if (TYPE == 0) ti.far = s0 - (kb + 63) >= 128;
    else if (TYPE == 1) ti.far = (s0 - (kb + 63) >= 128) && (s0 + 31 - kb < 512);
    else ti.far = (blk < 3) && (s0 - (16 * (kb + 63) + 31) >= 128);
    return ti;
}
template <int TYPE> __device__ __forceinline__ void near_post(f32x16& P0, f32x16& P1, int blk, int t, float m, const LAS float* tbl, int hi) {
    const float NEGINF = -__builtin_inff(); const int kb = 64 * blk;
    asm volatile("" : "+v"(hi), "+v"(t));
#pragma unroll
    for (int r = 0; r < 16; ++r) {
        if ((r & 3) == 0) SBAR();
#pragma unroll
        for (int half = 0; half < 2; ++half) { const int k = kb + 32 * half + crow(r, hi); int rel; bool ok;
            if (TYPE >= 2) { rel = t - (16 * k + 31); ok = rel >= 0 && k < 255; } else { rel = t - k; ok = rel >= 0 && (TYPE == 0 || rel < 512); }
            const int idx = rel < 0 ? 0 : (rel > 128 ? 128 : rel);
            if (half) P1[r] = ok ? P1[r] + (tbl[idx] - m) : NEGINF; else P0[r] = ok ? P0[r] + (tbl[idx] - m) : NEGINF; }
    }
}
template <int TYPE>
__device__ __forceinline__ void nsa_step(f32x16& C0, f32x16& C1, bool csel, int cblk, f32x16& N0, f32x16& N1, const LAS char* Kn, int vbc, bool has_next, TileInfo tn, bool nsel,
                                         const LAS char* ql, float& m, float& alc, float& l, f32x16 (&o)[4], float b128, int t, const LAS float* tbl, LAS unsigned* impr, int r32, int hi) {
    bf16x8 pa0, pa1, pa2, pa3; float ps = 0.f;
    SBAR();
#define IMP_ADD(P, gq, J) do { const float own_ = 2.f * (P[4 * gq] + P[4 * gq + 1] + P[4 * gq + 2]) + P[4 * gq + 3]; \
        __hip_atomic_fetch_add(impr + 16 * cblk + hi + (J), (unsigned)(own_ * 67108864.f + 0.5f), __ATOMIC_RELAXED, __HIP_MEMORY_SCOPE_WORKGROUP); \
        __hip_atomic_fetch_add(impr + 16 * cblk + hi + (J) + 1, (unsigned)(P[4 * gq + 3] * 67108864.f + 0.5f), __ATOMIC_RELAXED, __HIP_MEMORY_SCOPE_WORKGROUP); } while (0)
#define SM2_SLICE(d) do { C1[2 * d] = __builtin_amdgcn_exp2f(C1[2 * d]); C1[2 * d + 1] = __builtin_amdgcn_exp2f(C1[2 * d + 1]); \
        if (TYPE != 2) ps += (C0[2 * d] + C0[2 * d + 1]) + (C1[2 * d] + C1[2 * d + 1]); \
        if (TYPE != 3) { if (d == 2) NSA_PK4(C0, 0, pa0); if (d == 4) NSA_PK4(C0, 8, pa1); if (d == 6) NSA_PK4(C1, 0, pa2); } \
        if (TYPE == 2 && (d & 1)) { IMP_ADD(C0, (d >> 1), 2 * (d >> 1)); IMP_ADD(C1, (d >> 1), 8 + 2 * (d >> 1)); } } while (0)
    if (has_next) {
        { const float ib = tn.far ? b128 - m : 0.f;
#pragma unroll
          for (int r = 0; r < 16; ++r) { N0[r] = ib; N1[r] = ib; } }
#pragma unroll
        for (int d = 0; d < 8; ++d) {
            const int cb = (d * 16 + hi * 8) * 2; const bf16x8 qf = *(const LAS bf16x8*)(ql + d * 1024), kf0 = *(const LAS bf16x8*)(Kn + KSWZ(r32, cb)), kf1 = *(const LAS bf16x8*)(Kn + KSWZ(32 + r32, cb));
            N0 = __builtin_amdgcn_mfma_f32_32x32x16_bf16(kf0, qf, N0, 0, 0, 0);
            N1 = __builtin_amdgcn_mfma_f32_32x32x16_bf16(kf1, qf, N1, 0, 0, 0);
            SM2_SLICE(d);
            SBAR();
        }
    } else {
#pragma unroll
        for (int d = 0; d < 8; ++d) SM2_SLICE(d);
    }
#undef SM2_SLICE
#undef IMP_ADD
    if (TYPE != 3) NSA_PK4(C1, 8, pa3);
    if (TYPE == 0 && !__all(csel)) {
        const unsigned km = csel ? 0xffffffffu : 0u; ps = csel ? ps : 0.f;
        u32x4 w0 = __builtin_bit_cast(u32x4, pa0), w1 = __builtin_bit_cast(u32x4, pa1), w2 = __builtin_bit_cast(u32x4, pa2), w3 = __builtin_bit_cast(u32x4, pa3);
        w0 &= km; w1 &= km; w2 &= km; w3 &= km;
        pa0 = __builtin_bit_cast(bf16x8, w0); pa1 = __builtin_bit_cast(bf16x8, w1); pa2 = __builtin_bit_cast(bf16x8, w2); pa3 = __builtin_bit_cast(bf16x8, w3); }
    if (TYPE != 2) { ps = xhalf_sum(ps); l = l * alc + ps; }
    SBAR();
    float aln = 1.f;
    if (TYPE != 3) pv_one<4, 0>(o[0], vbc, pa0, pa1, pa2, pa3);
    if (has_next && !tn.far) near_post<TYPE>(N0, N1, tn.blk, t, m, tbl, hi);
    SBAR();
    if (TYPE != 3) pv_one<4, 1>(o[1], vbc, pa0, pa1, pa2, pa3);
    float pmax = -__builtin_inff();
    if (TYPE != 2 && has_next) {
#pragma unroll
        for (int r = 0; r < 16; ++r) pmax = fmaxf(pmax, fmaxf(N0[r], N1[r]));
        pmax = xhalf_max(pmax); if (TYPE == 0) pmax = nsel ? pmax : -__builtin_inff(); }
    SBAR();
    if (TYPE != 3) pv_one<4, 2>(o[2], vbc, pa0, pa1, pa2, pa3);
    if (TYPE != 2 && has_next && __any(pmax > NSA_THR)) {
        const float dl = fmaxf(pmax, 0.f); m += dl; aln = __builtin_amdgcn_exp2f(-dl);
#pragma unroll
        for (int r = 0; r < 16; ++r) { N0[r] -= dl; N1[r] -= dl; } }
    SBAR();
    if (TYPE != 3) pv_one<4, 3>(o[3], vbc, pa0, pa1, pa2, pa3);
    if (has_next) {
#pragma unroll
        for (int r = 0; r < 16; ++r) N0[r] = __builtin_amdgcn_exp2f(N0[r]); }
    SBAR();
    if (TYPE < 2 && __any(aln != 1.f)) {
#pragma unroll
        for (int d = 0; d < 4; ++d)
#pragma unroll
            for (int r = 0; r < 16; ++r) o[d][r] *= aln; }
    alc = aln;
}
template <int TYPE>
__device__ __forceinline__ void nsa_branch_compute(const LAS char* Kl, int vb, const LAS int* tl, int n, const LAS char* ql, int t, int s0, unsigned long long mymask, const LAS float* tbl,
                                                   float& m, float& l, f32x16 (&o)[4], LAS unsigned* impr, int r32, int hi, bool nocompute) {
    float alc = 1.f; l = 0.f;
    if (TYPE != 3) {
#pragma unroll
        for (int d = 0; d < 4; ++d) o[d] = f32x16{}; }
    f32x16 pA0, pA1, pB0, pB1;
    if (nocompute) { l = 1.f; __syncthreads(); for (int i = 0; i < n; ++i) __syncthreads(); __syncthreads(); return; }
    const float b128 = tbl[128];
    __syncthreads();
    TileInfo ta = tile_info<TYPE>(tl[0], s0), tb_; bool sa = (TYPE == 0) ? ((mymask >> ta.blk) & 1ull) != 0ull : true, sb = true;
    {
        qkt_lq(pA0, pA1, Kl, ql, r32, hi);
        if (ta.far) {
#pragma unroll
            for (int r = 0; r < 16; ++r) { pA0[r] += b128; pA1[r] += b128; } }
        else near_post<TYPE>(pA0, pA1, ta.blk, t, 0.f, tbl, hi);
        if (TYPE != 2) {
            float pmax = -__builtin_inff();
#pragma unroll
            for (int r = 0; r < 16; ++r) pmax = fmaxf(pmax, fmaxf(pA0[r], pA1[r]));
            pmax = xhalf_max(pmax); if (TYPE == 0) pmax = sa ? pmax : -__builtin_inff();
            m = (pmax == -__builtin_inff()) ? 0.f : pmax; }
#pragma unroll
        for (int r = 0; r < 16; ++r) { pA0[r] = __builtin_amdgcn_exp2f(pA0[r] - m); pA1[r] -= m; } }
    for (int i = 0; i < n; i += 2) {
        __syncthreads();
        { const bool hn = i + 1 < n; tb_ = tile_info<TYPE>(hn ? tl[i + 1] : 0, s0); sb = (TYPE == 0) ? ((mymask >> tb_.blk) & 1ull) != 0ull : true;
          nsa_step<TYPE>(pA0, pA1, sa, ta.blk, pB0, pB1, Kl + 16384, vb, hn, tb_, sb, ql, m, alc, l, o, b128, t, tbl, impr, r32, hi); }
        if (i + 1 >= n) break;
        __syncthreads();
        { const bool hn = i + 2 < n; ta = tile_info<TYPE>(hn ? tl[i + 2] : 0, s0); sa = (TYPE == 0) ? ((mymask >> ta.blk) & 1ull) != 0ull : true;
          nsa_step<TYPE>(pB0, pB1, sb, tb_.blk, pA0, pA1, Kl, vb + 16384, hn, ta, sa, ql, m, alc, l, o, b128, t, tbl, impr, r32, hi); }
    }
    __syncthreads();
}
__device__ __forceinline__ void nsa_cmp_pass2(const LAS char* Kl, int vb, int n, const LAS char* ql, int t, int s0, const LAS float* tbl, float m2, f32x16 (&o)[4], LAS unsigned* impr, int r32, int hi) {
#pragma unroll
    for (int d = 0; d < 4; ++d) o[d] = f32x16{};
    bf16x8 pa0, pa1, pa2, pa3;
    const float b128 = tbl[128];
#define CMP_TILE(j, Kslot) do { f32x16 p0_, p1_; qkt_lq(p0_, p1_, Kslot, ql, r32, hi); const TileInfo ti_ = tile_info<2>(j, s0); \
        if (ti_.far) { const float ib_ = b128 - m2; _Pragma("unroll") for (int r = 0; r < 16; ++r) { p0_[r] = __builtin_amdgcn_exp2f(p0_[r] + ib_); p1_[r] = __builtin_amdgcn_exp2f(p1_[r] + ib_); } } \
        else { near_post<2>(p0_, p1_, j, t, m2, tbl, hi); _Pragma("unroll") for (int r = 0; r < 16; ++r) { p0_[r] = __builtin_amdgcn_exp2f(p0_[r]); p1_[r] = __builtin_amdgcn_exp2f(p1_[r]); } } \
        _Pragma("unroll") for (int gq = 0; gq < 4; ++gq) { \
            { const float own_ = 2.f * (p0_[4 * gq] + p0_[4 * gq + 1] + p0_[4 * gq + 2]) + p0_[4 * gq + 3]; \
              __hip_atomic_fetch_add(impr + 16 * (j) + hi + 2 * gq, (unsigned)(own_ * 67108864.f + 0.5f), __ATOMIC_RELAXED, __HIP_MEMORY_SCOPE_WORKGROUP); \
              __hip_atomic_fetch_add(impr + 16 * (j) + hi + 2 * gq + 1, (unsigned)(p0_[4 * gq + 3] * 67108864.f + 0.5f), __ATOMIC_RELAXED, __HIP_MEMORY_SCOPE_WORKGROUP); } \
            { const float own_ = 2.f * (p1_[4 * gq] + p1_[4 * gq + 1] + p1_[4 * gq + 2]) + p1_[4 * gq + 3]; \
              __hip_atomic_fetch_add(impr + 16 * (j) + hi + 8 + 2 * gq, (unsigned)(own_ * 67108864.f + 0.5f), __ATOMIC_RELAXED, __HIP_MEMORY_SCOPE_WORKGROUP); \
              __hip_atomic_fetch_add(impr + 16 * (j) + hi + 8 + 2 * gq + 1, (unsigned)(p1_[4 * gq + 3] * 67108864.f + 0.5f), __ATOMIC_RELAXED, __HIP_MEMORY_SCOPE_WORKGROUP); } } \
        pack_p(p0_, p1_, pa0, pa1, pa2, pa3); } while (0)
    __syncthreads();
    CMP_TILE(0, Kl);
    for (int i = 0; i < n; ++i) {
        __syncthreads();
        pv_all<4>(o, vb + (i & 1) * 16384, pa0, pa1, pa2, pa3);
        if (i + 1 < n) CMP_TILE(i + 1, Kl + ((i + 1) & 1) * 16384);
    }
    __syncthreads();
#undef CMP_TILE
}
__device__ __forceinline__ void nsa_branch_load(LAS char* Kl, LAS char* Vl, const LAS int* tl, int n, const bf16_t* kbase, const bf16_t* vbase, size_t ld, bool with_v, int lw, int lane, bool noload) {
    if (noload) { __syncthreads(); for (int s = 0; s < n; ++s) __syncthreads(); __syncthreads(); return; }
    dma_k(Kl, kbase + (size_t)tl[0] * 64 * ld, ld, lw, lane);
    __syncthreads();
    for (int s = 0; s < n; ++s) {
        if (s + 1 < n) dma_k(Kl + ((s + 1) & 1) * 16384, kbase + (size_t)tl[s + 1] * 64 * ld, ld, lw, lane);
        if (with_v) dma_v(Vl + (s & 1) * 16384, vbase + (size_t)tl[s] * 64 * ld, ld, lw, lane);
        __syncthreads();
    }
    __syncthreads();
}
__device__ __forceinline__ void nsa_topk(const LAS unsigned* imp, LAS unsigned long long* selm, int wave, int lane, int s0) {
    const int cur = s0 >> 6;
    for (int i = 0; i < 4; ++i) { const int tt = wave * 4 + i, tq = s0 + tt;
        unsigned v = imp[tt * 65 + lane] + 1u;
        const bool forced = (lane == 0) || (lane == cur) || (lane == cur - 1), future = lane * 64 > tq;
        v = forced ? 0xffffffffu : (future ? 0u : v);
        int rank = 0;
#pragma unroll
        for (int j = 0; j < 64; ++j) { const unsigned vj = (unsigned)__builtin_amdgcn_readlane((int)v, j); rank += (vj > v || (vj == v && j < lane)) ? 1 : 0; }
        unsigned long long msk = __ballot(rank < 8);
        msk &= (2ull << cur) - 1ull;
        if (lane == 0) selm[tt] = msk; }
}
__device__ __forceinline__ unsigned long long nsa_union(unsigned long long mymask) {
    unsigned lo = (unsigned)mymask, hi32 = (unsigned)(mymask >> 32);
#pragma unroll
    for (int off = 1; off < 32; off <<= 1) { lo |= __shfl_xor(lo, off); hi32 |= __shfl_xor(hi32, off); }
    return ((unsigned long long)(unsigned)__builtin_amdgcn_readfirstlane(hi32) << 32) | (unsigned)__builtin_amdgcn_readfirstlane(lo);
}
constexpr int NSA_Q_OFF = 65536, NSA_IMP_OFF = NSA_Q_OFF + 6 * 8192, NSA_LIST_OFF = NSA_IMP_OFF + 32 * 65 * 4, NSA_SEL_OFF = NSA_LIST_OFF + 96 * 4, NSA_TB_OFF = NSA_SEL_OFF + 256;
static_assert(NSA_TB_OFF + 12 * 132 * 4 <= 131072, "nsa lds");
__device__ __forceinline__ void nsa_phase(const Frame& F, bf16_t* Z, const float* gates, const bf16_t* kcmp, const bf16_t* vcmp, const float* tbias) {
    const int wave = F.wave;
    LAS char* Kl = (LAS char*)F.lds; LAS char* Vl = Kl + 32768;
    LAS unsigned* imp = (LAS unsigned*)(Kl + NSA_IMP_OFF); LAS unsigned long long* selm = (LAS unsigned long long*)(Kl + NSA_SEL_OFF); LAS float* tb = (LAS float*)(Kl + NSA_TB_OFF);
    LAS int* tls = (LAS int*)(Kl + NSA_LIST_OFF); LAS int* tlw = tls + 72; LAS int* tlc = tls + 88;
    const bool cw = wave < 6;
    for (int i = F.tid; i < 12 * 132; i += 512) tb[i] = tbias[i];
    if (F.tid < 4) tlc[F.tid] = F.tid;
    for (int round = 0; round < 8; ++round) {
        int tid = F.tid; asm volatile("" : "+v"(tid));
        const int lane = tid & 63, r32 = lane & 31, hi = lane >> 5;
        const int rank = round * 256 + ((round & 1) ? (255 - F.bid) : F.bid);
        if (F.bid >= 256) break;
        const int qt = 127 - (rank >> 4), bg = rank & 15, b = bg >> 1, g = bg & 1, s0 = qt * 32, t = s0 + r32;
        bf16_t* zb = Z + (size_t)b * SEQ * OD_LD;
        const bf16_t* kc = kcmp + (size_t)bg * 256 * 128; const bf16_t* vc = vcmp + (size_t)bg * 256 * 128;
        const int jmax = (s0 >> 4) > 254 ? 254 : (s0 >> 4), ntc = (jmax >> 6) + 1, cur = s0 >> 6;
        const int jt0 = (s0 - 511) < 0 ? 0 : (s0 - 511) >> 6, ntw = cur - jt0 + 1;
        for (int i = tid; i < 32 * 65; i += 512) imp[i] = 0u;
        if (cw) {
            const int head = wave, hg = g * 6 + head;
            const int vb = lds_addr(Vl) + v_rd_base(lane);
            const LAS float* tbl = tb + hg * 132;
#define NSA_AROW(tv) (zb + (size_t)(tv) * OD_LD + OD_Q + hg * 128)
#define NSA_GATE(tv, c) (gates[((size_t)b * SEQ + (tv)) * GATE_LD + hg + 12 * (c)])
            const LAS char* ql = Kl + NSA_Q_OFF + wave * 8192 + lane * 16;
            LAS unsigned* impr = imp + r32 * 65;
            f32x16 o[4];
            {
                bf16x8 qr[8]; q_load(qr, NSA_AROW(t), hi);
#pragma unroll
                for (int d0 = 0; d0 < 8; ++d0) { constexpr float C = 0.08838834764831845f * LOG2E; u32x4 w = __builtin_bit_cast(u32x4, qr[d0]);
                    w.x = cvt_pk_bf16(__builtin_bit_cast(float, w.x << 16) * C, __builtin_bit_cast(float, w.x & 0xffff0000u) * C); w.y = cvt_pk_bf16(__builtin_bit_cast(float, w.y << 16) * C, __builtin_bit_cast(float, w.y & 0xffff0000u) * C);
                    w.z = cvt_pk_bf16(__builtin_bit_cast(float, w.z << 16) * C, __builtin_bit_cast(float, w.z & 0xffff0000u) * C); w.w = cvt_pk_bf16(__builtin_bit_cast(float, w.w << 16) * C, __builtin_bit_cast(float, w.w & 0xffff0000u) * C);
                    *(LAS u32x4*)(Kl + NSA_Q_OFF + wave * 8192 + lane * 16 + d0 * 1024) = w; } }
            float m = 0.f, l = 0.f;
            nsa_branch_compute<3>(Kl, vb, tlc, ntc, ql, t, s0, 0ull, tbl, m, l, o, impr, r32, hi, false);
            float m2 = (l > 0.f && t >= 31) ? m + __builtin_amdgcn_logf(l) : __builtin_inff();
            nsa_cmp_pass2(Kl, vb, ntc, ql, t, s0, tbl, m2, o, impr, r32, hi);
            { int tv = t; asm volatile("" : "+v"(tv)); acc_step<0>(NSA_AROW(tv), nullptr, o, NSA_GATE(tv, 0), hi, false); }
            nsa_topk(imp, selm, wave, lane, s0);
            __syncthreads();
            const unsigned long long mymask = selm[r32]; const unsigned long long uni = nsa_union(mymask);
            const int ns = __builtin_popcountll(uni);
            __syncthreads();
            float lb = 1.f, mb;
            if (!(PROBE_VARIANT == 4 && F.dry)) {
            nsa_branch_compute<0>(Kl, vb, tls, ns, ql, t, s0, mymask, tbl, mb, lb, o, impr, r32, hi, PROBE_VARIANT == 2 && F.dry);
            { int tv = t; asm volatile("" : "+v"(tv)); acc_step<1>(NSA_AROW(tv), nullptr, o, NSA_GATE(tv, 1) / lb, hi, false); }
            nsa_branch_compute<1>(Kl, vb, tlw, ntw, ql, t, s0, mymask, tbl, mb, lb, o, impr, r32, hi, PROBE_VARIANT == 2 && F.dry);
            }
            { int tv = t; asm volatile("" : "+v"(tv)); acc_step<2>(NSA_AROW(tv), Z + ((size_t)b * SEQ + tv) * OD_LD + OD_G + hg * 128, o, NSA_GATE(tv, 2) / lb, hi, F.dry != 0); }
#undef NSA_AROW
#undef NSA_GATE
        } else {
            const int lw = wave - 6;
            nsa_branch_load(Kl, Vl, tlc, ntc, kc, vc, 128, false, lw, lane, false);
            nsa_branch_load(Kl, Vl, tlc, ntc, kc, vc, 128, true, lw, lane, false);
            nsa_topk(imp, selm, wave, lane, s0);
            __syncthreads();
            const unsigned long long uni = nsa_union(selm[r32]);
            const int ns = __builtin_popcountll(uni);
            if (wave == 7) {
                if (lane == 0) { unsigned long long rem = uni; int k = 0; while (rem) { tls[k++] = __builtin_ctzll(rem); rem &= rem - 1; } }
                if (lane < ntw) tlw[lane] = jt0 + lane; }
            __syncthreads();
            if (!(PROBE_VARIANT == 4 && F.dry)) {
            nsa_branch_load(Kl, Vl, tls, ns, zb + OD_KS + g * 128, zb + OD_VS + g * 128, OD_LD, true, lw, lane, (PROBE_VARIANT == 1 || PROBE_VARIANT == 3) && F.dry);
            nsa_branch_load(Kl, Vl, tlw, ntw, zb + OD_KW + g * 128, zb + OD_VW + g * 128, OD_LD, true, lw, lane, (PROBE_VARIANT == 1 || PROBE_VARIANT == 3) && F.dry);
            }
        }
        __syncthreads();
    }
}

template <int MAP>
__device__ __forceinline__ void transpose_item(const float* W, int K, int N, bf16_t* WT, const float* kscale, LAS float* scr, int item, int lane) {
    const int nblk = (N + 31) / 32, kb = item / nblk, nb = item % nblk, k0 = 64 * kb, n0 = 32 * nb;
    const int nl = n0 + (lane & 31);
#pragma unroll 8
    for (int i = 0; i < 32; ++i) { const int kk = 2 * i + (lane >> 5); float v = 0.f; if (nl < N) v = W[(size_t)(k0 + kk) * N + nl]; if (kscale) v *= kscale[k0 + kk]; scr[kk * 33 + (lane & 31)] = v; }
    LDS_WAIT(); asm volatile("" ::: "memory");
    const int c = lane & 7;
#pragma unroll
    for (int j = 0; j < 4; ++j) { const int n = (lane >> 3) + 8 * j; const LAS float* s = scr + (8 * c) * 33 + n;
        u32x4 o; o.x = pk2(s[0 * 33], s[1 * 33]); o.y = pk2(s[2 * 33], s[3 * 33]); o.z = pk2(s[4 * 33], s[5 * 33]); o.w = pk2(s[6 * 33], s[7 * 33]);
        const int ncol = n0 + n;
        if (ncol < N) {
            int drow = ncol;
            if (MAP == 1) { if (ncol >= 3620) drow = OD_G + (ncol - 3620); else if (ncol >= 3108) drow = OD_XQ + (ncol - 3108); else if (ncol >= 3072) drow = OD_LD + (ncol - 3072); }
            *(u32x4*)(WT + (size_t)drow * K + k0 + 8 * c) = o; } }
    LDS_WAIT(); asm volatile("" ::: "memory");
}
__device__ __forceinline__ int t5_bucket(int n) {
    if (n < 16) return n;
    int l = 16 + (int)(__logf((float)n * (1.f / 16.f)) / 2.0794415416798357f * 16.f);
    return l < 31 ? l : 31;
}
__device__ __forceinline__ void prologue(const Frame& F, const Args& a) {
    LAS float* scr = (LAS float*)(F.lds + F.wave * 16384);
    const int gw = F.bid * 8 + F.wave, NGW = F.G * 8, lane = F.lane;
    unsigned char* ws = F.ws;
    const float* norm_g = a.in[2];
    constexpr int I0 = 16 * 160, I1 = 16 * 178, IO = 32 * 32, IM = 16 * 32, IC1 = 64 * 8, IC2 = 4 * 4, IP = 3 * 6;
    constexpr int NITEMS = I0 + I1 + 2 * IO + 2 * IM + 2 * IC1 + 2 * IC2 + 4 * IP;
    for (int it = gw; it < NITEMS; it += NGW) {
        int r = it;
        if (r < I0) { transpose_item<0>(a.in[6], DM, EV_LD, (bf16_t*)(ws + WS_W0), norm_g, scr, r, lane); continue; } r -= I0;
        if (r < I1) { transpose_item<1>(a.in[11], DM, OD_COLS, (bf16_t*)(ws + WS_W1), norm_g + DM, scr, r, lane); continue; } r -= I1;
        if (r < IO) { transpose_item<0>(a.in[10], DIN, DM, (bf16_t*)(ws + WS_WO0), nullptr, scr, r, lane); continue; } r -= IO;
        if (r < IO) { transpose_item<0>(a.in[17], DIN, DM, (bf16_t*)(ws + WS_WO1), nullptr, scr, r, lane); continue; } r -= IO;
        if (r < IM) { transpose_item<0>(a.in[9], DM, DM, (bf16_t*)(ws + WS_WM0), nullptr, scr, r, lane); continue; } r -= IM;
        if (r < IM) { transpose_item<0>(a.in[16], DM, DM, (bf16_t*)(ws + WS_WM1), nullptr, scr, r, lane); continue; } r -= IM;
        if (r < 2 * IC1) { const int kv = r / IC1; transpose_item<0>(a.in[13] + (size_t)kv * 4096 * 256, 4096, 256, (bf16_t*)(ws + WS_WC1) + (size_t)kv * 256 * 4096, nullptr, scr, r % IC1, lane); continue; } r -= 2 * IC1;
        if (r < 2 * IC2) { const int kv = r / IC2; transpose_item<0>(a.in[15] + (size_t)kv * 256 * 128, 256, 128, (bf16_t*)(ws + WS_WC2) + (size_t)kv * 128 * 256, nullptr, scr, r % IC2, lane); continue; } r -= 2 * IC2;
        { const int gi = r / IP; transpose_item<0>(a.in[7] + (size_t)gi * 192 * 192, 192, 192, (bf16_t*)(ws + WS_WP) + (size_t)gi * 192 * 192, nullptr, scr, r % IP, lane); }
    }
    { u32x4* p = (u32x4*)((bf16_t*)(ws + WS_W1) + (size_t)OD_COLS * DM); const int n16 = (OD_N - OD_COLS) * DM * 2 / 16;
      for (int i = F.bid * 512 + F.tid; i < n16; i += F.G * 512) p[i] = (u32x4){0u, 0u, 0u, 0u}; }
    { const float* x = a.in[0]; bf16_t* xb = (bf16_t*)(ws + WS_R); float* part = (float*)(ws + WS_PART);
      for (int m = gw; m < MTOK; m += NGW) {
          const f32x4* xr = (const f32x4*)(x + (size_t)m * DM) + lane; f32x4 v[4]; float s = 0.f;
#pragma unroll
          for (int j = 0; j < 4; ++j) { v[j] = xr[64 * j]; s += (v[j].x * v[j].x + v[j].y * v[j].y) + (v[j].z * v[j].z + v[j].w * v[j].w); }
          s = wave_sum(s);
          u32x2* o8 = (u32x2*)(xb + (size_t)m * DM) + lane;
#pragma unroll
          for (int j = 0; j < 4; ++j) o8[64 * j] = (u32x2){pk2(v[j].x, v[j].y), pk2(v[j].z, v[j].w)};
          if (lane < 16) part[(size_t)m * 16 + lane] = (lane == 0) ? s : 0.f;
      } }
    { const float* mem = a.in[1]; const float* mg = a.in[4]; bf16_t* mn = (bf16_t*)(ws + WS_MEMN);
      for (int m = gw; m < BATCH * NMEM; m += NGW) {
          const f32x4* xr = (const f32x4*)(mem + (size_t)m * DM) + lane; const f32x4* gr = (const f32x4*)mg + lane; f32x4 v[4]; float s = 0.f;
#pragma unroll
          for (int j = 0; j < 4; ++j) { v[j] = xr[64 * j]; s += (v[j].x * v[j].x + v[j].y * v[j].y) + (v[j].z * v[j].z + v[j].w * v[j].w); }
          const float rs = 1.0f / sqrtf(wave_sum(s) * (1.f / DM) + EPS);
          u32x2* o8 = (u32x2*)(mn + (size_t)m * DM) + lane;
#pragma unroll
          for (int j = 0; j < 4; ++j) { const f32x4 g = gr[64 * j]; o8[64 * j] = (u32x2){pk2(v[j].x * rs * g.x, v[j].y * rs * g.y), pk2(v[j].z * rs * g.z, v[j].w * rs * g.w)}; }
      } }
    { float* ct = (float*)(ws + WS_ROPE); float* st = ct + SEQ * 64;
      for (int i = F.bid * 512 + F.tid; i < SEQ * 64; i += F.G * 512) {
          const int s = i >> 6, f = i & 63;
          const float inv = exp2f(-((float)f * (1.f / 64.f)) * 13.287712379549449f);
          const float ang = (float)s * inv;
          const double x = (double)ang; const double kq = rint(x * 0.6366197723675814);
          double r = fma(-kq, 1.5707963267948966, x); r = fma(-kq, 6.123233995736766e-17, r);
          const double r2 = r * r;
          const double sn = r * (1.0 + r2 * (-1.0 / 6 + r2 * (1.0 / 120 + r2 * (-1.0 / 5040 + r2 * (1.0 / 362880 - r2 * (1.0 / 39916800))))));
          const double cs = 1.0 + r2 * (-0.5 + r2 * (1.0 / 24 + r2 * (-1.0 / 720 + r2 * (1.0 / 40320 - r2 * (1.0 / 3628800)))));
          const int q = ((int)kq) & 3;
          double c_, s_;
          if (q == 0) { c_ = cs; s_ = sn; } else if (q == 1) { c_ = -sn; s_ = cs; } else if (q == 2) { c_ = -cs; s_ = -sn; } else { c_ = sn; s_ = -cs; }
          ct[i] = (float)c_; st[i] = (float)s_;
      } }
    if (F.bid == 0) { float* tb = (float*)(ws + WS_MISC); const float* rb = a.in[5];
        for (int i = F.tid; i < 12 * 132; i += 512) { const int h = i / 132, r = i % 132; const int bk = r >= 128 ? 31 : t5_bucket(r); tb[i] = rb[bk * 12 + h] * LOG2E; } }
    if (F.bid < 64 && F.tid < 256) { const int kv = F.bid >> 5, j = F.bid & 31, c = F.tid; const float* pe = a.in[12] + (size_t)kv * 4096; const float* w1 = a.in[13] + (size_t)kv * 4096 * 256;
        float s = 0.f;
        for (int k = 128 * j; k < 128 * j + 128; ++k) s += pe[k] * w1[(size_t)k * 256 + c];
        ((float*)(ws + WS_MISC + 65536))[(kv * 32 + j) * 256 + c] = s; }
}

__device__ __forceinline__ void final_norm(const Frame& F, float* out, const float* part, const float* fg) {
    const int gw = F.bid * 8 + F.wave, NGW = F.G * 8, lane = F.lane;
    for (int m = gw; m < MTOK; m += NGW) {
        float ps = (lane < 16) ? part[(size_t)m * 16 + lane] : 0.f;
        float tot = 0.f;
#pragma unroll
        for (int j = 0; j < 16; ++j) tot += __shfl(ps, j);
        const float rs = 1.0f / sqrtf(tot * (1.f / DM) + EPS);
        f32x4* xr = (f32x4*)(out + (size_t)m * DM) + lane; const f32x4* gr = (const f32x4*)fg + lane;
#pragma unroll
        for (int j = 0; j < 4; ++j) { f32x4 v = xr[64 * j]; const f32x4 g = gr[64 * j]; v.x = v.x * rs * g.x; v.y = v.y * rs * g.y; v.z = v.z * rs * g.z; v.w = v.w * rs * g.w; if (!F.dry) xr[64 * j] = v; }
    }
}
__device__ __forceinline__ void fill_rstd(const Frame& F, const pg8::StaticOrder& S, const float* part) {
    LAS float* rl = (LAS float*)(F.lds + RSTD_OFF); pg8::Unit u;
    for (int i = 0; i < 12 && S.next(i, u); ++i) {
        if (F.tid < 256) { const f32x4* p = (const f32x4*)(part + ((size_t)u.pm * 256 + F.tid) * 16);
            const f32x4 a = p[0], b = p[1], c = p[2], d = p[3];
            float tot = 0.f; tot += a.x; tot += a.y; tot += a.z; tot += a.w; tot += b.x; tot += b.y; tot += b.z; tot += b.w; tot += c.x; tot += c.y; tot += c.z; tot += c.w; tot += d.x; tot += d.y; tot += d.z; tot += d.w;
            rl[i * 256 + F.tid] = 1.0f / sqrtf(tot * (1.f / DM) + EPS); }
    }
    __syncthreads();
}

constexpr int NPHASE = 12;
__global__ void __launch_bounds__(512, 2) fwd_kernel(Args args) {
    extern __shared__ __attribute__((aligned(16))) unsigned char lds_raw[];
    Frame F; F.lds = (LAS unsigned char*)lds_raw; F.tid = threadIdx.x; F.lane = F.tid & 63; F.wave = __builtin_amdgcn_readfirstlane(F.tid >> 6);
    F.G = gridDim.x; F.bid = blockIdx.x; F.ws = args.ws; F.dry = 0;
    unsigned char* ws = args.ws;
    const int lo = args.ph_lo, hi = args.ph_hi;
#define IN(k) (lo <= (k) && (k) < hi)
    { volatile LAS unsigned* mw = (volatile LAS unsigned*)(F.lds + MISC_OFF); if (F.tid < 16) mw[F.tid] = 0u; }
    __syncthreads();
    const XcdBarrier xbar = xcd_barrier_post((unsigned*)(ws + WS_CTL) + 4096, (volatile LAS unsigned*)(F.lds + MISC_OFF));
#define SEAM(k) do { if (IN(k) && IN((k) + 1)) xcd_barrier(xbar); } while (0)
    float* part = (float*)(ws + WS_PART);
    bf16_t* Z = (bf16_t*)(ws + WS_Z);
    bf16_t* HB = (bf16_t*)(ws + WS_R);

#define PHASE(k, ...) if (IN(k)) { { F.dry = 0; __VA_ARGS__ } if ((PROBE_REP >> (k)) & 1) { xcd_barrier(xbar); F.dry = 1; __VA_ARGS__ } }
    PHASE(0, prologue(F, args);)
    SEAM(0);
    PHASE(1,
        { pg8::StaticOrder S; S.init(MTOK, EV_LD, F.G, F.bid); fill_rstd(F, S, part);
          pg8::Gemm g{HB, (const bf16_t*)(ws + WS_W0), MTOK, EV_LD, DM, DM};
          EpiIn E{Z, EV_LD, (const LAS float*)(F.lds + RSTD_OFF), EV_G / 256, -1, nullptr, 0, 0};
          pg8::gemm_phase(F.lds, g, S, E); }
        { pg8::StaticOrder S; S.init(BATCH * NMEM, DM, F.G, F.bid);
          pg8::Gemm g{(const bf16_t*)(ws + WS_MEMN), (const bf16_t*)(ws + WS_WM0), BATCH * NMEM, DM, DM, DM};
          EpiBf E{(bf16_t*)(ws + WS_MKV0), DM};
          pg8::gemm_phase(F.lds, g, S, E); }
        { pg8::StaticOrder S; S.init(BATCH * NMEM, DM, F.G, (F.bid + 128) % F.G);
          pg8::Gemm g{(const bf16_t*)(ws + WS_MEMN), (const bf16_t*)(ws + WS_WM1), BATCH * NMEM, DM, DM, DM};
          EpiBf E{(bf16_t*)(ws + WS_MKV1), DM};
          pg8::gemm_phase(F.lds, g, S, E); }
    )
    SEAM(1);
    PHASE(2,
        ret_a_phase(F, Z, (const float*)(ws + WS_ROPE), (const float*)(ws + WS_ROPE) + SEQ * 64, (float*)(ws + WS_R), F.bid, F.G);
        pool_phase(F, Z, (const bf16_t*)(ws + WS_WP), args.in[8], F.bid, F.G);
        mem_attn_phase(F, Z, EV_LD, EV_XQ, EV_G + 1536, (const bf16_t*)(ws + WS_MKV0), F.bid, F.G);
    )
    SEAM(2);
    PHASE(3, ret_scan_phase(F, (float*)(ws + WS_R));)
    SEAM(3);
    PHASE(4, ret_c_phase(F, Z, (const float*)(ws + WS_R), F.bid, F.G);)
    SEAM(4);
    PHASE(5,
        pg8::StaticOrder S; S.init(MTOK, DM, F.G, F.bid);
        pg8::Gemm g{Z + EV_G, (const bf16_t*)(ws + WS_WO0), MTOK, DM, DIN, EV_LD};
        EpiOut E{args.in[0], args.out, HB, part, F.dry};
        pg8::gemm_phase(F.lds, g, S, E);
    )
    SEAM(5);
    PHASE(6,
        pg8::StaticOrder S; S.init(MTOK, OD_N, F.G, F.bid); fill_rstd(F, S, part);
        pg8::Gemm g{HB, (const bf16_t*)(ws + WS_W1), MTOK, OD_N, DM, DM};
        EpiIn E{Z, OD_LD, (const LAS float*)(F.lds + RSTD_OFF), OD_G / 256, OD_LD / 256, (float*)(ws + WS_GATES), 0, 0};
        pg8::gemm_phase(F.lds, g, S, E);
    )
    SEAM(6);
    PHASE(7,
        if (F.bid < 128) compress_phase(F, Z, (const bf16_t*)(ws + WS_WC1), (const bf16_t*)(ws + WS_WC2), args.in[14], (const float*)(ws + WS_MISC + 65536), (bf16_t*)(ws + WS_KCMP), (bf16_t*)(ws + WS_VCMP), F.bid, 128);
        else mem_attn_phase(F, Z, OD_LD, OD_XQ, OD_G + 1536, (const bf16_t*)(ws + WS_MKV1), F.bid - 128, F.G - 128);
    )
    SEAM(7);
    PHASE(8, nsa_phase(F, Z, (const float*)(ws + WS_GATES), (const bf16_t*)(ws + WS_KCMP), (const bf16_t*)(ws + WS_VCMP), (const float*)(ws + WS_MISC));)
    SEAM(8); SEAM(9);
    PHASE(10,
        pg8::StaticOrder S; S.init(MTOK, DM, F.G, F.bid);
        pg8::Gemm g{Z + OD_G, (const bf16_t*)(ws + WS_WO1), MTOK, DM, DIN, OD_LD};
        EpiOut E{args.out, args.out, HB, part, F.dry};
        pg8::gemm_phase(F.lds, g, S, E);
    )
    SEAM(10);
    PHASE(11, final_norm(F, args.out, part, args.in[3]);)
#undef PHASE
#undef IN
#undef SEAM
}

extern "C" void kernel_launch(void* const* d_in, const int* in_sizes, int n_in, void* d_out, int out_size, void* d_ws, size_t ws_size, hipStream_t stream) {
    static int grid = 0;
    if (grid == 0) {
        if (n_in != 18 || out_size != MTOK * DM || ws_size < WS_END) { fprintf(stderr, "kernel_launch: unexpected shapes: n_in %d out %d ws %zu (need %zu)\n", n_in, out_size, ws_size, (size_t)WS_END); grid = -1; return; }
        int dev = 0, cus = 0, per_cu = 0;
        hipGetDevice(&dev); hipDeviceGetAttribute(&cus, hipDeviceAttributeMultiprocessorCount, dev);
        if (hipFuncSetAttribute((const void*)fwd_kernel, hipFuncAttributeMaxDynamicSharedMemorySize, LDS_BYTES) != hipSuccess) { fprintf(stderr, "kernel_launch: hipFuncSetAttribute failed\n"); grid = -1; return; }
        if (hipOccupancyMaxActiveBlocksPerMultiprocessor(&per_cu, (const void*)fwd_kernel, 512, LDS_BYTES) != hipSuccess || per_cu < 1) { fprintf(stderr, "kernel_launch: occupancy query says %d\n", per_cu); per_cu = 1; }
        (void)hipGetLastError();
        grid = cus;
    }
    if (grid < 0) return;
    if (hipMemsetAsync((char*)d_ws + WS_CTL, 0, CTL_BYTES, stream) != hipSuccess) { fprintf(stderr, "kernel_launch: memset failed\n"); return; }
    Args a{};
    for (int i = 0; i < 18; ++i) a.in[i] = (const float*)d_in[i];
    a.out = (float*)d_out; a.ws = (unsigned char*)d_ws; a.ph_lo = 0; a.ph_hi = NPHASE;
    void* kargs[] = {&a};
    hipError_t e = hipLaunchCooperativeKernel((const void*)fwd_kernel, dim3(grid), dim3(512), kargs, LDS_BYTES, stream);
    if (e != hipSuccess) fprintf(stderr, "kernel_launch: cooperative launch failed: %s (grid %d)\n", hipGetErrorString(e), grid);
}
```

```cpp
#include <hip/hip_runtime.h>
#include <hip/hip_cooperative_groups.h>
#include <cstdio>
#include <cstdint>
namespace cg = cooperative_groups;

#define LAS __attribute__((address_space(3)))
#define GAS __attribute__((address_space(1)))
typedef unsigned short bf16_t;
typedef short bf16x8 __attribute__((ext_vector_type(8)));
typedef short s16x4 __attribute__((ext_vector_type(4)));
typedef float f32x4 __attribute__((ext_vector_type(4)));
typedef float f32x16 __attribute__((ext_vector_type(16)));
typedef unsigned u32x4 __attribute__((ext_vector_type(4)));
typedef unsigned u32x2 __attribute__((ext_vector_type(2)));

#ifndef PROBE_REP
#define PROBE_REP 0
#endif
#ifndef PROBE_SPIN
#define PROBE_SPIN 0
#endif
#ifndef PROBE_VARIANT
#define PROBE_VARIANT 0
#endif
constexpr int BATCH = 8, SEQ = 4096, DM = 1024, MTOK = BATCH * SEQ, NMEM = 256, DIN = 2048;
constexpr float EPS = 1e-6f;
constexpr float LOG2E = 1.4426950408889634f;
constexpr int EV_LD = 5120, EV_ZA = 0, EV_RQ = 768, EV_RK = 1280, EV_RV = 1792, EV_XQ = 2560, EV_G = 3072;
constexpr int OD_LD = 5632, OD_N = 5888, OD_COLS = 5668, OD_Q = 0, OD_KC = 1536, OD_VC = 1792, OD_KS = 2048, OD_VS = 2304, OD_KW = 2560, OD_VW = 2816, OD_XQ = 3072, OD_G = 3584;
constexpr int GATE_LD = 40;
constexpr size_t MiB = 1u << 20;
constexpr size_t WS_CTL = 0, CTL_BYTES = 1 * MiB;
constexpr size_t WS_W0 = 1 * MiB;
constexpr size_t WS_W1 = WS_W0 + (size_t)EV_LD * DM * 2;
constexpr size_t WS_WO0 = WS_W1 + (size_t)OD_N * DM * 2;
constexpr size_t WS_WO1 = WS_WO0 + (size_t)DM * DIN * 2;
constexpr size_t WS_WM0 = WS_WO1 + (size_t)DM * DIN * 2;
constexpr size_t WS_WM1 = WS_WM0 + (size_t)DM * DM * 2;
constexpr size_t WS_WC1 = WS_WM1 + (size_t)DM * DM * 2;
constexpr size_t WS_WC2 = WS_WC1 + (size_t)2 * 256 * 4096 * 2;
constexpr size_t WS_WP = WS_WC2 + (size_t)2 * 128 * 256 * 2;
constexpr size_t WS_WEND = WS_WP + (size_t)4 * 192 * 192 * 2;
static_assert(WS_WEND <= 41 * MiB, "weights");
constexpr size_t WS_MEMN = 41 * MiB, WS_MKV0 = 45 * MiB, WS_MKV1 = 49 * MiB;
constexpr size_t WS_ROPE = 53 * MiB;
constexpr size_t WS_PART = 55 * MiB;
constexpr size_t WS_MISC = 57 * MiB;
constexpr size_t WS_Z = 58 * MiB;
constexpr size_t WS_R = 410 * MiB;
constexpr size_t WS_GATES = WS_R + 64 * MiB;
constexpr size_t WS_KCMP = WS_R + 70 * MiB, WS_VCMP = WS_R + 71 * MiB;
constexpr size_t WS_END = 506 * MiB;

constexpr int RING_BYTES = 131072, RSTD_OFF = RING_BYTES, RSTD_BYTES = 12 * 1024, LDS_BYTES = 163840, MISC_OFF = LDS_BYTES - 256;

__device__ __forceinline__ unsigned f2bf(float f) { unsigned u = __builtin_bit_cast(unsigned, f); return (u + 0x7fffu + ((u >> 16) & 1u)) >> 16; }
__device__ __forceinline__ unsigned pk2(float lo, float hi) { return f2bf(lo) | (f2bf(hi) << 16); }
__device__ __forceinline__ float bf2f(unsigned short b) { return __builtin_bit_cast(float, (unsigned)b << 16); }
typedef float f32x2_t __attribute__((ext_vector_type(2))); typedef __bf16 bf16x2_t __attribute__((ext_vector_type(2)));
__device__ __forceinline__ unsigned cvt_pk_bf16(float lo, float hi) { f32x2_t v = {lo, hi}; bf16x2_t b = __builtin_convertvector(v, bf16x2_t); return __builtin_bit_cast(unsigned, b); }
__device__ __forceinline__ float wave_sum(float v) {
#pragma unroll
    for (int o = 1; o < 64; o <<= 1) v += __shfl_xor(v, o);
    return v;
}
__device__ __forceinline__ float fast_sigmoid(float v) { return __builtin_amdgcn_rcpf(1.f + __builtin_amdgcn_exp2f(-v * LOG2E)); }
#define LDS_WAIT() asm volatile("s_waitcnt lgkmcnt(0)" ::: "memory")
#define VM_WAIT() asm volatile("s_waitcnt vmcnt(0)" ::: "memory")

#define XB_TMO      128
#define XB_XCNT(j)  (256  + 64 * (j))
#define XB_XSUB(j)  (1280 + 64 * (j))
#define XB_XGEN(j)  (2304 + 64 * (j))
#define XB_TOP      3328
#define XB_TOPGEN   3392
#define XCD_BAR_WORDS 3456
#define XB_SPIN_CAP (1u << 18)
__device__ __forceinline__ unsigned xb_ld(unsigned* p)              { return __hip_atomic_load(p, __ATOMIC_RELAXED, __HIP_MEMORY_SCOPE_AGENT); }
__device__ __forceinline__ unsigned xb_add(unsigned* p, unsigned v) { return __hip_atomic_fetch_add(p, v, __ATOMIC_RELAXED, __HIP_MEMORY_SCOPE_AGENT); }
__device__ __forceinline__ unsigned xb_xcc_id() { return (unsigned)__builtin_amdgcn_s_getreg((3 << 11) | 20) & 0xFu; }
#define XB_SPIN(cond, bar) do { unsigned _sp = 0; while (cond) { __builtin_amdgcn_s_sleep(1); \
    if ((++_sp & 255u) == 0u) { if (xb_ld(&(bar)[XB_TMO])) break; if (_sp > XB_SPIN_CAP) { atomicAdd(&(bar)[XB_TMO], 1u); break; } } } } while (0)
struct XcdBarrier { unsigned* bar; unsigned x; volatile LAS unsigned* st; };
__device__ __forceinline__ XcdBarrier xcd_barrier_post(unsigned* bar, volatile LAS unsigned* st) {
    XcdBarrier b; b.bar = bar; b.x = xb_xcc_id(); b.st = st;
    if (threadIdx.x == 0) (void)xb_add(&bar[XB_XCNT(b.x)], 1u);
    return b;
}
__device__ __forceinline__ void xcd_barrier_complete(unsigned* bar, unsigned x, unsigned& nloc, unsigned& nx) {
    const unsigned G = gridDim.x * gridDim.y * gridDim.z;
    unsigned sum, cnt, mine, sp = 0u;
    for (;;) {
        sum = 0u; cnt = 0u; mine = 0u;
#pragma unroll
        for (unsigned j = 0; j < 16; ++j) { const unsigned c = xb_ld(&bar[XB_XCNT(j)]); sum += c; cnt += (c > 0u) ? 1u : 0u; mine = (j == x) ? c : mine; }
        if (sum == G) break;
        __builtin_amdgcn_s_sleep(1);
        if ((++sp & 255u) == 0u) { if (xb_ld(&bar[XB_TMO])) break; if (sp > XB_SPIN_CAP) { atomicAdd(&bar[XB_TMO], 1u); break; } }
    }
    nloc = mine > 0u ? mine : 1u; nx = cnt > 0u ? cnt : 1u;
}
__device__ __forceinline__ void xcd_barrier(const XcdBarrier& b) {
    asm volatile("s_waitcnt vmcnt(0)" ::: "memory");
    __syncthreads();
    if (threadIdx.x == 0) {
        unsigned* bar = b.bar;
        __builtin_amdgcn_s_waitcnt(0);
        unsigned nloc = b.st[0], nx = b.st[1];
        if (nloc == 0u) { xcd_barrier_complete(bar, b.x, nloc, nx); b.st[0] = nloc; b.st[1] = nx; }
        const unsigned old = xb_add(&bar[XB_XSUB(b.x)], 1u);
        const unsigned gen = old / nloc;
        if (old + 1u == (gen + 1u) * nloc) {
            __builtin_amdgcn_fence(__ATOMIC_RELEASE, "agent");
            asm volatile("s_waitcnt vmcnt(0)" ::: "memory");
            const unsigned og = xb_add(&bar[XB_TOP], 1u);
            const unsigned tg = og / nx;
            if (og + 1u == (tg + 1u) * nx) xb_add(&bar[XB_TOPGEN], 1u);
            else XB_SPIN(xb_ld(&bar[XB_TOPGEN]) == tg, bar);
            __builtin_amdgcn_fence(__ATOMIC_ACQUIRE, "agent");
            xb_add(&bar[XB_XGEN(b.x)], 1u);
            asm volatile("s_waitcnt vmcnt(0)" ::: "memory");
        } else {
            XB_SPIN(xb_ld(&bar[XB_XGEN(b.x)]) == gen, bar);
            __builtin_amdgcn_fence(__ATOMIC_ACQUIRE, "agent");
            asm volatile("s_waitcnt vmcnt(0)" ::: "memory");
        }
    }
    __syncthreads();
}

namespace pg8 {
constexpr int BM = 256, BK = 64, HALF = 128, HTB = HALF * BK * 2, STAGE_BYTES = 8 * HTB, NXCD = 8, WGM = 8;
__host__ __device__ __forceinline__ int lds_byte(int r, int c) { const int st = (r >> 4) * 2 + (c >> 5), rr = r & 15, cc = c & 31, ob = rr * 64 + cc * 2; return st * 1024 + (ob ^ (((ob >> 9) & 1) << 5)); }
__host__ __device__ __forceinline__ void stage_rc(int b, int& R, int& C) { const int st = b / 1024, sb = b % 1024, swz = sb ^ (((sb >> 9) & 1) << 5); R = (st >> 1) * 16 + swz / 64; C = (st & 1) * 32 + (swz % 64) / 2; }
__host__ __device__ __forceinline__ int perm32(int rho) { const int n = rho >> 4, i = rho & 15; return 8 * (i >> 2) + 4 * n + (i & 3); }
struct Unit { int pm, pn, idx; };
struct Gemm { const bf16_t* A; const bf16_t* Bt; int M, N, K, lda; };
struct StaticOrder {
    int nM, nN, nwg, G, c;
    __device__ void init(int M, int N, int G_, int c_) { nM = M / BM; nN = N / BM; nwg = nM * nN; G = G_; c = c_; }
    __device__ bool next(int i, Unit& u) const {
        const long L = (long)i * G + c; if (L >= nwg) return false;
        int wgid = (int)L; { const int q = nwg / NXCD, r = nwg % NXCD, xcd = wgid % NXCD, off = wgid / NXCD; wgid = (xcd < r ? xcd * (q + 1) : r * (q + 1) + (xcd - r) * q) + off; }
        const int nig = WGM * nN, gid = wgid / nig, fm = gid * WGM, gsz = (nM - fm) < WGM ? (nM - fm) : WGM;
        u.pm = fm + ((wgid % nig) % gsz); u.pn = (wgid % nig) / gsz; u.idx = i; return true;
    }
};
template <class Epi>
__device__ __forceinline__ void gemm_phase(LAS unsigned char* lds, const Gemm g, const StaticOrder& S, const Epi& E) {
    const int tid = threadIdx.x, wid = __builtin_amdgcn_readfirstlane(tid >> 6), lane = tid & 63, wr = wid >> 2, wc = wid & 3, fr = lane & 15, fq = lane >> 4;
    const int K = g.K, nt = K / BK, lda = g.lda;
    unsigned voffA[2], voffB[2];
#pragma unroll
    for (int i = 0; i < 2; ++i) { int R, C; stage_rc(tid * 16 + i * 8192, R, C); const int Rb = (R & ~31) + perm32(R & 31);
        voffA[i] = (unsigned)(R * lda + C) * 2u; voffB[i] = (unsigned)(Rb * K + C) * 2u; }
    const size_t kstep = (size_t)(BK * 2);
    const size_t hstepA = (size_t)HALF * lda * 2, hstepB = (size_t)HALF * K * 2;
    const size_t tstepA = 2 * hstepA, tstepB = 2 * hstepB;
    const unsigned ldsw = (unsigned)wid * 1024u;
    const int aoff = lds_byte(wr * 64 + fr, fq * 8), boff = lds_byte(wc * 32 + fr, fq * 8);
#define PG8_SA(b, h) (((b) * 2 + (h)) * HTB)
#define PG8_SB(b, h) ((4 + (b) * 2 + (h)) * HTB)
#define PG8_STAGE(bufoff, gbase, voff) do { _Pragma("unroll") for (int _i = 0; _i < 2; ++_i) \
        __builtin_amdgcn_global_load_lds((const unsigned*)((const char*)(gbase) + (voff)[_i]), (LAS unsigned*)(lds + (bufoff) + ldsw + _i * 8192), 16, 0, 0); } while (0)
#define PG8_LDA(dst, b, h) do { _Pragma("unroll") for (int m = 0; m < 4; ++m) _Pragma("unroll") for (int k = 0; k < 2; ++k) dst[m][k] = *(const LAS bf16x8*)(lds + PG8_SA(b, h) + aoff + m * 2048 + k * 1024); } while (0)
#define PG8_LDB(dst, b, h) do { _Pragma("unroll") for (int n = 0; n < 2; ++n) _Pragma("unroll") for (int k = 0; k < 2; ++k) dst[n][k] = *(const LAS bf16x8*)(lds + PG8_SB(b, h) + boff + n * 2048 + k * 1024); } while (0)
#define PG8_MMA(ai, bj, At, Bt) do { __builtin_amdgcn_s_setprio(1); _Pragma("unroll") for (int m = 0; m < 4; ++m) _Pragma("unroll") for (int n = 0; n < 2; ++n) _Pragma("unroll") for (int k = 0; k < 2; ++k) \
        acc[ai][bj][m][n] = __builtin_amdgcn_mfma_f32_16x16x32_bf16(Bt[n][k], At[m][k], acc[ai][bj][m][n], 0, 0, 0); __builtin_amdgcn_s_setprio(0); } while (0)
#define PG8_WAIT_V(n) asm volatile("s_waitcnt vmcnt(" #n ")" ::: "memory")
#define PG8_WAIT_L(n) asm volatile("s_waitcnt lgkmcnt(" #n ")" ::: "memory")
#define PG8_BAR __builtin_amdgcn_s_barrier()
#define PG8_SCHED __builtin_amdgcn_sched_barrier(0)
    Unit cur, nxt; int ui = 0;
    if (!S.next(0, cur)) return;
    f32x4 acc[2][2][4][2];
#pragma unroll
    for (int a = 0; a < 2; ++a)
#pragma unroll
        for (int b = 0; b < 2; ++b)
#pragma unroll
            for (int m = 0; m < 4; ++m)
#pragma unroll
                for (int n = 0; n < 2; ++n) acc[a][b][m][n] = (f32x4){0.f, 0.f, 0.f, 0.f};
    bf16x8 At[4][2], B0[2][2], B1[2][2];
    const char* cA = (const char*)g.A + (size_t)cur.pm * tstepA; const char* cB = (const char*)g.Bt + (size_t)cur.pn * tstepB;
    PG8_STAGE(PG8_SB(0, 0), cB, voffB); PG8_STAGE(PG8_SB(0, 1), cB + hstepB, voffB); PG8_STAGE(PG8_SA(0, 0), cA, voffA); PG8_STAGE(PG8_SA(0, 1), cA + hstepA, voffA);
    if (wr == 1) PG8_BAR;
    PG8_WAIT_V(2); PG8_BAR;
    PG8_STAGE(PG8_SB(1, 0), cB + kstep, voffB); PG8_STAGE(PG8_SA(1, 0), cA + kstep, voffA); PG8_STAGE(PG8_SB(1, 1), cB + hstepB + kstep, voffB);
    PG8_WAIT_V(6); PG8_BAR;
    for (;;) {
        const bool has_next = S.next(ui + 1, nxt);
        const char* nA = has_next ? (const char*)g.A + (size_t)nxt.pm * tstepA : cA; const char* nB = has_next ? (const char*)g.Bt + (size_t)nxt.pn * tstepB : cB;
        for (int t = 0; t < nt; t += 2) {
            const bool last = (t == nt - 2);
            const char* a1 = cA + (size_t)(t + 1) * kstep;
            const char* a2 = last ? nA : cA + (size_t)(t + 2) * kstep; const char* b2 = last ? nB : cB + (size_t)(t + 2) * kstep;
            const char* a3 = a2 + kstep; const char* b3 = b2 + kstep;
            PG8_LDB(B0, 0, 0); PG8_LDB(B1, 0, 1); PG8_SCHED; PG8_LDA(At, 0, 0); PG8_STAGE(PG8_SA(1, 1), a1 + hstepA, voffA);
            PG8_WAIT_V(8); PG8_WAIT_L(0); PG8_BAR; PG8_MMA(0, 0, At, B0); PG8_MMA(0, 1, At, B1); PG8_BAR; PG8_SCHED;
            PG8_LDA(At, 0, 1); PG8_STAGE(PG8_SB(0, 0), b2, voffB); PG8_STAGE(PG8_SB(0, 1), b2 + hstepB, voffB); PG8_STAGE(PG8_SA(0, 0), a2, voffA);
            PG8_WAIT_V(8); PG8_WAIT_L(0); PG8_BAR; PG8_MMA(1, 0, At, B0); PG8_MMA(1, 1, At, B1); PG8_BAR; PG8_SCHED;
            PG8_LDB(B0, 1, 0); PG8_LDB(B1, 1, 1); PG8_SCHED; PG8_LDA(At, 1, 0); PG8_STAGE(PG8_SA(0, 1), a2 + hstepA, voffA);
            PG8_WAIT_V(8); PG8_WAIT_L(0); PG8_BAR; PG8_MMA(0, 0, At, B0); PG8_MMA(0, 1, At, B1); PG8_BAR; PG8_SCHED;
            PG8_LDA(At, 1, 1); PG8_STAGE(PG8_SB(1, 0), b3, voffB); PG8_STAGE(PG8_SB(1, 1), b3 + hstepB, voffB); PG8_STAGE(PG8_SA(1, 0), a3, voffA);
            PG8_WAIT_V(8); PG8_WAIT_L(0); PG8_BAR; PG8_MMA(1, 0, At, B0); PG8_MMA(1, 1, At, B1); PG8_BAR; PG8_SCHED;
        }
        if (wr == 0) PG8_BAR;
        E(acc, cur, wr, wc, fr, fq);
        if (!has_next) break;
#pragma unroll
        for (int a = 0; a < 2; ++a)
#pragma unroll
            for (int b = 0; b < 2; ++b)
#pragma unroll
                for (int m = 0; m < 4; ++m)
#pragma unroll
                    for (int n = 0; n < 2; ++n) acc[a][b][m][n] = (f32x4){0.f, 0.f, 0.f, 0.f};
        cur = nxt; cA = nA; cB = nB; ++ui;
        if (wr == 1) PG8_BAR;
    }
    PG8_WAIT_V(0);
    PG8_BAR;
#undef PG8_SA
#undef PG8_SB
#undef PG8_STAGE
#undef PG8_LDA
#undef PG8_LDB
#undef PG8_MMA
#undef PG8_WAIT_V
#undef PG8_WAIT_L
#undef PG8_BAR
#undef PG8_SCHED
}
}

struct EpiIn {
    bf16_t* Z; int ldz; const LAS float* rstd; int pn_silu, pn_gate; float* gates; int zlo, zhi;
    __device__ __forceinline__ void operator()(const f32x4 (&acc)[2][2][4][2], const pg8::Unit& u, int wr, int wc, int fr, int fq) const {
        const int rl0 = wr * 64 + fr, col0 = u.pn * 256 + wc * 32 + 8 * fq;
        const bool is_gate = (u.pn == pn_gate), is_silu = (u.pn >= pn_silu) && !is_gate;
#pragma unroll
        for (int ai = 0; ai < 2; ++ai)
#pragma unroll
            for (int m = 0; m < 4; ++m) {
                const int rl = rl0 + ai * 128 + m * 16; const float rs = rstd[u.idx * 256 + rl]; const size_t row = (size_t)u.pm * 256 + rl;
#pragma unroll
                for (int bj = 0; bj < 2; ++bj) {
                    f32x4 v0 = acc[ai][bj][m][0] * rs, v1 = acc[ai][bj][m][1] * rs;
                    if (is_gate) {
                        const int c = wc * 32 + 8 * fq + bj * 128;
                        if (c < 36) { float* gp = gates + row * GATE_LD + c;
#pragma unroll
                            for (int j = 0; j < 4; ++j) { gp[j] = fast_sigmoid(v0[j]); if (c + 4 + j < 36) gp[4 + j] = fast_sigmoid(v1[j]); } }
                    } else {
                        if (is_silu) {
#pragma unroll
                            for (int j = 0; j < 4; ++j) { v0[j] = v0[j] * fast_sigmoid(v0[j]); v1[j] = v1[j] * fast_sigmoid(v1[j]); }
                            if (u.pn >= zlo && u.pn < zhi) { v0 = (f32x4){0.f, 0.f, 0.f, 0.f}; v1 = v0; }
                        }
                        u32x4 w; w.x = cvt_pk_bf16(v0[0], v0[1]); w.y = cvt_pk_bf16(v0[2], v0[3]); w.z = cvt_pk_bf16(v1[0], v1[1]); w.w = cvt_pk_bf16(v1[2], v1[3]);
                        *(u32x4*)(Z + row * ldz + col0 + bj * 128) = w;
                    }
                }
            }
    }
};
struct EpiBf {
    bf16_t* O; int ldc;
    __device__ __forceinline__ void operator()(const f32x4 (&acc)[2][2][4][2], const pg8::Unit& u, int wr, int wc, int fr, int fq) const {
        const int row0 = u.pm * 256 + wr * 64 + fr, col0 = u.pn * 256 + wc * 32 + 8 * fq;
#pragma unroll
        for (int ai = 0; ai < 2; ++ai)
#pragma unroll
            for (int m = 0; m < 4; ++m)
#pragma unroll
                for (int bj = 0; bj < 2; ++bj) {
                    const f32x4 v0 = acc[ai][bj][m][0], v1 = acc[ai][bj][m][1];
                    u32x4 w; w.x = cvt_pk_bf16(v0[0], v0[1]); w.y = cvt_pk_bf16(v0[2], v0[3]); w.z = cvt_pk_bf16(v1[0], v1[1]); w.w = cvt_pk_bf16(v1[2], v1[3]);
                    *(u32x4*)(O + (size_t)(row0 + ai * 128 + m * 16) * ldc + col0 + bj * 128) = w;
                }
    }
};
template <bool BASE_F32> struct EpiOut {
    const float* base; bf16_t* hb; float* part; int dry;
    __device__ __forceinline__ void operator()(const f32x4 (&acc)[2][2][4][2], const pg8::Unit& u, int wr, int wc, int fr, int fq) const {
        const int row0 = u.pm * 256 + wr * 64 + fr, col0 = u.pn * 256 + wc * 32 + 8 * fq;
#pragma unroll
        for (int ai = 0; ai < 2; ++ai) {
            f32x4 bv[4][2][2]; u32x4 hv[4][2];
#pragma unroll
            for (int m = 0; m < 4; ++m)
#pragma unroll
                for (int bj = 0; bj < 2; ++bj) { const size_t off = (size_t)(row0 + ai * 128 + m * 16) * DM + col0 + bj * 128;
                    if (BASE_F32) { bv[m][bj][0] = *(const f32x4*)(base + off); bv[m][bj][1] = *(const f32x4*)(base + off + 4); } else hv[m][bj] = *(const u32x4*)(hb + off); }
#pragma unroll
            for (int m = 0; m < 4; ++m) {
                const size_t row = (size_t)(row0 + ai * 128 + m * 16); float ss = 0.f;
#pragma unroll
                for (int bj = 0; bj < 2; ++bj) {
                    const size_t off = row * DM + col0 + bj * 128;
                    f32x4 b0, b1;
                    if (BASE_F32) { b0 = bv[m][bj][0]; b1 = bv[m][bj][1]; }
                    else { const u32x4 hw = hv[m][bj];
                        b0 = (f32x4){__builtin_bit_cast(float, hw.x << 16), __builtin_bit_cast(float, hw.x & 0xffff0000u), __builtin_bit_cast(float, hw.y << 16), __builtin_bit_cast(float, hw.y & 0xffff0000u)};
                        b1 = (f32x4){__builtin_bit_cast(float, hw.z << 16), __builtin_bit_cast(float, hw.z & 0xffff0000u), __builtin_bit_cast(float, hw.w << 16), __builtin_bit_cast(float, hw.w & 0xffff0000u)}; }
                    const f32x4 v0 = acc[ai][bj][m][0] + b0, v1 = acc[ai][bj][m][1] + b1;
                    u32x4 w; w.x = cvt_pk_bf16(v0[0], v0[1]); w.y = cvt_pk_bf16(v0[2], v0[3]); w.z = cvt_pk_bf16(v1[0], v1[1]); w.w = cvt_pk_bf16(v1[2], v1[3]);
                    if (!dry) *(u32x4*)(hb + off) = w;
                    ss += (v0[0] * v0[0] + v0[1] * v0[1]) + (v0[2] * v0[2] + v0[3] * v0[3]) + (v1[0] * v1[0] + v1[1] * v1[1]) + (v1[2] * v1[2] + v1[3] * v1[3]);
                }
                ss += __shfl_xor(ss, 16); ss += __shfl_xor(ss, 32);
                if (fq == 0 && !dry) part[row * 16 + u.pn * 4 + wc] = ss;
            }
        }
    }
};
struct EpiFinal {
    const bf16_t* hb; float* out; float* part; const float* fg; unsigned* flags; unsigned* bar;
    __device__ __forceinline__ void operator()(f32x4 (&acc)[2][2][4][2], const pg8::Unit& u, int wr, int wc, int fr, int fq) const {
        const int row0 = u.pm * 256 + wr * 64 + fr, col0 = u.pn * 256 + wc * 32 + 8 * fq;
        u32x4 hwv[2][4][2];
#pragma unroll
        for (int ai = 0; ai < 2; ++ai)
#pragma unroll
            for (int m = 0; m < 4; ++m)
#pragma unroll
                for (int bj = 0; bj < 2; ++bj) hwv[ai][m][bj] = *(const u32x4*)(hb + (size_t)(row0 + ai * 128 + m * 16) * DM + col0 + bj * 128);
#pragma unroll
        for (int ai = 0; ai < 2; ++ai)
#pragma unroll
            for (int m = 0; m < 4; ++m) {
                const size_t row = (size_t)(row0 + ai * 128 + m * 16); float ss = 0.f;
#pragma unroll
                for (int bj = 0; bj < 2; ++bj) {
                    const u32x4 hw = hwv[ai][m][bj];
                    const f32x4 b0 = {__builtin_bit_cast(float, hw.x << 16), __builtin_bit_cast(float, hw.x & 0xffff0000u), __builtin_bit_cast(float, hw.y << 16), __builtin_bit_cast(float, hw.y & 0xffff0000u)};
                    const f32x4 b1 = {__builtin_bit_cast(float, hw.z << 16), __builtin_bit_cast(float, hw.z & 0xffff0000u), __builtin_bit_cast(float, hw.w << 16), __builtin_bit_cast(float, hw.w & 0xffff0000u)};
                    const f32x4 v0 = acc[ai][bj][m][0] + b0, v1 = acc[ai][bj][m][1] + b1;
                    acc[ai][bj][m][0] = v0; acc[ai][bj][m][1] = v1;
                    ss += (v0[0] * v0[0] + v0[1] * v0[1]) + (v0[2] * v0[2] + v0[3] * v0[3]) + (v1[0] * v1[0] + v1[1] * v1[1]) + (v1[2] * v1[2] + v1[3] * v1[3]);
                }
                ss += __shfl_xor(ss, 16); ss += __shfl_xor(ss, 32);
                if (fq == 0) __hip_atomic_store(part + row * 16 + u.pn * 4 + wc, ss, __ATOMIC_RELAXED, __HIP_MEMORY_SCOPE_AGENT);
            }
        unsigned* fl = flags + (u.pm * 2 + wr) * 16;
        asm volatile("s_waitcnt vmcnt(0)" ::: "memory");
        if (fr == 0 && fq == 0) (void)xb_add(fl, 1u);
        XB_SPIN(xb_ld(fl) < 16u, bar);
        asm volatile("" ::: "memory");
        float t0, t1;
        { const float* pa = part + (size_t)(u.pm * 256 + wr * 64 + fr + 16 * fq) * 16; const float* pb = pa + (size_t)128 * 16;
          f32x4 a0, a1, a2, a3, b0, b1, b2, b3;
          asm volatile("global_load_dwordx4 %0, %1, off sc1" : "=v"(a0) : "v"(pa) : "memory");
          asm volatile("global_load_dwordx4 %0, %1, off offset:16 sc1" : "=v"(a1) : "v"(pa) : "memory");
          asm volatile("global_load_dwordx4 %0, %1, off offset:32 sc1" : "=v"(a2) : "v"(pa) : "memory");
          asm volatile("global_load_dwordx4 %0, %1, off offset:48 sc1" : "=v"(a3) : "v"(pa) : "memory");
          asm volatile("global_load_dwordx4 %0, %1, off sc1" : "=v"(b0) : "v"(pb) : "memory");
          asm volatile("global_load_dwordx4 %0, %1, off offset:16 sc1" : "=v"(b1) : "v"(pb) : "memory");
          asm volatile("global_load_dwordx4 %0, %1, off offset:32 sc1" : "=v"(b2) : "v"(pb) : "memory");
          asm volatile("global_load_dwordx4 %0, %1, off offset:48 sc1" : "=v"(b3) : "v"(pb) : "memory");
          asm volatile("s_waitcnt vmcnt(0)" : "+v"(a0), "+v"(a1), "+v"(a2), "+v"(a3), "+v"(b0), "+v"(b1), "+v"(b2), "+v"(b3) :: "memory");
          t0 = 0.f; t1 = 0.f;
#pragma unroll
          for (int j = 0; j < 4; ++j) t0 += a0[j];
#pragma unroll
          for (int j = 0; j < 4; ++j) t0 += a1[j];
#pragma unroll
          for (int j = 0; j < 4; ++j) t0 += a2[j];
#pragma unroll
          for (int j = 0; j < 4; ++j) t0 += a3[j];
#pragma unroll
          for (int j = 0; j < 4; ++j) t1 += b0[j];
#pragma unroll
          for (int j = 0; j < 4; ++j) t1 += b1[j];
#pragma unroll
          for (int j = 0; j < 4; ++j) t1 += b2[j];
#pragma unroll
          for (int j = 0; j < 4; ++j) t1 += b3[j]; }
#pragma unroll
        for (int ai = 0; ai < 2; ++ai)
#pragma unroll
            for (int m = 0; m < 4; ++m) {
                const size_t row = (size_t)(row0 + ai * 128 + m * 16);
                const float tot = __shfl(ai ? t1 : t0, m * 16 + fr);
                const float rs = 1.0f / sqrtf(tot * (1.f / DM) + EPS);
#pragma unroll
                for (int bj = 0; bj < 2; ++bj) {
                    const size_t off = row * DM + col0 + bj * 128;
                    const f32x4 g0 = *(const f32x4*)(fg + col0 + bj * 128), g1 = *(const f32x4*)(fg + col0 + bj * 128 + 4);
                    *(f32x4*)(out + off) = acc[ai][bj][m][0] * rs * g0; *(f32x4*)(out + off + 4) = acc[ai][bj][m][1] * rs * g1;
                }
            }
    }
};

struct Args { const float* in[18]; float* out; unsigned char* ws; int ph_lo, ph_hi; };
struct Frame {
    LAS unsigned char* lds; int tid, lane, wave, G, bid;
    unsigned char* ws; int dry;
};
#define KSWZ(row, colB) ((row) * 256 + ((colB) ^ (((row) & 15) << 4)))
#define SBAR() __builtin_amdgcn_sched_barrier(0)
__device__ __forceinline__ int crow(int r, int hi) { return (r & 3) + 8 * (r >> 2) + 4 * hi; }
template <int NCB> __device__ __forceinline__ int v_st(int k, int c) { const int kk = (k & ~0xC) | ((k & 4) << 1) | ((k & 8) >> 1); return ((kk >> 3) * NCB + (c >> 5)) * 512 + ((kk & 7) * 32 + (c & 31)) * 2; }
__device__ __forceinline__ int v_rd_base(int lane) { return ((lane & 3) << 3) | (((lane >> 2) & 3) << 6) | (((lane >> 4) & 1) << 5) | (((lane >> 5) & 1) << 8); }
template <int OFF> __device__ __forceinline__ s16x4 tr_read(int vb) { s16x4 r; asm volatile("ds_read_b64_tr_b16 %0, %1 offset:%2" : "=&v"(r) : "v"(vb), "i"(OFF) : "memory"); return r; }
__device__ __forceinline__ int lds_addr(const LAS void* p) { return (int)(unsigned)(size_t)p; }
__device__ __forceinline__ void qkt(f32x16& p0, f32x16& p1, const LAS char* Ks, const bf16x8* qr, int r32, int hi) {
    p0 = f32x16{}; p1 = f32x16{};
#pragma unroll
    for (int d0 = 0; d0 < 8; ++d0) { const int cb = (d0 * 16 + hi * 8) * 2;
        const bf16x8 b0 = *(const LAS bf16x8*)(Ks + KSWZ(r32, cb));
        const bf16x8 b1 = *(const LAS bf16x8*)(Ks + KSWZ(32 + r32, cb));
        p0 = __builtin_amdgcn_mfma_f32_32x32x16_bf16(b0, qr[d0], p0, 0, 0, 0);
        p1 = __builtin_amdgcn_mfma_f32_32x32x16_bf16(b1, qr[d0], p1, 0, 0, 0); }
}
__device__ __forceinline__ void qkt_lq(f32x16& p0, f32x16& p1, const LAS char* Ks, const LAS char* ql, int r32, int hi) {
    p0 = f32x16{}; p1 = f32x16{};
#pragma unroll
    for (int d0 = 0; d0 < 8; ++d0) { const int cb = (d0 * 16 + hi * 8) * 2;
        const bf16x8 q = *(const LAS bf16x8*)(ql + d0 * 1024);
        const bf16x8 b0 = *(const LAS bf16x8*)(Ks + KSWZ(r32, cb));
        const bf16x8 b1 = *(const LAS bf16x8*)(Ks + KSWZ(32 + r32, cb));
        p0 = __builtin_amdgcn_mfma_f32_32x32x16_bf16(b0, q, p0, 0, 0, 0);
        p1 = __builtin_amdgcn_mfma_f32_32x32x16_bf16(b1, q, p1, 0, 0, 0); }
}
__device__ __forceinline__ void pack_p(const f32x16& p0, const f32x16& p1, bf16x8& pa0, bf16x8& pa1, bf16x8& pa2, bf16x8& pa3) {
#define PK4(P, BASE, OUT) do { unsigned a0 = cvt_pk_bf16(P[BASE + 0], P[BASE + 1]), a1 = cvt_pk_bf16(P[BASE + 2], P[BASE + 3]);   \
    unsigned b0 = cvt_pk_bf16(P[BASE + 4], P[BASE + 5]), b1 = cvt_pk_bf16(P[BASE + 6], P[BASE + 7]);                              \
    auto r0 = __builtin_amdgcn_permlane32_swap(a0, b0, false, false); auto r1 = __builtin_amdgcn_permlane32_swap(a1, b1, false, false); \
    u32x4 w = {r0[0], r1[0], r0[1], r1[1]}; OUT = __builtin_bit_cast(bf16x8, w); } while (0)
    PK4(p0, 0, pa0); PK4(p0, 8, pa1); PK4(p1, 0, pa2); PK4(p1, 8, pa3);
#undef PK4
}
__device__ __forceinline__ float xhalf_max(float v) { auto rr = __builtin_amdgcn_permlane32_swap(__float_as_uint(v), __float_as_uint(v), false, false); return fmaxf(__uint_as_float(rr[0]), __uint_as_float(rr[1])); }
__device__ __forceinline__ float xhalf_sum(float v) { auto rr = __builtin_amdgcn_permlane32_swap(__float_as_uint(v), __float_as_uint(v), false, false); return __uint_as_float(rr[0]) + __uint_as_float(rr[1]); }
template <int ND> __device__ __forceinline__ void softmax_step(f32x16& p0, f32x16& p1, float& m, float& l, f32x16 (&o)[ND]) {
    float pmax = p0[0];
#pragma unroll
    for (int r = 1; r < 16; ++r) pmax = fmaxf(pmax, p0[r]);
#pragma unroll
    for (int r = 0; r < 16; ++r) pmax = fmaxf(pmax, p1[r]);
    pmax = xhalf_max(pmax);
    const float mn = fmaxf(m, pmax);
    const float alpha = __builtin_amdgcn_exp2f(m - mn);
    m = mn;
    float ps = 0.f;
#pragma unroll
    for (int r = 0; r < 16; ++r) { p0[r] = __builtin_amdgcn_exp2f(p0[r] - mn); ps += p0[r]; }
#pragma unroll
    for (int r = 0; r < 16; ++r) { p1[r] = __builtin_amdgcn_exp2f(p1[r] - mn); ps += p1[r]; }
    ps = xhalf_sum(ps);
    l = l * alpha + ps;
    if (__any(alpha != 1.f)) {
#pragma unroll
        for (int d = 0; d < ND; ++d)
#pragma unroll
            for (int r = 0; r < 16; ++r) o[d][r] *= alpha;
    }
}
typedef short v4i16_t __attribute__((ext_vector_type(4)));
__device__ __forceinline__ s16x4 vtr(const LAS char* p) { return __builtin_bit_cast(s16x4, __builtin_amdgcn_ds_read_tr16_b64_v4i16((LAS v4i16_t*)p)); }
template <int NCB, int D0> __device__ __forceinline__ void pv_one(f32x16& od, int vb, bf16x8 pa0, bf16x8 pa1, bf16x8 pa2, bf16x8 pa3) {
    constexpr int KS = NCB * 1024, HF = NCB * 512, B0 = D0 * 512;
    const LAS char* vp = (const LAS char*)(size_t)(unsigned)vb;
    const s16x4 l0 = vtr(vp + B0), h0 = vtr(vp + B0 + HF), l1 = vtr(vp + B0 + KS), h1 = vtr(vp + B0 + KS + HF);
    const s16x4 l2 = vtr(vp + B0 + 2 * KS), h2 = vtr(vp + B0 + 2 * KS + HF), l3 = vtr(vp + B0 + 3 * KS), h3 = vtr(vp + B0 + 3 * KS + HF);
#define PKV(L, H) (bf16x8){L[0], L[1], L[2], L[3], H[0], H[1], H[2], H[3]}
    od = __builtin_amdgcn_mfma_f32_32x32x16_bf16(PKV(l0, h0), pa0, od, 0, 0, 0);
    od = __builtin_amdgcn_mfma_f32_32x32x16_bf16(PKV(l1, h1), pa1, od, 0, 0, 0);
    od = __builtin_amdgcn_mfma_f32_32x32x16_bf16(PKV(l2, h2), pa2, od, 0, 0, 0);
    od = __builtin_amdgcn_mfma_f32_32x32x16_bf16(PKV(l3, h3), pa3, od, 0, 0, 0);
#undef PKV
}
template <int NCB> __device__ __forceinline__ void pv_all(f32x16 (&o)[NCB], int vb, bf16x8 pa0, bf16x8 pa1, bf16x8 pa2, bf16x8 pa3) {
    pv_one<NCB, 0>(o[0], vb, pa0, pa1, pa2, pa3); pv_one<NCB, 1>(o[1], vb, pa0, pa1, pa2, pa3); pv_one<NCB, 2>(o[2], vb, pa0, pa1, pa2, pa3); pv_one<NCB, 3>(o[3], vb, pa0, pa1, pa2, pa3);
    if constexpr (NCB == 6) { pv_one<NCB, 4>(o[4], vb, pa0, pa1, pa2, pa3); pv_one<NCB, 5>(o[5], vb, pa0, pa1, pa2, pa3); }
}
struct KReg { bf16x8 a, b; };
template <int NCB> struct VReg { bf16x8 v[NCB == 4 ? 2 : 3]; };
__device__ __forceinline__ void k_load(KReg& s, const bf16_t* kp, size_t ld, int tid) { const int sr = tid >> 4, sc = (tid & 15) * 8;
    s.a = *(const bf16x8*)(kp + (size_t)sr * ld + sc); s.b = *(const bf16x8*)(kp + (size_t)(32 + sr) * ld + sc); }
__device__ __forceinline__ void k_write(LAS char* Kl, const KReg& s, int tid) { const int sr = tid >> 4, kc = (tid & 15) * 16;
    *(LAS bf16x8*)(Kl + KSWZ(sr, kc)) = s.a; *(LAS bf16x8*)(Kl + KSWZ(32 + sr, kc)) = s.b; }
template <int NCB> __device__ __forceinline__ void v_load(VReg<NCB>& s, const bf16_t* vp, size_t ld, int tid) {
    if constexpr (NCB == 4) { const int sr = tid >> 4, sc = (tid & 15) * 8; s.v[0] = *(const bf16x8*)(vp + (size_t)sr * ld + sc); s.v[1] = *(const bf16x8*)(vp + (size_t)(32 + sr) * ld + sc); }
    else {
#pragma unroll
        for (int i = 0; i < 3; ++i) { const int id = tid + 512 * i, row = id / 24, c = (id % 24) * 8; s.v[i] = *(const bf16x8*)(vp + (size_t)row * ld + c); } }
}
template <int NCB> __device__ __forceinline__ void v_write(LAS char* Vl, const VReg<NCB>& s, int tid) {
    if constexpr (NCB == 4) { const int sr = tid >> 4, sc = (tid & 15) * 8; *(LAS bf16x8*)(Vl + v_st<4>(sr, sc)) = s.v[0]; *(LAS bf16x8*)(Vl + v_st<4>(32 + sr, sc)) = s.v[1]; }
    else {
#pragma unroll
        for (int i = 0; i < 3; ++i) { const int id = tid + 512 * i, row = id / 24, c = (id % 24) * 8; *(LAS bf16x8*)(Vl + v_st<6>(row, c)) = s.v[i]; } }
}
__device__ __forceinline__ void q_load(bf16x8 (&qr)[8], const bf16_t* qrow  , int hi) {
#pragma unroll
    for (int d0 = 0; d0 < 8; ++d0) qr[d0] = *(const bf16x8*)(qrow + d0 * 16 + hi * 8);
}
template <int ND> __device__ __forceinline__ void store_y(LAS char* scr, bf16_t* yrow0, size_t ld, const f32x16 (&o)[ND], float sc, const float* colscale, int lane, bool dry) {
    const int r32 = lane & 31, hi = lane >> 5;
    u32x4 gv[ND][2];
#pragma unroll
    for (int d0 = 0; d0 < ND; ++d0)
#pragma unroll
        for (int i = 0; i < 2; ++i) { const int id = lane + 64 * i, tok = id >> 2, c16 = id & 3; gv[d0][i] = *(const u32x4*)(yrow0 + (size_t)tok * ld + 32 * d0 + c16 * 8); }
#pragma unroll
    for (int d0 = 0; d0 < ND; ++d0) {
#pragma unroll
        for (int rg = 0; rg < 4; ++rg) *(LAS u32x2*)(scr + r32 * 80 + (8 * rg + 4 * hi) * 2) = (u32x2){cvt_pk_bf16(o[d0][4 * rg] * sc, o[d0][4 * rg + 1] * sc), cvt_pk_bf16(o[d0][4 * rg + 2] * sc, o[d0][4 * rg + 3] * sc)};
#pragma unroll
        for (int i = 0; i < 2; ++i) { const int id = lane + 64 * i, tok = id >> 2, c16 = id & 3;
            const u32x4 v = *(const LAS u32x4*)(scr + tok * 80 + c16 * 16);
            bf16_t* yp = yrow0 + (size_t)tok * ld + 32 * d0 + c16 * 8; const u32x4 g = gv[d0][i];
            float f[8] = {__builtin_bit_cast(float, v.x << 16), __builtin_bit_cast(float, v.x & 0xffff0000u), __builtin_bit_cast(float, v.y << 16), __builtin_bit_cast(float, v.y & 0xffff0000u),
                          __builtin_bit_cast(float, v.z << 16), __builtin_bit_cast(float, v.z & 0xffff0000u), __builtin_bit_cast(float, v.w << 16), __builtin_bit_cast(float, v.w & 0xffff0000u)};
            const float gg[8] = {__builtin_bit_cast(float, g.x << 16), __builtin_bit_cast(float, g.x & 0xffff0000u), __builtin_bit_cast(float, g.y << 16), __builtin_bit_cast(float, g.y & 0xffff0000u),
                          __builtin_bit_cast(float, g.z << 16), __builtin_bit_cast(float, g.z & 0xffff0000u), __builtin_bit_cast(float, g.w << 16), __builtin_bit_cast(float, g.w & 0xffff0000u)};
            if (colscale) { const f32x4 s0 = *(const f32x4*)(colscale + 32 * d0 + c16 * 8), s1 = *(const f32x4*)(colscale + 32 * d0 + c16 * 8 + 4);
                f[0] *= s0.x; f[1] *= s0.y; f[2] *= s0.z; f[3] *= s0.w; f[4] *= s1.x; f[5] *= s1.y; f[6] *= s1.z; f[7] *= s1.w; }
#pragma unroll
            for (int j = 0; j < 8; ++j) f[j] *= gg[j];
            if (!dry) *(u32x4*)yp = (u32x4){cvt_pk_bf16(f[0], f[1]), cvt_pk_bf16(f[2], f[3]), cvt_pk_bf16(f[4], f[5]), cvt_pk_bf16(f[6], f[7])}; }
        asm volatile("" ::: "memory");
    }
}

__device__ __forceinline__ void dma_k2(LAS char* Kslot, const bf16_t* kp, size_t ld, int wave, int lane);
__device__ __forceinline__ void dma_v2(LAS char* Vslot, const bf16_t* vp, size_t ld, int wave, int lane);
__device__ __forceinline__ void q_rows_regs(bf16x8 (&qr)[8], LAS char* scr, const bf16_t* q0, size_t ld, int lane) {
    u32x4 wq[4][2];
#pragma unroll
    for (int p = 0; p < 4; ++p)
#pragma unroll
        for (int k = 0; k < 2; ++k) { const int id = lane + 64 * k, T = id >> 2, c = 4 * p + (id & 3); wq[p][k] = *(const u32x4*)(q0 + (size_t)T * ld + c * 8); }
#pragma unroll
    for (int p = 0; p < 4; ++p) {
#pragma unroll
        for (int k = 0; k < 2; ++k) { const int id = lane + 64 * k, T = id >> 2, cc = id & 3; *(LAS u32x4*)(scr + (cc >> 1) * 1024 + ((cc & 1) * 32 + T) * 16) = wq[p][k]; }
        asm volatile("s_waitcnt lgkmcnt(0)" ::: "memory");
        qr[2 * p] = *(const LAS bf16x8*)(scr + lane * 16); qr[2 * p + 1] = *(const LAS bf16x8*)(scr + 1024 + lane * 16);
        asm volatile("s_waitcnt lgkmcnt(0)" ::: "memory");
    }
}
__device__ __forceinline__ void mem_attn_phase(const Frame& F, bf16_t* Z, int ldz, int xq_col, int y_col, const bf16_t* mkv, int widx, int nw) {
    int tid = F.tid; asm volatile("" : "+v"(tid));
    const int lane = tid & 63, r32 = lane & 31, hi = lane >> 5, wave = F.wave;
    LAS char* Kl = (LAS char*)F.lds; LAS char* Vl = Kl + 65536; LAS char* scr = Kl + 131072 + wave * 2560;
    constexpr float C = 0.08838834764831845f * LOG2E;
    const int per = nw >> 5, nun = 16 / per;
    const int bh = widx / per, b = bh >> 2, head = bh & 3, tb0 = (widx % per) * nun;
    const bf16_t* kp = mkv + (size_t)b * NMEM * DM + head * 128; const bf16_t* vp = kp + 512;
    __syncthreads();
#pragma unroll
    for (int j = 0; j < 4; ++j) { dma_k2(Kl + j * 16384, kp + (size_t)j * 64 * DM, DM, wave, lane); dma_v2(Vl + j * 16384, vp + (size_t)j * 64 * DM, DM, wave, lane); }
    __syncthreads();
    const int vb = lds_addr(Vl) + v_rd_base(lane);
    for (int ui = 0; ui < nun; ++ui) {
        const int tb = tb0 + ui;
        const size_t t0 = (size_t)b * SEQ + tb * 256 + wave * 32;
        bf16x8 qr[8]; q_rows_regs(qr, scr, Z + t0 * ldz + xq_col + head * 128, ldz, lane);
        float m = -1e30f, l = 0.f; f32x16 o[4] = {};
#pragma unroll
        for (int j = 0; j < 4; ++j) {
            f32x16 p0, p1; qkt(p0, p1, Kl + j * 16384, qr, r32, hi);
#pragma unroll
            for (int r = 0; r < 16; ++r) { p0[r] *= C; p1[r] *= C; }
            softmax_step<4>(p0, p1, m, l, o);
            bf16x8 pa0, pa1, pa2, pa3; pack_p(p0, p1, pa0, pa1, pa2, pa3);
            pv_all<4>(o, vb + j * 16384, pa0, pa1, pa2, pa3);
        }
        store_y<4>(scr, Z + t0 * ldz + y_col + head * 128, ldz, o, 1.f / l, nullptr, lane, F.dry != 0);
    }
    __syncthreads();
}

constexpr int POOL_W_BYTES = 192 * 400, POOL_ZROWS = 144;
__device__ __forceinline__ void pool_phase(const Frame& F, bf16_t* Z, const bf16_t* WP, const float* scale, int unit_lo, int unit_step) {
    int tid = F.tid; asm volatile("" : "+v"(tid));
    const int lane = tid & 63, r32 = lane & 31, hi = lane >> 5, wave = F.wave;
    LAS char* Wl = (LAS char*)F.lds;
    LAS char* Zl = Wl + POOL_W_BYTES;
    for (int u = unit_lo; u < BATCH * 32 * 4; u += unit_step) {
        const int g = (u + (u >> 8)) & 3, tb = (u >> 2) & 31, b = u >> 7, t0 = tb * 128;
        const int win = 2 << g;
        { const bf16_t* wsrc = WP + (size_t)g * 192 * 192; int ts = tid; asm volatile("" : "+v"(ts));
#pragma unroll
          for (int i = 0; i < 9; ++i) { const int id = ts + 512 * i, row = id / 24, c = id % 24; *(LAS bf16x8*)(Wl + row * 400 + c * 16) = *(const bf16x8*)(wsrc + row * 192 + c * 8); }
          const bf16_t* zsrc = Z + ((size_t)b * SEQ + t0 - 16) * EV_LD + EV_ZA + g * 192;
#pragma unroll
          for (int i = 0; i < 7; ++i) { const int id = ts + 512 * i, row = id / 24, c = id % 24;
              if (id < POOL_ZROWS * 24) { bf16x8 v = bf16x8{}; if (t0 - 16 + row >= 0) v = *(const bf16x8*)(zsrc + (size_t)row * EV_LD + c * 8); *(LAS bf16x8*)(Zl + row * 400 + c * 16) = v; } } }
        __syncthreads();
        const int tt = wave & 3, obh = wave >> 2, tloc = t0 + tt * 32 + r32;
        const int cnt = (tloc + 1 < win) ? tloc + 1 : win; const float icnt = 1.0f / (float)cnt;
        const LAS char* zr = Zl + (16 + tt * 32 + r32) * 400 + 16 * hi;
        f32x16 o[3] = {};
#define POOL_KSTEPS(WIN) do { _Pragma("unroll 1") for (int s = 0; s < 12; ++s) { bf16x8 wv[WIN]; \
            _Pragma("unroll") for (int i = 0; i < WIN; ++i) wv[i] = *(const LAS bf16x8*)(zr + 32 * s - i * 400); \
            float accv[8], cur[8]; \
            _Pragma("unroll") for (int j = 0; j < 8; ++j) { cur[j] = bf2f((unsigned short)wv[0][j]); accv[j] = cur[j]; } \
            _Pragma("unroll") for (int i = 1; i < WIN; ++i) { _Pragma("unroll") for (int j = 0; j < 8; ++j) accv[j] += bf2f((unsigned short)wv[i][j]); } \
            u32x4 w; w.x = cvt_pk_bf16(accv[0] * icnt - cur[0], accv[1] * icnt - cur[1]); w.y = cvt_pk_bf16(accv[2] * icnt - cur[2], accv[3] * icnt - cur[3]); \
            w.z = cvt_pk_bf16(accv[4] * icnt - cur[4], accv[5] * icnt - cur[5]); w.w = cvt_pk_bf16(accv[6] * icnt - cur[6], accv[7] * icnt - cur[7]); \
            const bf16x8 bfrag = __builtin_bit_cast(bf16x8, w); \
            _Pragma("unroll") for (int j = 0; j < 3; ++j) { const bf16x8 afrag = *(const LAS bf16x8*)(Wl + (32 * (3 * obh + j) + r32) * 400 + (16 * s + 8 * hi) * 2); \
                o[j] = __builtin_amdgcn_mfma_f32_32x32x16_bf16(afrag, bfrag, o[j], 0, 0, 0); } } } while (0)
        if (g == 0) POOL_KSTEPS(2); else if (g == 1) POOL_KSTEPS(4); else if (g == 2) POOL_KSTEPS(8); else POOL_KSTEPS(16);
#undef POOL_KSTEPS
        store_y<3>(Wl + POOL_W_BYTES + POOL_ZROWS * 400 + wave * 2560, Z + ((size_t)b * SEQ + t0 + tt * 32) * EV_LD + EV_G + g * 192 + 96 * obh, EV_LD, o, 1.f, scale + g * 192 + 96 * obh, lane, F.dry != 0);
        __syncthreads();
    }
}

__device__ __forceinline__ void unpack8(const u32x4 w, float (&f)[8]) {
    f[0] = __builtin_bit_cast(float, w.x << 16); f[1] = __builtin_bit_cast(float, w.x & 0xffff0000u); f[2] = __builtin_bit_cast(float, w.y << 16); f[3] = __builtin_bit_cast(float, w.y & 0xffff0000u);
    f[4] = __builtin_bit_cast(float, w.z << 16); f[5] = __builtin_bit_cast(float, w.z & 0xffff0000u); f[6] = __builtin_bit_cast(float, w.w << 16); f[7] = __builtin_bit_cast(float, w.w & 0xffff0000u);
}
constexpr int RET_KV_ELEMS = 192 * 128;
__device__ __forceinline__ float ret_log2_gamma(int h) { return log2f(1.0f - exp2f(-5.0f - (float)h)); }
struct RetAPre { bf16x8 x1[2], x2[2], v[6]; f32x4 ca[2], cb[2], sa[2], sb[2]; };
__device__ __forceinline__ void ret_a_load(RetAPre& P, const bf16_t* Z, const float* ropec, const float* ropes, int u, int tid) {
    asm volatile("" : "+v"(tid));
    const int b = u >> 7, h = (u >> 5) & 3, n = u & 31, c0 = n * 128;
#pragma unroll
    for (int i = 0; i < 2; ++i) {
        const int id = tid + 512 * i, m = id >> 3, c = id & 7, pos = c0 + m;
        const bf16_t* kp = Z + ((size_t)b * SEQ + pos) * EV_LD + EV_RK + h * 128 + 8 * c;
        P.x1[i] = *(const bf16x8*)kp; P.x2[i] = *(const bf16x8*)(kp + 64);
        P.ca[i] = *(const f32x4*)(ropec + pos * 64 + 8 * c); P.cb[i] = *(const f32x4*)(ropec + pos * 64 + 8 * c + 4);
        P.sa[i] = *(const f32x4*)(ropes + pos * 64 + 8 * c); P.sb[i] = *(const f32x4*)(ropes + pos * 64 + 8 * c + 4); }
#pragma unroll
    for (int i = 0; i < 6; ++i) { const int id = tid + 512 * i, m = id / 24, c = id % 24;
        P.v[i] = *(const bf16x8*)(Z + ((size_t)b * SEQ + c0 + m) * EV_LD + EV_RV + h * 192 + 8 * c); }
}
__device__ __forceinline__ void ret_a_phase(const Frame& F, const bf16_t* Z, const float* ropec, const float* ropes, bf16_t* kvT, int unit_lo, int unit_step) {
    int tid = F.tid; asm volatile("" : "+v"(tid));
    const int lane = tid & 63, wave = F.wave;
    LAS char* Kimg = (LAS char*)F.lds; LAS char* Vimg = Kimg + 32768;
    RetAPre P;
    if (unit_lo < BATCH * 4 * 32) ret_a_load(P, Z, ropec, ropes, unit_lo, tid);
    for (int u = unit_lo; u < BATCH * 4 * 32; u += unit_step) {
        const int h = (u >> 5) & 3;
        const float lgam = ret_log2_gamma(h);
#pragma unroll
        for (int i = 0; i < 2; ++i) {
            const int id = tid + 512 * i, m = id >> 3, c = id & 7;
            const f32x4 ca = P.ca[i], cb = P.cb[i], sa = P.sa[i], sb = P.sb[i];
            float cs[8] = {ca.x, ca.y, ca.z, ca.w, cb.x, cb.y, cb.z, cb.w}, sn[8] = {sa.x, sa.y, sa.z, sa.w, sb.x, sb.y, sb.z, sb.w};
            const float zeta = exp2f((float)(127 - m) * lgam);
            const bf16x8 x1 = P.x1[i], x2 = P.x2[i];
            float o1[8], o2[8];
#pragma unroll
            for (int j = 0; j < 8; ++j) { const float a = bf2f((unsigned short)x1[j]), bb = bf2f((unsigned short)x2[j]); o1[j] = (a * cs[j] - bb * sn[j]) * zeta; o2[j] = (a * sn[j] + bb * cs[j]) * zeta; }
            u32x4 z1 = {cvt_pk_bf16(o1[0], o1[1]), cvt_pk_bf16(o1[2], o1[3]), cvt_pk_bf16(o1[4], o1[5]), cvt_pk_bf16(o1[6], o1[7])};
            u32x4 z2 = {cvt_pk_bf16(o2[0], o2[1]), cvt_pk_bf16(o2[2], o2[3]), cvt_pk_bf16(o2[4], o2[5]), cvt_pk_bf16(o2[6], o2[7])};
            LAS char* img = Kimg + (m >> 6) * 16384;
            *(LAS u32x4*)(img + v_st<4>(m & 63, 8 * c)) = z1; *(LAS u32x4*)(img + v_st<4>(m & 63, 64 + 8 * c)) = z2;
        }
#pragma unroll
        for (int i = 0; i < 6; ++i) { const int id = tid + 512 * i, m = id / 24, c = id % 24;
            *(LAS bf16x8*)(Vimg + (m >> 6) * 24576 + v_st<6>(m & 63, 8 * c)) = P.v[i]; }
        __syncthreads();
        if (u + unit_step < BATCH * 4 * 32) ret_a_load(P, Z, ropec, ropes, u + unit_step, tid);
        const int kbk = wave & 3, dvb0 = (wave >> 2) * 3;
        const int vbK = lds_addr(Kimg) + v_rd_base(lane) + kbk * 512, vbV = lds_addr(Vimg) + v_rd_base(lane) + dvb0 * 512;
        f32x16 acc[3] = {};
#pragma unroll
        for (int T = 0; T < 2; ++T)
#pragma unroll
            for (int ks = 0; ks < 4; ++ks) {
                const s16x4 bl = tr_read<0>(vbK + T * 16384 + ks * 4096), bh = tr_read<0>(vbK + T * 16384 + ks * 4096 + 2048);
                s16x4 al[3], ah[3];
#pragma unroll
                for (int i = 0; i < 3; ++i) { al[i] = tr_read<0>(vbV + T * 24576 + ks * 6144 + i * 512); ah[i] = tr_read<0>(vbV + T * 24576 + ks * 6144 + 3072 + i * 512); }
                asm volatile("s_waitcnt lgkmcnt(0)" ::: "memory"); SBAR();
                const bf16x8 bf = (bf16x8){bl[0], bl[1], bl[2], bl[3], bh[0], bh[1], bh[2], bh[3]};
#pragma unroll
                for (int i = 0; i < 3; ++i) { const bf16x8 af = (bf16x8){al[i][0], al[i][1], al[i][2], al[i][3], ah[i][0], ah[i][1], ah[i][2], ah[i][3]};
                    acc[i] = __builtin_amdgcn_mfma_f32_32x32x16_bf16(af, bf, acc[i], 0, 0, 0); }
            }
        bf16_t* dst = kvT + (size_t)u * RET_KV_ELEMS;
        const int r32 = lane & 31, hi = lane >> 5;
        if (!F.dry)
#pragma unroll
        for (int i = 0; i < 3; ++i)
#pragma unroll
            for (int r = 0; r < 16; ++r) dst[(size_t)(32 * (dvb0 + i) + crow(r, hi)) * 128 + 32 * kbk + r32] = (bf16_t)(cvt_pk_bf16(acc[i][r], 0.f) & 0xffffu);
        __syncthreads();
    }
}
__device__ __forceinline__ void ret_scan_phase(const Frame& F, bf16_t* kvT) {
    for (int idx = F.bid * 512 + F.tid; idx < 32 * (RET_KV_ELEMS / 8); idx += F.G * 512) {
        const int bh = idx / (RET_KV_ELEMS / 8), e = idx % (RET_KV_ELEMS / 8), h = bh & 3;
        const float gch = exp2f(128.0f * ret_log2_gamma(h));
        u32x4* p = (u32x4*)(kvT + (size_t)bh * 32 * RET_KV_ELEMS) + e;
        float R[8];
#pragma unroll
        for (int j = 0; j < 8; ++j) R[j] = 0.f;
        u32x4 twv[32];
#pragma unroll
        for (int n = 0; n < 32; ++n) twv[n] = p[(size_t)n * (RET_KV_ELEMS / 8)];
#pragma unroll
        for (int n = 0; n < 32; ++n) { const u32x4 tw = twv[n]; float t[8]; unpack8(tw, t);
            if (!F.dry) p[(size_t)n * (RET_KV_ELEMS / 8)] = (u32x4){cvt_pk_bf16(R[0], R[1]), cvt_pk_bf16(R[2], R[3]), cvt_pk_bf16(R[4], R[5]), cvt_pk_bf16(R[6], R[7])};
#pragma unroll
            for (int j = 0; j < 8; ++j) R[j] = R[j] * gch + t[j]; }
    }
}
constexpr int RETC_SCR_OFF = 32768 + 49152 + 2048, RETC_R_OFF = RETC_SCR_OFF + 8 * 2560;
__device__ __forceinline__ void ret_c_phase(const Frame& F, bf16_t* Z, const float* ropec, const float* ropes, const bf16_t* kvT, int unit_lo, int unit_step) {
    int tid = F.tid; asm volatile("" : "+v"(tid));
    const int lane = tid & 63, wave = F.wave, r32 = lane & 31, hi = lane >> 5;
    LAS char* Kl = (LAS char*)F.lds; LAS char* Vl = Kl + 32768; LAS float* st = (LAS float*)(Kl + 32768 + 49152);
    LAS char* Rl = Kl + RETC_R_OFF;
    VReg<6> pv0, pv1; u32x4 pr[6];
#define RETC_PRE(U) do { int tp_ = tid; asm volatile("" : "+v"(tp_)); const int b_ = (U) >> 7, h_ = ((U) >> 5) & 3, n_ = (U) & 31; \
        const bf16_t* zv_ = Z + ((size_t)b_ * SEQ + n_ * 128) * EV_LD + EV_RV + h_ * 192; v_load<6>(pv0, zv_, EV_LD, tp_); v_load<6>(pv1, zv_ + (size_t)64 * EV_LD, EV_LD, tp_); \
        const u32x4* rp_ = (const u32x4*)(kvT + (size_t)(U) * RET_KV_ELEMS); _Pragma("unroll") for (int i_ = 0; i_ < 6; ++i_) pr[i_] = rp_[tp_ + 512 * i_]; } while (0)
    if (unit_lo < BATCH * 4 * 32) RETC_PRE(unit_lo);
    for (int u = unit_lo; u < BATCH * 4 * 32; u += unit_step) {
        const int b = u >> 7, h = (u >> 5) & 3, n = u & 31, c0 = n * 128;
        const float lgam = ret_log2_gamma(h);
        const bf16_t* zb = Z + ((size_t)b * SEQ + c0) * EV_LD;
        { const int sr = tid >> 4, cc = tid & 15, fq0 = 8 * (cc & 7);
#pragma unroll
          for (int i = 0; i < 4; ++i) { const int m = (i >> 1) * 64 + (i & 1) * 32 + sr, pos = c0 + m;
              const f32x4 ca = *(const f32x4*)(ropec + pos * 64 + fq0), cb = *(const f32x4*)(ropec + pos * 64 + fq0 + 4), sa = *(const f32x4*)(ropes + pos * 64 + fq0), sb = *(const f32x4*)(ropes + pos * 64 + fq0 + 4);
              const float cs[8] = {ca.x, ca.y, ca.z, ca.w, cb.x, cb.y, cb.z, cb.w}, sn[8] = {sa.x, sa.y, sa.z, sa.w, sb.x, sb.y, sb.z, sb.w};
#pragma unroll
              for (int qk = 0; qk < 2; ++qk) {
                  const bf16_t* kr = zb + (size_t)m * EV_LD + (qk ? EV_RK : EV_RQ) + h * 128;
                  const bf16x8 xo = *(const bf16x8*)(kr + 8 * cc), xp = *(const bf16x8*)(kr + 8 * (cc ^ 8));
                  const float sc = qk ? 1.0f : 0.08838834764831845f;
                  float o[8];
#pragma unroll
                  for (int j = 0; j < 8; ++j) { const float a = bf2f((unsigned short)xo[j]), p = bf2f((unsigned short)xp[j]); o[j] = ((cc < 8) ? a * cs[j] - p * sn[j] : p * sn[j] + a * cs[j]) * sc; }
                  *(LAS u32x4*)((qk ? Kl : Rl) + (i >> 1) * 16384 + KSWZ((i & 1) * 32 + sr, cc * 16)) = (u32x4){cvt_pk_bf16(o[0], o[1]), cvt_pk_bf16(o[2], o[3]), cvt_pk_bf16(o[4], o[5]), cvt_pk_bf16(o[6], o[7])}; } } }
        v_write<6>(Vl, pv0, tid); v_write<6>(Vl + 24576, pv1, tid);
        const int q4 = wave & 3, dvb0 = (wave >> 2) * 3, ti = 32 * q4 + r32;
        __syncthreads();
        bf16x8 qr[8];
#pragma unroll
        for (int s = 0; s < 8; ++s) qr[s] = *(const LAS bf16x8*)(Rl + (ti >> 6) * 16384 + KSWZ(ti & 63, (2 * s + hi) * 16));
        __syncthreads();
        { int ts = tid; asm volatile("" : "+v"(ts));
#pragma unroll
          for (int i = 0; i < 6; ++i) { const int id = ts + 512 * i, row = id >> 4, c8 = id & 15; *(LAS u32x4*)(Rl + row * 272 + c8 * 16) = pr[i]; } }
        if (u + unit_step < BATCH * 4 * 32) RETC_PRE(u + unit_step);
        f32x16 o[3] = {};
        const int ntile = (q4 >> 1) + 1;
        for (int j = 0; j < ntile; ++j) {
            f32x16 p0, p1; qkt(p0, p1, Kl + j * 16384, qr, r32, hi);
#pragma unroll
            for (int r = 0; r < 16; ++r) { const int d0 = ti - (64 * j + crow(r, hi)), d1 = d0 - 32;
                p0[r] = d0 >= 0 ? p0[r] * __builtin_amdgcn_exp2f((float)d0 * lgam) : 0.f; p1[r] = d1 >= 0 ? p1[r] * __builtin_amdgcn_exp2f((float)d1 * lgam) : 0.f; }
            bf16x8 pa0, pa1, pa2, pa3; pack_p(p0, p1, pa0, pa1, pa2, pa3);
            const int vb = lds_addr(Vl + j * 24576) + v_rd_base(lane) + dvb0 * 512;
            pv_one<6, 0>(o[0], vb, pa0, pa1, pa2, pa3); pv_one<6, 0>(o[1], vb + 512, pa0, pa1, pa2, pa3); pv_one<6, 0>(o[2], vb + 1024, pa0, pa1, pa2, pa3);
        }
        __syncthreads();
        { const float xi = exp2f((float)(ti + 1) * lgam);
#pragma unroll
          for (int s = 0; s < 8; ++s) { u32x4 w = __builtin_bit_cast(u32x4, qr[s]);
              w.x = cvt_pk_bf16(__builtin_bit_cast(float, w.x << 16) * xi, __builtin_bit_cast(float, w.x & 0xffff0000u) * xi); w.y = cvt_pk_bf16(__builtin_bit_cast(float, w.y << 16) * xi, __builtin_bit_cast(float, w.y & 0xffff0000u) * xi);
              w.z = cvt_pk_bf16(__builtin_bit_cast(float, w.z << 16) * xi, __builtin_bit_cast(float, w.z & 0xffff0000u) * xi); w.w = cvt_pk_bf16(__builtin_bit_cast(float, w.w << 16) * xi, __builtin_bit_cast(float, w.w & 0xffff0000u) * xi);
              qr[s] = __builtin_bit_cast(bf16x8, w); }
#pragma unroll
          for (int i = 0; i < 3; ++i)
#pragma unroll
              for (int s = 0; s < 8; ++s) { const bf16x8 af = *(const LAS bf16x8*)(Rl + (32 * (dvb0 + i) + r32) * 272 + (16 * s + 8 * hi) * 2);
                  o[i] = __builtin_amdgcn_mfma_f32_32x32x16_bf16(af, qr[s], o[i], 0, 0, 0); } }
        float s1 = 0.f, s2 = 0.f;
#pragma unroll
        for (int i = 0; i < 3; ++i)
#pragma unroll
            for (int r = 0; r < 16; ++r) { s1 += o[i][r]; s2 += o[i][r] * o[i][r]; }
        s1 = xhalf_sum(s1); s2 = xhalf_sum(s2);
        if (hi == 0) { st[(wave * 32 + r32) * 2] = s1; st[(wave * 32 + r32) * 2 + 1] = s2; }
        __syncthreads();
        const float t1 = s1 + st[((wave ^ 4) * 32 + r32) * 2], t2 = s2 + st[((wave ^ 4) * 32 + r32) * 2 + 1];
        const float mu = t1 * (1.f / 192.f), var = fmaxf(t2 * (1.f / 192.f) - mu * mu, 0.f), rs = 1.0f / sqrtf(var + EPS);
#pragma unroll
        for (int i = 0; i < 3; ++i)
#pragma unroll
            for (int r = 0; r < 16; ++r) o[i][r] = (o[i][r] - mu) * rs;
        store_y<3>(Kl + RETC_SCR_OFF + wave * 2560, Z + ((size_t)b * SEQ + c0 + 32 * q4) * EV_LD + EV_G + 768 + h * 192 + 32 * dvb0, EV_LD, o, 1.f, nullptr, lane, F.dry != 0);
        __syncthreads();
    }
}
#undef RETC_PRE

__device__ __forceinline__ void dma_k2(LAS char* Kslot, const bf16_t* kp, size_t ld, int wave, int lane);
__device__ __forceinline__ void compress_phase(const Frame& F, const bf16_t* Z, const bf16_t* W1t, const bf16_t* W2t, const float* b1, const float* b1part, bf16_t* kcmp, bf16_t* vcmp, int unit_lo, int unit_step) {
    const int tid = F.tid, lane = F.lane, wave = F.wave, r32 = lane & 31, hi = lane >> 5;
    LAS char* Wb = (LAS char*)F.lds; LAS char* Al = Wb + 131072; LAS char* Hs = Wb;
    volatile LAS unsigned* mw = (volatile LAS unsigned*)(F.lds + MISC_OFF); const unsigned sv0 = mw[0], sv1 = mw[1];
    for (int u = unit_lo; u < 128; u += unit_step) {
        const int kv = u >> 6, rt = u & 63;
        const bf16_t* w1 = W1t + (size_t)kv * 256 * 4096; const bf16_t* w2 = W2t + (size_t)kv * 128 * 256;
        bf16_t* dstc = kv ? vcmp : kcmp; const int zc = kv ? OD_VC : OD_KC;
        if (rt == 0 && tid < 256) { const int bg = tid >> 4, c = tid & 15; *(u32x4*)(dstc + ((size_t)bg * 256 + 255) * 128 + c * 8) = (u32x4){0u, 0u, 0u, 0u}; }
        const int sr = tid >> 4, sc = (tid & 15) * 8;
        const bf16_t* rp[2];
#pragma unroll
        for (int i = 0; i < 2; ++i) { int r = rt * 64 + sr + 32 * i; if (r > 4079) r = 4079; const int g = r & 1, bj = r >> 1, b = bj / 255, j = bj % 255;
            rp[i] = Z + ((size_t)b * SEQ + 16 * j) * OD_LD + zc + g * 128 + sc; }
        KReg a; a.a = *(const bf16x8*)rp[0]; a.b = *(const bf16x8*)rp[1];
#pragma unroll
        for (int q = 0; q < 4; ++q) dma_k2(Wb + q * 16384, w1 + (size_t)(64 * q) * 4096, 4096, wave, lane);
        k_write(Al, a, tid);
        f32x16 acc[2] = {};
#pragma unroll 1
        for (int l = 0; l < 32; ++l) {
            const LAS char* wt = Wb + (l & 1) * 65536 + (wave >> 1) * 16384;
            const LAS char* Ac = Al + (l & 1) * 16384;
            __syncthreads();
            if (l + 1 < 32) { a.a = *(const bf16x8*)(rp[0] + (size_t)(l + 1) * OD_LD); a.b = *(const bf16x8*)(rp[1] + (size_t)(l + 1) * OD_LD);
#pragma unroll
                for (int q = 0; q < 4; ++q) dma_k2(Wb + ((l + 1) & 1) * 65536 + q * 16384, w1 + (size_t)(64 * q) * 4096 + (l + 1) * 128, 4096, wave, lane); }
#pragma unroll
            for (int s = 0; s < 8; ++s) { const int cb = (16 * s + 8 * hi) * 2;
                const bf16x8 a0 = *(const LAS bf16x8*)(Ac + KSWZ(r32, cb)), a1 = *(const LAS bf16x8*)(Ac + KSWZ(32 + r32, cb));
                const bf16x8 bf = *(const LAS bf16x8*)(wt + KSWZ(32 * (wave & 1) + r32, cb));
                acc[0] = __builtin_amdgcn_mfma_f32_32x32x16_bf16(a0, bf, acc[0], 0, 0, 0);
                acc[1] = __builtin_amdgcn_mfma_f32_32x32x16_bf16(a1, bf, acc[1], 0, 0, 0); }
            if (l + 1 < 32) k_write(Al + ((l + 1) & 1) * 16384, a, tid);
        }
        { const int col = 32 * wave + r32; float bb = b1[kv * 256 + col];
          for (int j = 0; j < 32; ++j) bb += b1part[(kv * 32 + j) * 256 + col];
#pragma unroll
          for (int rb = 0; rb < 2; ++rb)
#pragma unroll
              for (int r = 0; r < 16; ++r) { const float v = acc[rb][r] + bb; const float sv = v * fast_sigmoid(v);
                  *(LAS unsigned short*)(Hs + (32 * rb + crow(r, hi)) * 528 + col * 2) = (unsigned short)f2bf(sv); } }
        __syncthreads();
        { const int rb = wave & 1, cbk = wave >> 1; f32x16 o2 = {};
#pragma unroll
          for (int s = 0; s < 16; ++s) { const bf16x8 af = *(const LAS bf16x8*)(Hs + (32 * rb + r32) * 528 + (16 * s + 8 * hi) * 2);
              const bf16x8 bf = *(const bf16x8*)(w2 + (size_t)(32 * cbk + r32) * 256 + 16 * s + 8 * hi);
              o2 = __builtin_amdgcn_mfma_f32_32x32x16_bf16(af, bf, o2, 0, 0, 0); }
#pragma unroll
          for (int r = 0; r < 16; ++r) { const int row = rt * 64 + 32 * rb + crow(r, hi);
              if (row < 4080) { const int g = row & 1, bj = row >> 1, b = bj / 255, j = bj % 255;
                  dstc[(((size_t)b * 2 + g) * 256 + j) * 128 + 32 * cbk + r32] = (bf16_t)f2bf(o2[r]); } } }
        __syncthreads();
    }
    if (tid == 0) { mw[0] = sv0; mw[1] = sv1; }
    __syncthreads();
}

__device__ __forceinline__ void nsa_post(f32x16& p0, f32x16& p1, int t, int kbase, int kstride, int limit, bool sel, int kvalid, const LAS float* tbl, int hi, bool fast) {
    constexpr float C = 0.08838834764831845f * LOG2E;
    const float NEGINF = -__builtin_inff();
    if (fast) { const float b128 = tbl[128];
#pragma unroll
        for (int r = 0; r < 16; ++r) { p0[r] = sel ? p0[r] * C + b128 : NEGINF; p1[r] = sel ? p1[r] * C + b128 : NEGINF; }
        return; }
    asm volatile("" : "+v"(hi), "+v"(t));
#pragma unroll
    for (int r = 0; r < 16; ++r) {
        { const int k = crow(r, hi); const int rel = t - (kbase + kstride * k); const bool ok = sel && rel >= 0 && rel < limit && k < kvalid; const int idx = rel < 0 ? 0 : (rel > 128 ? 128 : rel);
          p0[r] = ok ? p0[r] * C + tbl[idx] : NEGINF; }
        { const int k = 32 + crow(r, hi); const int rel = t - (kbase + kstride * k); const bool ok = sel && rel >= 0 && rel < limit && k < kvalid; const int idx = rel < 0 ? 0 : (rel > 128 ? 128 : rel);
          p1[r] = ok ? p1[r] * C + tbl[idx] : NEGINF; }
    }
}
__device__ __forceinline__ float fadd_s(float a, float b) { float r; asm("v_add_f32_e32 %0, %1, %2" : "=v"(r) : "v"(a), "v"(b)); return r; }
__device__ __forceinline__ float max3_s(float a, float b, float c) { float r; asm("v_max3_f32 %0, %1, %2, %3" : "=v"(r) : "v"(a), "v"(b), "v"(c)); return r; }
__device__ __forceinline__ void dma_k(LAS char* Kslot, const bf16_t* kp, size_t ld, int lw  , int lane) {
    asm volatile("" : "+v"(lane));
#pragma unroll
    for (int i = 0; i < 8; ++i) { const int pc = lw * 8 + i, row = pc * 4 + (lane >> 4), ch = (lane & 15) ^ (row & 15);
        __builtin_amdgcn_global_load_lds((const unsigned*)(kp + (size_t)row * ld + ch * 8), (LAS unsigned*)(Kslot + pc * 1024), 16, 0, 0); }
}
__device__ __forceinline__ void dma_v(LAS char* Vslot, const bf16_t* vp, size_t ld, int lw, int lane) {
    asm volatile("" : "+v"(lane));
#pragma unroll
    for (int i = 0; i < 8; ++i) { const int pc = lw * 8 + i, cblk = 2 * (pc & 1) + (lane >> 5), kk = (pc >> 1) * 8 + ((lane & 31) >> 2), k = (kk & ~0xC) | ((kk & 4) << 1) | ((kk & 8) >> 1), c = cblk * 32 + (lane & 3) * 8;
        __builtin_amdgcn_global_load_lds((const unsigned*)(vp + (size_t)k * ld + c), (LAS unsigned*)(Vslot + pc * 1024), 16, 0, 0); }
}
constexpr float NSA_THR = 24.0f;
template <int MODE>
__device__ __forceinline__ void acc_step(LAS char* scr, bf16_t* arow0, size_t ald, bf16_t* yrow0, size_t yld, const f32x16 (&o)[4], float sc, int lane, bool dry) {
    const int r32 = lane & 31, hi = lane >> 5;
    u32x4 av[4][2], yv[4][2];
    if (MODE >= 1) {
#pragma unroll
        for (int d0 = 0; d0 < 4; ++d0)
#pragma unroll
            for (int i = 0; i < 2; ++i) { const int id = lane + 64 * i, tok = id >> 2, c16 = id & 3; av[d0][i] = *(const u32x4*)(arow0 + (size_t)tok * ald + 32 * d0 + c16 * 8); } }
    if (MODE == 2) {
#pragma unroll
        for (int d0 = 0; d0 < 4; ++d0)
#pragma unroll
            for (int i = 0; i < 2; ++i) { const int id = lane + 64 * i, tok = id >> 2, c16 = id & 3; yv[d0][i] = *(const u32x4*)(yrow0 + (size_t)tok * yld + 32 * d0 + c16 * 8); } }
#pragma unroll
    for (int d0 = 0; d0 < 4; ++d0) {
#pragma unroll
        for (int rg = 0; rg < 4; ++rg) *(LAS u32x2*)(scr + r32 * 80 + (8 * rg + 4 * hi) * 2) = (u32x2){cvt_pk_bf16(o[d0][4 * rg] * sc, o[d0][4 * rg + 1] * sc), cvt_pk_bf16(o[d0][4 * rg + 2] * sc, o[d0][4 * rg + 3] * sc)};
#pragma unroll
        for (int i = 0; i < 2; ++i) { const int id = lane + 64 * i, tok = id >> 2, c16 = id & 3;
            float f[8]; unpack8(*(const LAS u32x4*)(scr + tok * 80 + c16 * 16), f);
            bf16_t* ap = arow0 + (size_t)tok * ald + 32 * d0 + c16 * 8;
            if (MODE >= 1) { float a[8]; unpack8(av[d0][i], a);
#pragma unroll
                for (int j = 0; j < 8; ++j) f[j] += a[j]; }
            if (MODE == 2) { bf16_t* yp = yrow0 + (size_t)tok * yld + 32 * d0 + c16 * 8; float g[8]; unpack8(yv[d0][i], g);
#pragma unroll
                for (int j = 0; j < 8; ++j) f[j] *= g[j];
                if (!dry) *(u32x4*)yp = (u32x4){cvt_pk_bf16(f[0], f[1]), cvt_pk_bf16(f[2], f[3]), cvt_pk_bf16(f[4], f[5]), cvt_pk_bf16(f[6], f[7])}; }
            else *(u32x4*)ap = (u32x4){cvt_pk_bf16(f[0], f[1]), cvt_pk_bf16(f[2], f[3]), cvt_pk_bf16(f[4], f[5]), cvt_pk_bf16(f[6], f[7])}; }
        asm volatile("" ::: "memory");
    }
}
#define NSA_PK4(P, BASE, OUT) do { unsigned a0_ = cvt_pk_bf16(P[BASE + 0], P[BASE + 1]), a1_ = cvt_pk_bf16(P[BASE + 2], P[BASE + 3]);   \
    unsigned b0_ = cvt_pk_bf16(P[BASE + 4], P[BASE + 5]), b1_ = cvt_pk_bf16(P[BASE + 6], P[BASE + 7]);                              \
    auto r0_ = __builtin_amdgcn_permlane32_swap(a0_, b0_, false, false); auto r1_ = __builtin_amdgcn_permlane32_swap(a1_, b1_, false, false); \
    u32x4 w_ = {r0_[0], r1_[0], r0_[1], r1_[1]}; OUT = __builtin_bit_cast(bf16x8, w_); } while (0)
struct TileInfo { int blk; bool far; };
template <int TYPE> __device__ __forceinline__ TileInfo tile_info(int blk, int s0) {
    TileInfo ti; ti.blk = blk; const int kb = 64 * blk;
    if (TYPE == 0) ti.far = s0 - (kb + 63) >= 128;
    else if (TYPE == 1) ti.far = (s0 - (kb + 63) >= 128) && (s0 + 31 - kb < 512);
    else ti.far = (blk < 3) && (s0 - (16 * (kb + 63) + 31) >= 128);
    return ti;
}
template <int TYPE> __device__ __forceinline__ void near_post(f32x16& P0, f32x16& P1, int blk, int t, float m, const LAS float* tbl, int hi) {
    const float NEGINF = -__builtin_inff();
    asm volatile("" : "+v"(hi), "+v"(t));
    const int rel0 = (TYPE >= 2) ? t - 31 - 16 * (64 * blk + 4 * hi) : t - 64 * blk - 4 * hi;
    const int jlim = 255 - 64 * blk - 4 * hi;
#pragma unroll
    for (int q = 0; q < 4; ++q) {
        float bv[8]; int rl[8];
#pragma unroll
        for (int e = 0; e < 8; ++e) { const int r = 4 * q + (e & 3), h = e >> 2, kc = 32 * h + (r & 3) + 8 * (r >> 2);
            rl[e] = (TYPE >= 2) ? rel0 - 16 * kc : rel0 - kc;
            const int idx = rl[e] < 0 ? 0 : (rl[e] > 128 ? 128 : rl[e]);
            bv[e] = tbl[idx]; }
#pragma unroll
        for (int e = 0; e < 8; ++e) { const int r = 4 * q + (e & 3), h = e >> 2, kc = 32 * h + (r & 3) + 8 * (r >> 2);
            bool ok = rl[e] >= 0; if (TYPE == 1) ok = ok && rl[e] < 512; if (TYPE >= 2) ok = ok && kc < jlim;
            if (h) { const float v = P1[r] + (bv[e] - m); P1[r] = ok ? v : NEGINF; } else { const float v = P0[r] + (bv[e] - m); P0[r] = ok ? v : NEGINF; } }
        SBAR();
    }
}
template <int TYPE>
__device__ __forceinline__ void nsa_step(f32x16& C0, f32x16& C1, bool csel, int cblk, f32x16& N0, f32x16& N1, const LAS char* Kn, int vbc, bool has_next, TileInfo tn, bool nsel,
                                         const LAS char* ql, float& m, float& alc, float& l, f32x16 (&o)[4], float b128, int t, const LAS float* tbl, LAS unsigned* impr, int r32, int hi, unsigned long long* tacc = nullptr) {
    bf16x8 pa0, pa1, pa2, pa3; float ps = 0.f, ps2 = 0.f;
    SBAR();
    unsigned long long tp_ = 0ull; if ((PROBE_SPIN >> 13) & 3) tp_ = __builtin_amdgcn_s_memrealtime();
#define IMP_ADD(P, gq, J) do { const float own_ = 2.f * (P[4 * gq] + P[4 * gq + 1] + P[4 * gq + 2]) + P[4 * gq + 3]; \
        __hip_atomic_fetch_add(impr + 16 * cblk + hi + (J), (unsigned)(own_ * 67108864.f + 0.5f), __ATOMIC_RELAXED, __HIP_MEMORY_SCOPE_WORKGROUP); \
        __hip_atomic_fetch_add(impr + 16 * cblk + hi + (J) + 1, (unsigned)(P[4 * gq + 3] * 67108864.f + 0.5f), __ATOMIC_RELAXED, __HIP_MEMORY_SCOPE_WORKGROUP); } while (0)
#define SM2_SLICE(d) do { C1[2 * d] = __builtin_amdgcn_exp2f(C1[2 * d]); C1[2 * d + 1] = __builtin_amdgcn_exp2f(C1[2 * d + 1]); \
        if (TYPE != 2) { ps = fadd_s(ps, C0[2 * d]); ps2 = fadd_s(ps2, C0[2 * d + 1]); ps = fadd_s(ps, C1[2 * d]); ps2 = fadd_s(ps2, C1[2 * d + 1]); } \
        if (TYPE != 3) { if (d == 2) NSA_PK4(C0, 0, pa0); if (d == 4) NSA_PK4(C0, 8, pa1); if (d == 6) NSA_PK4(C1, 0, pa2); } \
        if (TYPE == 2 && (d & 1)) { IMP_ADD(C0, (d >> 1), 2 * (d >> 1)); IMP_ADD(C1, (d >> 1), 8 + 2 * (d >> 1)); } } while (0)
    N0 = f32x16{}; N1 = f32x16{};
    if (has_next) {
        bf16x8 qf[8], kf0[8], kf1[8];
        qf[0] = *(const LAS bf16x8*)(ql); kf0[0] = *(const LAS bf16x8*)(Kn + KSWZ(r32, hi * 16)); kf1[0] = *(const LAS bf16x8*)(Kn + KSWZ(32 + r32, hi * 16));
#pragma unroll
        for (int d = 0; d < 8; ++d) {
            if (d + 1 < 8) { const int cb = ((d + 1) * 16 + hi * 8) * 2; qf[d + 1] = *(const LAS bf16x8*)(ql + (d + 1) * 1024); kf0[d + 1] = *(const LAS bf16x8*)(Kn + KSWZ(r32, cb)); kf1[d + 1] = *(const LAS bf16x8*)(Kn + KSWZ(32 + r32, cb)); }
            N0 = __builtin_amdgcn_mfma_f32_32x32x16_bf16(kf0[d], qf[d], N0, 0, 0, 0);
            N1 = __builtin_amdgcn_mfma_f32_32x32x16_bf16(kf1[d], qf[d], N1, 0, 0, 0);
            SM2_SLICE(d);
            SBAR();
        }
    } else {
#pragma unroll
        for (int d = 0; d < 8; ++d) SM2_SLICE(d);
    }
#undef SM2_SLICE
#undef IMP_ADD
    if (TYPE != 3) NSA_PK4(C1, 8, pa3);
    if (TYPE == 0 && !__all(csel)) {
        const unsigned km = csel ? 0xffffffffu : 0u; ps = csel ? ps : 0.f; ps2 = csel ? ps2 : 0.f;
        u32x4 w0 = __builtin_bit_cast(u32x4, pa0), w1 = __builtin_bit_cast(u32x4, pa1), w2 = __builtin_bit_cast(u32x4, pa2), w3 = __builtin_bit_cast(u32x4, pa3);
        w0 &= km; w1 &= km; w2 &= km; w3 &= km;
        pa0 = __builtin_bit_cast(bf16x8, w0); pa1 = __builtin_bit_cast(bf16x8, w1); pa2 = __builtin_bit_cast(bf16x8, w2); pa3 = __builtin_bit_cast(bf16x8, w3); }
    if (TYPE != 2) { ps = xhalf_sum(ps + ps2); l = l * alc + ps; }
    SBAR();
    if (tacc && ((PROBE_SPIN >> 13) & 3)) { const unsigned long long n_ = __builtin_amdgcn_s_memrealtime(); if ((PROBE_SPIN >> 13) & 1) *tacc += n_ - tp_; tp_ = n_; }
    float aln = 1.f;
    const LAS char* vp = (const LAS char*)(size_t)(unsigned)vbc;
    s16x4 va[8], vb2[8];
#define VRD(D0, A) do { A[0] = vtr(vp + D0 * 512); A[1] = vtr(vp + D0 * 512 + 2048); A[2] = vtr(vp + D0 * 512 + 4096); A[3] = vtr(vp + D0 * 512 + 6144); \
                        A[4] = vtr(vp + D0 * 512 + 8192); A[5] = vtr(vp + D0 * 512 + 10240); A[6] = vtr(vp + D0 * 512 + 12288); A[7] = vtr(vp + D0 * 512 + 14336); } while (0)
#define PVM(OD, A) do { OD = __builtin_amdgcn_mfma_f32_32x32x16_bf16((bf16x8){A[0][0], A[0][1], A[0][2], A[0][3], A[1][0], A[1][1], A[1][2], A[1][3]}, pa0, OD, 0, 0, 0); \
                        OD = __builtin_amdgcn_mfma_f32_32x32x16_bf16((bf16x8){A[2][0], A[2][1], A[2][2], A[2][3], A[3][0], A[3][1], A[3][2], A[3][3]}, pa1, OD, 0, 0, 0); \
                        OD = __builtin_amdgcn_mfma_f32_32x32x16_bf16((bf16x8){A[4][0], A[4][1], A[4][2], A[4][3], A[5][0], A[5][1], A[5][2], A[5][3]}, pa2, OD, 0, 0, 0); \
                        OD = __builtin_amdgcn_mfma_f32_32x32x16_bf16((bf16x8){A[6][0], A[6][1], A[6][2], A[6][3], A[7][0], A[7][1], A[7][2], A[7][3]}, pa3, OD, 0, 0, 0); } while (0)
    if (TYPE != 3) { VRD(0, va); SBAR(); VRD(1, vb2); PVM(o[0], va); }
    if (has_next) {
        if (!tn.far) near_post<TYPE>(N0, N1, tn.blk, t, m + b128, tbl, hi);
        else if (__any(m != 0.f)) {
#pragma unroll
            for (int r = 0; r < 16; ++r) { N0[r] -= m; N1[r] -= m; } } }
    SBAR();
    if (TYPE != 3) { VRD(2, va); PVM(o[1], vb2); }
    float pmax = -__builtin_inff();
    if (TYPE != 2 && has_next) {
        if (TYPE <= 1) {
            float a = max3_s(N0[0], N0[1], N1[0]), b2 = max3_s(N0[2], N0[3], N1[1]); a = max3_s(a, N1[2], N1[3]);
#pragma unroll
            for (int r = 4; r < 16; r += 4) { a = max3_s(a, N0[r], N0[r + 1]); b2 = max3_s(b2, N0[r + 2], N0[r + 3]); a = max3_s(a, N1[r], N1[r + 1]); b2 = max3_s(b2, N1[r + 2], N1[r + 3]); }
            pmax = fmaxf(a, b2);
        } else {
#pragma unroll
            for (int r = 0; r < 16; ++r) pmax = fmaxf(pmax, fmaxf(N0[r], N1[r])); }
        pmax = xhalf_max(pmax); if (TYPE == 0) pmax = nsel ? pmax : -__builtin_inff(); }
    SBAR();
    if (TYPE != 3) { VRD(3, vb2); PVM(o[2], va); }
    if (TYPE != 2 && has_next && __any(pmax > NSA_THR)) {
        const float dl = fmaxf(pmax, 0.f); m += dl; aln = __builtin_amdgcn_exp2f(-dl);
#pragma unroll
        for (int r = 0; r < 16; ++r) { N0[r] -= dl; N1[r] -= dl; } }
    SBAR();
    if (TYPE != 3) PVM(o[3], vb2);
    if (has_next) {
#pragma unroll
        for (int r = 0; r < 16; ++r) N0[r] = __builtin_amdgcn_exp2f(N0[r]); }
    SBAR();
#undef VRD
#undef PVM
    if (TYPE < 2 && __any(aln != 1.f)) {
#pragma unroll
        for (int d = 0; d < 4; ++d)
#pragma unroll
            for (int r = 0; r < 16; ++r) o[d][r] *= aln; }
    alc = aln;
    if (tacc && ((PROBE_SPIN >> 14) & 1)) *tacc += __builtin_amdgcn_s_memrealtime() - tp_;
}
template <int TYPE, bool NEAR>
__device__ __forceinline__ bool nsa_fast(f32x16& C0, f32x16& C1, bool csel, f32x16& N0, f32x16& N1, const LAS char* Kn, int vbc, const LAS char* ql, float& l, f32x16 (&o)[4], int r32, int hi,
                                         int nblk = 0, int t = 0, float b128 = 0.f, const LAS float* tbl = nullptr) {
    bf16x8 pa0, pa1, pa2, pa3; float ps = 0.f, ps2 = 0.f;
    asm volatile("" : "+v"(r32), "+v"(hi));
    SBAR();
    N0 = f32x16{}; N1 = f32x16{};
    {   bf16x8 qf[8], kf0[8], kf1[8];
        qf[0] = *(const LAS bf16x8*)(ql); kf0[0] = *(const LAS bf16x8*)(Kn + KSWZ(r32, hi * 16)); kf1[0] = *(const LAS bf16x8*)(Kn + KSWZ(32 + r32, hi * 16));
#pragma unroll
        for (int d = 0; d < 8; ++d) {
            if (d + 1 < 8) { const int cb = ((d + 1) * 16 + hi * 8) * 2; qf[d + 1] = *(const LAS bf16x8*)(ql + (d + 1) * 1024); kf0[d + 1] = *(const LAS bf16x8*)(Kn + KSWZ(r32, cb)); kf1[d + 1] = *(const LAS bf16x8*)(Kn + KSWZ(32 + r32, cb)); }
            N0 = __builtin_amdgcn_mfma_f32_32x32x16_bf16(kf0[d], qf[d], N0, 0, 0, 0);
            N1 = __builtin_amdgcn_mfma_f32_32x32x16_bf16(kf1[d], qf[d], N1, 0, 0, 0);
            C1[2 * d] = __builtin_amdgcn_exp2f(C1[2 * d]); C1[2 * d + 1] = __builtin_amdgcn_exp2f(C1[2 * d + 1]);
            ps = fadd_s(ps, C0[2 * d]); ps2 = fadd_s(ps2, C0[2 * d + 1]); ps = fadd_s(ps, C1[2 * d]); ps2 = fadd_s(ps2, C1[2 * d + 1]);
            if (d == 2) NSA_PK4(C0, 0, pa0); if (d == 4) NSA_PK4(C0, 8, pa1); if (d == 6) NSA_PK4(C1, 0, pa2);
            SBAR();
        } }
    NSA_PK4(C1, 8, pa3);
    if (TYPE == 0 && !__all(csel)) {
        const unsigned km = csel ? 0xffffffffu : 0u; ps = csel ? ps : 0.f; ps2 = csel ? ps2 : 0.f;
        u32x4 w0 = __builtin_bit_cast(u32x4, pa0), w1 = __builtin_bit_cast(u32x4, pa1), w2 = __builtin_bit_cast(u32x4, pa2), w3 = __builtin_bit_cast(u32x4, pa3);
        w0 &= km; w1 &= km; w2 &= km; w3 &= km;
        pa0 = __builtin_bit_cast(bf16x8, w0); pa1 = __builtin_bit_cast(bf16x8, w1); pa2 = __builtin_bit_cast(bf16x8, w2); pa3 = __builtin_bit_cast(bf16x8, w3); }
    ps = xhalf_sum(ps + ps2); l += ps;
    SBAR();
    const LAS char* vp = (const LAS char*)(size_t)(unsigned)vbc;
    s16x4 va[8], vb2[8];
#define VRD(D0, A) do { A[0] = vtr(vp + D0 * 512); A[1] = vtr(vp + D0 * 512 + 2048); A[2] = vtr(vp + D0 * 512 + 4096); A[3] = vtr(vp + D0 * 512 + 6144); \
                        A[4] = vtr(vp + D0 * 512 + 8192); A[5] = vtr(vp + D0 * 512 + 10240); A[6] = vtr(vp + D0 * 512 + 12288); A[7] = vtr(vp + D0 * 512 + 14336); } while (0)
#define PVM(OD, A) do { OD = __builtin_amdgcn_mfma_f32_32x32x16_bf16((bf16x8){A[0][0], A[0][1], A[0][2], A[0][3], A[1][0], A[1][1], A[1][2], A[1][3]}, pa0, OD, 0, 0, 0); \
                        OD = __builtin_amdgcn_mfma_f32_32x32x16_bf16((bf16x8){A[2][0], A[2][1], A[2][2], A[2][3], A[3][0], A[3][1], A[3][2], A[3][3]}, pa1, OD, 0, 0, 0); \
                        OD = __builtin_amdgcn_mfma_f32_32x32x16_bf16((bf16x8){A[4][0], A[4][1], A[4][2], A[4][3], A[5][0], A[5][1], A[5][2], A[5][3]}, pa2, OD, 0, 0, 0); \
                        OD = __builtin_amdgcn_mfma_f32_32x32x16_bf16((bf16x8){A[6][0], A[6][1], A[6][2], A[6][3], A[7][0], A[7][1], A[7][2], A[7][3]}, pa3, OD, 0, 0, 0); } while (0)
#define EXQ(R0) do { N0[R0] = __builtin_amdgcn_exp2f(N0[R0]); N0[R0 + 1] = __builtin_amdgcn_exp2f(N0[R0 + 1]); N0[R0 + 2] = __builtin_amdgcn_exp2f(N0[R0 + 2]); N0[R0 + 3] = __builtin_amdgcn_exp2f(N0[R0 + 3]); } while (0)
    if (!NEAR) {
        VRD(0, va); SBAR(); VRD(1, vb2); PVM(o[0], va); EXQ(0);
        SBAR();
        VRD(2, va); PVM(o[1], vb2); EXQ(4);
        SBAR();
        VRD(3, vb2); PVM(o[2], va); EXQ(8);
        SBAR();
        PVM(o[3], vb2); EXQ(12);
        SBAR();
    } else {
        VRD(0, va); SBAR(); VRD(1, vb2); PVM(o[0], va);
        near_post<TYPE>(N0, N1, nblk, t, b128, tbl, hi);
        SBAR();
        VRD(2, va); PVM(o[1], vb2); EXQ(0); EXQ(4);
        SBAR();
        VRD(3, vb2); PVM(o[2], va); EXQ(8);
        SBAR();
        PVM(o[3], vb2); EXQ(12);
        SBAR();
    }
#undef VRD
#undef PVM
#undef EXQ
    return __any(ps > 1.0e12f);
}
template <int TYPE>
__device__ __forceinline__ void nsa_branch_compute(const LAS char* Kl, int vb, const LAS int* tl, int n, const LAS char* ql, int t, int s0, unsigned long long mymask, const LAS float* tbl,
                                                   float& m, float& l, f32x16 (&o)[4], LAS unsigned* impr, int r32, int hi, bool nocompute) {
    float alc = 1.f; l = 0.f;
    if (TYPE != 3) {
#pragma unroll
        for (int d = 0; d < 4; ++d) o[d] = f32x16{}; }
    f32x16 pA0, pA1, pB0, pB1;
    if (nocompute) { l = 1.f; __syncthreads(); for (int i = 0; i < n; ++i) __syncthreads(); __syncthreads(); return; }
    const float b128 = tbl[128];
    __syncthreads();
    TileInfo ta = tile_info<TYPE>(tl[0], s0), tb_; bool sa = (TYPE == 0) ? ((mymask >> ta.blk) & 1ull) != 0ull : true, sb = true;
    {
        qkt_lq(pA0, pA1, Kl, ql, r32, hi);
        m = 0.f;
        if (!ta.far) near_post<TYPE>(pA0, pA1, ta.blk, t, b128, tbl, hi);
        float pmax = -__builtin_inff();
#pragma unroll
        for (int r = 0; r < 16; ++r) pmax = fmaxf(pmax, fmaxf(pA0[r], pA1[r]));
        pmax = xhalf_max(pmax); if (TYPE == 0) pmax = sa ? pmax : -__builtin_inff();
        if (__any(pmax > NSA_THR)) { m = fmaxf(pmax, 0.f);
#pragma unroll
            for (int r = 0; r < 16; ++r) { pA0[r] -= m; pA1[r] -= m; } }
#pragma unroll
        for (int r = 0; r < 16; ++r) pA0[r] = __builtin_amdgcn_exp2f(pA0[r]); }
    int kq = 16384, vq = 0;
#define NSA_ROT() do { kq = (kq == 32768) ? 0 : kq + 16384; vq = (vq == 32768) ? 0 : vq + 16384; } while (0)
    for (int i = 0; i < n; i += 2) {
        __syncthreads();
        { const bool hn = i + 1 < n; tb_ = tile_info<TYPE>(hn ? tl[i + 1] : 0, s0); sb = (TYPE == 0) ? ((mymask >> tb_.blk) & 1ull) != 0ull : true;
          nsa_step<TYPE>(pA0, pA1, sa, ta.blk, pB0, pB1, Kl + kq, vb + vq, hn, tb_, sb, ql, m, alc, l, o, b128, t, tbl, impr, r32, hi); }
        NSA_ROT();
        if (i + 1 >= n) break;
        __syncthreads();
        { const bool hn = i + 2 < n; ta = tile_info<TYPE>(hn ? tl[i + 2] : 0, s0); sa = (TYPE == 0) ? ((mymask >> ta.blk) & 1ull) != 0ull : true;
          nsa_step<TYPE>(pB0, pB1, sb, tb_.blk, pA0, pA1, Kl + kq, vb + vq, hn, ta, sa, ql, m, alc, l, o, b128, t, tbl, impr, r32, hi); }
        NSA_ROT();
    }
#undef NSA_ROT
    __syncthreads();
}
__device__ __forceinline__ void nsa_cmp_pass2(const LAS char* Kl, int vb, int n, const LAS char* ql, int t, int s0, const LAS float* tbl, float m2, f32x16 (&o)[4], LAS unsigned* impr, int r32, int hi) {
#pragma unroll
    for (int d = 0; d < 4; ++d) o[d] = f32x16{};
    bf16x8 pa0, pa1, pa2, pa3;
    const float b128 = tbl[128];
#define CMP_TILE(j, Kslot) do { f32x16 p0_, p1_; qkt_lq(p0_, p1_, Kslot, ql, r32, hi); const TileInfo ti_ = tile_info<2>(j, s0); \
        if (ti_.far) { _Pragma("unroll") for (int r = 0; r < 16; ++r) { p0_[r] = __builtin_amdgcn_exp2f(p0_[r] - m2); p1_[r] = __builtin_amdgcn_exp2f(p1_[r] - m2); } } \
        else { near_post<2>(p0_, p1_, j, t, m2 + b128, tbl, hi); _Pragma("unroll") for (int r = 0; r < 16; ++r) { p0_[r] = __builtin_amdgcn_exp2f(p0_[r]); p1_[r] = __builtin_amdgcn_exp2f(p1_[r]); } } \
        _Pragma("unroll") for (int gq = 0; gq < 4; ++gq) { \
            { const float own_ = 2.f * (p0_[4 * gq] + p0_[4 * gq + 1] + p0_[4 * gq + 2]) + p0_[4 * gq + 3]; \
              __hip_atomic_fetch_add(impr + 16 * (j) + hi + 2 * gq, (unsigned)(own_ * 67108864.f + 0.5f), __ATOMIC_RELAXED, __HIP_MEMORY_SCOPE_WORKGROUP); \
              __hip_atomic_fetch_add(impr + 16 * (j) + hi + 2 * gq + 1, (unsigned)(p0_[4 * gq + 3] * 67108864.f + 0.5f), __ATOMIC_RELAXED, __HIP_MEMORY_SCOPE_WORKGROUP); } \
            { const float own_ = 2.f * (p1_[4 * gq] + p1_[4 * gq + 1] + p1_[4 * gq + 2]) + p1_[4 * gq + 3]; \
              __hip_atomic_fetch_add(impr + 16 * (j) + hi + 8 + 2 * gq, (unsigned)(own_ * 67108864.f + 0.5f), __ATOMIC_RELAXED, __HIP_MEMORY_SCOPE_WORKGROUP); \
              __hip_atomic_fetch_add(impr + 16 * (j) + hi + 8 + 2 * gq + 1, (unsigned)(p1_[4 * gq + 3] * 67108864.f + 0.5f), __ATOMIC_RELAXED, __HIP_MEMORY_SCOPE_WORKGROUP); } } \
        pack_p(p0_, p1_, pa0, pa1, pa2, pa3); } while (0)
    __syncthreads();
    CMP_TILE(0, Kl);
    for (int i = 0; i < n; ++i) {
        __syncthreads();
        pv_all<4>(o, vb + (i % 3) * 16384, pa0, pa1, pa2, pa3);
        if (i + 1 < n) CMP_TILE(i + 1, Kl + ((i + 1) % 3) * 16384);
    }
    __syncthreads();
#undef CMP_TILE
}
__device__ __forceinline__ void dma_k2(LAS char* Kslot, const bf16_t* kp, size_t ld, int wave, int lane) {
    asm volatile("" : "+v"(lane));
#pragma unroll
    for (int i = 0; i < 2; ++i) { const int pc = wave * 2 + i, row = pc * 4 + (lane >> 4), ch = (lane & 15) ^ (row & 15);
        __builtin_amdgcn_global_load_lds((const unsigned*)(kp + (size_t)row * ld + ch * 8), (LAS unsigned*)(Kslot + pc * 1024), 16, 0, 0); }
}
__device__ __forceinline__ void dma_v2(LAS char* Vslot, const bf16_t* vp, size_t ld, int wave, int lane) {
    asm volatile("" : "+v"(lane));
#pragma unroll
    for (int i = 0; i < 2; ++i) { const int pc = wave * 2 + i, cblk = 2 * (pc & 1) + (lane >> 5), kk = (pc >> 1) * 8 + ((lane & 31) >> 2), k = (kk & ~0xC) | ((kk & 4) << 1) | ((kk & 8) >> 1), c = cblk * 32 + (lane & 3) * 8;
        __builtin_amdgcn_global_load_lds((const unsigned*)(vp + (size_t)k * ld + c), (LAS unsigned*)(Vslot + pc * 1024), 16, 0, 0); }
}
template <int TYPE>
__device__ __forceinline__ void nsa_branch_all(LAS char* Kl, LAS char* Vl, const LAS int* tl, int n, const bf16_t* kbase, const bf16_t* vbase, const LAS char* ql, int t, int s0, unsigned long long mymask,
                                               const LAS float* tbl, float& l, f32x16 (&o)[4], int wave, int lane, unsigned long long* tacc = nullptr, bool k0_issued = false) {
    const int r32 = lane & 31, hi = lane >> 5;
    const int vb = lds_addr(Vl) + v_rd_base(lane);
    float m = 0.f, alc = 1.f; l = 0.f;
#pragma unroll
    for (int d = 0; d < 4; ++d) o[d] = f32x16{};
    f32x16 pA0, pA1, pB0, pB1;
    const float b128 = tbl[128];
    if (!k0_issued) dma_k2(Kl, kbase + (size_t)tl[0] * 64 * OD_LD, OD_LD, wave, lane);
    __syncthreads();
    if (n > 1) dma_k2(Kl + 16384, kbase + (size_t)tl[1] * 64 * OD_LD, OD_LD, wave, lane);
    dma_v2(Vl, vbase + (size_t)tl[0] * 64 * OD_LD, OD_LD, wave, lane);
    TileInfo ta = tile_info<TYPE>(tl[0], s0), tb_; bool sa = (TYPE == 0) ? ((mymask >> ta.blk) & 1ull) != 0ull : true, sb = true;
    {
        qkt_lq(pA0, pA1, Kl, ql, r32, hi);
        if (!ta.far) near_post<TYPE>(pA0, pA1, ta.blk, t, b128, tbl, hi);
        float pmax = -__builtin_inff();
#pragma unroll
        for (int r = 0; r < 16; ++r) pmax = fmaxf(pmax, fmaxf(pA0[r], pA1[r]));
        pmax = xhalf_max(pmax); if (TYPE == 0) pmax = sa ? pmax : -__builtin_inff();
        if (__any(pmax > NSA_THR)) { m = fmaxf(pmax, 0.f);
#pragma unroll
            for (int r = 0; r < 16; ++r) { pA0[r] -= m; pA1[r] -= m; } }
#pragma unroll
        for (int r = 0; r < 16; ++r) pA0[r] = __builtin_amdgcn_exp2f(pA0[r]); }
    bool plain = !__any(m != 0.f);
    int i = 0;
#define NSA_BAR() do { unsigned long long tq_ = 0ull; if ((PROBE_SPIN >> 12) & 1) tq_ = __builtin_amdgcn_s_memrealtime(); __syncthreads(); \
                       if (tacc && ((PROBE_SPIN >> 12) & 1)) *tacc += __builtin_amdgcn_s_memrealtime() - tq_; } while (0)
#define NSA_FARPAIR() (tile_info<TYPE>(tl[i + 1], s0).far && tile_info<TYPE>(tl[i + 2], s0).far)
#define NSA_GEN_PAIR() \
        NSA_BAR(); \
        if (i + 2 < n) dma_k2(Kl, kbase + (size_t)tl[i + 2] * 64 * OD_LD, OD_LD, wave, lane); \
        if (i + 1 < n) dma_v2(Vl + 16384, vbase + (size_t)tl[i + 1] * 64 * OD_LD, OD_LD, wave, lane); \
        { const bool hn = i + 1 < n; tb_ = tile_info<TYPE>(hn ? tl[i + 1] : 0, s0); sb = (TYPE == 0) ? ((mymask >> tb_.blk) & 1ull) != 0ull : true; \
          nsa_step<TYPE>(pA0, pA1, sa, ta.blk, pB0, pB1, Kl + 16384, vb, hn, tb_, sb, ql, m, alc, l, o, b128, t, tbl, nullptr, r32, hi, tacc); } \
        if (i + 1 >= n) { i = n; break; } \
        NSA_BAR(); \
        if (i + 3 < n) dma_k2(Kl + 16384, kbase + (size_t)tl[i + 3] * 64 * OD_LD, OD_LD, wave, lane); \
        if (i + 2 < n) dma_v2(Vl, vbase + (size_t)tl[i + 2] * 64 * OD_LD, OD_LD, wave, lane); \
        { const bool hn = i + 2 < n; ta = tile_info<TYPE>(hn ? tl[i + 2] : 0, s0); sa = (TYPE == 0) ? ((mymask >> ta.blk) & 1ull) != 0ull : true; \
          nsa_step<TYPE>(pB0, pB1, sb, tb_.blk, pA0, pA1, Kl, vb + 16384, hn, ta, sa, ql, m, alc, l, o, b128, t, tbl, nullptr, r32, hi, tacc); }
#define NSA_FAST_PAIR(NEARF) \
        NSA_BAR(); \
        dma_k2(Kl, kbase + (size_t)tl[i + 2] * 64 * OD_LD, OD_LD, wave, lane); \
        dma_v2(Vl + 16384, vbase + (size_t)tl[i + 1] * 64 * OD_LD, OD_LD, wave, lane); \
        sb = (TYPE == 0) ? ((mymask >> tl[i + 1]) & 1ull) != 0ull : true; \
        const bool f1 = nsa_fast<TYPE, NEARF>(pA0, pA1, sa, pB0, pB1, Kl + 16384, vb, ql, l, o, r32, hi, tl[i + 1], t, b128, tbl); \
        NSA_BAR(); \
        if (i + 3 < n) dma_k2(Kl + 16384, kbase + (size_t)tl[i + 3] * 64 * OD_LD, OD_LD, wave, lane); \
        dma_v2(Vl, vbase + (size_t)tl[i + 2] * 64 * OD_LD, OD_LD, wave, lane); \
        sa = (TYPE == 0) ? ((mymask >> tl[i + 2]) & 1ull) != 0ull : true; \
        const bool f2 = nsa_fast<TYPE, NEARF>(pB0, pB1, sb, pA0, pA1, Kl, vb + 16384, ql, l, o, r32, hi, tl[i + 2], t, b128, tbl); \
        plain = !(f1 || f2); \
        i += 2;
    if (TYPE == 1) {
#pragma unroll 1
        while (plain && i + 2 < n && i < 2 && !NSA_FARPAIR()) { NSA_FAST_PAIR(true) }
    }
#pragma unroll 1
    while (plain && i + 2 < n && NSA_FARPAIR()) { NSA_FAST_PAIR(false) }
#pragma unroll 1
    while (plain && i + 2 < n) { NSA_FAST_PAIR(true) }
#pragma unroll 1
    for (; i < n; i += 2) {
        NSA_GEN_PAIR()
    }
#undef NSA_FAST_PAIR
#undef NSA_FARPAIR
#undef NSA_GEN_PAIR
#undef NSA_BAR
    __syncthreads();
}
__device__ __forceinline__ void nsa_wait_vm(int n) {
    if (n >= 16) asm volatile("s_waitcnt vmcnt(16)" ::: "memory"); else if (n >= 8) asm volatile("s_waitcnt vmcnt(8)" ::: "memory"); else asm volatile("s_waitcnt vmcnt(0)" ::: "memory");
}
__device__ __forceinline__ void nsa_branch_load(LAS char* Kl, LAS char* Vl, const LAS int* tl, int n, const bf16_t* kbase, const bf16_t* vbase, size_t ld, bool with_v, int lw, int lane) {
    dma_k(Kl, kbase + (size_t)tl[0] * 64 * ld, ld, lw, lane);
    int c = 0;
    if (n > 1) { dma_k(Kl + 16384, kbase + (size_t)tl[1] * 64 * ld, ld, lw, lane); c += 8; }
    if (with_v) { dma_v(Vl, vbase + (size_t)tl[0] * 64 * ld, ld, lw, lane); c += 8; }
    nsa_wait_vm(c); __builtin_amdgcn_s_barrier();
    int ks = 32768, vs = 16384;
    for (int s = 0; s < n; ++s) {
        c = 0;
        if (s + 2 < n) { dma_k(Kl + ks, kbase + (size_t)tl[s + 2] * 64 * ld, ld, lw, lane); c += 8; }
        if (with_v && s + 1 < n) { dma_v(Vl + vs, vbase + (size_t)tl[s + 1] * 64 * ld, ld, lw, lane); c += 8; }
        nsa_wait_vm(c); __builtin_amdgcn_s_barrier();
        ks = (ks == 32768) ? 0 : ks + 16384; vs = (vs == 32768) ? 0 : vs + 16384;
    }
    asm volatile("s_waitcnt vmcnt(0)" ::: "memory"); __builtin_amdgcn_s_barrier();
}
__device__ __forceinline__ void nsa_topk(const LAS unsigned* imp, LAS unsigned long long* selm, int wave, int lane, int s0) {
    const int cur = s0 >> 6;
    unsigned v[4], thr[4];
#pragma unroll
    for (int i = 0; i < 4; ++i) { const int tt = wave * 4 + i, tq = s0 + tt;
        unsigned x = imp[tt * 65 + lane] + 1u;
        const bool forced = (lane == 0) || (lane == cur) || (lane == cur - 1), future = lane * 64 > tq;
        v[i] = forced ? 0xffffffffu : (future ? 0u : x); thr[i] = 0u; }
#pragma unroll
    for (int b = 31; b >= 0; --b)
#pragma unroll
        for (int i = 0; i < 4; ++i) { const unsigned cand = thr[i] | (1u << b); if (__builtin_popcountll(__ballot(v[i] >= cand)) >= 8) thr[i] = cand; }
#pragma unroll
    for (int i = 0; i < 4; ++i) { const int tt = wave * 4 + i;
        const unsigned long long gt = __ballot(v[i] > thr[i]), eq = __ballot(v[i] == thr[i]);
        const int need = 8 - __builtin_popcountll(gt);
        const int myord = __builtin_popcountll(eq & ((1ull << lane) - 1ull));
        unsigned long long msk = gt | __ballot(v[i] == thr[i] && myord < need);
        msk &= (2ull << cur) - 1ull;
        if (lane == 0) selm[tt] = msk; }
}
__device__ __forceinline__ unsigned long long nsa_union(unsigned long long mymask) {
    unsigned lo = (unsigned)mymask, hi32 = (unsigned)(mymask >> 32);
#pragma unroll
    for (int off = 1; off < 32; off <<= 1) { lo |= __shfl_xor(lo, off); hi32 |= __shfl_xor(hi32, off); }
    return ((unsigned long long)(unsigned)__builtin_amdgcn_readfirstlane(hi32) << 32) | (unsigned)__builtin_amdgcn_readfirstlane(lo);
}
constexpr int NSA_V_OFF = 49152, NSA_Q_OFF = 98304, NSA_IMP_OFF = NSA_Q_OFF + 6 * 8192, NSA_LIST_OFF = NSA_IMP_OFF + 32 * 65 * 4, NSA_SEL_OFF = NSA_LIST_OFF + 96 * 4, NSA_TB_OFF = NSA_SEL_OFF + 1024;
constexpr int NSA2_V_OFF = 32768, NSA2_Q_OFF = 65536, NSA2_SCR_OFF = 131072;
static_assert(NSA_TB_OFF + 12 * 132 * 4 <= MISC_OFF && NSA2_SCR_OFF + 8 * 2560 <= NSA_LIST_OFF, "nsa lds");
constexpr int ACC_LD = 1536;
__device__ __forceinline__ void q_park(LAS char* qdst  , const bf16_t* q0  , int lane) {
    constexpr float C = 0.08838834764831845f * LOG2E;
#pragma unroll
    for (int i = 0; i < 8; ++i) { const int T = 4 * i + (lane >> 4), c = lane & 15;
        u32x4 w = *(const u32x4*)(q0 + (size_t)T * OD_LD + c * 8);
        w.x = cvt_pk_bf16(__builtin_bit_cast(float, w.x << 16) * C, __builtin_bit_cast(float, w.x & 0xffff0000u) * C); w.y = cvt_pk_bf16(__builtin_bit_cast(float, w.y << 16) * C, __builtin_bit_cast(float, w.y & 0xffff0000u) * C);
        w.z = cvt_pk_bf16(__builtin_bit_cast(float, w.z << 16) * C, __builtin_bit_cast(float, w.z & 0xffff0000u) * C); w.w = cvt_pk_bf16(__builtin_bit_cast(float, w.w << 16) * C, __builtin_bit_cast(float, w.w & 0xffff0000u) * C);
        *(LAS u32x4*)(qdst + (c >> 1) * 1024 + ((c & 1) * 32 + T) * 16) = w; }
}
__device__ __forceinline__ void q_pieces(u32x4 (&wq)[4][2], const bf16_t* q0, int lane) {
#pragma unroll
    for (int p = 0; p < 4; ++p)
#pragma unroll
        for (int k = 0; k < 2; ++k) { const int id = lane + 64 * k, T = id >> 2, c = 4 * p + (id & 3); wq[p][k] = *(const u32x4*)(q0 + (size_t)T * OD_LD + c * 8); }
}
__device__ __forceinline__ void q_regs(bf16x8 (&qr)[8], LAS char* scr, const u32x4 (&wq)[4][2], int lane) {
    constexpr float C = 0.08838834764831845f * LOG2E;
#pragma unroll
    for (int p = 0; p < 4; ++p) {
#pragma unroll
        for (int k = 0; k < 2; ++k) { const int id = lane + 64 * k, T = id >> 2, cc = id & 3;
            u32x4 w = wq[p][k];
            w.x = cvt_pk_bf16(__builtin_bit_cast(float, w.x << 16) * C, __builtin_bit_cast(float, w.x & 0xffff0000u) * C); w.y = cvt_pk_bf16(__builtin_bit_cast(float, w.y << 16) * C, __builtin_bit_cast(float, w.y & 0xffff0000u) * C);
            w.z = cvt_pk_bf16(__builtin_bit_cast(float, w.z << 16) * C, __builtin_bit_cast(float, w.z & 0xffff0000u) * C); w.w = cvt_pk_bf16(__builtin_bit_cast(float, w.w << 16) * C, __builtin_bit_cast(float, w.w & 0xffff0000u) * C);
            *(LAS u32x4*)(scr + (cc >> 1) * 1024 + ((cc & 1) * 32 + T) * 16) = w; }
        asm volatile("s_waitcnt lgkmcnt(0)" ::: "memory");
        qr[2 * p] = *(const LAS bf16x8*)(scr + lane * 16); qr[2 * p + 1] = *(const LAS bf16x8*)(scr + 1024 + lane * 16);
        asm volatile("s_waitcnt lgkmcnt(0)" ::: "memory");
    }
}
__device__ __forceinline__ void cmp_pass1_res(const LAS char* Kres, int n, const bf16x8 (&qr)[8], int t, int s0, const LAS float* tbl, float& m, float& l, int r32, int hi) {
    const float b128 = tbl[128], NEGINF = -__builtin_inff();
    m = NEGINF; l = 0.f;
    for (int j = 0; j < n; ++j) {
        f32x16 p0, p1; qkt(p0, p1, Kres + j * 16384, qr, r32, hi);
        const TileInfo ti = tile_info<3>(j, s0);
        if (!ti.far) near_post<3>(p0, p1, j, t, b128, tbl, hi);
        float pmax = NEGINF;
#pragma unroll
        for (int r = 0; r < 16; ++r) pmax = fmaxf(pmax, fmaxf(p0[r], p1[r]));
        pmax = xhalf_max(pmax);
        const float mn = fmaxf(m, pmax), mref = (mn == NEGINF) ? 0.f : mn;
        float ps = 0.f, ps2 = 0.f;
#pragma unroll
        for (int r = 0; r < 16; ++r) { ps += __builtin_amdgcn_exp2f(p0[r] - mref); ps2 += __builtin_amdgcn_exp2f(p1[r] - mref); }
        l = l * __builtin_amdgcn_exp2f(m - mref) + xhalf_sum(ps + ps2); m = mn;
    }
}
__device__ __forceinline__ void cmp_pass2_res(const LAS char* Kres, int vb, int n, const bf16x8 (&qr)[8], int t, int s0, const LAS float* tbl, float m2, f32x16 (&o)[4], LAS unsigned* impr, int r32, int hi) {
#pragma unroll
    for (int d = 0; d < 4; ++d) o[d] = f32x16{};
    const float b128 = tbl[128];
    for (int j = 0; j < n; ++j) {
        f32x16 p0_, p1_; qkt(p0_, p1_, Kres + j * 16384, qr, r32, hi);
        const TileInfo ti_ = tile_info<2>(j, s0);
        if (ti_.far) {
#pragma unroll
            for (int r = 0; r < 16; ++r) { p0_[r] = __builtin_amdgcn_exp2f(p0_[r] - m2); p1_[r] = __builtin_amdgcn_exp2f(p1_[r] - m2); } }
        else { near_post<2>(p0_, p1_, j, t, m2 + b128, tbl, hi);
#pragma unroll
            for (int r = 0; r < 16; ++r) { p0_[r] = __builtin_amdgcn_exp2f(p0_[r]); p1_[r] = __builtin_amdgcn_exp2f(p1_[r]); } }
#pragma unroll
        for (int gq = 0; gq < 4; ++gq) {
            { const float own_ = 2.f * (p0_[4 * gq] + p0_[4 * gq + 1] + p0_[4 * gq + 2]) + p0_[4 * gq + 3];
              __hip_atomic_fetch_add(impr + 16 * j + hi + 2 * gq, (unsigned)(own_ * 67108864.f + 0.5f), __ATOMIC_RELAXED, __HIP_MEMORY_SCOPE_WORKGROUP);
              __hip_atomic_fetch_add(impr + 16 * j + hi + 2 * gq + 1, (unsigned)(p0_[4 * gq + 3] * 67108864.f + 0.5f), __ATOMIC_RELAXED, __HIP_MEMORY_SCOPE_WORKGROUP); }
            { const float own_ = 2.f * (p1_[4 * gq] + p1_[4 * gq + 1] + p1_[4 * gq + 2]) + p1_[4 * gq + 3];
              __hip_atomic_fetch_add(impr + 16 * j + hi + 8 + 2 * gq, (unsigned)(own_ * 67108864.f + 0.5f), __ATOMIC_RELAXED, __HIP_MEMORY_SCOPE_WORKGROUP);
              __hip_atomic_fetch_add(impr + 16 * j + hi + 8 + 2 * gq + 1, (unsigned)(p1_[4 * gq + 3] * 67108864.f + 0.5f), __ATOMIC_RELAXED, __HIP_MEMORY_SCOPE_WORKGROUP); } }
        bf16x8 pa0, pa1, pa2, pa3; pack_p(p0_, p1_, pa0, pa1, pa2, pa3);
        pv_all<4>(o, vb + j * 16384, pa0, pa1, pa2, pa3);
    }
}
__device__ __forceinline__ float cmp_single_res(const LAS char* Kres, int vb, int n, const bf16x8 (&qr)[8], int t, int s0, const LAS float* tbl, f32x16 (&o)[4], LAS unsigned* impr, int r32, int hi) {
    const float b128 = tbl[128], NEGINF = -__builtin_inff();
    f32x16 sa[4], sb[4];
    float m = NEGINF;
#pragma unroll
    for (int j = 0; j < 4; ++j) if (j < n) {
        qkt(sa[j], sb[j], Kres + j * 16384, qr, r32, hi);
        const TileInfo ti = tile_info<3>(j, s0);
        if (!ti.far) near_post<3>(sa[j], sb[j], j, t, b128, tbl, hi);
        float pmax = NEGINF;
#pragma unroll
        for (int r = 0; r < 16; ++r) pmax = fmaxf(pmax, fmaxf(sa[j][r], sb[j][r]));
        m = fmaxf(m, pmax); }
    m = xhalf_max(m);
    const float mref = (m == NEGINF) ? 0.f : m;
    float ps = 0.f, ps2 = 0.f;
#pragma unroll
    for (int j = 0; j < 4; ++j) if (j < n) {
#pragma unroll
        for (int r = 0; r < 16; ++r) { sa[j][r] = __builtin_amdgcn_exp2f(sa[j][r] - mref); sb[j][r] = __builtin_amdgcn_exp2f(sb[j][r] - mref); ps += sa[j][r]; ps2 += sb[j][r]; } }
    const float l = xhalf_sum(ps + ps2);
    const float inv = (l > 0.f && t >= 31) ? 1.0f / l : 0.f;
    const float fx = inv * 67108864.f;
#pragma unroll
    for (int d = 0; d < 4; ++d) o[d] = f32x16{};
#pragma unroll
    for (int j = 0; j < 4; ++j) if (j < n) {
#pragma unroll
        for (int gq = 0; gq < 4; ++gq) {
            { const float own_ = 2.f * (sa[j][4 * gq] + sa[j][4 * gq + 1] + sa[j][4 * gq + 2]) + sa[j][4 * gq + 3];
              __hip_atomic_fetch_add(impr + 16 * j + hi + 2 * gq, (unsigned)(own_ * fx + 0.5f), __ATOMIC_RELAXED, __HIP_MEMORY_SCOPE_WORKGROUP);
              __hip_atomic_fetch_add(impr + 16 * j + hi + 2 * gq + 1, (unsigned)(sa[j][4 * gq + 3] * fx + 0.5f), __ATOMIC_RELAXED, __HIP_MEMORY_SCOPE_WORKGROUP); }
            { const float own_ = 2.f * (sb[j][4 * gq] + sb[j][4 * gq + 1] + sb[j][4 * gq + 2]) + sb[j][4 * gq + 3];
              __hip_atomic_fetch_add(impr + 16 * j + hi + 8 + 2 * gq, (unsigned)(own_ * fx + 0.5f), __ATOMIC_RELAXED, __HIP_MEMORY_SCOPE_WORKGROUP);
              __hip_atomic_fetch_add(impr + 16 * j + hi + 8 + 2 * gq + 1, (unsigned)(sb[j][4 * gq + 3] * fx + 0.5f), __ATOMIC_RELAXED, __HIP_MEMORY_SCOPE_WORKGROUP); } }
        bf16x8 pa0, pa1, pa2, pa3; pack_p(sa[j], sb[j], pa0, pa1, pa2, pa3);
        pv_all<4>(o, vb + j * 16384, pa0, pa1, pa2, pa3); }
    return inv;
}
__device__ __forceinline__ void nsa_phase(const Frame& F, bf16_t* Z, const float* gates, const bf16_t* kcmp, const bf16_t* vcmp, const float* tbias, bf16_t* ACC, unsigned long long& tacc) {
    const int wave = F.wave;
    LAS char* Kl = (LAS char*)F.lds; LAS char* Vl = Kl + NSA_V_OFF;
    LAS unsigned* imp = (LAS unsigned*)(Kl + NSA_IMP_OFF); LAS unsigned long long* selm = (LAS unsigned long long*)(Kl + NSA_SEL_OFF); LAS float* tb = (LAS float*)(Kl + NSA_TB_OFF);
    LAS int* tls = (LAS int*)(Kl + NSA_LIST_OFF); LAS int* tlw = tls + 72; LAS int* tlc = tls + 88;
    const bool cw = wave < 6;
    for (int i = F.tid; i < 12 * 132; i += 512) tb[i] = tbias[i];
    if (F.tid < 4) tlc[F.tid] = F.tid;
    for (int round = 0; round < 2; ++round) {
        const int rank = round * 256 + ((round & 1) ? (255 - F.bid) : F.bid);
        if (F.bid >= 256) break;
        const int bg = rank & 15, b = bg >> 1, g = bg & 1, T0 = (31 - (rank >> 4)) * 128;
        bf16_t* zb = Z + (size_t)b * SEQ * OD_LD;
        const bf16_t* kc = kcmp + (size_t)bg * 256 * 128; const bf16_t* vc = vcmp + (size_t)bg * 256 * 128;
        unsigned long long tp1_ = 0ull; if ((PROBE_SPIN >> 15) & 1) tp1_ = __builtin_amdgcn_s_memrealtime();
        { const int ntc_su = ((((T0 + 96) >> 4) > 254 ? 254 : ((T0 + 96) >> 4)) >> 6) + 1;
          int ld_ = F.tid & 63;
          for (int j = 0; j < ntc_su; ++j) { dma_k2(Kl + j * 16384, kc + (size_t)j * 64 * 128, 128, wave, ld_); dma_v2(Kl + 65536 + j * 16384, vc + (size_t)j * 64 * 128, 128, wave, ld_); } }
        for (int sub = 0; sub < 4; ++sub) {
            int tid = F.tid; asm volatile("" : "+v"(tid));
            const int lane = tid & 63, r32 = lane & 31, hi = lane >> 5;
            const int s0 = T0 + 32 * sub, t = s0 + r32;
            const int jmax = (s0 >> 4) > 254 ? 254 : (s0 >> 4), ntc = (jmax >> 6) + 1;
            for (int i = tid; i < 32 * 65; i += 512) imp[i] = 0u;
            __syncthreads();
            if (cw) {
                const int head = wave, hg = g * 6 + head;
                const int vb = lds_addr(Kl + 65536) + v_rd_base(lane);
                const LAS float* tbl = tb + hg * 132;
                LAS unsigned* impr = imp + r32 * 65;
                LAS char* scr = Kl + 131072 + wave * 2560;
                bf16x8 qr[8]; { u32x4 wq[4][2]; q_pieces(wq, zb + (size_t)s0 * OD_LD + OD_Q + hg * 128, lane); q_regs(qr, scr, wq, lane); }
                f32x16 o[4];
                const float inv = cmp_single_res(Kl, vb, ntc, qr, t, s0, tbl, o, impr, r32, hi);
                { int tv = t; asm volatile("" : "+v"(tv));
                  acc_step<0>(scr, ACC + ((size_t)b * SEQ + s0) * ACC_LD + hg * 128, ACC_LD, nullptr, 0, o, gates[((size_t)b * SEQ + tv) * GATE_LD + hg] * inv, (tv & 31) | (hi << 5), false); }
            }
            __syncthreads();
            nsa_topk(imp, selm + sub * 32, wave, lane, s0);
            __syncthreads();
        }
        if ((PROBE_SPIN >> 15) & 1) tacc += __builtin_amdgcn_s_memrealtime() - tp1_;
        for (int rr = 0; rr < 3; ++rr) {
            int tid = F.tid; asm volatile("" : "+v"(tid));
            const int lane = tid & 63, r32 = lane & 31, hi = lane >> 5;
            const int task = 8 * rr + wave, sub = task / 6, head = task - 6 * sub, hg = g * 6 + head, s0 = T0 + 32 * sub, t = s0 + r32;
            const LAS float* tbl = tb + hg * 132;
            LAS char* K2 = Kl; LAS char* V2 = Kl + NSA2_V_OFF;
            const LAS char* ql = Kl + NSA2_Q_OFF + wave * 8192 + lane * 16;
            q_park(Kl + NSA2_Q_OFF + wave * 8192, zb + (size_t)s0 * OD_LD + OD_Q + hg * 128, lane);
            const unsigned long long mymask = selm[sub * 32 + r32];
            const int s_lo = T0 + 32 * rr, s_hi = s_lo + 32, cur_hi = s_hi >> 6;
            const int jt0 = (s_lo - 511) < 0 ? 0 : (s_lo - 511) >> 6, ntw = cur_hi - jt0 + 1;
            unsigned long long uni;
            { const unsigned long long mk = selm[rr * 32 + lane]; unsigned lo = (unsigned)mk, h32 = (unsigned)(mk >> 32);
#pragma unroll
              for (int off = 1; off < 64; off <<= 1) { lo |= __shfl_xor(lo, off); h32 |= __shfl_xor(h32, off); }
              uni = ((unsigned long long)(unsigned)__builtin_amdgcn_readfirstlane(h32) << 32) | (unsigned)__builtin_amdgcn_readfirstlane(lo); }
            const int ns = __builtin_popcountll(uni);
            if (wave == 7) {
                if ((uni >> lane) & 1ull) tls[__builtin_popcountll(uni & ((1ull << lane) - 1ull))] = lane;
                if (lane < ntw) tlw[lane] = jt0 + lane; }
            dma_k2(K2, zb + OD_KS + g * 128 + (size_t)__builtin_ctzll(uni) * 64 * OD_LD, OD_LD, wave, lane);
            __syncthreads();
            f32x16 o[4]; float lb;
            bf16_t* arow0 = ACC + ((size_t)b * SEQ + s0) * ACC_LD + hg * 128;
            nsa_branch_all<0>(K2, V2, tls, ns, zb + OD_KS + g * 128, zb + OD_VS + g * 128, ql, t, s0, mymask, tbl, lb, o, wave, lane, &tacc, true);
            dma_k2(K2, zb + OD_KW + g * 128 + (size_t)jt0 * 64 * OD_LD, OD_LD, wave, lane);
            { int tv = t; asm volatile("" : "+v"(tv));
              acc_step<1>(Kl + NSA2_SCR_OFF + wave * 2560, arow0, ACC_LD, nullptr, 0, o, gates[((size_t)b * SEQ + tv) * GATE_LD + hg + 12] / lb, (tv & 31) | (hi << 5), false); }
            nsa_branch_all<1>(K2, V2, tlw, ntw, zb + OD_KW + g * 128, zb + OD_VW + g * 128, ql, t, s0, mymask, tbl, lb, o, wave, lane, &tacc, true);
            { int tv = t; asm volatile("" : "+v"(tv));
              acc_step<2>(Kl + NSA2_SCR_OFF + wave * 2560, arow0, ACC_LD, Z + ((size_t)b * SEQ + s0) * OD_LD + OD_G + hg * 128, OD_LD, o, gates[((size_t)b * SEQ + tv) * GATE_LD + hg + 24] / lb, (tv & 31) | (hi << 5), F.dry != 0); }
            __syncthreads();
        }
    }
}

template <int MAP>
__device__ __forceinline__ void transpose_item(const float* W, int K, int N, bf16_t* WT, const float* kscale, LAS float* scr, int item, int lane) {
    const int nblk = (N + 31) / 32, kb = item / nblk, nb = item % nblk, k0 = 64 * kb, n0 = 32 * nb;
    const int nl = n0 + (lane & 31);
    float tv[32];
#pragma unroll
    for (int i = 0; i < 32; ++i) { const int kk = 2 * i + (lane >> 5); tv[i] = 0.f; if (nl < N) tv[i] = W[(size_t)(k0 + kk) * N + nl]; }
#pragma unroll
    for (int i = 0; i < 32; ++i) { const int kk = 2 * i + (lane >> 5); float v = tv[i]; if (kscale) v *= kscale[k0 + kk]; scr[kk * 33 + (lane & 31)] = v; }
    LDS_WAIT(); asm volatile("" ::: "memory");
    const int c = lane & 7;
#pragma unroll
    for (int j = 0; j < 4; ++j) { const int n = (lane >> 3) + 8 * j; const LAS float* s = scr + (8 * c) * 33 + n;
        u32x4 o; o.x = pk2(s[0 * 33], s[1 * 33]); o.y = pk2(s[2 * 33], s[3 * 33]); o.z = pk2(s[4 * 33], s[5 * 33]); o.w = pk2(s[6 * 33], s[7 * 33]);
        const int ncol = n0 + n;
        if (ncol < N) {
            int drow = ncol;
            if (MAP == 1) { if (ncol >= 3620) drow = OD_G + (ncol - 3620); else if (ncol >= 3108) drow = OD_XQ + (ncol - 3108); else if (ncol >= 3072) drow = OD_LD + (ncol - 3072); }
            *(u32x4*)(WT + (size_t)drow * K + k0 + 8 * c) = o; } }
    LDS_WAIT(); asm volatile("" ::: "memory");
}
__device__ __forceinline__ int t5_bucket(int n) {
    if (n < 16) return n;
    int l = 16 + (int)(__logf((float)n * (1.f / 16.f)) / 2.0794415416798357f * 16.f);
    return l < 31 ? l : 31;
}
__device__ __forceinline__ void prologue(const Frame& F, const Args& a) {
    LAS float* scr = (LAS float*)(F.lds + F.wave * 16384);
    const int gw = F.bid * 8 + F.wave, NGW = F.G * 8, lane = F.lane;
    unsigned char* ws = F.ws;
    const float* norm_g = a.in[2];
    constexpr int I0 = 16 * 160, I1 = 16 * 178, IO = 32 * 32, IM = 16 * 32, IC1 = 64 * 8, IC2 = 4 * 4, IP = 3 * 6;
    constexpr int NITEMS = I0 + I1 + 2 * IO + 2 * IM + 2 * IC1 + 2 * IC2 + 4 * IP;
    for (int it = gw; it < NITEMS; it += NGW) {
        int r = it;
        if (r < I0) { transpose_item<0>(a.in[6], DM, EV_LD, (bf16_t*)(ws + WS_W0), norm_g, scr, r, lane); continue; } r -= I0;
        if (r < I1) { transpose_item<1>(a.in[11], DM, OD_COLS, (bf16_t*)(ws + WS_W1), norm_g + DM, scr, r, lane); continue; } r -= I1;
        if (r < IO) { transpose_item<0>(a.in[10], DIN, DM, (bf16_t*)(ws + WS_WO0), nullptr, scr, r, lane); continue; } r -= IO;
        if (r < IO) { transpose_item<0>(a.in[17], DIN, DM, (bf16_t*)(ws + WS_WO1), nullptr, scr, r, lane); continue; } r -= IO;
        if (r < IM) { transpose_item<0>(a.in[9], DM, DM, (bf16_t*)(ws + WS_WM0), nullptr, scr, r, lane); continue; } r -= IM;
        if (r < IM) { transpose_item<0>(a.in[16], DM, DM, (bf16_t*)(ws + WS_WM1), nullptr, scr, r, lane); continue; } r -= IM;
        if (r < 2 * IC1) { const int kv = r / IC1; transpose_item<0>(a.in[13] + (size_t)kv * 4096 * 256, 4096, 256, (bf16_t*)(ws + WS_WC1) + (size_t)kv * 256 * 4096, nullptr, scr, r % IC1, lane); continue; } r -= 2 * IC1;
        if (r < 2 * IC2) { const int kv = r / IC2; transpose_item<0>(a.in[15] + (size_t)kv * 256 * 128, 256, 128, (bf16_t*)(ws + WS_WC2) + (size_t)kv * 128 * 256, nullptr, scr, r % IC2, lane); continue; } r -= 2 * IC2;
        { const int gi = r / IP; transpose_item<0>(a.in[7] + (size_t)gi * 192 * 192, 192, 192, (bf16_t*)(ws + WS_WP) + (size_t)gi * 192 * 192, nullptr, scr, r % IP, lane); }
    }
    { u32x4* p = (u32x4*)((bf16_t*)(ws + WS_W1) + (size_t)OD_COLS * DM); const int n16 = (OD_N - OD_COLS) * DM * 2 / 16;
      for (int i = F.bid * 512 + F.tid; i < n16; i += F.G * 512) p[i] = (u32x4){0u, 0u, 0u, 0u}; }
    { const float* x = a.in[0]; bf16_t* xb = (bf16_t*)(ws + WS_R); float* part = (float*)(ws + WS_PART);
      for (int m = gw; m < MTOK; m += 4 * NGW) {
          f32x4 v[4][4]; float s[4]; bool ok[4]; int mr[4];
#pragma unroll
          for (int q = 0; q < 4; ++q) { ok[q] = m + q * NGW < MTOK; mr[q] = ok[q] ? m + q * NGW : m; const f32x4* xr = (const f32x4*)(x + (size_t)mr[q] * DM) + lane;
#pragma unroll
              for (int j = 0; j < 4; ++j) v[q][j] = xr[64 * j]; }
#pragma unroll
          for (int q = 0; q < 4; ++q) { s[q] = 0.f;
#pragma unroll
              for (int j = 0; j < 4; ++j) s[q] += (v[q][j].x * v[q][j].x + v[q][j].y * v[q][j].y) + (v[q][j].z * v[q][j].z + v[q][j].w * v[q][j].w);
              s[q] = wave_sum(s[q]); }
#pragma unroll
          for (int q = 0; q < 4; ++q) if (ok[q]) { u32x2* o8 = (u32x2*)(xb + (size_t)mr[q] * DM) + lane;
#pragma unroll
              for (int j = 0; j < 4; ++j) o8[64 * j] = (u32x2){pk2(v[q][j].x, v[q][j].y), pk2(v[q][j].z, v[q][j].w)};
              if (lane < 16) part[(size_t)mr[q] * 16 + lane] = (lane == 0) ? s[q] : 0.f; }
      } }
    { const float* mem = a.in[1]; const float* mg = a.in[4]; bf16_t* mn = (bf16_t*)(ws + WS_MEMN);
      for (int m = gw; m < BATCH * NMEM; m += NGW) {
          const f32x4* xr = (const f32x4*)(mem + (size_t)m * DM) + lane; const f32x4* gr = (const f32x4*)mg + lane; f32x4 v[4]; float s = 0.f;
#pragma unroll
          for (int j = 0; j < 4; ++j) { v[j] = xr[64 * j]; s += (v[j].x * v[j].x + v[j].y * v[j].y) + (v[j].z * v[j].z + v[j].w * v[j].w); }
          const float rs = 1.0f / sqrtf(wave_sum(s) * (1.f / DM) + EPS);
          u32x2* o8 = (u32x2*)(mn + (size_t)m * DM) + lane;
#pragma unroll
          for (int j = 0; j < 4; ++j) { const f32x4 g = gr[64 * j]; o8[64 * j] = (u32x2){pk2(v[j].x * rs * g.x, v[j].y * rs * g.y), pk2(v[j].z * rs * g.z, v[j].w * rs * g.w)}; }
      } }
    { float* ct = (float*)(ws + WS_ROPE); float* st = ct + SEQ * 64;
      for (int i = F.bid * 512 + F.tid; i < SEQ * 64; i += F.G * 512) {
          const int s = i >> 6, f = i & 63;
          const float inv = exp2f(-((float)f * (1.f / 64.f)) * 13.287712379549449f);
          const float ang = (float)s * inv;
          const double x = (double)ang; const double kq = rint(x * 0.6366197723675814);
          double r = fma(-kq, 1.5707963267948966, x); r = fma(-kq, 6.123233995736766e-17, r);
          const double r2 = r * r;
          const double sn = r * (1.0 + r2 * (-1.0 / 6 + r2 * (1.0 / 120 + r2 * (-1.0 / 5040 + r2 * (1.0 / 362880 - r2 * (1.0 / 39916800))))));
          const double cs = 1.0 + r2 * (-0.5 + r2 * (1.0 / 24 + r2 * (-1.0 / 720 + r2 * (1.0 / 40320 - r2 * (1.0 / 3628800)))));
          const int q = ((int)kq) & 3;
          double c_, s_;
          if (q == 0) { c_ = cs; s_ = sn; } else if (q == 1) { c_ = -sn; s_ = cs; } else if (q == 2) { c_ = -cs; s_ = -sn; } else { c_ = sn; s_ = -cs; }
          ct[i] = (float)c_; st[i] = (float)s_;
      } }
    if (F.bid == 0) { float* tb = (float*)(ws + WS_MISC); const float* rb = a.in[5];
        for (int i = F.tid; i < 12 * 132; i += 512) { const int h = i / 132, r = i % 132; const int bk = r >= 128 ? 31 : t5_bucket(r); tb[i] = rb[bk * 12 + h] * LOG2E; } }
    for (int w = F.bid; w < 256; w += F.G) { const int kv = w >> 7, j = (w >> 2) & 31, cl = F.tid & 63, c = (w & 3) * 64 + cl, kg = F.tid >> 6;
        const float* pe = a.in[12] + (size_t)kv * 4096 + 128 * j + 16 * kg; const float* w1 = a.in[13] + (size_t)kv * 4096 * 256 + (size_t)(128 * j + 16 * kg) * 256 + c;
        float pv[16], wv[16];
#pragma unroll
        for (int i = 0; i < 16; ++i) { pv[i] = pe[i]; wv[i] = w1[(size_t)i * 256]; }
        float s = 0.f;
#pragma unroll
        for (int i = 0; i < 16; ++i) s += pv[i] * wv[i];
        LAS float* red = (LAS float*)(F.lds + RSTD_OFF);
        red[kg * 64 + cl] = s;
        __syncthreads();
        if (kg == 0) { float tot = 0.f;
#pragma unroll
            for (int q = 0; q < 8; ++q) tot += red[q * 64 + cl];
            ((float*)(ws + WS_MISC + 65536))[(kv * 32 + j) * 256 + c] = tot; }
        __syncthreads(); }
}

__device__ __forceinline__ void final_norm(const Frame& F, float* out, const bf16_t* hb, const float* part, const float* fg) {
    const int gw = F.bid * 8 + F.wave, NGW = F.G * 8, lane = F.lane;
    for (int m = gw; m < MTOK; m += NGW) {
        float ps = (lane < 16) ? part[(size_t)m * 16 + lane] : 0.f;
        float tot = 0.f;
#pragma unroll
        for (int j = 0; j < 16; ++j) tot += __shfl(ps, j);
        const float rs = 1.0f / sqrtf(tot * (1.f / DM) + EPS);
        const u32x4* hr = (const u32x4*)(hb + (size_t)m * DM) + lane; f32x4* xr = (f32x4*)(out + (size_t)m * DM) + 2 * lane; const f32x4* gr = (const f32x4*)fg + 2 * lane;
#pragma unroll
        for (int j = 0; j < 2; ++j) { const u32x4 hw = hr[64 * j]; const f32x4 g0 = gr[128 * j], g1 = gr[128 * j + 1];
            f32x4 v0 = {__builtin_bit_cast(float, hw.x << 16), __builtin_bit_cast(float, hw.x & 0xffff0000u), __builtin_bit_cast(float, hw.y << 16), __builtin_bit_cast(float, hw.y & 0xffff0000u)};
            f32x4 v1 = {__builtin_bit_cast(float, hw.z << 16), __builtin_bit_cast(float, hw.z & 0xffff0000u), __builtin_bit_cast(float, hw.w << 16), __builtin_bit_cast(float, hw.w & 0xffff0000u)};
            v0 = v0 * rs * g0; v1 = v1 * rs * g1;
            if (!F.dry) { xr[128 * j] = v0; xr[128 * j + 1] = v1; } }
    }
}
__device__ __forceinline__ void fill_rstd(const Frame& F, const pg8::StaticOrder& S, const float* part) {
    LAS float* rl = (LAS float*)(F.lds + RSTD_OFF);
    f32x4 pv[6][4]; bool ok[6];
#pragma unroll
    for (int j = 0; j < 6; ++j) { const int en = F.tid + 512 * j, i = en >> 8, r = en & 255; pg8::Unit u; ok[j] = S.next(i, u);
        const f32x4* p = (const f32x4*)(part + ((size_t)(ok[j] ? u.pm : 0) * 256 + r) * 16);
#pragma unroll
        for (int q = 0; q < 4; ++q) pv[j][q] = p[q]; }
#pragma unroll
    for (int j = 0; j < 6; ++j) { const int en = F.tid + 512 * j;
        float tot = 0.f;
#pragma unroll
        for (int q = 0; q < 4; ++q) { tot += pv[j][q].x; tot += pv[j][q].y; tot += pv[j][q].z; tot += pv[j][q].w; }
        if (ok[j]) rl[en] = 1.0f / sqrtf(tot * (1.f / DM) + EPS); }
    __syncthreads();
}

constexpr int NPHASE = 12;
__global__ void __launch_bounds__(512, 2) fwd_kernel(Args args) {
    extern __shared__ __attribute__((aligned(16))) unsigned char lds_raw[];
    Frame F; F.lds = (LAS unsigned char*)lds_raw; F.tid = threadIdx.x; F.lane = F.tid & 63; F.wave = __builtin_amdgcn_readfirstlane(F.tid >> 6);
    F.G = gridDim.x; F.bid = blockIdx.x; F.ws = args.ws; F.dry = 0;
    unsigned char* ws = args.ws;
    const int lo = args.ph_lo, hi = args.ph_hi;
#define IN(k) (lo <= (k) && (k) < hi)
    { volatile LAS unsigned* mw = (volatile LAS unsigned*)(F.lds + MISC_OFF); if (F.tid < 16) mw[F.tid] = 0u; }
    __syncthreads();
    const XcdBarrier xbar = xcd_barrier_post((unsigned*)(ws + WS_CTL) + 4096, (volatile LAS unsigned*)(F.lds + MISC_OFF));
    unsigned long long ts_prev = 0ull, ts_acc = 0ull;
    if (PROBE_SPIN) ts_prev = __builtin_amdgcn_s_memrealtime();
#define SEAM(k) do { if (IN(k) && IN((k) + 1)) xcd_barrier(xbar); if (PROBE_SPIN) { const unsigned long long now_ = __builtin_amdgcn_s_memrealtime(); if ((PROBE_SPIN >> (k)) & 1) ts_acc += now_ - ts_prev; ts_prev = now_; } } while (0)
    float* part = (float*)(ws + WS_PART);
    bf16_t* Z = (bf16_t*)(ws + WS_Z);
    bf16_t* HB = (bf16_t*)(ws + WS_R);

#define PHASE(k, ...) if (IN(k)) { { F.dry = 0; __VA_ARGS__ } if ((PROBE_REP >> (k)) & 1) { xcd_barrier(xbar); F.dry = 1; __VA_ARGS__ } }
    PHASE(0, prologue(F, args);)
    SEAM(0);
    PHASE(1,
        { pg8::StaticOrder S; S.init(MTOK, EV_LD, F.G, F.bid); fill_rstd(F, S, part);
          pg8::Gemm g{HB, (const bf16_t*)(ws + WS_W0), MTOK, EV_LD, DM, DM};
          EpiIn E{Z, EV_LD, (const LAS float*)(F.lds + RSTD_OFF), EV_G / 256, -1, nullptr, 0, 0};
          pg8::gemm_phase(F.lds, g, S, E); }
        { pg8::StaticOrder S; S.init(BATCH * NMEM, DM, F.G, F.bid);
          pg8::Gemm g{(const bf16_t*)(ws + WS_MEMN), (const bf16_t*)(ws + WS_WM0), BATCH * NMEM, DM, DM, DM};
          EpiBf E{(bf16_t*)(ws + WS_MKV0), DM};
          pg8::gemm_phase(F.lds, g, S, E); }
    )
    SEAM(1);
    PHASE(2,
        ret_a_phase(F, Z, (const float*)(ws + WS_ROPE), (const float*)(ws + WS_ROPE) + SEQ * 64, (bf16_t*)(ws + WS_R), F.bid, F.G);
        pool_phase(F, Z, (const bf16_t*)(ws + WS_WP), args.in[8], F.bid, F.G);
        mem_attn_phase(F, Z, EV_LD, EV_XQ, EV_G + 1536, (const bf16_t*)(ws + WS_MKV0), F.bid, 256);
    )
    SEAM(2);
    PHASE(3, ret_scan_phase(F, (bf16_t*)(ws + WS_R));)
    SEAM(3);
    PHASE(4, ret_c_phase(F, Z, (const float*)(ws + WS_ROPE), (const float*)(ws + WS_ROPE) + SEQ * 64, (const bf16_t*)(ws + WS_R), F.bid, F.G);)
    SEAM(4);
    PHASE(5,
        pg8::StaticOrder S; S.init(MTOK, DM, F.G, F.bid);
        pg8::Gemm g{Z + EV_G, (const bf16_t*)(ws + WS_WO0), MTOK, DM, DIN, EV_LD};
        EpiOut<true> E{args.in[0], HB, part, F.dry};
        pg8::gemm_phase(F.lds, g, S, E);
    )
    SEAM(5);
    PHASE(6,
        pg8::StaticOrder S; S.init(MTOK, OD_N, F.G, F.bid); fill_rstd(F, S, part);
        pg8::Gemm g{HB, (const bf16_t*)(ws + WS_W1), MTOK, OD_N, DM, DM};
        EpiIn E{Z, OD_LD, (const LAS float*)(F.lds + RSTD_OFF), OD_G / 256, OD_LD / 256, (float*)(ws + WS_GATES), 0, 0};
        pg8::gemm_phase(F.lds, g, S, E);
        { pg8::StaticOrder S2; S2.init(BATCH * NMEM, DM, F.G, (F.bid + 128) % F.G);
          pg8::Gemm g2{(const bf16_t*)(ws + WS_MEMN), (const bf16_t*)(ws + WS_WM1), BATCH * NMEM, DM, DM, DM};
          EpiBf E2{(bf16_t*)(ws + WS_MKV1), DM};
          pg8::gemm_phase(F.lds, g2, S2, E2); }
    )
    SEAM(6);
    PHASE(7,
        if (F.bid < 128) compress_phase(F, Z, (const bf16_t*)(ws + WS_WC1), (const bf16_t*)(ws + WS_WC2), args.in[14], (const float*)(ws + WS_MISC + 65536), (bf16_t*)(ws + WS_KCMP), (bf16_t*)(ws + WS_VCMP), F.bid, 128);
        else mem_attn_phase(F, Z, OD_LD, OD_XQ, OD_G + 1536, (const bf16_t*)(ws + WS_MKV1), F.bid - 128, 128);
    )
    SEAM(7);
    PHASE(8, nsa_phase(F, Z, (const float*)(ws + WS_GATES), (const bf16_t*)(ws + WS_KCMP), (const bf16_t*)(ws + WS_VCMP), (const float*)(ws + WS_MISC), (bf16_t*)args.out, ts_acc);)
    SEAM(8);
    PHASE(10,
        pg8::StaticOrder S; S.init(MTOK, DM, F.G, F.bid);
        pg8::Gemm g{Z + OD_G, (const bf16_t*)(ws + WS_WO1), MTOK, DM, DIN, OD_LD};
        EpiFinal E{HB, args.out, part, args.in[3], (unsigned*)(ws + WS_CTL) + 16384, xbar.bar};
        pg8::gemm_phase(F.lds, g, S, E);
    )
#undef PHASE
    if (PROBE_SPIN) { const unsigned long long now_ = __builtin_amdgcn_s_memrealtime(); if ((PROBE_SPIN >> 11) & 1) ts_acc += now_ - ts_prev;
        if (F.bid == 0) { const unsigned long long t0_ = __builtin_amdgcn_s_memrealtime(); while (__builtin_amdgcn_s_memrealtime() - t0_ < ts_acc) __builtin_amdgcn_s_sleep(8); } }
#undef IN
#undef SEAM
}

extern "C" void kernel_launch(void* const* d_in, const int* in_sizes, int n_in, void* d_out, int out_size, void* d_ws, size_t ws_size, hipStream_t stream) {
    static int grid = 0;
    if (grid == 0) {
        if (n_in != 18 || out_size != MTOK * DM || ws_size < WS_END) { fprintf(stderr, "kernel_launch: unexpected shapes: n_in %d out %d ws %zu (need %zu)\n", n_in, out_size, ws_size, (size_t)WS_END); grid = -1; return; }
        int dev = 0, cus = 0, per_cu = 0;
        hipGetDevice(&dev); hipDeviceGetAttribute(&cus, hipDeviceAttributeMultiprocessorCount, dev);
        if (hipFuncSetAttribute((const void*)fwd_kernel, hipFuncAttributeMaxDynamicSharedMemorySize, LDS_BYTES) != hipSuccess) { fprintf(stderr, "kernel_launch: hipFuncSetAttribute failed\n"); grid = -1; return; }
        if (hipOccupancyMaxActiveBlocksPerMultiprocessor(&per_cu, (const void*)fwd_kernel, 512, LDS_BYTES) != hipSuccess || per_cu < 1) { fprintf(stderr, "kernel_launch: occupancy query says %d\n", per_cu); per_cu = 1; }
        (void)hipGetLastError();
        grid = cus;
    }
    if (grid < 0) return;
    if (hipMemsetAsync((char*)d_ws + WS_CTL, 0, CTL_BYTES, stream) != hipSuccess) { fprintf(stderr, "kernel_launch: memset failed\n"); return; }
    Args a{};
    for (int i = 0; i < 18; ++i) a.in[i] = (const float*)d_in[i];
    a.out = (float*)d_out; a.ws = (unsigned char*)d_ws; a.ph_lo = 0; a.ph_hi = NPHASE;
    void* kargs[] = {&a};
    hipError_t e = hipLaunchCooperativeKernel((const void*)fwd_kernel, dim3(grid), dim3(512), kargs, LDS_BYTES, stream);
    if (e != hipSuccess) fprintf(stderr, "kernel_launch: cooperative launch failed: %s (grid %d)\n", hipGetErrorString(e), grid);
}
```

```cpp
#include <hip/hip_runtime.h>
#include <hip/hip_cooperative_groups.h>
#include <cstdio>
#include <cstdint>
namespace cg = cooperative_groups;

#define LAS __attribute__((address_space(3)))
#define GAS __attribute__((address_space(1)))
typedef unsigned short bf16_t;
typedef short bf16x8 __attribute__((ext_vector_type(8)));
typedef short s16x4 __attribute__((ext_vector_type(4)));
typedef float f32x4 __attribute__((ext_vector_type(4)));
typedef float f32x16 __attribute__((ext_vector_type(16)));
typedef unsigned u32x4 __attribute__((ext_vector_type(4)));
typedef unsigned u32x2 __attribute__((ext_vector_type(2)));

#ifndef PROBE_REP
#define PROBE_REP 0
#endif
#ifndef PROBE_SPIN
#define PROBE_SPIN 0
#endif
#ifndef PROBE_VARIANT
#define PROBE_VARIANT 0
#endif
constexpr int BATCH = 8, SEQ = 4096, DM = 1024, MTOK = BATCH * SEQ, NMEM = 256, DIN = 2048;
constexpr float EPS = 1e-6f;
constexpr float LOG2E = 1.4426950408889634f;
constexpr int EV_LD = 5120, EV_ZA = 0, EV_RQ = 768, EV_RK = 1280, EV_RV = 1792, EV_XQ = 2560, EV_G = 3072;
constexpr int OD_LD = 5632, OD_N = 5888, OD_COLS = 5668, OD_Q = 0, OD_KC = 1536, OD_VC = 1792, OD_KS = 2048, OD_VS = 2304, OD_KW = 2560, OD_VW = 2816, OD_XQ = 3072, OD_G = 3584;
constexpr int GATE_LD = 40;
constexpr size_t MiB = 1u << 20;
constexpr size_t WS_CTL = 0, CTL_BYTES = 1 * MiB;
constexpr size_t WS_W0 = 1 * MiB;
constexpr size_t WS_W1 = WS_W0 + (size_t)EV_LD * DM * 2;
constexpr size_t WS_WO0 = WS_W1 + (size_t)OD_N * DM * 2;
constexpr size_t WS_WO1 = WS_WO0 + (size_t)DM * DIN * 2;
constexpr size_t WS_WM0 = WS_WO1 + (size_t)DM * DIN * 2;
constexpr size_t WS_WM1 = WS_WM0 + (size_t)DM * DM * 2;
constexpr size_t WS_WC1 = WS_WM1 + (size_t)DM * DM * 2;
constexpr size_t WS_WC2 = WS_WC1 + (size_t)2 * 256 * 4096 * 2;
constexpr size_t WS_WP = WS_WC2 + (size_t)2 * 128 * 256 * 2;
constexpr size_t WS_WEND = WS_WP + (size_t)4 * 192 * 192 * 2;
static_assert(WS_WEND <= 41 * MiB, "weights");
constexpr size_t WS_MEMN = 41 * MiB, WS_MKV0 = 45 * MiB, WS_MKV1 = 49 * MiB;
constexpr size_t WS_ROPE = 53 * MiB;
constexpr size_t WS_PART = 55 * MiB;
constexpr size_t WS_MISC = 57 * MiB;
constexpr size_t WS_Z = 58 * MiB;
constexpr size_t WS_R = 410 * MiB;
constexpr size_t WS_GATES = WS_R + 64 * MiB;
constexpr size_t WS_KCMP = WS_R + 70 * MiB, WS_VCMP = WS_R + 71 * MiB;
constexpr size_t WS_END = 506 * MiB;

constexpr int RING_BYTES = 131072, RSTD_OFF = RING_BYTES, RSTD_BYTES = 12 * 1024, LDS_BYTES = 163840, MISC_OFF = LDS_BYTES - 256;

__device__ __forceinline__ unsigned f2bf(float f) { unsigned u = __builtin_bit_cast(unsigned, f); return (u + 0x7fffu + ((u >> 16) & 1u)) >> 16; }
__device__ __forceinline__ unsigned pk2(float lo, float hi) { return f2bf(lo) | (f2bf(hi) << 16); }
__device__ __forceinline__ float bf2f(unsigned short b) { return __builtin_bit_cast(float, (unsigned)b << 16); }
typedef float f32x2_t __attribute__((ext_vector_type(2))); typedef __bf16 bf16x2_t __attribute__((ext_vector_type(2)));
__device__ __forceinline__ unsigned cvt_pk_bf16(float lo, float hi) { f32x2_t v = {lo, hi}; bf16x2_t b = __builtin_convertvector(v, bf16x2_t); return __builtin_bit_cast(unsigned, b); }
__device__ __forceinline__ float wave_sum(float v) {
#pragma unroll
    for (int o = 1; o < 64; o <<= 1) v += __shfl_xor(v, o);
    return v;
}
__device__ __forceinline__ float fast_sigmoid(float v) { return __builtin_amdgcn_rcpf(1.f + __builtin_amdgcn_exp2f(-v * LOG2E)); }
#define LDS_WAIT() asm volatile("s_waitcnt lgkmcnt(0)" ::: "memory")
#define VM_WAIT() asm volatile("s_waitcnt vmcnt(0)" ::: "memory")

#define XB_TMO      128
#define XB_XCNT(j)  (256  + 64 * (j))
#define XB_XSUB(j)  (1280 + 64 * (j))
#define XB_XGEN(j)  (2304 + 64 * (j))
#define XB_TOP      3328
#define XB_TOPGEN   3392
#define XCD_BAR_WORDS 3456
#define XB_SPIN_CAP (1u << 18)
__device__ __forceinline__ unsigned xb_ld(unsigned* p)              { return __hip_atomic_load(p, __ATOMIC_RELAXED, __HIP_MEMORY_SCOPE_AGENT); }
__device__ __forceinline__ unsigned xb_add(unsigned* p, unsigned v) { return __hip_atomic_fetch_add(p, v, __ATOMIC_RELAXED, __HIP_MEMORY_SCOPE_AGENT); }
__device__ __forceinline__ unsigned xb_xcc_id() { return (unsigned)__builtin_amdgcn_s_getreg((3 << 11) | 20) & 0xFu; }
#define XB_SPIN(cond, bar) do { unsigned _sp = 0; while (cond) { __builtin_amdgcn_s_sleep(1); \
    if ((++_sp & 255u) == 0u) { if (xb_ld(&(bar)[XB_TMO])) break; if (_sp > XB_SPIN_CAP) { atomicAdd(&(bar)[XB_TMO], 1u); break; } } } } while (0)
struct XcdBarrier { unsigned* bar; unsigned x; volatile LAS unsigned* st; };
__device__ __forceinline__ XcdBarrier xcd_barrier_post(unsigned* bar, volatile LAS unsigned* st) {
    XcdBarrier b; b.bar = bar; b.x = xb_xcc_id(); b.st = st;
    if (threadIdx.x == 0) (void)xb_add(&bar[XB_XCNT(b.x)], 1u);
    return b;
}
__device__ __forceinline__ void xcd_barrier_complete(unsigned* bar, unsigned x, unsigned& nloc, unsigned& nx) {
    const unsigned G = gridDim.x * gridDim.y * gridDim.z;
    unsigned sum, cnt, mine, sp = 0u;
    for (;;) {
        sum = 0u; cnt = 0u; mine = 0u;
#pragma unroll
        for (unsigned j = 0; j < 16; ++j) { const unsigned c = xb_ld(&bar[XB_XCNT(j)]); sum += c; cnt += (c > 0u) ? 1u : 0u; mine = (j == x) ? c : mine; }
        if (sum == G) break;
        __builtin_amdgcn_s_sleep(1);
        if ((++sp & 255u) == 0u) { if (xb_ld(&bar[XB_TMO])) break; if (sp > XB_SPIN_CAP) { atomicAdd(&bar[XB_TMO], 1u); break; } }
    }
    nloc = mine > 0u ? mine : 1u; nx = cnt > 0u ? cnt : 1u;
}
__device__ __forceinline__ void xcd_barrier(const XcdBarrier& b) {
    asm volatile("s_waitcnt vmcnt(0)" ::: "memory");
    __syncthreads();
    if (threadIdx.x == 0) {
        unsigned* bar = b.bar;
        __builtin_amdgcn_s_waitcnt(0);
        unsigned nloc = b.st[0], nx = b.st[1];
        if (nloc == 0u) { xcd_barrier_complete(bar, b.x, nloc, nx); b.st[0] = nloc; b.st[1] = nx; }
        const unsigned old = xb_add(&bar[XB_XSUB(b.x)], 1u);
        const unsigned gen = old / nloc;
        if (old + 1u == (gen + 1u) * nloc) {
            __builtin_amdgcn_fence(__ATOMIC_RELEASE, "agent");
            asm volatile("s_waitcnt vmcnt(0)" ::: "memory");
            const unsigned og = xb_add(&bar[XB_TOP], 1u);
            const unsigned tg = og / nx;
            if (og + 1u == (tg + 1u) * nx) xb_add(&bar[XB_TOPGEN], 1u);
            else XB_SPIN(xb_ld(&bar[XB_TOPGEN]) == tg, bar);
            __builtin_amdgcn_fence(__ATOMIC_ACQUIRE, "agent");
            xb_add(&bar[XB_XGEN(b.x)], 1u);
            asm volatile("s_waitcnt vmcnt(0)" ::: "memory");
        } else {
            XB_SPIN(xb_ld(&bar[XB_XGEN(b.x)]) == gen, bar);
            __builtin_amdgcn_fence(__ATOMIC_ACQUIRE, "agent");
            asm volatile("s_waitcnt vmcnt(0)" ::: "memory");
        }
    }
    __syncthreads();
}

namespace pg8 {
constexpr int BM = 256, BK = 64, HALF = 128, HTB = HALF * BK * 2, STAGE_BYTES = 8 * HTB, NXCD = 8, WGM = 8;
__host__ __device__ __forceinline__ int lds_byte(int r, int c) { const int st = (r >> 4) * 2 + (c >> 5), rr = r & 15, cc = c & 31, ob = rr * 64 + cc * 2; return st * 1024 + (ob ^ (((ob >> 9) & 1) << 5)); }
__host__ __device__ __forceinline__ void stage_rc(int b, int& R, int& C) { const int st = b / 1024, sb = b % 1024, swz = sb ^ (((sb >> 9) & 1) << 5); R = (st >> 1) * 16 + swz / 64; C = (st & 1) * 32 + (swz % 64) / 2; }
__host__ __device__ __forceinline__ int perm32(int rho) { const int n = rho >> 4, i = rho & 15; return 8 * (i >> 2) + 4 * n + (i & 3); }
struct Unit { int pm, pn, idx; };
struct Gemm { const bf16_t* A; const bf16_t* Bt; int M, N, K, lda; };
struct StaticOrder {
    int nM, nN, nwg, G, c;
    __device__ void init(int M, int N, int G_, int c_) { nM = M / BM; nN = N / BM; nwg = nM * nN; G = G_; c = c_; }
    __device__ bool next(int i, Unit& u) const {
        const long L = (long)i * G + c; if (L >= nwg) return false;
        int wgid = (int)L; { const int q = nwg / NXCD, r = nwg % NXCD, xcd = wgid % NXCD, off = wgid / NXCD; wgid = (xcd < r ? xcd * (q + 1) : r * (q + 1) + (xcd - r) * q) + off; }
        const int nig = WGM * nN, gid = wgid / nig, fm = gid * WGM, gsz = (nM - fm) < WGM ? (nM - fm) : WGM;
        u.pm = fm + ((wgid % nig) % gsz); u.pn = (wgid % nig) / gsz; u.idx = i; return true;
    }
};
template <class Epi>
__device__ __forceinline__ void gemm_phase(LAS unsigned char* lds, const Gemm g, const StaticOrder& S, const Epi& E) {
    const int tid = threadIdx.x, wid = __builtin_amdgcn_readfirstlane(tid >> 6), lane = tid & 63, wr = wid >> 2, wc = wid & 3, fr = lane & 15, fq = lane >> 4;
    const int K = g.K, nt = K / BK, lda = g.lda;
    unsigned voffA[2], voffB[2];
#pragma unroll
    for (int i = 0; i < 2; ++i) { int R, C; stage_rc(tid * 16 + i * 8192, R, C); const int Rb = (R & ~31) + perm32(R & 31);
        voffA[i] = (unsigned)(R * lda + C) * 2u; voffB[i] = (unsigned)(Rb * K + C) * 2u; }
    const size_t kstep = (size_t)(BK * 2);
    const size_t hstepA = (size_t)HALF * lda * 2, hstepB = (size_t)HALF * K * 2;
    const size_t tstepA = 2 * hstepA, tstepB = 2 * hstepB;
    const unsigned ldsw = (unsigned)wid * 1024u;
    const int aoff = lds_byte(wr * 64 + fr, fq * 8), boff = lds_byte(wc * 32 + fr, fq * 8);
#define PG8_SA(b, h) (((b) * 2 + (h)) * HTB)
#define PG8_SB(b, h) ((4 + (b) * 2 + (h)) * HTB)
#define PG8_STAGE(bufoff, gbase, voff) do { _Pragma("unroll") for (int _i = 0; _i < 2; ++_i) \
        __builtin_amdgcn_global_load_lds((const unsigned*)((const char*)(gbase) + (voff)[_i]), (LAS unsigned*)(lds + (bufoff) + ldsw + _i * 8192), 16, 0, 0); } while (0)
#define PG8_LDA(dst, b, h) do { _Pragma("unroll") for (int m = 0; m < 4; ++m) _Pragma("unroll") for (int k = 0; k < 2; ++k) dst[m][k] = *(const LAS bf16x8*)(lds + PG8_SA(b, h) + aoff + m * 2048 + k * 1024); } while (0)
#define PG8_LDB(dst, b, h) do { _Pragma("unroll") for (int n = 0; n < 2; ++n) _Pragma("unroll") for (int k = 0; k < 2; ++k) dst[n][k] = *(const LAS bf16x8*)(lds + PG8_SB(b, h) + boff + n * 2048 + k * 1024); } while (0)
#define PG8_MMA(ai, bj, At, Bt) do { __builtin_amdgcn_s_setprio(1); _Pragma("unroll") for (int m = 0; m < 4; ++m) _Pragma("unroll") for (int n = 0; n < 2; ++n) _Pragma("unroll") for (int k = 0; k < 2; ++k) \
        acc[ai][bj][m][n] = __builtin_amdgcn_mfma_f32_16x16x32_bf16(Bt[n][k], At[m][k], acc[ai][bj][m][n], 0, 0, 0); __builtin_amdgcn_s_setprio(0); } while (0)
#define PG8_WAIT_V(n) asm volatile("s_waitcnt vmcnt(" #n ")" ::: "memory")
#define PG8_WAIT_L(n) asm volatile("s_waitcnt lgkmcnt(" #n ")" ::: "memory")
#define PG8_BAR __builtin_amdgcn_s_barrier()
#define PG8_SCHED __builtin_amdgcn_sched_barrier(0)
    Unit cur, nxt; int ui = 0;
    if (!S.next(0, cur)) return;
    f32x4 acc[2][2][4][2];
#pragma unroll
    for (int a = 0; a < 2; ++a)
#pragma unroll
        for (int b = 0; b < 2; ++b)
#pragma unroll
            for (int m = 0; m < 4; ++m)
#pragma unroll
                for (int n = 0; n < 2; ++n) acc[a][b][m][n] = (f32x4){0.f, 0.f, 0.f, 0.f};
    bf16x8 At[4][2], B0[2][2], B1[2][2];
    const char* cA = (const char*)g.A + (size_t)cur.pm * tstepA; const char* cB = (const char*)g.Bt + (size_t)cur.pn * tstepB;
    PG8_STAGE(PG8_SB(0, 0), cB, voffB); PG8_STAGE(PG8_SB(0, 1), cB + hstepB, voffB); PG8_STAGE(PG8_SA(0, 0), cA, voffA); PG8_STAGE(PG8_SA(0, 1), cA + hstepA, voffA);
    if (wr == 1) PG8_BAR;
    PG8_WAIT_V(2); PG8_BAR;
    PG8_STAGE(PG8_SB(1, 0), cB + kstep, voffB); PG8_STAGE(PG8_SA(1, 0), cA + kstep, voffA); PG8_STAGE(PG8_SB(1, 1), cB + hstepB + kstep, voffB);
    PG8_WAIT_V(6); PG8_BAR;
    for (;;) {
        const bool has_next = S.next(ui + 1, nxt);
        const char* nA = has_next ? (const char*)g.A + (size_t)nxt.pm * tstepA : cA; const char* nB = has_next ? (const char*)g.Bt + (size_t)nxt.pn * tstepB : cB;
        for (int t = 0; t < nt; t += 2) {
            const bool last = (t == nt - 2);
            const char* a1 = cA + (size_t)(t + 1) * kstep;
            const char* a2 = last ? nA : cA + (size_t)(t + 2) * kstep; const char* b2 = last ? nB : cB + (size_t)(t + 2) * kstep;
            const char* a3 = a2 + kstep; const char* b3 = b2 + kstep;
            PG8_LDB(B0, 0, 0); PG8_LDB(B1, 0, 1); PG8_SCHED; PG8_LDA(At, 0, 0); PG8_STAGE(PG8_SA(1, 1), a1 + hstepA, voffA);
            PG8_WAIT_V(8); PG8_WAIT_L(0); PG8_BAR; PG8_MMA(0, 0, At, B0); PG8_MMA(0, 1, At, B1); PG8_BAR; PG8_SCHED;
            PG8_LDA(At, 0, 1); PG8_STAGE(PG8_SB(0, 0), b2, voffB); PG8_STAGE(PG8_SB(0, 1), b2 + hstepB, voffB); PG8_STAGE(PG8_SA(0, 0), a2, voffA);
            PG8_WAIT_V(8); PG8_WAIT_L(0); PG8_BAR; PG8_MMA(1, 0, At, B0); PG8_MMA(1, 1, At, B1); PG8_BAR; PG8_SCHED;
            PG8_LDB(B0, 1, 0); PG8_LDB(B1, 1, 1); PG8_SCHED; PG8_LDA(At, 1, 0); PG8_STAGE(PG8_SA(0, 1), a2 + hstepA, voffA);
            PG8_WAIT_V(8); PG8_WAIT_L(0); PG8_BAR; PG8_MMA(0, 0, At, B0); PG8_MMA(0, 1, At, B1); PG8_BAR; PG8_SCHED;
            PG8_LDA(At, 1, 1); PG8_STAGE(PG8_SB(1, 0), b3, voffB); PG8_STAGE(PG8_SB(1, 1), b3 + hstepB, voffB); PG8_STAGE(PG8_SA(1, 0), a3, voffA);
            PG8_WAIT_V(8); PG8_WAIT_L(0); PG8_BAR; PG8_MMA(1, 0, At, B0); PG8_MMA(1, 1, At, B1); PG8_BAR; PG8_SCHED;
        }
        if (wr == 0) PG8_BAR;
        E(acc, cur, wr, wc, fr, fq);
        if (!has_next) break;
#pragma unroll
        for (int a = 0; a < 2; ++a)
#pragma unroll
            for (int b = 0; b < 2; ++b)
#pragma unroll
                for (int m = 0; m < 4; ++m)
#pragma unroll
                    for (int n = 0; n < 2; ++n) acc[a][b][m][n] = (f32x4){0.f, 0.f, 0.f, 0.f};
        cur = nxt; cA = nA; cB = nB; ++ui;
        if (wr == 1) PG8_BAR;
    }
    PG8_WAIT_V(0);
    PG8_BAR;
#undef PG8_SA
#undef PG8_SB
#undef PG8_STAGE
#undef PG8_LDA
#undef PG8_LDB
#undef PG8_MMA
#undef PG8_WAIT_V
#undef PG8_WAIT_L
#undef PG8_BAR
#undef PG8_SCHED
}
}

struct EpiIn {
    bf16_t* Z; int ldz; const LAS float* rstd; int pn_silu, pn_gate; float* gates; int zlo, zhi;
    __device__ __forceinline__ void operator()(const f32x4 (&acc)[2][2][4][2], const pg8::Unit& u, int wr, int wc, int fr, int fq) const {
        const int rl0 = wr * 64 + fr, col0 = u.pn * 256 + wc * 32 + 8 * fq;
        const bool is_gate = (u.pn == pn_gate), is_silu = (u.pn >= pn_silu) && !is_gate;
#pragma unroll
        for (int ai = 0; ai < 2; ++ai)
#pragma unroll
            for (int m = 0; m < 4; ++m) {
                const int rl = rl0 + ai * 128 + m * 16; const float rs = rstd[u.idx * 256 + rl]; const size_t row = (size_t)u.pm * 256 + rl;
#pragma unroll
                for (int bj = 0; bj < 2; ++bj) {
                    f32x4 v0 = acc[ai][bj][m][0] * rs, v1 = acc[ai][bj][m][1] * rs;
                    if (is_gate) {
                        const int c = wc * 32 + 8 * fq + bj * 128;
                        if (c < 36) { float* gp = gates + row * GATE_LD + c;
#pragma unroll
                            for (int j = 0; j < 4; ++j) { gp[j] = fast_sigmoid(v0[j]); if (c + 4 + j < 36) gp[4 + j] = fast_sigmoid(v1[j]); } }
                    } else {
                        if (is_silu) {
#pragma unroll
                            for (int j = 0; j < 4; ++j) { v0[j] = v0[j] * fast_sigmoid(v0[j]); v1[j] = v1[j] * fast_sigmoid(v1[j]); }
                            if (u.pn >= zlo && u.pn < zhi) { v0 = (f32x4){0.f, 0.f, 0.f, 0.f}; v1 = v0; }
                        }
                        u32x4 w; w.x = cvt_pk_bf16(v0[0], v0[1]); w.y = cvt_pk_bf16(v0[2], v0[3]); w.z = cvt_pk_bf16(v1[0], v1[1]); w.w = cvt_pk_bf16(v1[2], v1[3]);
                        *(u32x4*)(Z + row * ldz + col0 + bj * 128) = w;
                    }
                }
            }
    }
};
struct EpiBf {
    bf16_t* O; int ldc;
    __device__ __forceinline__ void operator()(const f32x4 (&acc)[2][2][4][2], const pg8::Unit& u, int wr, int wc, int fr, int fq) const {
        const int row0 = u.pm * 256 + wr * 64 + fr, col0 = u.pn * 256 + wc * 32 + 8 * fq;
#pragma unroll
        for (int ai = 0; ai < 2; ++ai)
#pragma unroll
            for (int m = 0; m < 4; ++m)
#pragma unroll
                for (int bj = 0; bj < 2; ++bj) {
                    const f32x4 v0 = acc[ai][bj][m][0], v1 = acc[ai][bj][m][1];
                    u32x4 w; w.x = cvt_pk_bf16(v0[0], v0[1]); w.y = cvt_pk_bf16(v0[2], v0[3]); w.z = cvt_pk_bf16(v1[0], v1[1]); w.w = cvt_pk_bf16(v1[2], v1[3]);
                    *(u32x4*)(O + (size_t)(row0 + ai * 128 + m * 16) * ldc + col0 + bj * 128) = w;
                }
    }
};
template <bool BASE_F32> struct EpiOut {
    const float* base; bf16_t* hb; float* part; int dry;
    __device__ __forceinline__ void operator()(const f32x4 (&acc)[2][2][4][2], const pg8::Unit& u, int wr, int wc, int fr, int fq) const {
        const int row0 = u.pm * 256 + wr * 64 + fr, col0 = u.pn * 256 + wc * 32 + 8 * fq;
#pragma unroll
        for (int ai = 0; ai < 2; ++ai) {
            f32x4 bv[4][2][2]; u32x4 hv[4][2];
#pragma unroll
            for (int m = 0; m < 4; ++m)
#pragma unroll
                for (int bj = 0; bj < 2; ++bj) { const size_t off = (size_t)(row0 + ai * 128 + m * 16) * DM + col0 + bj * 128;
                    if (BASE_F32) { bv[m][bj][0] = *(const f32x4*)(base + off); bv[m][bj][1] = *(const f32x4*)(base + off + 4); } else hv[m][bj] = *(const u32x4*)(hb + off); }
#pragma unroll
            for (int m = 0; m < 4; ++m) {
                const size_t row = (size_t)(row0 + ai * 128 + m * 16); float ss = 0.f;
#pragma unroll
                for (int bj = 0; bj < 2; ++bj) {
                    const size_t off = row * DM + col0 + bj * 128;
                    f32x4 b0, b1;
                    if (BASE_F32) { b0 = bv[m][bj][0]; b1 = bv[m][bj][1]; }
                    else { const u32x4 hw = hv[m][bj];
                        b0 = (f32x4){__builtin_bit_cast(float, hw.x << 16), __builtin_bit_cast(float, hw.x & 0xffff0000u), __builtin_bit_cast(float, hw.y << 16), __builtin_bit_cast(float, hw.y & 0xffff0000u)};
                        b1 = (f32x4){__builtin_bit_cast(float, hw.z << 16), __builtin_bit_cast(float, hw.z & 0xffff0000u), __builtin_bit_cast(float, hw.w << 16), __builtin_bit_cast(float, hw.w & 0xffff0000u)}; }
                    const f32x4 v0 = acc[ai][bj][m][0] + b0, v1 = acc[ai][bj][m][1] + b1;
                    u32x4 w; w.x = cvt_pk_bf16(v0[0], v0[1]); w.y = cvt_pk_bf16(v0[2], v0[3]); w.z = cvt_pk_bf16(v1[0], v1[1]); w.w = cvt_pk_bf16(v1[2], v1[3]);
                    if (!dry) *(u32x4*)(hb + off) = w;
                    ss += (v0[0] * v0[0] + v0[1] * v0[1]) + (v0[2] * v0[2] + v0[3] * v0[3]) + (v1[0] * v1[0] + v1[1] * v1[1]) + (v1[2] * v1[2] + v1[3] * v1[3]);
                }
                ss += __shfl_xor(ss, 16); ss += __shfl_xor(ss, 32);
                if (fq == 0 && !dry) part[row * 16 + u.pn * 4 + wc] = ss;
            }
        }
    }
};
struct EpiFinal {
    const bf16_t* hb; float* out; float* part; const float* fg; unsigned* flags; unsigned* bar;
    __device__ __forceinline__ void operator()(f32x4 (&acc)[2][2][4][2], const pg8::Unit& u, int wr, int wc, int fr, int fq) const {
        const int row0 = u.pm * 256 + wr * 64 + fr, col0 = u.pn * 256 + wc * 32 + 8 * fq;
        u32x4 hwv[2][4][2];
#pragma unroll
        for (int ai = 0; ai < 2; ++ai)
#pragma unroll
            for (int m = 0; m < 4; ++m)
#pragma unroll
                for (int bj = 0; bj < 2; ++bj) hwv[ai][m][bj] = *(const u32x4*)(hb + (size_t)(row0 + ai * 128 + m * 16) * DM + col0 + bj * 128);
#pragma unroll
        for (int ai = 0; ai < 2; ++ai)
#pragma unroll
            for (int m = 0; m < 4; ++m) {
                const size_t row = (size_t)(row0 + ai * 128 + m * 16); float ss = 0.f;
#pragma unroll
                for (int bj = 0; bj < 2; ++bj) {
                    const u32x4 hw = hwv[ai][m][bj];
                    const f32x4 b0 = {__builtin_bit_cast(float, hw.x << 16), __builtin_bit_cast(float, hw.x & 0xffff0000u), __builtin_bit_cast(float, hw.y << 16), __builtin_bit_cast(float, hw.y & 0xffff0000u)};
                    const f32x4 b1 = {__builtin_bit_cast(float, hw.z << 16), __builtin_bit_cast(float, hw.z & 0xffff0000u), __builtin_bit_cast(float, hw.w << 16), __builtin_bit_cast(float, hw.w & 0xffff0000u)};
                    const f32x4 v0 = acc[ai][bj][m][0] + b0, v1 = acc[ai][bj][m][1] + b1;
                    acc[ai][bj][m][0] = v0; acc[ai][bj][m][1] = v1;
                    ss += (v0[0] * v0[0] + v0[1] * v0[1]) + (v0[2] * v0[2] + v0[3] * v0[3]) + (v1[0] * v1[0] + v1[1] * v1[1]) + (v1[2] * v1[2] + v1[3] * v1[3]);
                }
                ss += __shfl_xor(ss, 16); ss += __shfl_xor(ss, 32);
                if (fq == 0) __hip_atomic_store(part + row * 16 + u.pn * 4 + wc, ss, __ATOMIC_RELAXED, __HIP_MEMORY_SCOPE_AGENT);
            }
        unsigned* fl = flags + (u.pm * 2 + wr) * 16;
        asm volatile("s_waitcnt vmcnt(0)" ::: "memory");
        if (fr == 0 && fq == 0) (void)xb_add(fl, 1u);
        XB_SPIN(xb_ld(fl) < 16u, bar);
        asm volatile("" ::: "memory");
        float t0, t1;
        { const float* pa = part + (size_t)(u.pm * 256 + wr * 64 + fr + 16 * fq) * 16; const float* pb = pa + (size_t)128 * 16;
          f32x4 a0, a1, a2, a3, b0, b1, b2, b3;
          asm volatile("global_load_dwordx4 %0, %1, off sc1" : "=v"(a0) : "v"(pa) : "memory");
          asm volatile("global_load_dwordx4 %0, %1, off offset:16 sc1" : "=v"(a1) : "v"(pa) : "memory");
          asm volatile("global_load_dwordx4 %0, %1, off offset:32 sc1" : "=v"(a2) : "v"(pa) : "memory");
          asm volatile("global_load_dwordx4 %0, %1, off offset:48 sc1" : "=v"(a3) : "v"(pa) : "memory");
          asm volatile("global_load_dwordx4 %0, %1, off sc1" : "=v"(b0) : "v"(pb) : "memory");
          asm volatile("global_load_dwordx4 %0, %1, off offset:16 sc1" : "=v"(b1) : "v"(pb) : "memory");
          asm volatile("global_load_dwordx4 %0, %1, off offset:32 sc1" : "=v"(b2) : "v"(pb) : "memory");
          asm volatile("global_load_dwordx4 %0, %1, off offset:48 sc1" : "=v"(b3) : "v"(pb) : "memory");
          asm volatile("s_waitcnt vmcnt(0)" : "+v"(a0), "+v"(a1), "+v"(a2), "+v"(a3), "+v"(b0), "+v"(b1), "+v"(b2), "+v"(b3) :: "memory");
          t0 = 0.f; t1 = 0.f;
#pragma unroll
          for (int j = 0; j < 4; ++j) t0 += a0[j];
#pragma unroll
          for (int j = 0; j < 4; ++j) t0 += a1[j];
#pragma unroll
          for (int j = 0; j < 4; ++j) t0 += a2[j];
#pragma unroll
          for (int j = 0; j < 4; ++j) t0 += a3[j];
#pragma unroll
          for (int j = 0; j < 4; ++j) t1 += b0[j];
#pragma unroll
          for (int j = 0; j < 4; ++j) t1 += b1[j];
#pragma unroll
          for (int j = 0; j < 4; ++j) t1 += b2[j];
#pragma unroll
          for (int j = 0; j < 4; ++j) t1 += b3[j]; }
#pragma unroll
        for (int ai = 0; ai < 2; ++ai)
#pragma unroll
            for (int m = 0; m < 4; ++m) {
                const size_t row = (size_t)(row0 + ai * 128 + m * 16);
                const float tot = __shfl(ai ? t1 : t0, m * 16 + fr);
                const float rs = 1.0f / sqrtf(tot * (1.f / DM) + EPS);
#pragma unroll
                for (int bj = 0; bj < 2; ++bj) {
                    const size_t off = row * DM + col0 + bj * 128;
                    const f32x4 g0 = *(const f32x4*)(fg + col0 + bj * 128), g1 = *(const f32x4*)(fg + col0 + bj * 128 + 4);
                    *(f32x4*)(out + off) = acc[ai][bj][m][0] * rs * g0; *(f32x4*)(out + off + 4) = acc[ai][bj][m][1] * rs * g1;
                }
            }
    }
};

struct Args { const float* in[18]; float* out; unsigned char* ws; int ph_lo, ph_hi; };
struct Frame {
    LAS unsigned char* lds; int tid, lane, wave, G, bid;
    unsigned char* ws; int dry;
};
#define KSWZ(row, colB) ((row) * 256 + ((colB) ^ (((row) & 15) << 4)))
#define SBAR() __builtin_amdgcn_sched_barrier(0)
__device__ __forceinline__ int crow(int r, int hi) { return (r & 3) + 8 * (r >> 2) + 4 * hi; }
template <int NCB> __device__ __forceinline__ int v_st(int k, int c) { const int kk = (k & ~0xC) | ((k & 4) << 1) | ((k & 8) >> 1); return ((kk >> 3) * NCB + (c >> 5)) * 512 + ((kk & 7) * 32 + (c & 31)) * 2; }
__device__ __forceinline__ int v_rd_base(int lane) { return ((lane & 3) << 3) | (((lane >> 2) & 3) << 6) | (((lane >> 4) & 1) << 5) | (((lane >> 5) & 1) << 8); }
template <int OFF> __device__ __forceinline__ s16x4 tr_read(int vb) { s16x4 r; asm volatile("ds_read_b64_tr_b16 %0, %1 offset:%2" : "=&v"(r) : "v"(vb), "i"(OFF) : "memory"); return r; }
__device__ __forceinline__ int lds_addr(const LAS void* p) { return (int)(unsigned)(size_t)p; }
__device__ __forceinline__ void qkt(f32x16& p0, f32x16& p1, const LAS char* Ks, const bf16x8* qr, int r32, int hi) {
    p0 = f32x16{}; p1 = f32x16{};
#pragma unroll
    for (int d0 = 0; d0 < 8; ++d0) { const int cb = (d0 * 16 + hi * 8) * 2;
        const bf16x8 b0 = *(const LAS bf16x8*)(Ks + KSWZ(r32, cb));
        const bf16x8 b1 = *(const LAS bf16x8*)(Ks + KSWZ(32 + r32, cb));
        p0 = __builtin_amdgcn_mfma_f32_32x32x16_bf16(b0, qr[d0], p0, 0, 0, 0);
        p1 = __builtin_amdgcn_mfma_f32_32x32x16_bf16(b1, qr[d0], p1, 0, 0, 0); }
}
__device__ __forceinline__ void qkt_lq(f32x16& p0, f32x16& p1, const LAS char* Ks, const LAS char* ql, int r32, int hi) {
    p0 = f32x16{}; p1 = f32x16{};
#pragma unroll
    for (int d0 = 0; d0 < 8; ++d0) { const int cb = (d0 * 16 + hi * 8) * 2;
        const bf16x8 q = *(const LAS bf16x8*)(ql + d0 * 1024);
        const bf16x8 b0 = *(const LAS bf16x8*)(Ks + KSWZ(r32, cb));
        const bf16x8 b1 = *(const LAS bf16x8*)(Ks + KSWZ(32 + r32, cb));
        p0 = __builtin_amdgcn_mfma_f32_32x32x16_bf16(b0, q, p0, 0, 0, 0);
        p1 = __builtin_amdgcn_mfma_f32_32x32x16_bf16(b1, q, p1, 0, 0, 0); }
}
__device__ __forceinline__ void pack_p(const f32x16& p0, const f32x16& p1, bf16x8& pa0, bf16x8& pa1, bf16x8& pa2, bf16x8& pa3) {
#define PK4(P, BASE, OUT) do { unsigned a0 = cvt_pk_bf16(P[BASE + 0], P[BASE + 1]), a1 = cvt_pk_bf16(P[BASE + 2], P[BASE + 3]);   \
    unsigned b0 = cvt_pk_bf16(P[BASE + 4], P[BASE + 5]), b1 = cvt_pk_bf16(P[BASE + 6], P[BASE + 7]);                              \
    auto r0 = __builtin_amdgcn_permlane32_swap(a0, b0, false, false); auto r1 = __builtin_amdgcn_permlane32_swap(a1, b1, false, false); \
    u32x4 w = {r0[0], r1[0], r0[1], r1[1]}; OUT = __builtin_bit_cast(bf16x8, w); } while (0)
    PK4(p0, 0, pa0); PK4(p0, 8, pa1); PK4(p1, 0, pa2); PK4(p1, 8, pa3);
#undef PK4
}
__device__ __forceinline__ float xhalf_max(float v) { auto rr = __builtin_amdgcn_permlane32_swap(__float_as_uint(v), __float_as_uint(v), false, false); return fmaxf(__uint_as_float(rr[0]), __uint_as_float(rr[1])); }
__device__ __forceinline__ float xhalf_sum(float v) { auto rr = __builtin_amdgcn_permlane32_swap(__float_as_uint(v), __float_as_uint(v), false, false); return __uint_as_float(rr[0]) + __uint_as_float(rr[1]); }
template <int ND> __device__ __forceinline__ void softmax_step(f32x16& p0, f32x16& p1, float& m, float& l, f32x16 (&o)[ND]) {
    float pmax = p0[0];
#pragma unroll
    for (int r = 1; r < 16; ++r) pmax = fmaxf(pmax, p0[r]);
#pragma unroll
    for (int r = 0; r < 16; ++r) pmax = fmaxf(pmax, p1[r]);
    pmax = xhalf_max(pmax);
    const float mn = fmaxf(m, pmax);
    const float alpha = __builtin_amdgcn_exp2f(m - mn);
    m = mn;
    float ps = 0.f;
#pragma unroll
    for (int r = 0; r < 16; ++r) { p0[r] = __builtin_amdgcn_exp2f(p0[r] - mn); ps += p0[r]; }
#pragma unroll
    for (int r = 0; r < 16; ++r) { p1[r] = __builtin_amdgcn_exp2f(p1[r] - mn); ps += p1[r]; }
    ps = xhalf_sum(ps);
    l = l * alpha + ps;
    if (__any(alpha != 1.f)) {
#pragma unroll
        for (int d = 0; d < ND; ++d)
#pragma unroll
            for (int r = 0; r < 16; ++r) o[d][r] *= alpha;
    }
}
typedef short v4i16_t __attribute__((ext_vector_type(4)));
__device__ __forceinline__ s16x4 vtr(const LAS char* p) { return __builtin_bit_cast(s16x4, __builtin_amdgcn_ds_read_tr16_b64_v4i16((LAS v4i16_t*)p)); }
template <int NCB, int D0> __device__ __forceinline__ void pv_one(f32x16& od, int vb, bf16x8 pa0, bf16x8 pa1, bf16x8 pa2, bf16x8 pa3) {
    constexpr int KS = NCB * 1024, HF = NCB * 512, B0 = D0 * 512;
    const LAS char* vp = (const LAS char*)(size_t)(unsigned)vb;
    const s16x4 l0 = vtr(vp + B0), h0 = vtr(vp + B0 + HF), l1 = vtr(vp + B0 + KS), h1 = vtr(vp + B0 + KS + HF);
    const s16x4 l2 = vtr(vp + B0 + 2 * KS), h2 = vtr(vp + B0 + 2 * KS + HF), l3 = vtr(vp + B0 + 3 * KS), h3 = vtr(vp + B0 + 3 * KS + HF);
#define PKV(L, H) (bf16x8){L[0], L[1], L[2], L[3], H[0], H[1], H[2], H[3]}
    od = __builtin_amdgcn_mfma_f32_32x32x16_bf16(PKV(l0, h0), pa0, od, 0, 0, 0);
    od = __builtin_amdgcn_mfma_f32_32x32x16_bf16(PKV(l1, h1), pa1, od, 0, 0, 0);
    od = __builtin_amdgcn_mfma_f32_32x32x16_bf16(PKV(l2, h2), pa2, od, 0, 0, 0);
    od = __builtin_amdgcn_mfma_f32_32x32x16_bf16(PKV(l3, h3), pa3, od, 0, 0, 0);
#undef PKV
}
template <int NCB> __device__ __forceinline__ void pv_all(f32x16 (&o)[NCB], int vb, bf16x8 pa0, bf16x8 pa1, bf16x8 pa2, bf16x8 pa3) {
    pv_one<NCB, 0>(o[0], vb, pa0, pa1, pa2, pa3); pv_one<NCB, 1>(o[1], vb, pa0, pa1, pa2, pa3); pv_one<NCB, 2>(o[2], vb, pa0, pa1, pa2, pa3); pv_one<NCB, 3>(o[3], vb, pa0, pa1, pa2, pa3);
    if constexpr (NCB == 6) { pv_one<NCB, 4>(o[4], vb, pa0, pa1, pa2, pa3); pv_one<NCB, 5>(o[5], vb, pa0, pa1, pa2, pa3); }
}
struct KReg { bf16x8 a, b; };
template <int NCB> struct VReg { bf16x8 v[NCB == 4 ? 2 : 3]; };
__device__ __forceinline__ void k_load(KReg& s, const bf16_t* kp, size_t ld, int tid) { const int sr = tid >> 4, sc = (tid & 15) * 8;
    s.a = *(const bf16x8*)(kp + (size_t)sr * ld + sc); s.b = *(const bf16x8*)(kp + (size_t)(32 + sr) * ld + sc); }
__device__ __forceinline__ void k_write(LAS char* Kl, const KReg& s, int tid) { const int sr = tid >> 4, kc = (tid & 15) * 16;
    *(LAS bf16x8*)(Kl + KSWZ(sr, kc)) = s.a; *(LAS bf16x8*)(Kl + KSWZ(32 + sr, kc)) = s.b; }
template <int NCB> __device__ __forceinline__ void v_load(VReg<NCB>& s, const bf16_t* vp, size_t ld, int tid) {
    if constexpr (NCB == 4) { const int sr = tid >> 4, sc = (tid & 15) * 8; s.v[0] = *(const bf16x8*)(vp + (size_t)sr * ld + sc); s.v[1] = *(const bf16x8*)(vp + (size_t)(32 + sr) * ld + sc); }
    else {
#pragma unroll
        for (int i = 0; i < 3; ++i) { const int id = tid + 512 * i, row = id / 24, c = (id % 24) * 8; s.v[i] = *(const bf16x8*)(vp + (size_t)row * ld + c); } }
}
template <int NCB> __device__ __forceinline__ void v_write(LAS char* Vl, const VReg<NCB>& s, int tid) {
    if constexpr (NCB == 4) { const int sr = tid >> 4, sc = (tid & 15) * 8; *(LAS bf16x8*)(Vl + v_st<4>(sr, sc)) = s.v[0]; *(LAS bf16x8*)(Vl + v_st<4>(32 + sr, sc)) = s.v[1]; }
    else {
#pragma unroll
        for (int i = 0; i < 3; ++i) { const int id = tid + 512 * i, row = id / 24, c = (id % 24) * 8; *(LAS bf16x8*)(Vl + v_st<6>(row, c)) = s.v[i]; } }
}
__device__ __forceinline__ void q_load(bf16x8 (&qr)[8], const bf16_t* qrow  , int hi) {
#pragma unroll
    for (int d0 = 0; d0 < 8; ++d0) qr[d0] = *(const bf16x8*)(qrow + d0 * 16 + hi * 8);
}
template <int ND> __device__ __forceinline__ void store_y(LAS char* scr, bf16_t* yrow0, size_t ld, const f32x16 (&o)[ND], float sc, const float* colscale, int lane, bool dry) {
    const int r32 = lane & 31, hi = lane >> 5;
    u32x4 gv[ND][2];
#pragma unroll
    for (int d0 = 0; d0 < ND; ++d0)
#pragma unroll
        for (int i = 0; i < 2; ++i) { const int id = lane + 64 * i, tok = id >> 2, c16 = id & 3; gv[d0][i] = *(const u32x4*)(yrow0 + (size_t)tok * ld + 32 * d0 + c16 * 8); }
#pragma unroll
    for (int d0 = 0; d0 < ND; ++d0) {
#pragma unroll
        for (int rg = 0; rg < 4; ++rg) *(LAS u32x2*)(scr + r32 * 80 + (8 * rg + 4 * hi) * 2) = (u32x2){cvt_pk_bf16(o[d0][4 * rg] * sc, o[d0][4 * rg + 1] * sc), cvt_pk_bf16(o[d0][4 * rg + 2] * sc, o[d0][4 * rg + 3] * sc)};
#pragma unroll
        for (int i = 0; i < 2; ++i) { const int id = lane + 64 * i, tok = id >> 2, c16 = id & 3;
            const u32x4 v = *(const LAS u32x4*)(scr + tok * 80 + c16 * 16);
            bf16_t* yp = yrow0 + (size_t)tok * ld + 32 * d0 + c16 * 8; const u32x4 g = gv[d0][i];
            float f[8] = {__builtin_bit_cast(float, v.x << 16), __builtin_bit_cast(float, v.x & 0xffff0000u), __builtin_bit_cast(float, v.y << 16), __builtin_bit_cast(float, v.y & 0xffff0000u),
                          __builtin_bit_cast(float, v.z << 16), __builtin_bit_cast(float, v.z & 0xffff0000u), __builtin_bit_cast(float, v.w << 16), __builtin_bit_cast(float, v.w & 0xffff0000u)};
            const float gg[8] = {__builtin_bit_cast(float, g.x << 16), __builtin_bit_cast(float, g.x & 0xffff0000u), __builtin_bit_cast(float, g.y << 16), __builtin_bit_cast(float, g.y & 0xffff0000u),
                          __builtin_bit_cast(float, g.z << 16), __builtin_bit_cast(float, g.z & 0xffff0000u), __builtin_bit_cast(float, g.w << 16), __builtin_bit_cast(float, g.w & 0xffff0000u)};
            if (colscale) { const f32x4 s0 = *(const f32x4*)(colscale + 32 * d0 + c16 * 8), s1 = *(const f32x4*)(colscale + 32 * d0 + c16 * 8 + 4);
                f[0] *= s0.x; f[1] *= s0.y; f[2] *= s0.z; f[3] *= s0.w; f[4] *= s1.x; f[5] *= s1.y; f[6] *= s1.z; f[7] *= s1.w; }
#pragma unroll
            for (int j = 0; j < 8; ++j) f[j] *= gg[j];
            if (!dry) *(u32x4*)yp = (u32x4){cvt_pk_bf16(f[0], f[1]), cvt_pk_bf16(f[2], f[3]), cvt_pk_bf16(f[4], f[5]), cvt_pk_bf16(f[6], f[7])}; }
        asm volatile("" ::: "memory");
    }
}

__device__ __forceinline__ void dma_k2(LAS char* Kslot, const bf16_t* kp, size_t ld, int wave, int lane);
__device__ __forceinline__ void dma_v2(LAS char* Vslot, const bf16_t* vp, size_t ld, int wave, int lane);
__device__ __forceinline__ void q_rows_regs(bf16x8 (&qr)[8], LAS char* scr, const bf16_t* q0, size_t ld, int lane) {
    u32x4 wq[4][2];
#pragma unroll
    for (int p = 0; p < 4; ++p)
#pragma unroll
        for (int k = 0; k < 2; ++k) { const int id = lane + 64 * k, T = id >> 2, c = 4 * p + (id & 3); wq[p][k] = *(const u32x4*)(q0 + (size_t)T * ld + c * 8); }
#pragma unroll
    for (int p = 0; p < 4; ++p) {
#pragma unroll
        for (int k = 0; k < 2; ++k) { const int id = lane + 64 * k, T = id >> 2, cc = id & 3; *(LAS u32x4*)(scr + (cc >> 1) * 1024 + ((cc & 1) * 32 + T) * 16) = wq[p][k]; }
        asm volatile("s_waitcnt lgkmcnt(0)" ::: "memory");
        qr[2 * p] = *(const LAS bf16x8*)(scr + lane * 16); qr[2 * p + 1] = *(const LAS bf16x8*)(scr + 1024 + lane * 16);
        asm volatile("s_waitcnt lgkmcnt(0)" ::: "memory");
    }
}
__device__ __forceinline__ void mem_attn_phase(const Frame& F, bf16_t* Z, int ldz, int xq_col, int y_col, const bf16_t* mkv, int widx, int nw) {
    int tid = F.tid; asm volatile("" : "+v"(tid));
    const int lane = tid & 63, r32 = lane & 31, hi = lane >> 5, wave = F.wave;
    LAS char* Kl = (LAS char*)F.lds; LAS char* Vl = Kl + 65536; LAS char* scr = Kl + 131072 + wave * 2560;
    constexpr float C = 0.08838834764831845f * LOG2E;
    const int per = nw >> 5, nun = 16 / per;
    const int bh = widx / per, b = bh >> 2, head = bh & 3, tb0 = (widx % per) * nun;
    const bf16_t* kp = mkv + (size_t)b * NMEM * DM + head * 128; const bf16_t* vp = kp + 512;
    __syncthreads();
#pragma unroll
    for (int j = 0; j < 4; ++j) { dma_k2(Kl + j * 16384, kp + (size_t)j * 64 * DM, DM, wave, lane); dma_v2(Vl + j * 16384, vp + (size_t)j * 64 * DM, DM, wave, lane); }
    __syncthreads();
    const int vb = lds_addr(Vl) + v_rd_base(lane);
    for (int ui = 0; ui < nun; ++ui) {
        const int tb = tb0 + ui;
        const size_t t0 = (size_t)b * SEQ + tb * 256 + wave * 32;
        bf16x8 qr[8]; q_rows_regs(qr, scr, Z + t0 * ldz + xq_col + head * 128, ldz, lane);
        float m = -1e30f, l = 0.f; f32x16 o[4] = {};
#pragma unroll
        for (int j = 0; j < 4; ++j) {
            f32x16 p0, p1; qkt(p0, p1, Kl + j * 16384, qr, r32, hi);
#pragma unroll
            for (int r = 0; r < 16; ++r) { p0[r] *= C; p1[r] *= C; }
            softmax_step<4>(p0, p1, m, l, o);
            bf16x8 pa0, pa1, pa2, pa3; pack_p(p0, p1, pa0, pa1, pa2, pa3);
            pv_all<4>(o, vb + j * 16384, pa0, pa1, pa2, pa3);
        }
        store_y<4>(scr, Z + t0 * ldz + y_col + head * 128, ldz, o, 1.f / l, nullptr, lane, F.dry != 0);
    }
    __syncthreads();
}

constexpr int POOL_W_BYTES = 192 * 400, POOL_ZROWS = 144;
__device__ __forceinline__ void pool_phase(const Frame& F, bf16_t* Z, const bf16_t* WP, const float* scale, int unit_lo, int unit_step) {
    int tid = F.tid; asm volatile("" : "+v"(tid));
    const int lane = tid & 63, r32 = lane & 31, hi = lane >> 5, wave = F.wave;
    LAS char* Wl = (LAS char*)F.lds;
    LAS char* Zl = Wl + POOL_W_BYTES;
    for (int u = unit_lo; u < BATCH * 32 * 4; u += unit_step) {
        const int g = (u + (u >> 8)) & 3, tb = (u >> 2) & 31, b = u >> 7, t0 = tb * 128;
        const int win = 2 << g;
        { const bf16_t* wsrc = WP + (size_t)g * 192 * 192; int ts = tid; asm volatile("" : "+v"(ts));
#pragma unroll
          for (int i = 0; i < 9; ++i) { const int id = ts + 512 * i, row = id / 24, c = id % 24; *(LAS bf16x8*)(Wl + row * 400 + c * 16) = *(const bf16x8*)(wsrc + row * 192 + c * 8); }
          const bf16_t* zsrc = Z + ((size_t)b * SEQ + t0 - 16) * EV_LD + EV_ZA + g * 192;
#pragma unroll
          for (int i = 0; i < 7; ++i) { const int id = ts + 512 * i, row = id / 24, c = id % 24;
              if (id < POOL_ZROWS * 24) { bf16x8 v = bf16x8{}; if (t0 - 16 + row >= 0) v = *(const bf16x8*)(zsrc + (size_t)row * EV_LD + c * 8); *(LAS bf16x8*)(Zl + row * 400 + c * 16) = v; } } }
        __syncthreads();
        const int tt = wave & 3, obh = wave >> 2, tloc = t0 + tt * 32 + r32;
        const int cnt = (tloc + 1 < win) ? tloc + 1 : win; const float icnt = 1.0f / (float)cnt;
        const LAS char* zr = Zl + (16 + tt * 32 + r32) * 400 + 16 * hi;
        f32x16 o[3] = {};
#define POOL_KSTEPS(WIN) do { _Pragma("unroll 1") for (int s = 0; s < 12; ++s) { bf16x8 wv[WIN]; \
            _Pragma("unroll") for (int i = 0; i < WIN; ++i) wv[i] = *(const LAS bf16x8*)(zr + 32 * s - i * 400); \
            float accv[8], cur[8]; \
            _Pragma("unroll") for (int j = 0; j < 8; ++j) { cur[j] = bf2f((unsigned short)wv[0][j]); accv[j] = cur[j]; } \
            _Pragma("unroll") for (int i = 1; i < WIN; ++i) { _Pragma("unroll") for (int j = 0; j < 8; ++j) accv[j] += bf2f((unsigned short)wv[i][j]); } \
            u32x4 w; w.x = cvt_pk_bf16(accv[0] * icnt - cur[0], accv[1] * icnt - cur[1]); w.y = cvt_pk_bf16(accv[2] * icnt - cur[2], accv[3] * icnt - cur[3]); \
            w.z = cvt_pk_bf16(accv[4] * icnt - cur[4], accv[5] * icnt - cur[5]); w.w = cvt_pk_bf16(accv[6] * icnt - cur[6], accv[7] * icnt - cur[7]); \
            const bf16x8 bfrag = __builtin_bit_cast(bf16x8, w); \
            _Pragma("unroll") for (int j = 0; j < 3; ++j) { const bf16x8 afrag = *(const LAS bf16x8*)(Wl + (32 * (3 * obh + j) + r32) * 400 + (16 * s + 8 * hi) * 2); \
                o[j] = __builtin_amdgcn_mfma_f32_32x32x16_bf16(afrag, bfrag, o[j], 0, 0, 0); } } } while (0)
        if (g == 0) POOL_KSTEPS(2); else if (g == 1) POOL_KSTEPS(4); else if (g == 2) POOL_KSTEPS(8); else POOL_KSTEPS(16);
#undef POOL_KSTEPS
        store_y<3>(Wl + POOL_W_BYTES + POOL_ZROWS * 400 + wave * 2560, Z + ((size_t)b * SEQ + t0 + tt * 32) * EV_LD + EV_G + g * 192 + 96 * obh, EV_LD, o, 1.f, scale + g * 192 + 96 * obh, lane, F.dry != 0);
        __syncthreads();
    }
}

__device__ __forceinline__ void unpack8(const u32x4 w, float (&f)[8]) {
    f[0] = __builtin_bit_cast(float, w.x << 16); f[1] = __builtin_bit_cast(float, w.x & 0xffff0000u); f[2] = __builtin_bit_cast(float, w.y << 16); f[3] = __builtin_bit_cast(float, w.y & 0xffff0000u);
    f[4] = __builtin_bit_cast(float, w.z << 16); f[5] = __builtin_bit_cast(float, w.z & 0xffff0000u); f[6] = __builtin_bit_cast(float, w.w << 16); f[7] = __builtin_bit_cast(float, w.w & 0xffff0000u);
}
constexpr int RET_KV_ELEMS = 192 * 128;
__device__ __forceinline__ float ret_log2_gamma(int h) { return log2f(1.0f - exp2f(-5.0f - (float)h)); }
struct RetAPre { bf16x8 x1[2], x2[2], v[6]; f32x4 ca[2], cb[2], sa[2], sb[2]; };
__device__ __forceinline__ void ret_a_load(RetAPre& P, const bf16_t* Z, const float* ropec, const float* ropes, int u, int tid) {
    asm volatile("" : "+v"(tid));
    const int b = u >> 7, h = (u >> 5) & 3, n = u & 31, c0 = n * 128;
#pragma unroll
    for (int i = 0; i < 2; ++i) {
        const int id = tid + 512 * i, m = id >> 3, c = id & 7, pos = c0 + m;
        const bf16_t* kp = Z + ((size_t)b * SEQ + pos) * EV_LD + EV_RK + h * 128 + 8 * c;
        P.x1[i] = *(const bf16x8*)kp; P.x2[i] = *(const bf16x8*)(kp + 64);
        P.ca[i] = *(const f32x4*)(ropec + pos * 64 + 8 * c); P.cb[i] = *(const f32x4*)(ropec + pos * 64 + 8 * c + 4);
        P.sa[i] = *(const f32x4*)(ropes + pos * 64 + 8 * c); P.sb[i] = *(const f32x4*)(ropes + pos * 64 + 8 * c + 4); }
#pragma unroll
    for (int i = 0; i < 6; ++i) { const int id = tid + 512 * i, m = id / 24, c = id % 24;
        P.v[i] = *(const bf16x8*)(Z + ((size_t)b * SEQ + c0 + m) * EV_LD + EV_RV + h * 192 + 8 * c); }
}
__device__ __forceinline__ void ret_a_phase(const Frame& F, const bf16_t* Z, const float* ropec, const float* ropes, bf16_t* kvT, int unit_lo, int unit_step) {
    int tid = F.tid; asm volatile("" : "+v"(tid));
    const int lane = tid & 63, wave = F.wave;
    LAS char* Kimg = (LAS char*)F.lds; LAS char* Vimg = Kimg + 32768;
    RetAPre P;
    if (unit_lo < BATCH * 4 * 32) ret_a_load(P, Z, ropec, ropes, unit_lo, tid);
    for (int u = unit_lo; u < BATCH * 4 * 32; u += unit_step) {
        const int h = (u >> 5) & 3;
        const float lgam = ret_log2_gamma(h);
#pragma unroll
        for (int i = 0; i < 2; ++i) {
            const int id = tid + 512 * i, m = id >> 3, c = id & 7;
            const f32x4 ca = P.ca[i], cb = P.cb[i], sa = P.sa[i], sb = P.sb[i];
            float cs[8] = {ca.x, ca.y, ca.z, ca.w, cb.x, cb.y, cb.z, cb.w}, sn[8] = {sa.x, sa.y, sa.z, sa.w, sb.x, sb.y, sb.z, sb.w};
            const float zeta = exp2f((float)(127 - m) * lgam);
            const bf16x8 x1 = P.x1[i], x2 = P.x2[i];
            float o1[8], o2[8];
#pragma unroll
            for (int j = 0; j < 8; ++j) { const float a = bf2f((unsigned short)x1[j]), bb = bf2f((unsigned short)x2[j]); o1[j] = (a * cs[j] - bb * sn[j]) * zeta; o2[j] = (a * sn[j] + bb * cs[j]) * zeta; }
            u32x4 z1 = {cvt_pk_bf16(o1[0], o1[1]), cvt_pk_bf16(o1[2], o1[3]), cvt_pk_bf16(o1[4], o1[5]), cvt_pk_bf16(o1[6], o1[7])};
            u32x4 z2 = {cvt_pk_bf16(o2[0], o2[1]), cvt_pk_bf16(o2[2], o2[3]), cvt_pk_bf16(o2[4], o2[5]), cvt_pk_bf16(o2[6], o2[7])};
            LAS char* img = Kimg + (m >> 6) * 16384;
            *(LAS u32x4*)(img + v_st<4>(m & 63, 8 * c)) = z1; *(LAS u32x4*)(img + v_st<4>(m & 63, 64 + 8 * c)) = z2;
        }
#pragma unroll
        for (int i = 0; i < 6; ++i) { const int id = tid + 512 * i, m = id / 24, c = id % 24;
            *(LAS bf16x8*)(Vimg + (m >> 6) * 24576 + v_st<6>(m & 63, 8 * c)) = P.v[i]; }
        __syncthreads();
        if (u + unit_step < BATCH * 4 * 32) ret_a_load(P, Z, ropec, ropes, u + unit_step, tid);
        const int kbk = wave & 3, dvb0 = (wave >> 2) * 3;
        const int vbK = lds_addr(Kimg) + v_rd_base(lane) + kbk * 512, vbV = lds_addr(Vimg) + v_rd_base(lane) + dvb0 * 512;
        f32x16 acc[3] = {};
#pragma unroll
        for (int T = 0; T < 2; ++T)
#pragma unroll
            for (int ks = 0; ks < 4; ++ks) {
                const s16x4 bl = tr_read<0>(vbK + T * 16384 + ks * 4096), bh = tr_read<0>(vbK + T * 16384 + ks * 4096 + 2048);
                s16x4 al[3], ah[3];
#pragma unroll
                for (int i = 0; i < 3; ++i) { al[i] = tr_read<0>(vbV + T * 24576 + ks * 6144 + i * 512); ah[i] = tr_read<0>(vbV + T * 24576 + ks * 6144 + 3072 + i * 512); }
                asm volatile("s_waitcnt lgkmcnt(0)" ::: "memory"); SBAR();
                const bf16x8 bf = (bf16x8){bl[0], bl[1], bl[2], bl[3], bh[0], bh[1], bh[2], bh[3]};
#pragma unroll
                for (int i = 0; i < 3; ++i) { const bf16x8 af = (bf16x8){al[i][0], al[i][1], al[i][2], al[i][3], ah[i][0], ah[i][1], ah[i][2], ah[i][3]};
                    acc[i] = __builtin_amdgcn_mfma_f32_32x32x16_bf16(af, bf, acc[i], 0, 0, 0); }
            }
        bf16_t* dst = kvT + (size_t)u * RET_KV_ELEMS;
        const int r32 = lane & 31, hi = lane >> 5;
        if (!F.dry)
#pragma unroll
        for (int i = 0; i < 3; ++i)
#pragma unroll
            for (int r = 0; r < 16; ++r) dst[(size_t)(32 * (dvb0 + i) + crow(r, hi)) * 128 + 32 * kbk + r32] = (bf16_t)(cvt_pk_bf16(acc[i][r], 0.f) & 0xffffu);
        __syncthreads();
    }
}
__device__ __forceinline__ void ret_scan_phase(const Frame& F, bf16_t* kvT) {
    for (int idx = F.bid * 512 + F.tid; idx < 32 * (RET_KV_ELEMS / 8); idx += F.G * 512) {
        const int bh = idx / (RET_KV_ELEMS / 8), e = idx % (RET_KV_ELEMS / 8), h = bh & 3;
        const float gch = exp2f(128.0f * ret_log2_gamma(h));
        u32x4* p = (u32x4*)(kvT + (size_t)bh * 32 * RET_KV_ELEMS) + e;
        float R[8];
#pragma unroll
        for (int j = 0; j < 8; ++j) R[j] = 0.f;
        u32x4 twv[32];
#pragma unroll
        for (int n = 0; n < 32; ++n) twv[n] = p[(size_t)n * (RET_KV_ELEMS / 8)];
#pragma unroll
        for (int n = 0; n < 32; ++n) { const u32x4 tw = twv[n]; float t[8]; unpack8(tw, t);
            if (!F.dry) p[(size_t)n * (RET_KV_ELEMS / 8)] = (u32x4){cvt_pk_bf16(R[0], R[1]), cvt_pk_bf16(R[2], R[3]), cvt_pk_bf16(R[4], R[5]), cvt_pk_bf16(R[6], R[7])};
#pragma unroll
            for (int j = 0; j < 8; ++j) R[j] = R[j] * gch + t[j]; }
    }
}
constexpr int RETC_SCR_OFF = 32768 + 49152 + 2048, RETC_R_OFF = RETC_SCR_OFF + 8 * 2560;
__device__ __forceinline__ void ret_c_phase(const Frame& F, bf16_t* Z, const float* ropec, const float* ropes, const bf16_t* kvT, int unit_lo, int unit_step) {
    int tid = F.tid; asm volatile("" : "+v"(tid));
    const int lane = tid & 63, wave = F.wave, r32 = lane & 31, hi = lane >> 5;
    LAS char* Kl = (LAS char*)F.lds; LAS char* Vl = Kl + 32768; LAS float* st = (LAS float*)(Kl + 32768 + 49152);
    LAS char* Rl = Kl + RETC_R_OFF;
    VReg<6> pv0, pv1; u32x4 pr[6];
#define RETC_PRE(U) do { int tp_ = tid; asm volatile("" : "+v"(tp_)); const int b_ = (U) >> 7, h_ = ((U) >> 5) & 3, n_ = (U) & 31; \
        const bf16_t* zv_ = Z + ((size_t)b_ * SEQ + n_ * 128) * EV_LD + EV_RV + h_ * 192; v_load<6>(pv0, zv_, EV_LD, tp_); v_load<6>(pv1, zv_ + (size_t)64 * EV_LD, EV_LD, tp_); \
        const u32x4* rp_ = (const u32x4*)(kvT + (size_t)(U) * RET_KV_ELEMS); _Pragma("unroll") for (int i_ = 0; i_ < 6; ++i_) pr[i_] = rp_[tp_ + 512 * i_]; } while (0)
    if (unit_lo < BATCH * 4 * 32) RETC_PRE(unit_lo);
    for (int u = unit_lo; u < BATCH * 4 * 32; u += unit_step) {
        const int b = u >> 7, h = (u >> 5) & 3, n = u & 31, c0 = n * 128;
        const float lgam = ret_log2_gamma(h);
        const bf16_t* zb = Z + ((size_t)b * SEQ + c0) * EV_LD;
        { const int sr = tid >> 4, cc = tid & 15, fq0 = 8 * (cc & 7);
#pragma unroll
          for (int i = 0; i < 4; ++i) { const int m = (i >> 1) * 64 + (i & 1) * 32 + sr, pos = c0 + m;
              const f32x4 ca = *(const f32x4*)(ropec + pos * 64 + fq0), cb = *(const f32x4*)(ropec + pos * 64 + fq0 + 4), sa = *(const f32x4*)(ropes + pos * 64 + fq0), sb = *(const f32x4*)(ropes + pos * 64 + fq0 + 4);
              const float cs[8] = {ca.x, ca.y, ca.z, ca.w, cb.x, cb.y, cb.z, cb.w}, sn[8] = {sa.x, sa.y, sa.z, sa.w, sb.x, sb.y, sb.z, sb.w};
#pragma unroll
              for (int qk = 0; qk < 2; ++qk) {
                  const bf16_t* kr = zb + (size_t)m * EV_LD + (qk ? EV_RK : EV_RQ) + h * 128;
                  const bf16x8 xo = *(const bf16x8*)(kr + 8 * cc), xp = *(const bf16x8*)(kr + 8 * (cc ^ 8));
                  const float sc = qk ? 1.0f : 0.08838834764831845f;
                  float o[8];
#pragma unroll
                  for (int j = 0; j < 8; ++j) { const float a = bf2f((unsigned short)xo[j]), p = bf2f((unsigned short)xp[j]); o[j] = ((cc < 8) ? a * cs[j] - p * sn[j] : p * sn[j] + a * cs[j]) * sc; }
                  *(LAS u32x4*)((qk ? Kl : Rl) + (i >> 1) * 16384 + KSWZ((i & 1) * 32 + sr, cc * 16)) = (u32x4){cvt_pk_bf16(o[0], o[1]), cvt_pk_bf16(o[2], o[3]), cvt_pk_bf16(o[4], o[5]), cvt_pk_bf16(o[6], o[7])}; } } }
        v_write<6>(Vl, pv0, tid); v_write<6>(Vl + 24576, pv1, tid);
        const int q4 = wave & 3, dvb0 = (wave >> 2) * 3, ti = 32 * q4 + r32;
        __syncthreads();
        bf16x8 qr[8];
#pragma unroll
        for (int s = 0; s < 8; ++s) qr[s] = *(const LAS bf16x8*)(Rl + (ti >> 6) * 16384 + KSWZ(ti & 63, (2 * s + hi) * 16));
        __syncthreads();
        { int ts = tid; asm volatile("" : "+v"(ts));
#pragma unroll
          for (int i = 0; i < 6; ++i) { const int id = ts + 512 * i, row = id >> 4, c8 = id & 15; *(LAS u32x4*)(Rl + row * 272 + c8 * 16) = pr[i]; } }
        if (u + unit_step < BATCH * 4 * 32) RETC_PRE(u + unit_step);
        f32x16 o[3] = {};
        const int ntile = (q4 >> 1) + 1;
        for (int j = 0; j < ntile; ++j) {
            f32x16 p0, p1; qkt(p0, p1, Kl + j * 16384, qr, r32, hi);
#pragma unroll
            for (int r = 0; r < 16; ++r) { const int d0 = ti - (64 * j + crow(r, hi)), d1 = d0 - 32;
                p0[r] = d0 >= 0 ? p0[r] * __builtin_amdgcn_exp2f((float)d0 * lgam) : 0.f; p1[r] = d1 >= 0 ? p1[r] * __builtin_amdgcn_exp2f((float)d1 * lgam) : 0.f; }
            bf16x8 pa0, pa1, pa2, pa3; pack_p(p0, p1, pa0, pa1, pa2, pa3);
            const int vb = lds_addr(Vl + j * 24576) + v_rd_base(lane) + dvb0 * 512;
            pv_one<6, 0>(o[0], vb, pa0, pa1, pa2, pa3); pv_one<6, 0>(o[1], vb + 512, pa0, pa1, pa2, pa3); pv_one<6, 0>(o[2], vb + 1024, pa0, pa1, pa2, pa3);
        }
        __syncthreads();
        { const float xi = exp2f((float)(ti + 1) * lgam);
#pragma unroll
          for (int s = 0; s < 8; ++s) { u32x4 w = __builtin_bit_cast(u32x4, qr[s]);
              w.x = cvt_pk_bf16(__builtin_bit_cast(float, w.x << 16) * xi, __builtin_bit_cast(float, w.x & 0xffff0000u) * xi); w.y = cvt_pk_bf16(__builtin_bit_cast(float, w.y << 16) * xi, __builtin_bit_cast(float, w.y & 0xffff0000u) * xi);
              w.z = cvt_pk_bf16(__builtin_bit_cast(float, w.z << 16) * xi, __builtin_bit_cast(float, w.z & 0xffff0000u) * xi); w.w = cvt_pk_bf16(__builtin_bit_cast(float, w.w << 16) * xi, __builtin_bit_cast(float, w.w & 0xffff0000u) * xi);
              qr[s] = __builtin_bit_cast(bf16x8, w); }
#pragma unroll
          for (int i = 0; i < 3; ++i)
#pragma unroll
              for (int s = 0; s < 8; ++s) { const bf16x8 af = *(const LAS bf16x8*)(Rl + (32 * (dvb0 + i) + r32) * 272 + (16 * s + 8 * hi) * 2);
                  o[i] = __builtin_amdgcn_mfma_f32_32x32x16_bf16(af, qr[s], o[i], 0, 0, 0); } }
        float s1 = 0.f, s2 = 0.f;
#pragma unroll
        for (int i = 0; i < 3; ++i)
#pragma unroll
            for (int r = 0; r < 16; ++r) { s1 += o[i][r]; s2 += o[i][r] * o[i][r]; }
        s1 = xhalf_sum(s1); s2 = xhalf_sum(s2);
        if (hi == 0) { st[(wave * 32 + r32) * 2] = s1; st[(wave * 32 + r32) * 2 + 1] = s2; }
        __syncthreads();
        const float t1 = s1 + st[((wave ^ 4) * 32 + r32) * 2], t2 = s2 + st[((wave ^ 4) * 32 + r32) * 2 + 1];
        const float mu = t1 * (1.f / 192.f), var = fmaxf(t2 * (1.f / 192.f) - mu * mu, 0.f), rs = 1.0f / sqrtf(var + EPS);
#pragma unroll
        for (int i = 0; i < 3; ++i)
#pragma unroll
            for (int r = 0; r < 16; ++r) o[i][r] = (o[i][r] - mu) * rs;
        store_y<3>(Kl + RETC_SCR_OFF + wave * 2560, Z + ((size_t)b * SEQ + c0 + 32 * q4) * EV_LD + EV_G + 768 + h * 192 + 32 * dvb0, EV_LD, o, 1.f, nullptr, lane, F.dry != 0);
        __syncthreads();
    }
}
#undef RETC_PRE

__device__ __forceinline__ void dma_k2(LAS char* Kslot, const bf16_t* kp, size_t ld, int wave, int lane);
__device__ __forceinline__ void compress_phase(const Frame& F, const bf16_t* Z, const bf16_t* W1t, const bf16_t* W2t, const float* b1, const float* b1part, bf16_t* kcmp, bf16_t* vcmp, int unit_lo, int unit_step) {
    const int tid = F.tid, lane = F.lane, wave = F.wave, r32 = lane & 31, hi = lane >> 5;
    LAS char* Wb = (LAS char*)F.lds; LAS char* Al = Wb + 131072; LAS char* Hs = Wb;
    volatile LAS unsigned* mw = (volatile LAS unsigned*)(F.lds + MISC_OFF); const unsigned sv0 = mw[0], sv1 = mw[1];
    for (int u = unit_lo; u < 128; u += unit_step) {
        const int kv = u >> 6, rt = u & 63;
        const bf16_t* w1 = W1t + (size_t)kv * 256 * 4096; const bf16_t* w2 = W2t + (size_t)kv * 128 * 256;
        bf16_t* dstc = kv ? vcmp : kcmp; const int zc = kv ? OD_VC : OD_KC;
        if (rt == 0 && tid < 256) { const int bg = tid >> 4, c = tid & 15; *(u32x4*)(dstc + ((size_t)bg * 256 + 255) * 128 + c * 8) = (u32x4){0u, 0u, 0u, 0u}; }
        const int sr = tid >> 4, sc = (tid & 15) * 8;
        const bf16_t* rp[2];
#pragma unroll
        for (int i = 0; i < 2; ++i) { int r = rt * 64 + sr + 32 * i; if (r > 4079) r = 4079; const int g = r & 1, bj = r >> 1, b = bj / 255, j = bj % 255;
            rp[i] = Z + ((size_t)b * SEQ + 16 * j) * OD_LD + zc + g * 128 + sc; }
        KReg a; a.a = *(const bf16x8*)rp[0]; a.b = *(const bf16x8*)rp[1];
#pragma unroll
        for (int q = 0; q < 4; ++q) dma_k2(Wb + q * 16384, w1 + (size_t)(64 * q) * 4096, 4096, wave, lane);
        k_write(Al, a, tid);
        f32x16 acc[2] = {};
#pragma unroll 1
        for (int l = 0; l < 32; ++l) {
            const LAS char* wt = Wb + (l & 1) * 65536 + (wave >> 1) * 16384;
            const LAS char* Ac = Al + (l & 1) * 16384;
            __syncthreads();
            if (l + 1 < 32) { a.a = *(const bf16x8*)(rp[0] + (size_t)(l + 1) * OD_LD); a.b = *(const bf16x8*)(rp[1] + (size_t)(l + 1) * OD_LD);
#pragma unroll
                for (int q = 0; q < 4; ++q) dma_k2(Wb + ((l + 1) & 1) * 65536 + q * 16384, w1 + (size_t)(64 * q) * 4096 + (l + 1) * 128, 4096, wave, lane); }
#pragma unroll
            for (int s = 0; s < 8; ++s) { const int cb = (16 * s + 8 * hi) * 2;
                const bf16x8 a0 = *(const LAS bf16x8*)(Ac + KSWZ(r32, cb)), a1 = *(const LAS bf16x8*)(Ac + KSWZ(32 + r32, cb));
                const bf16x8 bf = *(const LAS bf16x8*)(wt + KSWZ(32 * (wave & 1) + r32, cb));
                acc[0] = __builtin_amdgcn_mfma_f32_32x32x16_bf16(a0, bf, acc[0], 0, 0, 0);
                acc[1] = __builtin_amdgcn_mfma_f32_32x32x16_bf16(a1, bf, acc[1], 0, 0, 0); }
            if (l + 1 < 32) k_write(Al + ((l + 1) & 1) * 16384, a, tid);
        }
        { const int col = 32 * wave + r32; float bb = b1[kv * 256 + col];
          for (int j = 0; j < 32; ++j) bb += b1part[(kv * 32 + j) * 256 + col];
#pragma unroll
          for (int rb = 0; rb < 2; ++rb)
#pragma unroll
              for (int r = 0; r < 16; ++r) { const float v = acc[rb][r] + bb; const float sv = v * fast_sigmoid(v);
                  *(LAS unsigned short*)(Hs + (32 * rb + crow(r, hi)) * 528 + col * 2) = (unsigned short)f2bf(sv); } }
        __syncthreads();
        { const int rb = wave & 1, cbk = wave >> 1; f32x16 o2 = {};
#pragma unroll
          for (int s = 0; s < 16; ++s) { const bf16x8 af = *(const LAS bf16x8*)(Hs + (32 * rb + r32) * 528 + (16 * s + 8 * hi) * 2);
              const bf16x8 bf = *(const bf16x8*)(w2 + (size_t)(32 * cbk + r32) * 256 + 16 * s + 8 * hi);
              o2 = __builtin_amdgcn_mfma_f32_32x32x16_bf16(af, bf, o2, 0, 0, 0); }
#pragma unroll
          for (int r = 0; r < 16; ++r) { const int row = rt * 64 + 32 * rb + crow(r, hi);
              if (row < 4080) { const int g = row & 1, bj = row >> 1, b = bj / 255, j = bj % 255;
                  dstc[(((size_t)b * 2 + g) * 256 + j) * 128 + 32 * cbk + r32] = (bf16_t)f2bf(o2[r]); } } }
        __syncthreads();
    }
    if (tid == 0) { mw[0] = sv0; mw[1] = sv1; }
    __syncthreads();
}

__device__ __forceinline__ void nsa_post(f32x16& p0, f32x16& p1, int t, int kbase, int kstride, int limit, bool sel, int kvalid, const LAS float* tbl, int hi, bool fast) {
    constexpr float C = 0.08838834764831845f * LOG2E;
    const float NEGINF = -__builtin_inff();
    if (fast) { const float b128 = tbl[128];
#pragma unroll
        for (int r = 0; r < 16; ++r) { p0[r] = sel ? p0[r] * C + b128 : NEGINF; p1[r] = sel ? p1[r] * C + b128 : NEGINF; }
        return; }
    asm volatile("" : "+v"(hi), "+v"(t));
#pragma unroll
    for (int r = 0; r < 16; ++r) {
        { const int k = crow(r, hi); const int rel = t - (kbase + kstride * k); const bool ok = sel && rel >= 0 && rel < limit && k < kvalid; const int idx = rel < 0 ? 0 : (rel > 128 ? 128 : rel);
          p0[r] = ok ? p0[r] * C + tbl[idx] : NEGINF; }
        { const int k = 32 + crow(r, hi); const int rel = t - (kbase + kstride * k); const bool ok = sel && rel >= 0 && rel < limit && k < kvalid; const int idx = rel < 0 ? 0 : (rel > 128 ? 128 : rel);
          p1[r] = ok ? p1[r] * C + tbl[idx] : NEGINF; }
    }
}
__device__ __forceinline__ float fadd_s(float a, float b) { float r; asm("v_add_f32_e32 %0, %1, %2" : "=v"(r) : "v"(a), "v"(b)); return r; }
__device__ __forceinline__ float max3_s(float a, float b, float c) { float r; asm("v_max3_f32 %0, %1, %2, %3" : "=v"(r) : "v"(a), "v"(b), "v"(c)); return r; }
__device__ __forceinline__ void dma_k(LAS char* Kslot, const bf16_t* kp, size_t ld, int lw  , int lane) {
    asm volatile("" : "+v"(lane));
#pragma unroll
    for (int i = 0; i < 8; ++i) { const int pc = lw * 8 + i, row = pc * 4 + (lane >> 4), ch = (lane & 15) ^ (row & 15);
        __builtin_amdgcn_global_load_lds((const unsigned*)(kp + (size_t)row * ld + ch * 8), (LAS unsigned*)(Kslot + pc * 1024), 16, 0, 0); }
}
__device__ __forceinline__ void dma_v(LAS char* Vslot, const bf16_t* vp, size_t ld, int lw, int lane) {
    asm volatile("" : "+v"(lane));
#pragma unroll
    for (int i = 0; i < 8; ++i) { const int pc = lw * 8 + i, cblk = 2 * (pc & 1) + (lane >> 5), kk = (pc >> 1) * 8 + ((lane & 31) >> 2), k = (kk & ~0xC) | ((kk & 4) << 1) | ((kk & 8) >> 1), c = cblk * 32 + (lane & 3) * 8;
        __builtin_amdgcn_global_load_lds((const unsigned*)(vp + (size_t)k * ld + c), (LAS unsigned*)(Vslot + pc * 1024), 16, 0, 0); }
}
constexpr float NSA_THR = 24.0f;
template <int MODE>
__device__ __forceinline__ void acc_step(LAS char* scr, bf16_t* arow0, size_t ald, bf16_t* yrow0, size_t yld, const f32x16 (&o)[4], float sc, int lane, bool dry) {
    const int r32 = lane & 31, hi = lane >> 5;
    u32x4 av[4][2], yv[4][2];
    if (MODE >= 1) {
#pragma unroll
        for (int d0 = 0; d0 < 4; ++d0)
#pragma unroll
            for (int i = 0; i < 2; ++i) { const int id = lane + 64 * i, tok = id >> 2, c16 = id & 3; av[d0][i] = *(const u32x4*)(arow0 + (size_t)tok * ald + 32 * d0 + c16 * 8); } }
    if (MODE == 2) {
#pragma unroll
        for (int d0 = 0; d0 < 4; ++d0)
#pragma unroll
            for (int i = 0; i < 2; ++i) { const int id = lane + 64 * i, tok = id >> 2, c16 = id & 3; yv[d0][i] = *(const u32x4*)(yrow0 + (size_t)tok * yld + 32 * d0 + c16 * 8); } }
#pragma unroll
    for (int d0 = 0; d0 < 4; ++d0) {
#pragma unroll
        for (int rg = 0; rg < 4; ++rg) *(LAS u32x2*)(scr + r32 * 80 + (8 * rg + 4 * hi) * 2) = (u32x2){cvt_pk_bf16(o[d0][4 * rg] * sc, o[d0][4 * rg + 1] * sc), cvt_pk_bf16(o[d0][4 * rg + 2] * sc, o[d0][4 * rg + 3] * sc)};
#pragma unroll
        for (int i = 0; i < 2; ++i) { const int id = lane + 64 * i, tok = id >> 2, c16 = id & 3;
            float f[8]; unpack8(*(const LAS u32x4*)(scr + tok * 80 + c16 * 16), f);
            bf16_t* ap = arow0 + (size_t)tok * ald + 32 * d0 + c16 * 8;
            if (MODE >= 1) { float a[8]; unpack8(av[d0][i], a);
#pragma unroll
                for (int j = 0; j < 8; ++j) f[j] += a[j]; }
            if (MODE == 2) { bf16_t* yp = yrow0 + (size_t)tok * yld + 32 * d0 + c16 * 8; float g[8]; unpack8(yv[d0][i], g);
#pragma unroll
                for (int j = 0; j < 8; ++j) f[j] *= g[j];
                if (!dry) *(u32x4*)yp = (u32x4){cvt_pk_bf16(f[0], f[1]), cvt_pk_bf16(f[2], f[3]), cvt_pk_bf16(f[4], f[5]), cvt_pk_bf16(f[6], f[7])}; }
            else *(u32x4*)ap = (u32x4){cvt_pk_bf16(f[0], f[1]), cvt_pk_bf16(f[2], f[3]), cvt_pk_bf16(f[4], f[5]), cvt_pk_bf16(f[6], f[7])}; }
        asm volatile("" ::: "memory");
    }
}
#define NSA_PK4(P, BASE, OUT) do { unsigned a0_ = cvt_pk_bf16(P[BASE + 0], P[BASE + 1]), a1_ = cvt_pk_bf16(P[BASE + 2], P[BASE + 3]);   \
    unsigned b0_ = cvt_pk_bf16(P[BASE + 4], P[BASE + 5]), b1_ = cvt_pk_bf16(P[BASE + 6], P[BASE + 7]);                              \
    auto r0_ = __builtin_amdgcn_permlane32_swap(a0_, b0_, false, false); auto r1_ = __builtin_amdgcn_permlane32_swap(a1_, b1_, false, false); \
    u32x4 w_ = {r0_[0], r1_[0], r0_[1], r1_[1]}; OUT = __builtin_bit_cast(bf16x8, w_); } while (0)
struct TileInfo { int blk; bool far; };
template <int TYPE> __device__ __forceinline__ TileInfo tile_info(int blk, int s0) {
    TileInfo ti; ti.blk = blk; const int kb = 64 * blk;
    if (TYPE == 0) ti.far = s0 - (kb + 63) >= 128;
    else if (TYPE == 1) ti.far = (s0 - (kb + 63) >= 128) && (s0 + 31 - kb < 512);
    else ti.far = (blk < 3) && (s0 - (16 * (kb + 63) + 31) >= 128);
    return ti;
}
template <int TYPE> __device__ __forceinline__ void near_post(f32x16& P0, f32x16& P1, int blk, int t, float m, const LAS float* tbl, int hi) {
    const float NEGINF = -__builtin_inff();
    asm volatile("" : "+v"(hi), "+v"(t));
    const int rel0 = (TYPE >= 2) ? t - 31 - 16 * (64 * blk + 4 * hi) : t - 64 * blk - 4 * hi;
    const int jlim = 255 - 64 * blk - 4 * hi;
#pragma unroll
    for (int q = 0; q < 4; ++q) {
        float bv[8]; int rl[8];
#pragma unroll
        for (int e = 0; e < 8; ++e) { const int r = 4 * q + (e & 3), h = e >> 2, kc = 32 * h + (r & 3) + 8 * (r >> 2);
            rl[e] = (TYPE >= 2) ? rel0 - 16 * kc : rel0 - kc;
            const int idx = rl[e] < 0 ? 0 : (rl[e] > 128 ? 128 : rl[e]);
            bv[e] = tbl[idx]; }
#pragma unroll
        for (int e = 0; e < 8; ++e) { const int r = 4 * q + (e & 3), h = e >> 2, kc = 32 * h + (r & 3) + 8 * (r >> 2);
            bool ok = rl[e] >= 0; if (TYPE == 1) ok = ok && rl[e] < 512; if (TYPE >= 2) ok = ok && kc < jlim;
            if (h) { const float v = P1[r] + (bv[e] - m); P1[r] = ok ? v : NEGINF; } else { const float v = P0[r] + (bv[e] - m); P0[r] = ok ? v : NEGINF; } }
        SBAR();
    }
}
template <int TYPE>
__device__ __forceinline__ void nsa_step(f32x16& C0, f32x16& C1, bool csel, int cblk, f32x16& N0, f32x16& N1, const LAS char* Kn, int vbc, bool has_next, TileInfo tn, bool nsel,
                                         const LAS char* ql, float& m, float& alc, float& l, f32x16 (&o)[4], float b128, int t, const LAS float* tbl, LAS unsigned* impr, int r32, int hi, unsigned long long* tacc = nullptr) {
    bf16x8 pa0, pa1, pa2, pa3; float ps = 0.f, ps2 = 0.f;
    SBAR();
    unsigned long long tp_ = 0ull; if ((PROBE_SPIN >> 13) & 3) tp_ = __builtin_amdgcn_s_memrealtime();
#define IMP_ADD(P, gq, J) do { const float own_ = 2.f * (P[4 * gq] + P[4 * gq + 1] + P[4 * gq + 2]) + P[4 * gq + 3]; \
        __hip_atomic_fetch_add(impr + 16 * cblk + hi + (J), (unsigned)(own_ * 67108864.f + 0.5f), __ATOMIC_RELAXED, __HIP_MEMORY_SCOPE_WORKGROUP); \
        __hip_atomic_fetch_add(impr + 16 * cblk + hi + (J) + 1, (unsigned)(P[4 * gq + 3] * 67108864.f + 0.5f), __ATOMIC_RELAXED, __HIP_MEMORY_SCOPE_WORKGROUP); } while (0)
#define SM2_SLICE(d) do { C1[2 * d] = __builtin_amdgcn_exp2f(C1[2 * d]); C1[2 * d + 1] = __builtin_amdgcn_exp2f(C1[2 * d + 1]); \
        if (TYPE != 2) { ps = fadd_s(ps, C0[2 * d]); ps2 = fadd_s(ps2, C0[2 * d + 1]); ps = fadd_s(ps, C1[2 * d]); ps2 = fadd_s(ps2, C1[2 * d + 1]); } \
        if (TYPE != 3) { if (d == 2) NSA_PK4(C0, 0, pa0); if (d == 4) NSA_PK4(C0, 8, pa1); if (d == 6) NSA_PK4(C1, 0, pa2); } \
        if (TYPE == 2 && (d & 1)) { IMP_ADD(C0, (d >> 1), 2 * (d >> 1)); IMP_ADD(C1, (d >> 1), 8 + 2 * (d >> 1)); } } while (0)
    N0 = f32x16{}; N1 = f32x16{};
    if (has_next) {
        bf16x8 qf[8], kf0[8], kf1[8];
        qf[0] = *(const LAS bf16x8*)(ql); kf0[0] = *(const LAS bf16x8*)(Kn + KSWZ(r32, hi * 16)); kf1[0] = *(const LAS bf16x8*)(Kn + KSWZ(32 + r32, hi * 16));
#pragma unroll
        for (int d = 0; d < 8; ++d) {
            if (d + 1 < 8) { const int cb = ((d + 1) * 16 + hi * 8) * 2; qf[d + 1] = *(const LAS bf16x8*)(ql + (d + 1) * 1024); kf0[d + 1] = *(const LAS bf16x8*)(Kn + KSWZ(r32, cb)); kf1[d + 1] = *(const LAS bf16x8*)(Kn + KSWZ(32 + r32, cb)); }
            N0 = __builtin_amdgcn_mfma_f32_32x32x16_bf16(kf0[d], qf[d], N0, 0, 0, 0);
            N1 = __builtin_amdgcn_mfma_f32_32x32x16_bf16(kf1[d], qf[d], N1, 0, 0, 0);
            SM2_SLICE(d);
            SBAR();
        }
    } else {
#pragma unroll
        for (int d = 0; d < 8; ++d) SM2_SLICE(d);
    }
#undef SM2_SLICE
#undef IMP_ADD
    if (TYPE != 3) NSA_PK4(C1, 8, pa3);
    if (TYPE == 0 && !__all(csel)) {
        const unsigned km = csel ? 0xffffffffu : 0u; ps = csel ? ps : 0.f; ps2 = csel ? ps2 : 0.f;
        u32x4 w0 = __builtin_bit_cast(u32x4, pa0), w1 = __builtin_bit_cast(u32x4, pa1), w2 = __builtin_bit_cast(u32x4, pa2), w3 = __builtin_bit_cast(u32x4, pa3);
        w0 &= km; w1 &= km; w2 &= km; w3 &= km;
        pa0 = __builtin_bit_cast(bf16x8, w0); pa1 = __builtin_bit_cast(bf16x8, w1); pa2 = __builtin_bit_cast(bf16x8, w2); pa3 = __builtin_bit_cast(bf16x8, w3); }
    if (TYPE != 2) { ps = xhalf_sum(ps + ps2); l = l * alc + ps; }
    SBAR();
    if (tacc && ((PROBE_SPIN >> 13) & 3)) { const unsigned long long n_ = __builtin_amdgcn_s_memrealtime(); if ((PROBE_SPIN >> 13) & 1) *tacc += n_ - tp_; tp_ = n_; }
    float aln = 1.f;
    const LAS char* vp = (const LAS char*)(size_t)(unsigned)vbc;
    s16x4 va[8], vb2[8];
#define VRD(D0, A) do { A[0] = vtr(vp + D0 * 512); A[1] = vtr(vp + D0 * 512 + 2048); A[2] = vtr(vp + D0 * 512 + 4096); A[3] = vtr(vp + D0 * 512 + 6144); \
                        A[4] = vtr(vp + D0 * 512 + 8192); A[5] = vtr(vp + D0 * 512 + 10240); A[6] = vtr(vp + D0 * 512 + 12288); A[7] = vtr(vp + D0 * 512 + 14336); } while (0)
#define PVM(OD, A) do { OD = __builtin_amdgcn_mfma_f32_32x32x16_bf16((bf16x8){A[0][0], A[0][1], A[0][2], A[0][3], A[1][0], A[1][1], A[1][2], A[1][3]}, pa0, OD, 0, 0, 0); \
                        OD = __builtin_amdgcn_mfma_f32_32x32x16_bf16((bf16x8){A[2][0], A[2][1], A[2][2], A[2][3], A[3][0], A[3][1], A[3][2], A[3][3]}, pa1, OD, 0, 0, 0); \
                        OD = __builtin_amdgcn_mfma_f32_32x32x16_bf16((bf16x8){A[4][0], A[4][1], A[4][2], A[4][3], A[5][0], A[5][1], A[5][2], A[5][3]}, pa2, OD, 0, 0, 0); \
                        OD = __builtin_amdgcn_mfma_f32_32x32x16_bf16((bf16x8){A[6][0], A[6][1], A[6][2], A[6][3], A[7][0], A[7][1], A[7][2], A[7][3]}, pa3, OD, 0, 0, 0); } while (0)
    if (TYPE != 3) { VRD(0, va); SBAR(); VRD(1, vb2); PVM(o[0], va); }
    if (has_next) {
        if (!tn.far) near_post<TYPE>(N0, N1, tn.blk, t, m + b128, tbl, hi);
        else if (__any(m != 0.f)) {
#pragma unroll
            for (int r = 0; r < 16; ++r) { N0[r] -= m; N1[r] -= m; } } }
    SBAR();
    if (TYPE != 3) { VRD(2, va); PVM(o[1], vb2); }
    float pmax = -__builtin_inff();
    if (TYPE != 2 && has_next) {
        if (TYPE <= 1) {
            float a = max3_s(N0[0], N0[1], N1[0]), b2 = max3_s(N0[2], N0[3], N1[1]); a = max3_s(a, N1[2], N1[3]);
#pragma unroll
            for (int r = 4; r < 16; r += 4) { a = max3_s(a, N0[r], N0[r + 1]); b2 = max3_s(b2, N0[r + 2], N0[r + 3]); a = max3_s(a, N1[r], N1[r + 1]); b2 = max3_s(b2, N1[r + 2], N1[r + 3]); }
            pmax = fmaxf(a, b2);
        } else {
#pragma unroll
            for (int r = 0; r < 16; ++r) pmax = fmaxf(pmax, fmaxf(N0[r], N1[r])); }
        pmax = xhalf_max(pmax); if (TYPE == 0) pmax = nsel ? pmax : -__builtin_inff(); }
    SBAR();
    if (TYPE != 3) { VRD(3, vb2); PVM(o[2], va); }
    if (TYPE != 2 && has_next && __any(pmax > NSA_THR)) {
        const float dl = fmaxf(pmax, 0.f); m += dl; aln = __builtin_amdgcn_exp2f(-dl);
#pragma unroll
        for (int r = 0; r < 16; ++r) { N0[r] -= dl; N1[r] -= dl; } }
    SBAR();
    if (TYPE != 3) PVM(o[3], vb2);
    if (has_next) {
#pragma unroll
        for (int r = 0; r < 16; ++r) N0[r] = __builtin_amdgcn_exp2f(N0[r]); }
    SBAR();
#undef VRD
#undef PVM
    if (TYPE < 2 && __any(aln != 1.f)) {
#pragma unroll
        for (int d = 0; d < 4; ++d)
#pragma unroll
            for (int r = 0; r < 16; ++r) o[d][r] *= aln; }
    alc = aln;
    if (tacc && ((PROBE_SPIN >> 14) & 1)) *tacc += __builtin_amdgcn_s_memrealtime() - tp_;
}
template <int TYPE, bool NEAR>
__device__ __forceinline__ bool nsa_fast(f32x16& C0, f32x16& C1, bool csel, f32x16& N0, f32x16& N1, const LAS char* Kn, int vbc, const LAS char* ql, float& l, f32x16 (&o)[4], int r32, int hi,
                                         int nblk = 0, int t = 0, float b128 = 0.f, const LAS float* tbl = nullptr) {
    bf16x8 pa0, pa1, pa2, pa3; float ps = 0.f, ps2 = 0.f;
    asm volatile("" : "+v"(r32), "+v"(hi));
    SBAR();
    N0 = f32x16{}; N1 = f32x16{};
    {   bf16x8 qf[8], kf0[8], kf1[8];
        qf[0] = *(const LAS bf16x8*)(ql); kf0[0] = *(const LAS bf16x8*)(Kn + KSWZ(r32, hi * 16)); kf1[0] = *(const LAS bf16x8*)(Kn + KSWZ(32 + r32, hi * 16));
#pragma unroll
        for (int d = 0; d < 8; ++d) {
            if (d + 1 < 8) { const int cb = ((d + 1) * 16 + hi * 8) * 2; qf[d + 1] = *(const LAS bf16x8*)(ql + (d + 1) * 1024); kf0[d + 1] = *(const LAS bf16x8*)(Kn + KSWZ(r32, cb)); kf1[d + 1] = *(const LAS bf16x8*)(Kn + KSWZ(32 + r32, cb)); }
            N0 = __builtin_amdgcn_mfma_f32_32x32x16_bf16(kf0[d], qf[d], N0, 0, 0, 0);
            N1 = __builtin_amdgcn_mfma_f32_32x32x16_bf16(kf1[d], qf[d], N1, 0, 0, 0);
            C1[2 * d] = __builtin_amdgcn_exp2f(C1[2 * d]); C1[2 * d + 1] = __builtin_amdgcn_exp2f(C1[2 * d + 1]);
            ps = fadd_s(ps, C0[2 * d]); ps2 = fadd_s(ps2, C0[2 * d + 1]); ps = fadd_s(ps, C1[2 * d]); ps2 = fadd_s(ps2, C1[2 * d + 1]);
            if (d == 2) NSA_PK4(C0, 0, pa0); if (d == 4) NSA_PK4(C0, 8, pa1); if (d == 6) NSA_PK4(C1, 0, pa2);
            SBAR();
        } }
    NSA_PK4(C1, 8, pa3);
    if (TYPE == 0 && !__all(csel)) {
        const unsigned km = csel ? 0xffffffffu : 0u; ps = csel ? ps : 0.f; ps2 = csel ? ps2 : 0.f;
        u32x4 w0 = __builtin_bit_cast(u32x4, pa0), w1 = __builtin_bit_cast(u32x4, pa1), w2 = __builtin_bit_cast(u32x4, pa2), w3 = __builtin_bit_cast(u32x4, pa3);
        w0 &= km; w1 &= km; w2 &= km; w3 &= km;
        pa0 = __builtin_bit_cast(bf16x8, w0); pa1 = __builtin_bit_cast(bf16x8, w1); pa2 = __builtin_bit_cast(bf16x8, w2); pa3 = __builtin_bit_cast(bf16x8, w3); }
    ps = xhalf_sum(ps + ps2); l += ps;
    SBAR();
    const LAS char* vp = (const LAS char*)(size_t)(unsigned)vbc;
    s16x4 va[8], vb2[8];
#define VRD(D0, A) do { A[0] = vtr(vp + D0 * 512); A[1] = vtr(vp + D0 * 512 + 2048); A[2] = vtr(vp + D0 * 512 + 4096); A[3] = vtr(vp + D0 * 512 + 6144); \
                        A[4] = vtr(vp + D0 * 512 + 8192); A[5] = vtr(vp + D0 * 512 + 10240); A[6] = vtr(vp + D0 * 512 + 12288); A[7] = vtr(vp + D0 * 512 + 14336); } while (0)
#define PVM(OD, A) do { OD = __builtin_amdgcn_mfma_f32_32x32x16_bf16((bf16x8){A[0][0], A[0][1], A[0][2], A[0][3], A[1][0], A[1][1], A[1][2], A[1][3]}, pa0, OD, 0, 0, 0); \
                        OD = __builtin_amdgcn_mfma_f32_32x32x16_bf16((bf16x8){A[2][0], A[2][1], A[2][2], A[2][3], A[3][0], A[3][1], A[3][2], A[3][3]}, pa1, OD, 0, 0, 0); \
                        OD = __builtin_amdgcn_mfma_f32_32x32x16_bf16((bf16x8){A[4][0], A[4][1], A[4][2], A[4][3], A[5][0], A[5][1], A[5][2], A[5][3]}, pa2, OD, 0, 0, 0); \
                        OD = __builtin_amdgcn_mfma_f32_32x32x16_bf16((bf16x8){A[6][0], A[6][1], A[6][2], A[6][3], A[7][0], A[7][1], A[7][2], A[7][3]}, pa3, OD, 0, 0, 0); } while (0)
#define EXQ(R0) do { N0[R0] = __builtin_amdgcn_exp2f(N0[R0]); N0[R0 + 1] = __builtin_amdgcn_exp2f(N0[R0 + 1]); N0[R0 + 2] = __builtin_amdgcn_exp2f(N0[R0 + 2]); N0[R0 + 3] = __builtin_amdgcn_exp2f(N0[R0 + 3]); } while (0)
    if (!NEAR) {
        VRD(0, va); SBAR(); VRD(1, vb2); PVM(o[0], va); EXQ(0);
        SBAR();
        VRD(2, va); PVM(o[1], vb2); EXQ(4);
        SBAR();
        VRD(3, vb2); PVM(o[2], va); EXQ(8);
        SBAR();
        PVM(o[3], vb2); EXQ(12);
        SBAR();
    } else {
        VRD(0, va); SBAR(); VRD(1, vb2); PVM(o[0], va);
        near_post<TYPE>(N0, N1, nblk, t, b128, tbl, hi);
        SBAR();
        VRD(2, va); PVM(o[1], vb2); EXQ(0); EXQ(4);
        SBAR();
        VRD(3, vb2); PVM(o[2], va); EXQ(8);
        SBAR();
        PVM(o[3], vb2); EXQ(12);
        SBAR();
    }
#undef VRD
#undef PVM
#undef EXQ
    return __any(ps > 1.0e12f);
}
template <int TYPE>
__device__ __forceinline__ void nsa_branch_compute(const LAS char* Kl, int vb, const LAS int* tl, int n, const LAS char* ql, int t, int s0, unsigned long long mymask, const LAS float* tbl,
                                                   float& m, float& l, f32x16 (&o)[4], LAS unsigned* impr, int r32, int hi, bool nocompute) {
    float alc = 1.f; l = 0.f;
    if (TYPE != 3) {
#pragma unroll
        for (int d = 0; d < 4; ++d) o[d] = f32x16{}; }
    f32x16 pA0, pA1, pB0, pB1;
    if (nocompute) { l = 1.f; __syncthreads(); for (int i = 0; i < n; ++i) __syncthreads(); __syncthreads(); return; }
    const float b128 = tbl[128];
    __syncthreads();
    TileInfo ta = tile_info<TYPE>(tl[0], s0), tb_; bool sa = (TYPE == 0) ? ((mymask >> ta.blk) & 1ull) != 0ull : true, sb = true;
    {
        qkt_lq(pA0, pA1, Kl, ql, r32, hi);
        m = 0.f;
        if (!ta.far) near_post<TYPE>(pA0, pA1, ta.blk, t, b128, tbl, hi);
        float pmax = -__builtin_inff();
#pragma unroll
        for (int r = 0; r < 16; ++r) pmax = fmaxf(pmax, fmaxf(pA0[r], pA1[r]));
        pmax = xhalf_max(pmax); if (TYPE == 0) pmax = sa ? pmax : -__builtin_inff();
        if (__any(pmax > NSA_THR)) { m = fmaxf(pmax, 0.f);
#pragma unroll
            for (int r = 0; r < 16; ++r) { pA0[r] -= m; pA1[r] -= m; } }
#pragma unroll
        for (int r = 0; r < 16; ++r) pA0[r] = __builtin_amdgcn_exp2f(pA0[r]); }
    int kq = 16384, vq = 0;
#define NSA_ROT() do { kq = (kq == 32768) ? 0 : kq + 16384; vq = (vq == 32768) ? 0 : vq + 16384; } while (0)
    for (int i = 0; i < n; i += 2) {
        __syncthreads();
        { const bool hn = i + 1 < n; tb_ = tile_info<TYPE>(hn ? tl[i + 1] : 0, s0); sb = (TYPE == 0) ? ((mymask >> tb_.blk) & 1ull) != 0ull : true;
          nsa_step<TYPE>(pA0, pA1, sa, ta.blk, pB0, pB1, Kl + kq, vb + vq, hn, tb_, sb, ql, m, alc, l, o, b128, t, tbl, impr, r32, hi); }
        NSA_ROT();
        if (i + 1 >= n) break;
        __syncthreads();
        { const bool hn = i + 2 < n; ta = tile_info<TYPE>(hn ? tl[i + 2] : 0, s0); sa = (TYPE == 0) ? ((mymask >> ta.blk) & 1ull) != 0ull : true;
          nsa_step<TYPE>(pB0, pB1, sb, tb_.blk, pA0, pA1, Kl + kq, vb + vq, hn, ta, sa, ql, m, alc, l, o, b128, t, tbl, impr, r32, hi); }
        NSA_ROT();
    }
#undef NSA_ROT
    __syncthreads();
}
__device__ __forceinline__ void nsa_cmp_pass2(const LAS char* Kl, int vb, int n, const LAS char* ql, int t, int s0, const LAS float* tbl, float m2, f32x16 (&o)[4], LAS unsigned* impr, int r32, int hi) {
#pragma unroll
    for (int d = 0; d < 4; ++d) o[d] = f32x16{};
    bf16x8 pa0, pa1, pa2, pa3;
    const float b128 = tbl[128];
#define CMP_TILE(j, Kslot) do { f32x16 p0_, p1_; qkt_lq(p0_, p1_, Kslot, ql, r32, hi); const TileInfo ti_ = tile_info<2>(j, s0); \
        if (ti_.far) { _Pragma("unroll") for (int r = 0; r < 16; ++r) { p0_[r] = __builtin_amdgcn_exp2f(p0_[r] - m2); p1_[r] = __builtin_amdgcn_exp2f(p1_[r] - m2); } } \
        else { near_post<2>(p0_, p1_, j, t, m2 + b128, tbl, hi); _Pragma("unroll") for (int r = 0; r < 16; ++r) { p0_[r] = __builtin_amdgcn_exp2f(p0_[r]); p1_[r] = __builtin_amdgcn_exp2f(p1_[r]); } } \
        _Pragma("unroll") for (int gq = 0; gq < 4; ++gq) { \
            { const float own_ = 2.f * (p0_[4 * gq] + p0_[4 * gq + 1] + p0_[4 * gq + 2]) + p0_[4 * gq + 3]; \
              __hip_atomic_fetch_add(impr + 16 * (j) + hi + 2 * gq, (unsigned)(own_ * 67108864.f + 0.5f), __ATOMIC_RELAXED, __HIP_MEMORY_SCOPE_WORKGROUP); \
              __hip_atomic_fetch_add(impr + 16 * (j) + hi + 2 * gq + 1, (unsigned)(p0_[4 * gq + 3] * 67108864.f + 0.5f), __ATOMIC_RELAXED, __HIP_MEMORY_SCOPE_WORKGROUP); } \
            { const float own_ = 2.f * (p1_[4 * gq] + p1_[4 * gq + 1] + p1_[4 * gq + 2]) + p1_[4 * gq + 3]; \
              __hip_atomic_fetch_add(impr + 16 * (j) + hi + 8 + 2 * gq, (unsigned)(own_ * 67108864.f + 0.5f), __ATOMIC_RELAXED, __HIP_MEMORY_SCOPE_WORKGROUP); \
              __hip_atomic_fetch_add(impr + 16 * (j) + hi + 8 + 2 * gq + 1, (unsigned)(p1_[4 * gq + 3] * 67108864.f + 0.5f), __ATOMIC_RELAXED, __HIP_MEMORY_SCOPE_WORKGROUP); } } \
        pack_p(p0_, p1_, pa0, pa1, pa2, pa3); } while (0)
    __syncthreads();
    CMP_TILE(0, Kl);
    for (int i = 0; i < n; ++i) {
        __syncthreads();
        pv_all<4>(o, vb + (i % 3) * 16384, pa0, pa1, pa2, pa3);
        if (i + 1 < n) CMP_TILE(i + 1, Kl + ((i + 1) % 3) * 16384);
    }
    __syncthreads();
#undef CMP_TILE
}
__device__ __forceinline__ void dma_k2(LAS char* Kslot, const bf16_t* kp, size_t ld, int wave, int lane) {
    asm volatile("" : "+v"(lane));
#pragma unroll
    for (int i = 0; i < 2; ++i) { const int pc = wave * 2 + i, row = pc * 4 + (lane >> 4), ch = (lane & 15) ^ (row & 15);
        __builtin_amdgcn_global_load_lds((const unsigned*)(kp + (size_t)row * ld + ch * 8), (LAS unsigned*)(Kslot + pc * 1024), 16, 0, 0); }
}
__device__ __forceinline__ void dma_v2(LAS char* Vslot, const bf16_t* vp, size_t ld, int wave, int lane) {
    asm volatile("" : "+v"(lane));
#pragma unroll
    for (int i = 0; i < 2; ++i) { const int pc = wave * 2 + i, cblk = 2 * (pc & 1) + (lane >> 5), kk = (pc >> 1) * 8 + ((lane & 31) >> 2), k = (kk & ~0xC) | ((kk & 4) << 1) | ((kk & 8) >> 1), c = cblk * 32 + (lane & 3) * 8;
        __builtin_amdgcn_global_load_lds((const unsigned*)(vp + (size_t)k * ld + c), (LAS unsigned*)(Vslot + pc * 1024), 16, 0, 0); }
}
struct DmaOfs { unsigned k[2], v[2]; };
__device__ __forceinline__ DmaOfs dma_ofs(int wave, int lane) {
    DmaOfs d;
#pragma unroll
    for (int i = 0; i < 2; ++i) { const int pc = wave * 2 + i, row = pc * 4 + (lane >> 4), ch = (lane & 15) ^ (row & 15); d.k[i] = (unsigned)(row * OD_LD + ch * 8) * 2u;
        const int cblk = 2 * (pc & 1) + (lane >> 5), kk = (pc >> 1) * 8 + ((lane & 31) >> 2), k = (kk & ~0xC) | ((kk & 4) << 1) | ((kk & 8) >> 1), c = cblk * 32 + (lane & 3) * 8; d.v[i] = (unsigned)(k * OD_LD + c) * 2u; }
    return d;
}
__device__ __forceinline__ void dma_k2o(LAS char* Kslot, const bf16_t* kbase, int blk, const DmaOfs& d, int wave) {
    const char* tb = (const char*)(kbase + (size_t)__builtin_amdgcn_readfirstlane(blk) * 64 * OD_LD);
#pragma unroll
    for (int i = 0; i < 2; ++i) __builtin_amdgcn_global_load_lds((const unsigned*)(tb + d.k[i]), (LAS unsigned*)(Kslot + (wave * 2 + i) * 1024), 16, 0, 0);
}
__device__ __forceinline__ void dma_v2o(LAS char* Vslot, const bf16_t* vbase, int blk, const DmaOfs& d, int wave) {
    const char* tb = (const char*)(vbase + (size_t)__builtin_amdgcn_readfirstlane(blk) * 64 * OD_LD);
#pragma unroll
    for (int i = 0; i < 2; ++i) __builtin_amdgcn_global_load_lds((const unsigned*)(tb + d.v[i]), (LAS unsigned*)(Vslot + (wave * 2 + i) * 1024), 16, 0, 0);
}
template <int TYPE>
__device__ __forceinline__ void nsa_branch_all(LAS char* Kl, LAS char* Vl, const LAS int* tl, int n, const bf16_t* kbase, const bf16_t* vbase, const LAS char* ql, int t, int s0, unsigned long long mymask,
                                               const LAS float* tbl, float& l, f32x16 (&o)[4], int wave, int lane, unsigned long long* tacc = nullptr, bool k0_issued = false) {
    const int r32 = lane & 31, hi = lane >> 5;
    const DmaOfs dofs = dma_ofs(wave, lane);
    const int vb = lds_addr(Vl) + v_rd_base(lane);
    float m = 0.f, alc = 1.f; l = 0.f;
#pragma unroll
    for (int d = 0; d < 4; ++d) o[d] = f32x16{};
    f32x16 pA0, pA1, pB0, pB1;
    const float b128 = tbl[128];
    if (!k0_issued) dma_k2o(Kl, kbase, tl[0], dofs, wave);
    __syncthreads();
    if (n > 1) dma_k2o(Kl + 16384, kbase, tl[1], dofs, wave);
    dma_v2o(Vl, vbase, tl[0], dofs, wave);
    TileInfo ta = tile_info<TYPE>(tl[0], s0), tb_; bool sa = (TYPE == 0) ? ((mymask >> ta.blk) & 1ull) != 0ull : true, sb = true;
    {
        qkt_lq(pA0, pA1, Kl, ql, r32, hi);
        if (!ta.far) near_post<TYPE>(pA0, pA1, ta.blk, t, b128, tbl, hi);
        float pmax = -__builtin_inff();
#pragma unroll
        for (int r = 0; r < 16; ++r) pmax = fmaxf(pmax, fmaxf(pA0[r], pA1[r]));
        pmax = xhalf_max(pmax); if (TYPE == 0) pmax = sa ? pmax : -__builtin_inff();
        if (__any(pmax > NSA_THR)) { m = fmaxf(pmax, 0.f);
#pragma unroll
            for (int r = 0; r < 16; ++r) { pA0[r] -= m; pA1[r] -= m; } }
#pragma unroll
        for (int r = 0; r < 16; ++r) pA0[r] = __builtin_amdgcn_exp2f(pA0[r]); }
    bool plain = !__any(m != 0.f);
    int i = 0;
#define NSA_BAR() do { unsigned long long tq_ = 0ull; if ((PROBE_SPIN >> 12) & 1) tq_ = __builtin_amdgcn_s_memrealtime(); __syncthreads(); \
                       if (tacc && ((PROBE_SPIN >> 12) & 1)) *tacc += __builtin_amdgcn_s_memrealtime() - tq_; } while (0)
#define NSA_FARPAIR() (tile_info<TYPE>(tl[i + 1], s0).far && tile_info<TYPE>(tl[i + 2], s0).far)
#define NSA_GEN_PAIR() \
        NSA_BAR(); \
        if (i + 2 < n) dma_k2o(Kl, kbase, tl[i + 2], dofs, wave); \
        if (i + 1 < n) dma_v2o(Vl + 16384, vbase, tl[i + 1], dofs, wave); \
        { const bool hn = i + 1 < n; tb_ = tile_info<TYPE>(hn ? tl[i + 1] : 0, s0); sb = (TYPE == 0) ? ((mymask >> tb_.blk) & 1ull) != 0ull : true; \
          nsa_step<TYPE>(pA0, pA1, sa, ta.blk, pB0, pB1, Kl + 16384, vb, hn, tb_, sb, ql, m, alc, l, o, b128, t, tbl, nullptr, r32, hi, tacc); } \
        if (i + 1 >= n) { i = n; break; } \
        NSA_BAR(); \
        if (i + 3 < n) dma_k2o(Kl + 16384, kbase, tl[i + 3], dofs, wave); \
        if (i + 2 < n) dma_v2o(Vl, vbase, tl[i + 2], dofs, wave); \
        { const bool hn = i + 2 < n; ta = tile_info<TYPE>(hn ? tl[i + 2] : 0, s0); sa = (TYPE == 0) ? ((mymask >> ta.blk) & 1ull) != 0ull : true; \
          nsa_step<TYPE>(pB0, pB1, sb, tb_.blk, pA0, pA1, Kl, vb + 16384, hn, ta, sa, ql, m, alc, l, o, b128, t, tbl, nullptr, r32, hi, tacc); }
#define NSA_FAST_PAIR(NEARF) \
        NSA_BAR(); \
        dma_k2o(Kl, kbase, tl[i + 2], dofs, wave); \
        dma_v2o(Vl + 16384, vbase, tl[i + 1], dofs, wave); \
        sb = (TYPE == 0) ? ((mymask >> tl[i + 1]) & 1ull) != 0ull : true; \
        const bool f1 = nsa_fast<TYPE, NEARF>(pA0, pA1, sa, pB0, pB1, Kl + 16384, vb, ql, l, o, r32, hi, tl[i + 1], t, b128, tbl); \
        NSA_BAR(); \
        if (i + 3 < n) dma_k2o(Kl + 16384, kbase, tl[i + 3], dofs, wave); \
        dma_v2o(Vl, vbase, tl[i + 2], dofs, wave); \
        sa = (TYPE == 0) ? ((mymask >> tl[i + 2]) & 1ull) != 0ull : true; \
        const bool f2 = nsa_fast<TYPE, NEARF>(pB0, pB1, sb, pA0, pA1, Kl, vb + 16384, ql, l, o, r32, hi, tl[i + 2], t, b128, tbl); \
        plain = !(f1 || f2); \
        i += 2;
    if (TYPE == 1) {
#pragma unroll 1
        while (plain && i + 2 < n && i < 2 && !NSA_FARPAIR()) { NSA_FAST_PAIR(true) }
    }
#pragma unroll 1
    while (plain && i + 2 < n && NSA_FARPAIR()) { NSA_FAST_PAIR(false) }
#pragma unroll 1
    while (plain && i + 2 < n) { NSA_FAST_PAIR(true) }
#pragma unroll 1
    for (; i < n; i += 2) {
        NSA_GEN_PAIR()
    }
#undef NSA_FAST_PAIR
#undef NSA_FARPAIR
#undef NSA_GEN_PAIR
#undef NSA_BAR
    __syncthreads();
}
__device__ __forceinline__ void nsa_wait_vm(int n) {
    if (n >= 16) asm volatile("s_waitcnt vmcnt(16)" ::: "memory"); else if (n >= 8) asm volatile("s_waitcnt vmcnt(8)" ::: "memory"); else asm volatile("s_waitcnt vmcnt(0)" ::: "memory");
}
__device__ __forceinline__ void nsa_branch_load(LAS char* Kl, LAS char* Vl, const LAS int* tl, int n, const bf16_t* kbase, const bf16_t* vbase, size_t ld, bool with_v, int lw, int lane) {
    dma_k(Kl, kbase + (size_t)tl[0] * 64 * ld, ld, lw, lane);
    int c = 0;
    if (n > 1) { dma_k(Kl + 16384, kbase + (size_t)tl[1] * 64 * ld, ld, lw, lane); c += 8; }
    if (with_v) { dma_v(Vl, vbase + (size_t)tl[0] * 64 * ld, ld, lw, lane); c += 8; }
    nsa_wait_vm(c); __builtin_amdgcn_s_barrier();
    int ks = 32768, vs = 16384;
    for (int s = 0; s < n; ++s) {
        c = 0;
        if (s + 2 < n) { dma_k(Kl + ks, kbase + (size_t)tl[s + 2] * 64 * ld, ld, lw, lane); c += 8; }
        if (with_v && s + 1 < n) { dma_v(Vl + vs, vbase + (size_t)tl[s + 1] * 64 * ld, ld, lw, lane); c += 8; }
        nsa_wait_vm(c); __builtin_amdgcn_s_barrier();
        ks = (ks == 32768) ? 0 : ks + 16384; vs = (vs == 32768) ? 0 : vs + 16384;
    }
    asm volatile("s_waitcnt vmcnt(0)" ::: "memory"); __builtin_amdgcn_s_barrier();
}
__device__ __forceinline__ void nsa_topk(const LAS unsigned* imp, LAS unsigned long long* selm, int wave, int lane, int s0) {
    const int cur = s0 >> 6;
    unsigned v[4], thr[4];
#pragma unroll
    for (int i = 0; i < 4; ++i) { const int tt = wave * 4 + i, tq = s0 + tt;
        unsigned x = imp[tt * 65 + lane] + 1u;
        const bool forced = (lane == 0) || (lane == cur) || (lane == cur - 1), future = lane * 64 > tq;
        v[i] = forced ? 0xffffffffu : (future ? 0u : x); thr[i] = 0u; }
#pragma unroll
    for (int b = 31; b >= 0; --b)
#pragma unroll
        for (int i = 0; i < 4; ++i) { const unsigned cand = thr[i] | (1u << b); if (__builtin_popcountll(__ballot(v[i] >= cand)) >= 8) thr[i] = cand; }
#pragma unroll
    for (int i = 0; i < 4; ++i) { const int tt = wave * 4 + i;
        const unsigned long long gt = __ballot(v[i] > thr[i]), eq = __ballot(v[i] == thr[i]);
        const int need = 8 - __builtin_popcountll(gt);
        const int myord = __builtin_popcountll(eq & ((1ull << lane) - 1ull));
        unsigned long long msk = gt | __ballot(v[i] == thr[i] && myord < need);
        msk &= (2ull << cur) - 1ull;
        if (lane == 0) selm[tt] = msk; }
}
__device__ __forceinline__ unsigned long long nsa_union(unsigned long long mymask) {
    unsigned lo = (unsigned)mymask, hi32 = (unsigned)(mymask >> 32);
#pragma unroll
    for (int off = 1; off < 32; off <<= 1) { lo |= __shfl_xor(lo, off); hi32 |= __shfl_xor(hi32, off); }
    return ((unsigned long long)(unsigned)__builtin_amdgcn_readfirstlane(hi32) << 32) | (unsigned)__builtin_amdgcn_readfirstlane(lo);
}
constexpr int NSA_V_OFF = 49152, NSA_Q_OFF = 98304, NSA_IMP_OFF = NSA_Q_OFF + 6 * 8192, NSA_LIST_OFF = NSA_IMP_OFF + 32 * 65 * 4, NSA_SEL_OFF = NSA_LIST_OFF + 96 * 4, NSA_TB_OFF = NSA_SEL_OFF + 1024;
constexpr int NSA2_V_OFF = 32768, NSA2_Q_OFF = 65536, NSA2_SCR_OFF = 131072;
static_assert(NSA_TB_OFF + 12 * 132 * 4 <= MISC_OFF && NSA2_SCR_OFF + 8 * 2560 <= NSA_LIST_OFF, "nsa lds");
constexpr int ACC_LD = 1536;
__device__ __forceinline__ void q_park(LAS char* qdst  , const bf16_t* q0  , int lane) {
    constexpr float C = 0.08838834764831845f * LOG2E;
#pragma unroll
    for (int i = 0; i < 8; ++i) { const int T = 4 * i + (lane >> 4), c = lane & 15;
        u32x4 w = *(const u32x4*)(q0 + (size_t)T * OD_LD + c * 8);
        w.x = cvt_pk_bf16(__builtin_bit_cast(float, w.x << 16) * C, __builtin_bit_cast(float, w.x & 0xffff0000u) * C); w.y = cvt_pk_bf16(__builtin_bit_cast(float, w.y << 16) * C, __builtin_bit_cast(float, w.y & 0xffff0000u) * C);
        w.z = cvt_pk_bf16(__builtin_bit_cast(float, w.z << 16) * C, __builtin_bit_cast(float, w.z & 0xffff0000u) * C); w.w = cvt_pk_bf16(__builtin_bit_cast(float, w.w << 16) * C, __builtin_bit_cast(float, w.w & 0xffff0000u) * C);
        *(LAS u32x4*)(qdst + (c >> 1) * 1024 + ((c & 1) * 32 + T) * 16) = w; }
}
__device__ __forceinline__ void q_pieces(u32x4 (&wq)[4][2], const bf16_t* q0, int lane) {
#pragma unroll
    for (int p = 0; p < 4; ++p)
#pragma unroll
        for (int k = 0; k < 2; ++k) { const int id = lane + 64 * k, T = id >> 2, c = 4 * p + (id & 3); wq[p][k] = *(const u32x4*)(q0 + (size_t)T * OD_LD + c * 8); }
}
__device__ __forceinline__ void q_regs(bf16x8 (&qr)[8], LAS char* scr, const u32x4 (&wq)[4][2], int lane) {
    constexpr float C = 0.08838834764831845f * LOG2E;
#pragma unroll
    for (int p = 0; p < 4; ++p) {
#pragma unroll
        for (int k = 0; k < 2; ++k) { const int id = lane + 64 * k, T = id >> 2, cc = id & 3;
            u32x4 w = wq[p][k];
            w.x = cvt_pk_bf16(__builtin_bit_cast(float, w.x << 16) * C, __builtin_bit_cast(float, w.x & 0xffff0000u) * C); w.y = cvt_pk_bf16(__builtin_bit_cast(float, w.y << 16) * C, __builtin_bit_cast(float, w.y & 0xffff0000u) * C);
            w.z = cvt_pk_bf16(__builtin_bit_cast(float, w.z << 16) * C, __builtin_bit_cast(float, w.z & 0xffff0000u) * C); w.w = cvt_pk_bf16(__builtin_bit_cast(float, w.w << 16) * C, __builtin_bit_cast(float, w.w & 0xffff0000u) * C);
            *(LAS u32x4*)(scr + (cc >> 1) * 1024 + ((cc & 1) * 32 + T) * 16) = w; }
        asm volatile("s_waitcnt lgkmcnt(0)" ::: "memory");
        qr[2 * p] = *(const LAS bf16x8*)(scr + lane * 16); qr[2 * p + 1] = *(const LAS bf16x8*)(scr + 1024 + lane * 16);
        asm volatile("s_waitcnt lgkmcnt(0)" ::: "memory");
    }
}
__device__ __forceinline__ void cmp_pass1_res(const LAS char* Kres, int n, const bf16x8 (&qr)[8], int t, int s0, const LAS float* tbl, float& m, float& l, int r32, int hi) {
    const float b128 = tbl[128], NEGINF = -__builtin_inff();
    m = NEGINF; l = 0.f;
    for (int j = 0; j < n; ++j) {
        f32x16 p0, p1; qkt(p0, p1, Kres + j * 16384, qr, r32, hi);
        const TileInfo ti = tile_info<3>(j, s0);
        if (!ti.far) near_post<3>(p0, p1, j, t, b128, tbl, hi);
        float pmax = NEGINF;
#pragma unroll
        for (int r = 0; r < 16; ++r) pmax = fmaxf(pmax, fmaxf(p0[r], p1[r]));
        pmax = xhalf_max(pmax);
        const float mn = fmaxf(m, pmax), mref = (mn == NEGINF) ? 0.f : mn;
        float ps = 0.f, ps2 = 0.f;
#pragma unroll
        for (int r = 0; r < 16; ++r) { ps += __builtin_amdgcn_exp2f(p0[r] - mref); ps2 += __builtin_amdgcn_exp2f(p1[r] - mref); }
        l = l * __builtin_amdgcn_exp2f(m - mref) + xhalf_sum(ps + ps2); m = mn;
    }
}
__device__ __forceinline__ void cmp_pass2_res(const LAS char* Kres, int vb, int n, const bf16x8 (&qr)[8], int t, int s0, const LAS float* tbl, float m2, f32x16 (&o)[4], LAS unsigned* impr, int r32, int hi) {
#pragma unroll
    for (int d = 0; d < 4; ++d) o[d] = f32x16{};
    const float b128 = tbl[128];
    for (int j = 0; j < n; ++j) {
        f32x16 p0_, p1_; qkt(p0_, p1_, Kres + j * 16384, qr, r32, hi);
        const TileInfo ti_ = tile_info<2>(j, s0);
        if (ti_.far) {
#pragma unroll
            for (int r = 0; r < 16; ++r) { p0_[r] = __builtin_amdgcn_exp2f(p0_[r] - m2); p1_[r] = __builtin_amdgcn_exp2f(p1_[r] - m2); } }
        else { near_post<2>(p0_, p1_, j, t, m2 + b128, tbl, hi);
#pragma unroll
            for (int r = 0; r < 16; ++r) { p0_[r] = __builtin_amdgcn_exp2f(p0_[r]); p1_[r] = __builtin_amdgcn_exp2f(p1_[r]); } }
#pragma unroll
        for (int gq = 0; gq < 4; ++gq) {
            { const float own_ = 2.f * (p0_[4 * gq] + p0_[4 * gq + 1] + p0_[4 * gq + 2]) + p0_[4 * gq + 3];
              __hip_atomic_fetch_add(impr + 16 * j + hi + 2 * gq, (unsigned)(own_ * 67108864.f + 0.5f), __ATOMIC_RELAXED, __HIP_MEMORY_SCOPE_WORKGROUP);
              __hip_atomic_fetch_add(impr + 16 * j + hi + 2 * gq + 1, (unsigned)(p0_[4 * gq + 3] * 67108864.f + 0.5f), __ATOMIC_RELAXED, __HIP_MEMORY_SCOPE_WORKGROUP); }
            { const float own_ = 2.f * (p1_[4 * gq] + p1_[4 * gq + 1] + p1_[4 * gq + 2]) + p1_[4 * gq + 3];
              __hip_atomic_fetch_add(impr + 16 * j + hi + 8 + 2 * gq, (unsigned)(own_ * 67108864.f + 0.5f), __ATOMIC_RELAXED, __HIP_MEMORY_SCOPE_WORKGROUP);
              __hip_atomic_fetch_add(impr + 16 * j + hi + 8 + 2 * gq + 1, (unsigned)(p1_[4 * gq + 3] * 67108864.f + 0.5f), __ATOMIC_RELAXED, __HIP_MEMORY_SCOPE_WORKGROUP); } }
        bf16x8 pa0, pa1, pa2, pa3; pack_p(p0_, p1_, pa0, pa1, pa2, pa3);
        pv_all<4>(o, vb + j * 16384, pa0, pa1, pa2, pa3);
    }
}
__device__ __forceinline__ float cmp_single_res(const LAS char* Kres, int vb, int n, const bf16x8 (&qr)[8], int t, int s0, const LAS float* tbl, f32x16 (&o)[4], LAS unsigned* impr, int r32, int hi) {
    const float b128 = tbl[128], NEGINF = -__builtin_inff();
    f32x16 sa[4], sb[4];
    float m = NEGINF;
#pragma unroll
    for (int j = 0; j < 4; ++j) if (j < n) {
        qkt(sa[j], sb[j], Kres + j * 16384, qr, r32, hi);
        const TileInfo ti = tile_info<3>(j, s0);
        if (!ti.far) near_post<3>(sa[j], sb[j], j, t, b128, tbl, hi);
        float pmax = NEGINF;
#pragma unroll
        for (int r = 0; r < 16; ++r) pmax = fmaxf(pmax, fmaxf(sa[j][r], sb[j][r]));
        m = fmaxf(m, pmax); }
    m = xhalf_max(m);
    const float mref = (m == NEGINF) ? 0.f : m;
    float ps = 0.f, ps2 = 0.f;
#pragma unroll
    for (int j = 0; j < 4; ++j) if (j < n) {
#pragma unroll
        for (int r = 0; r < 16; ++r) { sa[j][r] = __builtin_amdgcn_exp2f(sa[j][r] - mref); sb[j][r] = __builtin_amdgcn_exp2f(sb[j][r] - mref); ps += sa[j][r]; ps2 += sb[j][r]; } }
    const float l = xhalf_sum(ps + ps2);
    const float inv = (l > 0.f && t >= 31) ? 1.0f / l : 0.f;
    const float fx = inv * 67108864.f;
#pragma unroll
    for (int d = 0; d < 4; ++d) o[d] = f32x16{};
#pragma unroll
    for (int j = 0; j < 4; ++j) if (j < n) {
#pragma unroll
        for (int gq = 0; gq < 4; ++gq) {
            { const float own_ = 2.f * (sa[j][4 * gq] + sa[j][4 * gq + 1] + sa[j][4 * gq + 2]) + sa[j][4 * gq + 3];
              __hip_atomic_fetch_add(impr + 16 * j + hi + 2 * gq, (unsigned)(own_ * fx + 0.5f), __ATOMIC_RELAXED, __HIP_MEMORY_SCOPE_WORKGROUP);
              __hip_atomic_fetch_add(impr + 16 * j + hi + 2 * gq + 1, (unsigned)(sa[j][4 * gq + 3] * fx + 0.5f), __ATOMIC_RELAXED, __HIP_MEMORY_SCOPE_WORKGROUP); }
            { const float own_ = 2.f * (sb[j][4 * gq] + sb[j][4 * gq + 1] + sb[j][4 * gq + 2]) + sb[j][4 * gq + 3];
              __hip_atomic_fetch_add(impr + 16 * j + hi + 8 + 2 * gq, (unsigned)(own_ * fx + 0.5f), __ATOMIC_RELAXED, __HIP_MEMORY_SCOPE_WORKGROUP);
              __hip_atomic_fetch_add(impr + 16 * j + hi + 8 + 2 * gq + 1, (unsigned)(sb[j][4 * gq + 3] * fx + 0.5f), __ATOMIC_RELAXED, __HIP_MEMORY_SCOPE_WORKGROUP); } }
        bf16x8 pa0, pa1, pa2, pa3; pack_p(sa[j], sb[j], pa0, pa1, pa2, pa3);
        pv_all<4>(o, vb + j * 16384, pa0, pa1, pa2, pa3); }
    return inv;
}
__device__ __forceinline__ void nsa_phase(const Frame& F, bf16_t* Z, const float* gates, const bf16_t* kcmp, const bf16_t* vcmp, const float* tbias, bf16_t* ACC, unsigned long long& tacc) {
    const int wave = F.wave;
    LAS char* Kl = (LAS char*)F.lds; LAS char* Vl = Kl + NSA_V_OFF;
    LAS unsigned* imp = (LAS unsigned*)(Kl + NSA_IMP_OFF); LAS unsigned long long* selm = (LAS unsigned long long*)(Kl + NSA_SEL_OFF); LAS float* tb = (LAS float*)(Kl + NSA_TB_OFF);
    LAS int* tls = (LAS int*)(Kl + NSA_LIST_OFF); LAS int* tlw = tls + 72; LAS int* tlc = tls + 88;
    const bool cw = wave < 6;
    for (int i = F.tid; i < 12 * 132; i += 512) tb[i] = tbias[i];
    if (F.tid < 4) tlc[F.tid] = F.tid;
    for (int round = 0; round < 2; ++round) {
        const int rank = round * 256 + ((round & 1) ? (255 - F.bid) : F.bid);
        if (F.bid >= 256) break;
        const int bg = rank & 15, b = bg >> 1, g = bg & 1, T0 = (31 - (rank >> 4)) * 128;
        bf16_t* zb = Z + (size_t)b * SEQ * OD_LD;
        const bf16_t* kc = kcmp + (size_t)bg * 256 * 128; const bf16_t* vc = vcmp + (size_t)bg * 256 * 128;
        unsigned long long tp1_ = 0ull; if ((PROBE_SPIN >> 15) & 1) tp1_ = __builtin_amdgcn_s_memrealtime();
        { const int ntc_su = ((((T0 + 96) >> 4) > 254 ? 254 : ((T0 + 96) >> 4)) >> 6) + 1;
          int ld_ = F.tid & 63;
          for (int j = 0; j < ntc_su; ++j) { dma_k2(Kl + j * 16384, kc + (size_t)j * 64 * 128, 128, wave, ld_); dma_v2(Kl + 65536 + j * 16384, vc + (size_t)j * 64 * 128, 128, wave, ld_); } }
        for (int sub = 0; sub < 4; ++sub) {
            int tid = F.tid; asm volatile("" : "+v"(tid));
            const int lane = tid & 63, r32 = lane & 31, hi = lane >> 5;
            const int s0 = T0 + 32 * sub, t = s0 + r32;
            const int jmax = (s0 >> 4) > 254 ? 254 : (s0 >> 4), ntc = (jmax >> 6) + 1;
            for (int i = tid; i < 32 * 65; i += 512) imp[i] = 0u;
            __syncthreads();
            if (cw) {
                const int head = wave, hg = g * 6 + head;
                const int vb = lds_addr(Kl + 65536) + v_rd_base(lane);
                const LAS float* tbl = tb + hg * 132;
                LAS unsigned* impr = imp + r32 * 65;
                LAS char* scr = Kl + 131072 + wave * 2560;
                bf16x8 qr[8]; { u32x4 wq[4][2]; q_pieces(wq, zb + (size_t)s0 * OD_LD + OD_Q + hg * 128, lane); q_regs(qr, scr, wq, lane); }
                f32x16 o[4];
                const float inv = cmp_single_res(Kl, vb, ntc, qr, t, s0, tbl, o, impr, r32, hi);
                { int tv = t; asm volatile("" : "+v"(tv));
                  acc_step<0>(scr, ACC + ((size_t)b * SEQ + s0) * ACC_LD + hg * 128, ACC_LD, nullptr, 0, o, gates[((size_t)b * SEQ + tv) * GATE_LD + hg] * inv, (tv & 31) | (hi << 5), false); }
            }
            __syncthreads();
            nsa_topk(imp, selm + sub * 32, wave, lane, s0);
            __syncthreads();
        }
        if ((PROBE_SPIN >> 15) & 1) tacc += __builtin_amdgcn_s_memrealtime() - tp1_;
        for (int rr = 0; rr < 3; ++rr) {
            int tid = F.tid; asm volatile("" : "+v"(tid));
            const int lane = tid & 63, r32 = lane & 31, hi = lane >> 5;
            const int task = 8 * rr + wave, sub = task / 6, head = task - 6 * sub, hg = g * 6 + head, s0 = T0 + 32 * sub, t = s0 + r32;
            const LAS float* tbl = tb + hg * 132;
            LAS char* K2 = Kl; LAS char* V2 = Kl + NSA2_V_OFF;
            const LAS char* ql = Kl + NSA2_Q_OFF + wave * 8192 + lane * 16;
            q_park(Kl + NSA2_Q_OFF + wave * 8192, zb + (size_t)s0 * OD_LD + OD_Q + hg * 128, lane);
            const unsigned long long mymask = selm[sub * 32 + r32];
            const int s_lo = T0 + 32 * rr, s_hi = s_lo + 32, cur_hi = s_hi >> 6;
            const int jt0 = (s_lo - 511) < 0 ? 0 : (s_lo - 511) >> 6, ntw = cur_hi - jt0 + 1;
            unsigned long long uni;
            { const unsigned long long mk = selm[rr * 32 + lane]; unsigned lo = (unsigned)mk, h32 = (unsigned)(mk >> 32);
#pragma unroll
              for (int off = 1; off < 64; off <<= 1) { lo |= __shfl_xor(lo, off); h32 |= __shfl_xor(h32, off); }
              uni = ((unsigned long long)(unsigned)__builtin_amdgcn_readfirstlane(h32) << 32) | (unsigned)__builtin_amdgcn_readfirstlane(lo); }
            const int ns = __builtin_popcountll(uni);
            if (wave == 7) {
                if ((uni >> lane) & 1ull) tls[__builtin_popcountll(uni & ((1ull << lane) - 1ull))] = lane;
                if (lane < ntw) tlw[lane] = jt0 + lane; }
            dma_k2(K2, zb + OD_KS + g * 128 + (size_t)__builtin_ctzll(uni) * 64 * OD_LD, OD_LD, wave, lane);
            __syncthreads();
            f32x16 o[4]; float lb;
            bf16_t* arow0 = ACC + ((size_t)b * SEQ + s0) * ACC_LD + hg * 128;
            nsa_branch_all<0>(K2, V2, tls, ns, zb + OD_KS + g * 128, zb + OD_VS + g * 128, ql, t, s0, mymask, tbl, lb, o, wave, lane, &tacc, true);
            dma_k2(K2, zb + OD_KW + g * 128 + (size_t)jt0 * 64 * OD_LD, OD_LD, wave, lane);
            { int tv = t; asm volatile("" : "+v"(tv));
              acc_step<1>(Kl + NSA2_SCR_OFF + wave * 2560, arow0, ACC_LD, nullptr, 0, o, gates[((size_t)b * SEQ + tv) * GATE_LD + hg + 12] / lb, (tv & 31) | (hi << 5), false); }
            nsa_branch_all<1>(K2, V2, tlw, ntw, zb + OD_KW + g * 128, zb + OD_VW + g * 128, ql, t, s0, mymask, tbl, lb, o, wave, lane, &tacc, true);
            { int tv = t; asm volatile("" : "+v"(tv));
              acc_step<2>(Kl + NSA2_SCR_OFF + wave * 2560, arow0, ACC_LD, Z + ((size_t)b * SEQ + s0) * OD_LD + OD_G + hg * 128, OD_LD, o, gates[((size_t)b * SEQ + tv) * GATE_LD + hg + 24] / lb, (tv & 31) | (hi << 5), F.dry != 0); }
            __syncthreads();
        }
    }
}

template <int MAP>
__device__ __forceinline__ void transpose_item(const float* W, int K, int N, bf16_t* WT, const float* kscale, LAS float* scr, int item, int lane) {
    const int nblk = (N + 31) / 32, kb = item / nblk, nb = item % nblk, k0 = 64 * kb, n0 = 32 * nb;
    const int nl = n0 + (lane & 31);
    float tv[32];
#pragma unroll
    for (int i = 0; i < 32; ++i) { const int kk = 2 * i + (lane >> 5); tv[i] = 0.f; if (nl < N) tv[i] = W[(size_t)(k0 + kk) * N + nl]; }
#pragma unroll
    for (int i = 0; i < 32; ++i) { const int kk = 2 * i + (lane >> 5); float v = tv[i]; if (kscale) v *= kscale[k0 + kk]; scr[kk * 33 + (lane & 31)] = v; }
    LDS_WAIT(); asm volatile("" ::: "memory");
    const int c = lane & 7;
#pragma unroll
    for (int j = 0; j < 4; ++j) { const int n = (lane >> 3) + 8 * j; const LAS float* s = scr + (8 * c) * 33 + n;
        u32x4 o; o.x = pk2(s[0 * 33], s[1 * 33]); o.y = pk2(s[2 * 33], s[3 * 33]); o.z = pk2(s[4 * 33], s[5 * 33]); o.w = pk2(s[6 * 33], s[7 * 33]);
        const int ncol = n0 + n;
        if (ncol < N) {
            int drow = ncol;
            if (MAP == 1) { if (ncol >= 3620) drow = OD_G + (ncol - 3620); else if (ncol >= 3108) drow = OD_XQ + (ncol - 3108); else if (ncol >= 3072) drow = OD_LD + (ncol - 3072); }
            *(u32x4*)(WT + (size_t)drow * K + k0 + 8 * c) = o; } }
    LDS_WAIT(); asm volatile("" ::: "memory");
}
__device__ __forceinline__ int t5_bucket(int n) {
    if (n < 16) return n;
    int l = 16 + (int)(__logf((float)n * (1.f / 16.f)) / 2.0794415416798357f * 16.f);
    return l < 31 ? l : 31;
}
__device__ __forceinline__ void prologue(const Frame& F, const Args& a) {
    LAS float* scr = (LAS float*)(F.lds + F.wave * 16384);
    const int gw = F.bid * 8 + F.wave, NGW = F.G * 8, lane = F.lane;
    unsigned char* ws = F.ws;
    const float* norm_g = a.in[2];
    constexpr int I0 = 16 * 160, I1 = 16 * 178, IO = 32 * 32, IM = 16 * 32, IC1 = 64 * 8, IC2 = 4 * 4, IP = 3 * 6;
    constexpr int NITEMS = I0 + I1 + 2 * IO + 2 * IM + 2 * IC1 + 2 * IC2 + 4 * IP;
    for (int it = gw; it < NITEMS; it += NGW) {
        int r = it;
        if (r < I0) { transpose_item<0>(a.in[6], DM, EV_LD, (bf16_t*)(ws + WS_W0), norm_g, scr, r, lane); continue; } r -= I0;
        if (r < I1) { transpose_item<1>(a.in[11], DM, OD_COLS, (bf16_t*)(ws + WS_W1), norm_g + DM, scr, r, lane); continue; } r -= I1;
        if (r < IO) { transpose_item<0>(a.in[10], DIN, DM, (bf16_t*)(ws + WS_WO0), nullptr, scr, r, lane); continue; } r -= IO;
        if (r < IO) { transpose_item<0>(a.in[17], DIN, DM, (bf16_t*)(ws + WS_WO1), nullptr, scr, r, lane); continue; } r -= IO;
        if (r < IM) { transpose_item<0>(a.in[9], DM, DM, (bf16_t*)(ws + WS_WM0), nullptr, scr, r, lane); continue; } r -= IM;
        if (r < IM) { transpose_item<0>(a.in[16], DM, DM, (bf16_t*)(ws + WS_WM1), nullptr, scr, r, lane); continue; } r -= IM;
        if (r < 2 * IC1) { const int kv = r / IC1; transpose_item<0>(a.in[13] + (size_t)kv * 4096 * 256, 4096, 256, (bf16_t*)(ws + WS_WC1) + (size_t)kv * 256 * 4096, nullptr, scr, r % IC1, lane); continue; } r -= 2 * IC1;
        if (r < 2 * IC2) { const int kv = r / IC2; transpose_item<0>(a.in[15] + (size_t)kv * 256 * 128, 256, 128, (bf16_t*)(ws + WS_WC2) + (size_t)kv * 128 * 256, nullptr, scr, r % IC2, lane); continue; } r -= 2 * IC2;
        { const int gi = r / IP; transpose_item<0>(a.in[7] + (size_t)gi * 192 * 192, 192, 192, (bf16_t*)(ws + WS_WP) + (size_t)gi * 192 * 192, nullptr, scr, r % IP, lane); }
    }
    { u32x4* p = (u32x4*)((bf16_t*)(ws + WS_W1) + (size_t)OD_COLS * DM); const int n16 = (OD_N - OD_COLS) * DM * 2 / 16;
      for (int i = F.bid * 512 + F.tid; i < n16; i += F.G * 512) p[i] = (u32x4){0u, 0u, 0u, 0u}; }
    { const float* x = a.in[0]; bf16_t* xb = (bf16_t*)(ws + WS_R); float* part = (float*)(ws + WS_PART);
      for (int m = gw; m < MTOK; m += 4 * NGW) {
          f32x4 v[4][4]; float s[4]; bool ok[4]; int mr[4];
#pragma unroll
          for (int q = 0; q < 4; ++q) { ok[q] = m + q * NGW < MTOK; mr[q] = ok[q] ? m + q * NGW : m; const f32x4* xr = (const f32x4*)(x + (size_t)mr[q] * DM) + lane;
#pragma unroll
              for (int j = 0; j < 4; ++j) v[q][j] = xr[64 * j]; }
#pragma unroll
          for (int q = 0; q < 4; ++q) { s[q] = 0.f;
#pragma unroll
              for (int j = 0; j < 4; ++j) s[q] += (v[q][j].x * v[q][j].x + v[q][j].y * v[q][j].y) + (v[q][j].z * v[q][j].z + v[q][j].w * v[q][j].w);
              s[q] = wave_sum(s[q]); }
#pragma unroll
          for (int q = 0; q < 4; ++q) if (ok[q]) { u32x2* o8 = (u32x2*)(xb + (size_t)mr[q] * DM) + lane;
#pragma unroll
              for (int j = 0; j < 4; ++j) o8[64 * j] = (u32x2){pk2(v[q][j].x, v[q][j].y), pk2(v[q][j].z, v[q][j].w)};
              if (lane < 16) part[(size_t)mr[q] * 16 + lane] = (lane == 0) ? s[q] : 0.f; }
      } }
    { const float* mem = a.in[1]; const float* mg = a.in[4]; bf16_t* mn = (bf16_t*)(ws + WS_MEMN);
      for (int m = gw; m < BATCH * NMEM; m += NGW) {
          const f32x4* xr = (const f32x4*)(mem + (size_t)m * DM) + lane; const f32x4* gr = (const f32x4*)mg + lane; f32x4 v[4]; float s = 0.f;
#pragma unroll
          for (int j = 0; j < 4; ++j) { v[j] = xr[64 * j]; s += (v[j].x * v[j].x + v[j].y * v[j].y) + (v[j].z * v[j].z + v[j].w * v[j].w); }
          const float rs = 1.0f / sqrtf(wave_sum(s) * (1.f / DM) + EPS);
          u32x2* o8 = (u32x2*)(mn + (size_t)m * DM) + lane;
#pragma unroll
          for (int j = 0; j < 4; ++j) { const f32x4 g = gr[64 * j]; o8[64 * j] = (u32x2){pk2(v[j].x * rs * g.x, v[j].y * rs * g.y), pk2(v[j].z * rs * g.z, v[j].w * rs * g.w)}; }
      } }
    { float* ct = (float*)(ws + WS_ROPE); float* st = ct + SEQ * 64;
      for (int i = F.bid * 512 + F.tid; i < SEQ * 64; i += F.G * 512) {
          const int s = i >> 6, f = i & 63;
          const float inv = exp2f(-((float)f * (1.f / 64.f)) * 13.287712379549449f);
          const float ang = (float)s * inv;
          const double x = (double)ang; const double kq = rint(x * 0.6366197723675814);
          double r = fma(-kq, 1.5707963267948966, x); r = fma(-kq, 6.123233995736766e-17, r);
          const double r2 = r * r;
          const double sn = r * (1.0 + r2 * (-1.0 / 6 + r2 * (1.0 / 120 + r2 * (-1.0 / 5040 + r2 * (1.0 / 362880 - r2 * (1.0 / 39916800))))));
          const double cs = 1.0 + r2 * (-0.5 + r2 * (1.0 / 24 + r2 * (-1.0 / 720 + r2 * (1.0 / 40320 - r2 * (1.0 / 3628800)))));
          const int q = ((int)kq) & 3;
          double c_, s_;
          if (q == 0) { c_ = cs; s_ = sn; } else if (q == 1) { c_ = -sn; s_ = cs; } else if (q == 2) { c_ = -cs; s_ = -sn; } else { c_ = sn; s_ = -cs; }
          ct[i] = (float)c_; st[i] = (float)s_;
      } }
    if (F.bid == 0) { float* tb = (float*)(ws + WS_MISC); const float* rb = a.in[5];
        for (int i = F.tid; i < 12 * 132; i += 512) { const int h = i / 132, r = i % 132; const int bk = r >= 128 ? 31 : t5_bucket(r); tb[i] = rb[bk * 12 + h] * LOG2E; } }
    for (int w = F.bid; w < 256; w += F.G) { const int kv = w >> 7, j = (w >> 2) & 31, cl = F.tid & 63, c = (w & 3) * 64 + cl, kg = F.tid >> 6;
        const float* pe = a.in[12] + (size_t)kv * 4096 + 128 * j + 16 * kg; const float* w1 = a.in[13] + (size_t)kv * 4096 * 256 + (size_t)(128 * j + 16 * kg) * 256 + c;
        float pv[16], wv[16];
#pragma unroll
        for (int i = 0; i < 16; ++i) { pv[i] = pe[i]; wv[i] = w1[(size_t)i * 256]; }
        float s = 0.f;
#pragma unroll
        for (int i = 0; i < 16; ++i) s += pv[i] * wv[i];
        LAS float* red = (LAS float*)(F.lds + RSTD_OFF);
        red[kg * 64 + cl] = s;
        __syncthreads();
        if (kg == 0) { float tot = 0.f;
#pragma unroll
            for (int q = 0; q < 8; ++q) tot += red[q * 64 + cl];
            ((float*)(ws + WS_MISC + 65536))[(kv * 32 + j) * 256 + c] = tot; }
        __syncthreads(); }
}

__device__ __forceinline__ void final_norm(const Frame& F, float* out, const bf16_t* hb, const float* part, const float* fg) {
    const int gw = F.bid * 8 + F.wave, NGW = F.G * 8, lane = F.lane;
    for (int m = gw; m < MTOK; m += NGW) {
        float ps = (lane < 16) ? part[(size_t)m * 16 + lane] : 0.f;
        float tot = 0.f;
#pragma unroll
        for (int j = 0; j < 16; ++j) tot += __shfl(ps, j);
        const float rs = 1.0f / sqrtf(tot * (1.f / DM) + EPS);
        const u32x4* hr = (const u32x4*)(hb + (size_t)m * DM) + lane; f32x4* xr = (f32x4*)(out + (size_t)m * DM) + 2 * lane; const f32x4* gr = (const f32x4*)fg + 2 * lane;
#pragma unroll
        for (int j = 0; j < 2; ++j) { const u32x4 hw = hr[64 * j]; const f32x4 g0 = gr[128 * j], g1 = gr[128 * j + 1];
            f32x4 v0 = {__builtin_bit_cast(float, hw.x << 16), __builtin_bit_cast(float, hw.x & 0xffff0000u), __builtin_bit_cast(float, hw.y << 16), __builtin_bit_cast(float, hw.y & 0xffff0000u)};
            f32x4 v1 = {__builtin_bit_cast(float, hw.z << 16), __builtin_bit_cast(float, hw.z & 0xffff0000u), __builtin_bit_cast(float, hw.w << 16), __builtin_bit_cast(float, hw.w & 0xffff0000u)};
            v0 = v0 * rs * g0; v1 = v1 * rs * g1;
            if (!F.dry) { xr[128 * j] = v0; xr[128 * j + 1] = v1; } }
    }
}
__device__ __forceinline__ void fill_rstd(const Frame& F, const pg8::StaticOrder& S, const float* part) {
    LAS float* rl = (LAS float*)(F.lds + RSTD_OFF);
    f32x4 pv[6][4]; bool ok[6];
#pragma unroll
    for (int j = 0; j < 6; ++j) { const int en = F.tid + 512 * j, i = en >> 8, r = en & 255; pg8::Unit u; ok[j] = S.next(i, u);
        const f32x4* p = (const f32x4*)(part + ((size_t)(ok[j] ? u.pm : 0) * 256 + r) * 16);
#pragma unroll
        for (int q = 0; q < 4; ++q) pv[j][q] = p[q]; }
#pragma unroll
    for (int j = 0; j < 6; ++j) { const int en = F.tid + 512 * j;
        float tot = 0.f;
#pragma unroll
        for (int q = 0; q < 4; ++q) { tot += pv[j][q].x; tot += pv[j][q].y; tot += pv[j][q].z; tot += pv[j][q].w; }
        if (ok[j]) rl[en] = 1.0f / sqrtf(tot * (1.f / DM) + EPS); }
    __syncthreads();
}

constexpr int NPHASE = 12;
__global__ void __launch_bounds__(512, 2) fwd_kernel(Args args) {
    extern __shared__ __attribute__((aligned(16))) unsigned char lds_raw[];
    Frame F; F.lds = (LAS unsigned char*)lds_raw; F.tid = threadIdx.x; F.lane = F.tid & 63; F.wave = __builtin_amdgcn_readfirstlane(F.tid >> 6);
    F.G = gridDim.x; F.bid = blockIdx.x; F.ws = args.ws; F.dry = 0;
    unsigned char* ws = args.ws;
    const int lo = args.ph_lo, hi = args.ph_hi;
#define IN(k) (lo <= (k) && (k) < hi)
    { volatile LAS unsigned* mw = (volatile LAS unsigned*)(F.lds + MISC_OFF); if (F.tid < 16) mw[F.tid] = 0u; }
    __syncthreads();
    const XcdBarrier xbar = xcd_barrier_post((unsigned*)(ws + WS_CTL) + 4096, (volatile LAS unsigned*)(F.lds + MISC_OFF));
    unsigned long long ts_prev = 0ull, ts_acc = 0ull;
    if (PROBE_SPIN) ts_prev = __builtin_amdgcn_s_memrealtime();
#define SEAM(k) do { if (IN(k) && IN((k) + 1)) xcd_barrier(xbar); if (PROBE_SPIN) { const unsigned long long now_ = __builtin_amdgcn_s_memrealtime(); if ((PROBE_SPIN >> (k)) & 1) ts_acc += now_ - ts_prev; ts_prev = now_; } } while (0)
    float* part = (float*)(ws + WS_PART);
    bf16_t* Z = (bf16_t*)(ws + WS_Z);
    bf16_t* HB = (bf16_t*)(ws + WS_R);

#define PHASE(k, ...) if (IN(k)) { { F.dry = 0; __VA_ARGS__ } if ((PROBE_REP >> (k)) & 1) { xcd_barrier(xbar); F.dry = 1; __VA_ARGS__ } }
    PHASE(0, prologue(F, args);)
    SEAM(0);
    PHASE(1,
        { pg8::StaticOrder S; S.init(MTOK, EV_LD, F.G, F.bid); fill_rstd(F, S, part);
          pg8::Gemm g{HB, (const bf16_t*)(ws + WS_W0), MTOK, EV_LD, DM, DM};
          EpiIn E{Z, EV_LD, (const LAS float*)(F.lds + RSTD_OFF), EV_G / 256, -1, nullptr, 0, 0};
          pg8::gemm_phase(F.lds, g, S, E); }
        { pg8::StaticOrder S; S.init(BATCH * NMEM, DM, F.G, F.bid);
          pg8::Gemm g{(const bf16_t*)(ws + WS_MEMN), (const bf16_t*)(ws + WS_WM0), BATCH * NMEM, DM, DM, DM};
          EpiBf E{(bf16_t*)(ws + WS_MKV0), DM};
          pg8::gemm_phase(F.lds, g, S, E); }
    )
    SEAM(1);
    PHASE(2,
        ret_a_phase(F, Z, (const float*)(ws + WS_ROPE), (const float*)(ws + WS_ROPE) + SEQ * 64, (bf16_t*)(ws + WS_R), F.bid, F.G);
        pool_phase(F, Z, (const bf16_t*)(ws + WS_WP), args.in[8], F.bid, F.G);
        mem_attn_phase(F, Z, EV_LD, EV_XQ, EV_G + 1536, (const bf16_t*)(ws + WS_MKV0), F.bid, 256);
    )
    SEAM(2);
    PHASE(3, ret_scan_phase(F, (bf16_t*)(ws + WS_R));)
    SEAM(3);
    PHASE(4, ret_c_phase(F, Z, (const float*)(ws + WS_ROPE), (const float*)(ws + WS_ROPE) + SEQ * 64, (const bf16_t*)(ws + WS_R), F.bid, F.G);)
    SEAM(4);
    PHASE(5,
        pg8::StaticOrder S; S.init(MTOK, DM, F.G, F.bid);
        pg8::Gemm g{Z + EV_G, (const bf16_t*)(ws + WS_WO0), MTOK, DM, DIN, EV_LD};
        EpiOut<true> E{args.in[0], HB, part, F.dry};
        pg8::gemm_phase(F.lds, g, S, E);
    )
    SEAM(5);
    PHASE(6,
        pg8::StaticOrder S; S.init(MTOK, OD_N, F.G, F.bid); fill_rstd(F, S, part);
        pg8::Gemm g{HB, (const bf16_t*)(ws + WS_W1), MTOK, OD_N, DM, DM};
        EpiIn E{Z, OD_LD, (const LAS float*)(F.lds + RSTD_OFF), OD_G / 256, OD_LD / 256, (float*)(ws + WS_GATES), 0, 0};
        pg8::gemm_phase(F.lds, g, S, E);
        { pg8::StaticOrder S2; S2.init(BATCH * NMEM, DM, F.G, (F.bid + 128) % F.G);
          pg8::Gemm g2{(const bf16_t*)(ws + WS_MEMN), (const bf16_t*)(ws + WS_WM1), BATCH * NMEM, DM, DM, DM};
          EpiBf E2{(bf16_t*)(ws + WS_MKV1), DM};
          pg8::gemm_phase(F.lds, g2, S2, E2); }
    )
    SEAM(6);
    PHASE(7,
        if (F.bid < 128) compress_phase(F, Z, (const bf16_t*)(ws + WS_WC1), (const bf16_t*)(ws + WS_WC2), args.in[14], (const float*)(ws + WS_MISC + 65536), (bf16_t*)(ws + WS_KCMP), (bf16_t*)(ws + WS_VCMP), F.bid, 128);
        else mem_attn_phase(F, Z, OD_LD, OD_XQ, OD_G + 1536, (const bf16_t*)(ws + WS_MKV1), F.bid - 128, 128);
    )
    SEAM(7);
    PHASE(8, nsa_phase(F, Z, (const float*)(ws + WS_GATES), (const bf16_t*)(ws + WS_KCMP), (const bf16_t*)(ws + WS_VCMP), (const float*)(ws + WS_MISC), (bf16_t*)args.out, ts_acc);)
    SEAM(8);
    PHASE(10,
        pg8::StaticOrder S; S.init(MTOK, DM, F.G, F.bid);
        pg8::Gemm g{Z + OD_G, (const bf16_t*)(ws + WS_WO1), MTOK, DM, DIN, OD_LD};
        EpiFinal E{HB, args.out, part, args.in[3], (unsigned*)(ws + WS_CTL) + 16384, xbar.bar};
        pg8::gemm_phase(F.lds, g, S, E);
    )
#undef PHASE
    if (PROBE_SPIN) { const unsigned long long now_ = __builtin_amdgcn_s_memrealtime(); if ((PROBE_SPIN >> 11) & 1) ts_acc += now_ - ts_prev;
        if (F.bid == 0) { const unsigned long long t0_ = __builtin_amdgcn_s_memrealtime(); while (__builtin_amdgcn_s_memrealtime() - t0_ < ts_acc) __builtin_amdgcn_s_sleep(8); } }
#undef IN
#undef SEAM
}

extern "C" void kernel_launch(void* const* d_in, const int* in_sizes, int n_in, void* d_out, int out_size, void* d_ws, size_t ws_size, hipStream_t stream) {
    static int grid = 0;
    if (grid == 0) {
        if (n_in != 18 || out_size != MTOK * DM || ws_size < WS_END) { fprintf(stderr, "kernel_launch: unexpected shapes: n_in %d out %d ws %zu (need %zu)\n", n_in, out_size, ws_size, (size_t)WS_END); grid = -1; return; }
        int dev = 0, cus = 0, per_cu = 0;
        hipGetDevice(&dev); hipDeviceGetAttribute(&cus, hipDeviceAttributeMultiprocessorCount, dev);
        if (hipFuncSetAttribute((const void*)fwd_kernel, hipFuncAttributeMaxDynamicSharedMemorySize, LDS_BYTES) != hipSuccess) { fprintf(stderr, "kernel_launch: hipFuncSetAttribute failed\n"); grid = -1; return; }
        if (hipOccupancyMaxActiveBlocksPerMultiprocessor(&per_cu, (const void*)fwd_kernel, 512, LDS_BYTES) != hipSuccess || per_cu < 1) { fprintf(stderr, "kernel_launch: occupancy query says %d\n", per_cu); per_cu = 1; }
        (void)hipGetLastError();
        grid = cus;
    }
    if (grid < 0) return;
    if (hipMemsetAsync((char*)d_ws + WS_CTL, 0, CTL_BYTES, stream) != hipSuccess) { fprintf(stderr, "kernel_launch: memset failed\n"); return; }
    Args a{};
    for (int i = 0; i < 18; ++i) a.in[i] = (const float*)d_in[i];
    a.out = (float*)d_out; a.ws = (unsigned char*)d_ws; a.ph_lo = 0; a.ph_hi = NPHASE;
    void* kargs[] = {&a};
    hipError_t e = hipLaunchCooperativeKernel((const void*)fwd_kernel, dim3(grid), dim3(512), kargs, LDS_BYTES, stream);
    if (e != hipSuccess) fprintf(stderr, "kernel_launch: cooperative launch failed: %s (grid %d)\n", hipGetErrorString(e), grid);
}
```

```cpp
#include <hip/hip_runtime.h>
#include <hip/hip_cooperative_groups.h>
#include <cstdio>
#include <cstdint>
namespace cg = cooperative_groups;

#define LAS __attribute__((address_space(3)))
#define GAS __attribute__((address_space(1)))
typedef unsigned short bf16_t;
typedef short bf16x8 __attribute__((ext_vector_type(8)));
typedef short s16x4 __attribute__((ext_vector_type(4)));
typedef float f32x4 __attribute__((ext_vector_type(4)));
typedef float f32x16 __attribute__((ext_vector_type(16)));
typedef unsigned u32x4 __attribute__((ext_vector_type(4)));
typedef unsigned u32x2 __attribute__((ext_vector_type(2)));

#ifndef PROBE_REP
#define PROBE_REP 0
#endif
#ifndef PROBE_SPIN
#define PROBE_SPIN 0
#endif
#ifndef PROBE_VARIANT
#define PROBE_VARIANT 0
#endif
constexpr int BATCH = 8, SEQ = 4096, DM = 1024, MTOK = BATCH * SEQ, NMEM = 256, DIN = 2048;
constexpr float EPS = 1e-6f;
constexpr float LOG2E = 1.4426950408889634f;
constexpr int EV_LD = 5120, EV_ZA = 0, EV_RQ = 768, EV_RK = 1280, EV_RV = 1792, EV_XQ = 2560, EV_G = 3072;
constexpr int OD_LD = 5632, OD_N = 5888, OD_COLS = 5668, OD_Q = 0, OD_KC = 1536, OD_VC = 1792, OD_KS = 2048, OD_VS = 2304, OD_KW = 2560, OD_VW = 2816, OD_XQ = 3072, OD_G = 3584;
constexpr int GATE_LD = 40;
constexpr size_t MiB = 1u << 20;
constexpr size_t WS_CTL = 0, CTL_BYTES = 1 * MiB;
constexpr size_t WS_W0 = 1 * MiB;
constexpr size_t WS_W1 = WS_W0 + (size_t)EV_LD * DM * 2;
constexpr size_t WS_WO0 = WS_W1 + (size_t)OD_N * DM * 2;
constexpr size_t WS_WO1 = WS_WO0 + (size_t)DM * DIN * 2;
constexpr size_t WS_WM0 = WS_WO1 + (size_t)DM * DIN * 2;
constexpr size_t WS_WM1 = WS_WM0 + (size_t)DM * DM * 2;
constexpr size_t WS_WC1 = WS_WM1 + (size_t)DM * DM * 2;
constexpr size_t WS_WC2 = WS_WC1 + (size_t)2 * 256 * 4096 * 2;
constexpr size_t WS_WP = WS_WC2 + (size_t)2 * 128 * 256 * 2;
constexpr size_t WS_WEND = WS_WP + (size_t)4 * 192 * 192 * 2;
static_assert(WS_WEND <= 41 * MiB, "weights");
constexpr size_t WS_MEMN = 41 * MiB, WS_MKV0 = 45 * MiB, WS_MKV1 = 49 * MiB;
constexpr size_t WS_ROPE = 53 * MiB;
constexpr size_t WS_PART = 55 * MiB;
constexpr size_t WS_MISC = 57 * MiB;
constexpr size_t WS_Z = 58 * MiB;
constexpr size_t WS_R = 410 * MiB;
constexpr size_t WS_GATES = WS_R + 64 * MiB;
constexpr size_t WS_KCMP = WS_R + 70 * MiB, WS_VCMP = WS_R + 71 * MiB;
constexpr size_t WS_END = 506 * MiB;

constexpr int RING_BYTES = 131072, RSTD_OFF = RING_BYTES, RSTD_BYTES = 12 * 1024, LDS_BYTES = 163840, MISC_OFF = LDS_BYTES - 256;

__device__ __forceinline__ unsigned f2bf(float f) { unsigned u = __builtin_bit_cast(unsigned, f); return (u + 0x7fffu + ((u >> 16) & 1u)) >> 16; }
__device__ __forceinline__ unsigned pk2(float lo, float hi) { return f2bf(lo) | (f2bf(hi) << 16); }
__device__ __forceinline__ float bf2f(unsigned short b) { return __builtin_bit_cast(float, (unsigned)b << 16); }
typedef float f32x2_t __attribute__((ext_vector_type(2))); typedef __bf16 bf16x2_t __attribute__((ext_vector_type(2)));
__device__ __forceinline__ unsigned cvt_pk_bf16(float lo, float hi) { f32x2_t v = {lo, hi}; bf16x2_t b = __builtin_convertvector(v, bf16x2_t); return __builtin_bit_cast(unsigned, b); }
__device__ __forceinline__ float wave_sum(float v) {
#pragma unroll
    for (int o = 1; o < 64; o <<= 1) v += __shfl_xor(v, o);
    return v;
}
__device__ __forceinline__ float fast_sigmoid(float v) { return __builtin_amdgcn_rcpf(1.f + __builtin_amdgcn_exp2f(-v * LOG2E)); }
#define LDS_WAIT() asm volatile("s_waitcnt lgkmcnt(0)" ::: "memory")
#define VM_WAIT() asm volatile("s_waitcnt vmcnt(0)" ::: "memory")

#define XB_TMO      128
#define XB_XCNT(j)  (256  + 64 * (j))
#define XB_XSUB(j)  (1280 + 64 * (j))
#define XB_XGEN(j)  (2304 + 64 * (j))
#define XB_TOP      3328
#define XB_TOPGEN   3392
#define XCD_BAR_WORDS 3456
#define XB_SPIN_CAP (1u << 18)
__device__ __forceinline__ unsigned xb_ld(unsigned* p)              { return __hip_atomic_load(p, __ATOMIC_RELAXED, __HIP_MEMORY_SCOPE_AGENT); }
__device__ __forceinline__ unsigned xb_add(unsigned* p, unsigned v) { return __hip_atomic_fetch_add(p, v, __ATOMIC_RELAXED, __HIP_MEMORY_SCOPE_AGENT); }
__device__ __forceinline__ unsigned xb_xcc_id() { return (unsigned)__builtin_amdgcn_s_getreg((3 << 11) | 20) & 0xFu; }
#define XB_SPIN(cond, bar) do { unsigned _sp = 0; while (cond) { __builtin_amdgcn_s_sleep(1); \
    if ((++_sp & 255u) == 0u) { if (xb_ld(&(bar)[XB_TMO])) break; if (_sp > XB_SPIN_CAP) { atomicAdd(&(bar)[XB_TMO], 1u); break; } } } } while (0)
struct XcdBarrier { unsigned* bar; unsigned x; volatile LAS unsigned* st; };
__device__ __forceinline__ XcdBarrier xcd_barrier_post(unsigned* bar, volatile LAS unsigned* st) {
    XcdBarrier b; b.bar = bar; b.x = xb_xcc_id(); b.st = st;
    if (threadIdx.x == 0) (void)xb_add(&bar[XB_XCNT(b.x)], 1u);
    return b;
}
__device__ __forceinline__ void xcd_barrier_complete(unsigned* bar, unsigned x, unsigned& nloc, unsigned& nx) {
    const unsigned G = gridDim.x * gridDim.y * gridDim.z;
    unsigned sum, cnt, mine, sp = 0u;
    for (;;) {
        sum = 0u; cnt = 0u; mine = 0u;
#pragma unroll
        for (unsigned j = 0; j < 16; ++j) { const unsigned c = xb_ld(&bar[XB_XCNT(j)]); sum += c; cnt += (c > 0u) ? 1u : 0u; mine = (j == x) ? c : mine; }
        if (sum == G) break;
        __builtin_amdgcn_s_sleep(1);
        if ((++sp & 255u) == 0u) { if (xb_ld(&bar[XB_TMO])) break; if (sp > XB_SPIN_CAP) { atomicAdd(&bar[XB_TMO], 1u); break; } }
    }
    nloc = mine > 0u ? mine : 1u; nx = cnt > 0u ? cnt : 1u;
}
__device__ __forceinline__ void xcd_barrier(const XcdBarrier& b) {
    asm volatile("s_waitcnt vmcnt(0)" ::: "memory");
    __syncthreads();
    if (threadIdx.x == 0) {
        unsigned* bar = b.bar;
        __builtin_amdgcn_s_waitcnt(0);
        unsigned nloc = b.st[0], nx = b.st[1];
        if (nloc == 0u) { xcd_barrier_complete(bar, b.x, nloc, nx); b.st[0] = nloc; b.st[1] = nx; }
        const unsigned old = xb_add(&bar[XB_XSUB(b.x)], 1u);
        const unsigned gen = old / nloc;
        if (old + 1u == (gen + 1u) * nloc) {
            __builtin_amdgcn_fence(__ATOMIC_RELEASE, "agent");
            asm volatile("s_waitcnt vmcnt(0)" ::: "memory");
            const unsigned og = xb_add(&bar[XB_TOP], 1u);
            const unsigned tg = og / nx;
            if (og + 1u == (tg + 1u) * nx) xb_add(&bar[XB_TOPGEN], 1u);
            else XB_SPIN(xb_ld(&bar[XB_TOPGEN]) == tg, bar);
            __builtin_amdgcn_fence(__ATOMIC_ACQUIRE, "agent");
            xb_add(&bar[XB_XGEN(b.x)], 1u);
            asm volatile("s_waitcnt vmcnt(0)" ::: "memory");
        } else {
            XB_SPIN(xb_ld(&bar[XB_XGEN(b.x)]) == gen, bar);
            __builtin_amdgcn_fence(__ATOMIC_ACQUIRE, "agent");
            asm volatile("s_waitcnt vmcnt(0)" ::: "memory");
        }
    }
    __syncthreads();
}

namespace pg8 {
constexpr int BM = 256, BK = 64, HALF = 128, HTB = HALF * BK * 2, STAGE_BYTES = 8 * HTB, NXCD = 8, WGM = 8;
__host__ __device__ __forceinline__ int lds_byte(int r, int c) { const int st = (r >> 4) * 2 + (c >> 5), rr = r & 15, cc = c & 31, ob = rr * 64 + cc * 2; return st * 1024 + (ob ^ (((ob >> 9) & 1) << 5)); }
__host__ __device__ __forceinline__ void stage_rc(int b, int& R, int& C) { const int st = b / 1024, sb = b % 1024, swz = sb ^ (((sb >> 9) & 1) << 5); R = (st >> 1) * 16 + swz / 64; C = (st & 1) * 32 + (swz % 64) / 2; }
__host__ __device__ __forceinline__ int perm32(int rho) { const int n = rho >> 4, i = rho & 15; return 8 * (i >> 2) + 4 * n + (i & 3); }
struct Unit { int pm, pn, idx; };
struct Gemm { const bf16_t* A; const bf16_t* Bt; int M, N, K, lda; };
struct StaticOrder {
    int nM, nN, nwg, G, c;
    __device__ void init(int M, int N, int G_, int c_) { nM = M / BM; nN = N / BM; nwg = nM * nN; G = G_; c = c_; }
    __device__ bool next(int i, Unit& u) const {
        const long L = (long)i * G + c; if (L >= nwg) return false;
        int wgid = (int)L; { const int q = nwg / NXCD, r = nwg % NXCD, xcd = wgid % NXCD, off = wgid / NXCD; wgid = (xcd < r ? xcd * (q + 1) : r * (q + 1) + (xcd - r) * q) + off; }
        const int nig = WGM * nN, gid = wgid / nig, fm = gid * WGM, gsz = (nM - fm) < WGM ? (nM - fm) : WGM;
        u.pm = fm + ((wgid % nig) % gsz); u.pn = (wgid % nig) / gsz; u.idx = i; return true;
    }
};
template <class Epi>
__device__ __forceinline__ void gemm_phase(LAS unsigned char* lds, const Gemm g, const StaticOrder& S, const Epi& E) {
    const int tid = threadIdx.x, wid = __builtin_amdgcn_readfirstlane(tid >> 6), lane = tid & 63, wr = wid >> 2, wc = wid & 3, fr = lane & 15, fq = lane >> 4;
    const int K = g.K, nt = K / BK, lda = g.lda;
    unsigned voffA[2], voffB[2];
#pragma unroll
    for (int i = 0; i < 2; ++i) { int R, C; stage_rc(tid * 16 + i * 8192, R, C); const int Rb = (R & ~31) + perm32(R & 31);
        voffA[i] = (unsigned)(R * lda + C) * 2u; voffB[i] = (unsigned)(Rb * K + C) * 2u; }
    const size_t kstep = (size_t)(BK * 2);
    const size_t hstepA = (size_t)HALF * lda * 2, hstepB = (size_t)HALF * K * 2;
    const size_t tstepA = 2 * hstepA, tstepB = 2 * hstepB;
    const unsigned ldsw = (unsigned)wid * 1024u;
    const int aoff = lds_byte(wr * 64 + fr, fq * 8), boff = lds_byte(wc * 32 + fr, fq * 8);
#define PG8_SA(b, h) (((b) * 2 + (h)) * HTB)
#define PG8_SB(b, h) ((4 + (b) * 2 + (h)) * HTB)
#define PG8_STAGE(bufoff, gbase, voff) do { _Pragma("unroll") for (int _i = 0; _i < 2; ++_i) \
        __builtin_amdgcn_global_load_lds((const unsigned*)((const char*)(gbase) + (voff)[_i]), (LAS unsigned*)(lds + (bufoff) + ldsw + _i * 8192), 16, 0, 0); } while (0)
#define PG8_LDA(dst, b, h) do { _Pragma("unroll") for (int m = 0; m < 4; ++m) _Pragma("unroll") for (int k = 0; k < 2; ++k) dst[m][k] = *(const LAS bf16x8*)(lds + PG8_SA(b, h) + aoff + m * 2048 + k * 1024); } while (0)
#define PG8_LDB(dst, b, h) do { _Pragma("unroll") for (int n = 0; n < 2; ++n) _Pragma("unroll") for (int k = 0; k < 2; ++k) dst[n][k] = *(const LAS bf16x8*)(lds + PG8_SB(b, h) + boff + n * 2048 + k * 1024); } while (0)
#define PG8_MMA(ai, bj, At, Bt) do { __builtin_amdgcn_s_setprio(1); _Pragma("unroll") for (int m = 0; m < 4; ++m) _Pragma("unroll") for (int n = 0; n < 2; ++n) _Pragma("unroll") for (int k = 0; k < 2; ++k) \
        acc[ai][bj][m][n] = __builtin_amdgcn_mfma_f32_16x16x32_bf16(Bt[n][k], At[m][k], acc[ai][bj][m][n], 0, 0, 0); __builtin_amdgcn_s_setprio(0); } while (0)
#define PG8_WAIT_V(n) asm volatile("s_waitcnt vmcnt(" #n ")" ::: "memory")
#define PG8_WAIT_L(n) asm volatile("s_waitcnt lgkmcnt(" #n ")" ::: "memory")
#define PG8_BAR __builtin_amdgcn_s_barrier()
#define PG8_SCHED __builtin_amdgcn_sched_barrier(0)
    Unit cur, nxt; int ui = 0;
    if (!S.next(0, cur)) return;
    f32x4 acc[2][2][4][2];
#pragma unroll
    for (int a = 0; a < 2; ++a)
#pragma unroll
        for (int b = 0; b < 2; ++b)
#pragma unroll
            for (int m = 0; m < 4; ++m)
#pragma unroll
                for (int n = 0; n < 2; ++n) acc[a][b][m][n] = (f32x4){0.f, 0.f, 0.f, 0.f};
    bf16x8 At[4][2], B0[2][2], B1[2][2];
    const char* cA = (const char*)g.A + (size_t)cur.pm * tstepA; const char* cB = (const char*)g.Bt + (size_t)cur.pn * tstepB;
    PG8_STAGE(PG8_SB(0, 0), cB, voffB); PG8_STAGE(PG8_SB(0, 1), cB + hstepB, voffB); PG8_STAGE(PG8_SA(0, 0), cA, voffA); PG8_STAGE(PG8_SA(0, 1), cA + hstepA, voffA);
    if (wr == 1) PG8_BAR;
    PG8_WAIT_V(2); PG8_BAR;
    PG8_STAGE(PG8_SB(1, 0), cB + kstep, voffB); PG8_STAGE(PG8_SA(1, 0), cA + kstep, voffA); PG8_STAGE(PG8_SB(1, 1), cB + hstepB + kstep, voffB);
    PG8_WAIT_V(6); PG8_BAR;
    for (;;) {
        const bool has_next = S.next(ui + 1, nxt);
        const char* nA = has_next ? (const char*)g.A + (size_t)nxt.pm * tstepA : cA; const char* nB = has_next ? (const char*)g.Bt + (size_t)nxt.pn * tstepB : cB;
        for (int t = 0; t < nt; t += 2) {
            const bool last = (t == nt - 2);
            const char* a1 = cA + (size_t)(t + 1) * kstep;
            const char* a2 = last ? nA : cA + (size_t)(t + 2) * kstep; const char* b2 = last ? nB : cB + (size_t)(t + 2) * kstep;
            const char* a3 = a2 + kstep; const char* b3 = b2 + kstep;
            PG8_LDB(B0, 0, 0); PG8_LDB(B1, 0, 1); PG8_SCHED; PG8_LDA(At, 0, 0); PG8_STAGE(PG8_SA(1, 1), a1 + hstepA, voffA);
            PG8_WAIT_V(8); PG8_WAIT_L(0); PG8_BAR; PG8_MMA(0, 0, At, B0); PG8_MMA(0, 1, At, B1); PG8_BAR; PG8_SCHED;
            PG8_LDA(At, 0, 1); PG8_STAGE(PG8_SB(0, 0), b2, voffB); PG8_STAGE(PG8_SB(0, 1), b2 + hstepB, voffB); PG8_STAGE(PG8_SA(0, 0), a2, voffA);
            PG8_WAIT_V(8); PG8_WAIT_L(0); PG8_BAR; PG8_MMA(1, 0, At, B0); PG8_MMA(1, 1, At, B1); PG8_BAR; PG8_SCHED;
            PG8_LDB(B0, 1, 0); PG8_LDB(B1, 1, 1); PG8_SCHED; PG8_LDA(At, 1, 0); PG8_STAGE(PG8_SA(0, 1), a2 + hstepA, voffA);
            PG8_WAIT_V(8); PG8_WAIT_L(0); PG8_BAR; PG8_MMA(0, 0, At, B0); PG8_MMA(0, 1, At, B1); PG8_BAR; PG8_SCHED;
            PG8_LDA(At, 1, 1); PG8_STAGE(PG8_SB(1, 0), b3, voffB); PG8_STAGE(PG8_SB(1, 1), b3 + hstepB, voffB); PG8_STAGE(PG8_SA(1, 0), a3, voffA);
            PG8_WAIT_V(8); PG8_WAIT_L(0); PG8_BAR; PG8_MMA(1, 0, At, B0); PG8_MMA(1, 1, At, B1); PG8_BAR; PG8_SCHED;
        }
        if (wr == 0) PG8_BAR;
        E(acc, cur, wr, wc, fr, fq);
        if (!has_next) break;
#pragma unroll
        for (int a = 0; a < 2; ++a)
#pragma unroll
            for (int b = 0; b < 2; ++b)
#pragma unroll
                for (int m = 0; m < 4; ++m)
#pragma unroll
                    for (int n = 0; n < 2; ++n) acc[a][b][m][n] = (f32x4){0.f, 0.f, 0.f, 0.f};
        cur = nxt; cA = nA; cB = nB; ++ui;
        if (wr == 1) PG8_BAR;
    }
    PG8_WAIT_V(0);
    PG8_BAR;
#undef PG8_SA
#undef PG8_SB
#undef PG8_STAGE
#undef PG8_LDA
#undef PG8_LDB
#undef PG8_MMA
#undef PG8_WAIT_V
#undef PG8_WAIT_L
#undef PG8_BAR
#undef PG8_SCHED
}
}

struct EpiIn {
    bf16_t* Z; int ldz; const LAS float* rstd; int pn_silu, pn_gate; float* gates; int zlo, zhi;
    __device__ __forceinline__ void operator()(const f32x4 (&acc)[2][2][4][2], const pg8::Unit& u, int wr, int wc, int fr, int fq) const {
        const int rl0 = wr * 64 + fr, col0 = u.pn * 256 + wc * 32 + 8 * fq;
        const bool is_gate = (u.pn == pn_gate), is_silu = (u.pn >= pn_silu) && !is_gate;
#pragma unroll
        for (int ai = 0; ai < 2; ++ai)
#pragma unroll
            for (int m = 0; m < 4; ++m) {
                const int rl = rl0 + ai * 128 + m * 16; const float rs = rstd[u.idx * 256 + rl]; const size_t row = (size_t)u.pm * 256 + rl;
#pragma unroll
                for (int bj = 0; bj < 2; ++bj) {
                    f32x4 v0 = acc[ai][bj][m][0] * rs, v1 = acc[ai][bj][m][1] * rs;
                    if (is_gate) {
                        const int c = wc * 32 + 8 * fq + bj * 128;
                        if (c < 36) { float* gp = gates + row * GATE_LD + c;
#pragma unroll
                            for (int j = 0; j < 4; ++j) { gp[j] = fast_sigmoid(v0[j]); if (c + 4 + j < 36) gp[4 + j] = fast_sigmoid(v1[j]); } }
                    } else {
                        if (is_silu) {
#pragma unroll
                            for (int j = 0; j < 4; ++j) { v0[j] = v0[j] * fast_sigmoid(v0[j]); v1[j] = v1[j] * fast_sigmoid(v1[j]); }
                            if (u.pn >= zlo && u.pn < zhi) { v0 = (f32x4){0.f, 0.f, 0.f, 0.f}; v1 = v0; }
                        }
                        u32x4 w; w.x = cvt_pk_bf16(v0[0], v0[1]); w.y = cvt_pk_bf16(v0[2], v0[3]); w.z = cvt_pk_bf16(v1[0], v1[1]); w.w = cvt_pk_bf16(v1[2], v1[3]);
                        *(u32x4*)(Z + row * ldz + col0 + bj * 128) = w;
                    }
                }
            }
    }
};
struct EpiBf {
    bf16_t* O; int ldc;
    __device__ __forceinline__ void operator()(const f32x4 (&acc)[2][2][4][2], const pg8::Unit& u, int wr, int wc, int fr, int fq) const {
        const int row0 = u.pm * 256 + wr * 64 + fr, col0 = u.pn * 256 + wc * 32 + 8 * fq;
#pragma unroll
        for (int ai = 0; ai < 2; ++ai)
#pragma unroll
            for (int m = 0; m < 4; ++m)
#pragma unroll
                for (int bj = 0; bj < 2; ++bj) {
                    const f32x4 v0 = acc[ai][bj][m][0], v1 = acc[ai][bj][m][1];
                    u32x4 w; w.x = cvt_pk_bf16(v0[0], v0[1]); w.y = cvt_pk_bf16(v0[2], v0[3]); w.z = cvt_pk_bf16(v1[0], v1[1]); w.w = cvt_pk_bf16(v1[2], v1[3]);
                    *(u32x4*)(O + (size_t)(row0 + ai * 128 + m * 16) * ldc + col0 + bj * 128) = w;
                }
    }
};
template <bool BASE_F32> struct EpiOut {
    const float* base; bf16_t* hb; float* part; int dry;
    __device__ __forceinline__ void operator()(const f32x4 (&acc)[2][2][4][2], const pg8::Unit& u, int wr, int wc, int fr, int fq) const {
        const int row0 = u.pm * 256 + wr * 64 + fr, col0 = u.pn * 256 + wc * 32 + 8 * fq;
#pragma unroll
        for (int ai = 0; ai < 2; ++ai) {
            f32x4 bv[4][2][2]; u32x4 hv[4][2];
#pragma unroll
            for (int m = 0; m < 4; ++m)
#pragma unroll
                for (int bj = 0; bj < 2; ++bj) { const size_t off = (size_t)(row0 + ai * 128 + m * 16) * DM + col0 + bj * 128;
                    if (BASE_F32) { bv[m][bj][0] = *(const f32x4*)(base + off); bv[m][bj][1] = *(const f32x4*)(base + off + 4); } else hv[m][bj] = *(const u32x4*)(hb + off); }
#pragma unroll
            for (int m = 0; m < 4; ++m) {
                const size_t row = (size_t)(row0 + ai * 128 + m * 16); float ss = 0.f;
#pragma unroll
                for (int bj = 0; bj < 2; ++bj) {
                    const size_t off = row * DM + col0 + bj * 128;
                    f32x4 b0, b1;
                    if (BASE_F32) { b0 = bv[m][bj][0]; b1 = bv[m][bj][1]; }
                    else { const u32x4 hw = hv[m][bj];
                        b0 = (f32x4){__builtin_bit_cast(float, hw.x << 16), __builtin_bit_cast(float, hw.x & 0xffff0000u), __builtin_bit_cast(float, hw.y << 16), __builtin_bit_cast(float, hw.y & 0xffff0000u)};
                        b1 = (f32x4){__builtin_bit_cast(float, hw.z << 16), __builtin_bit_cast(float, hw.z & 0xffff0000u), __builtin_bit_cast(float, hw.w << 16), __builtin_bit_cast(float, hw.w & 0xffff0000u)}; }
                    const f32x4 v0 = acc[ai][bj][m][0] + b0, v1 = acc[ai][bj][m][1] + b1;
                    u32x4 w; w.x = cvt_pk_bf16(v0[0], v0[1]); w.y = cvt_pk_bf16(v0[2], v0[3]); w.z = cvt_pk_bf16(v1[0], v1[1]); w.w = cvt_pk_bf16(v1[2], v1[3]);
                    if (!dry) *(u32x4*)(hb + off) = w;
                    ss += (v0[0] * v0[0] + v0[1] * v0[1]) + (v0[2] * v0[2] + v0[3] * v0[3]) + (v1[0] * v1[0] + v1[1] * v1[1]) + (v1[2] * v1[2] + v1[3] * v1[3]);
                }
                ss += __shfl_xor(ss, 16); ss += __shfl_xor(ss, 32);
                if (fq == 0 && !dry) part[row * 16 + u.pn * 4 + wc] = ss;
            }
        }
    }
};
struct EpiFinal {
    const bf16_t* hb; float* out; float* part; const float* fg; unsigned* flags; unsigned* bar;
    __device__ __forceinline__ void operator()(f32x4 (&acc)[2][2][4][2], const pg8::Unit& u, int wr, int wc, int fr, int fq) const {
        const int row0 = u.pm * 256 + wr * 64 + fr, col0 = u.pn * 256 + wc * 32 + 8 * fq;
        u32x4 hwv[2][4][2];
#pragma unroll
        for (int ai = 0; ai < 2; ++ai)
#pragma unroll
            for (int m = 0; m < 4; ++m)
#pragma unroll
                for (int bj = 0; bj < 2; ++bj) hwv[ai][m][bj] = *(const u32x4*)(hb + (size_t)(row0 + ai * 128 + m * 16) * DM + col0 + bj * 128);
#pragma unroll
        for (int ai = 0; ai < 2; ++ai)
#pragma unroll
            for (int m = 0; m < 4; ++m) {
                const size_t row = (size_t)(row0 + ai * 128 + m * 16); float ss = 0.f;
#pragma unroll
                for (int bj = 0; bj < 2; ++bj) {
                    const u32x4 hw = hwv[ai][m][bj];
                    const f32x4 b0 = {__builtin_bit_cast(float, hw.x << 16), __builtin_bit_cast(float, hw.x & 0xffff0000u), __builtin_bit_cast(float, hw.y << 16), __builtin_bit_cast(float, hw.y & 0xffff0000u)};
                    const f32x4 b1 = {__builtin_bit_cast(float, hw.z << 16), __builtin_bit_cast(float, hw.z & 0xffff0000u), __builtin_bit_cast(float, hw.w << 16), __builtin_bit_cast(float, hw.w & 0xffff0000u)};
                    const f32x4 v0 = acc[ai][bj][m][0] + b0, v1 = acc[ai][bj][m][1] + b1;
                    acc[ai][bj][m][0] = v0; acc[ai][bj][m][1] = v1;
                    ss += (v0[0] * v0[0] + v0[1] * v0[1]) + (v0[2] * v0[2] + v0[3] * v0[3]) + (v1[0] * v1[0] + v1[1] * v1[1]) + (v1[2] * v1[2] + v1[3] * v1[3]);
                }
                ss += __shfl_xor(ss, 16); ss += __shfl_xor(ss, 32);
                if (fq == 0) __hip_atomic_store(part + row * 16 + u.pn * 4 + wc, ss, __ATOMIC_RELAXED, __HIP_MEMORY_SCOPE_AGENT);
            }
        unsigned* fl = flags + (u.pm * 2 + wr) * 16;
        asm volatile("s_waitcnt vmcnt(0)" ::: "memory");
        if (fr == 0 && fq == 0) (void)xb_add(fl, 1u);
        XB_SPIN(xb_ld(fl) < 16u, bar);
        asm volatile("" ::: "memory");
        float t0, t1;
        { const float* pa = part + (size_t)(u.pm * 256 + wr * 64 + fr + 16 * fq) * 16; const float* pb = pa + (size_t)128 * 16;
          f32x4 a0, a1, a2, a3, b0, b1, b2, b3;
          asm volatile("global_load_dwordx4 %0, %1, off sc1" : "=v"(a0) : "v"(pa) : "memory");
          asm volatile("global_load_dwordx4 %0, %1, off offset:16 sc1" : "=v"(a1) : "v"(pa) : "memory");
          asm volatile("global_load_dwordx4 %0, %1, off offset:32 sc1" : "=v"(a2) : "v"(pa) : "memory");
          asm volatile("global_load_dwordx4 %0, %1, off offset:48 sc1" : "=v"(a3) : "v"(pa) : "memory");
          asm volatile("global_load_dwordx4 %0, %1, off sc1" : "=v"(b0) : "v"(pb) : "memory");
          asm volatile("global_load_dwordx4 %0, %1, off offset:16 sc1" : "=v"(b1) : "v"(pb) : "memory");
          asm volatile("global_load_dwordx4 %0, %1, off offset:32 sc1" : "=v"(b2) : "v"(pb) : "memory");
          asm volatile("global_load_dwordx4 %0, %1, off offset:48 sc1" : "=v"(b3) : "v"(pb) : "memory");
          asm volatile("s_waitcnt vmcnt(0)" : "+v"(a0), "+v"(a1), "+v"(a2), "+v"(a3), "+v"(b0), "+v"(b1), "+v"(b2), "+v"(b3) :: "memory");
          t0 = 0.f; t1 = 0.f;
#pragma unroll
          for (int j = 0; j < 4; ++j) t0 += a0[j];
#pragma unroll
          for (int j = 0; j < 4; ++j) t0 += a1[j];
#pragma unroll
          for (int j = 0; j < 4; ++j) t0 += a2[j];
#pragma unroll
          for (int j = 0; j < 4; ++j) t0 += a3[j];
#pragma unroll
          for (int j = 0; j < 4; ++j) t1 += b0[j];
#pragma unroll
          for (int j = 0; j < 4; ++j) t1 += b1[j];
#pragma unroll
          for (int j = 0; j < 4; ++j) t1 += b2[j];
#pragma unroll
          for (int j = 0; j < 4; ++j) t1 += b3[j]; }
#pragma unroll
        for (int ai = 0; ai < 2; ++ai)
#pragma unroll
            for (int m = 0; m < 4; ++m) {
                const size_t row = (size_t)(row0 + ai * 128 + m * 16);
                const float tot = __shfl(ai ? t1 : t0, m * 16 + fr);
                const float rs = 1.0f / sqrtf(tot * (1.f / DM) + EPS);
#pragma unroll
                for (int bj = 0; bj < 2; ++bj) {
                    const size_t off = row * DM + col0 + bj * 128;
                    const f32x4 g0 = *(const f32x4*)(fg + col0 + bj * 128), g1 = *(const f32x4*)(fg + col0 + bj * 128 + 4);
                    *(f32x4*)(out + off) = acc[ai][bj][m][0] * rs * g0; *(f32x4*)(out + off + 4) = acc[ai][bj][m][1] * rs * g1;
                }
            }
    }
};

struct Args { const float* in[18]; float* out; unsigned char* ws; int ph_lo, ph_hi; };
struct Frame {
    LAS unsigned char* lds; int tid, lane, wave, G, bid;
    unsigned char* ws; int dry;
};
#define KSWZ(row, colB) ((row) * 256 + ((colB) ^ (((row) & 15) << 4)))
#define SBAR() __builtin_amdgcn_sched_barrier(0)
__device__ __forceinline__ int crow(int r, int hi) { return (r & 3) + 8 * (r >> 2) + 4 * hi; }
template <int NCB> __device__ __forceinline__ int v_st(int k, int c) { const int kk = (k & ~0xC) | ((k & 4) << 1) | ((k & 8) >> 1); return ((kk >> 3) * NCB + (c >> 5)) * 512 + ((kk & 7) * 32 + (c & 31)) * 2; }
__device__ __forceinline__ int v_rd_base(int lane) { return ((lane & 3) << 3) | (((lane >> 2) & 3) << 6) | (((lane >> 4) & 1) << 5) | (((lane >> 5) & 1) << 8); }
template <int OFF> __device__ __forceinline__ s16x4 tr_read(int vb) { s16x4 r; asm volatile("ds_read_b64_tr_b16 %0, %1 offset:%2" : "=&v"(r) : "v"(vb), "i"(OFF) : "memory"); return r; }
__device__ __forceinline__ int lds_addr(const LAS void* p) { return (int)(unsigned)(size_t)p; }
__device__ __forceinline__ void qkt(f32x16& p0, f32x16& p1, const LAS char* Ks, const bf16x8* qr, int r32, int hi) {
    p0 = f32x16{}; p1 = f32x16{};
#pragma unroll
    for (int d0 = 0; d0 < 8; ++d0) { const int cb = (d0 * 16 + hi * 8) * 2;
        const bf16x8 b0 = *(const LAS bf16x8*)(Ks + KSWZ(r32, cb));
        const bf16x8 b1 = *(const LAS bf16x8*)(Ks + KSWZ(32 + r32, cb));
        p0 = __builtin_amdgcn_mfma_f32_32x32x16_bf16(b0, qr[d0], p0, 0, 0, 0);
        p1 = __builtin_amdgcn_mfma_f32_32x32x16_bf16(b1, qr[d0], p1, 0, 0, 0); }
}
__device__ __forceinline__ void qkt_lq(f32x16& p0, f32x16& p1, const LAS char* Ks, const LAS char* ql, int r32, int hi) {
    p0 = f32x16{}; p1 = f32x16{};
#pragma unroll
    for (int d0 = 0; d0 < 8; ++d0) { const int cb = (d0 * 16 + hi * 8) * 2;
        const bf16x8 q = *(const LAS bf16x8*)(ql + d0 * 1024);
        const bf16x8 b0 = *(const LAS bf16x8*)(Ks + KSWZ(r32, cb));
        const bf16x8 b1 = *(const LAS bf16x8*)(Ks + KSWZ(32 + r32, cb));
        p0 = __builtin_amdgcn_mfma_f32_32x32x16_bf16(b0, q, p0, 0, 0, 0);
        p1 = __builtin_amdgcn_mfma_f32_32x32x16_bf16(b1, q, p1, 0, 0, 0); }
}
__device__ __forceinline__ void pack_p(const f32x16& p0, const f32x16& p1, bf16x8& pa0, bf16x8& pa1, bf16x8& pa2, bf16x8& pa3) {
#define PK4(P, BASE, OUT) do { unsigned a0 = cvt_pk_bf16(P[BASE + 0], P[BASE + 1]), a1 = cvt_pk_bf16(P[BASE + 2], P[BASE + 3]);   \
    unsigned b0 = cvt_pk_bf16(P[BASE + 4], P[BASE + 5]), b1 = cvt_pk_bf16(P[BASE + 6], P[BASE + 7]);                              \
    auto r0 = __builtin_amdgcn_permlane32_swap(a0, b0, false, false); auto r1 = __builtin_amdgcn_permlane32_swap(a1, b1, false, false); \
    u32x4 w = {r0[0], r1[0], r0[1], r1[1]}; OUT = __builtin_bit_cast(bf16x8, w); } while (0)
    PK4(p0, 0, pa0); PK4(p0, 8, pa1); PK4(p1, 0, pa2); PK4(p1, 8, pa3);
#undef PK4
}
__device__ __forceinline__ float xhalf_max(float v) { auto rr = __builtin_amdgcn_permlane32_swap(__float_as_uint(v), __float_as_uint(v), false, false); return fmaxf(__uint_as_float(rr[0]), __uint_as_float(rr[1])); }
__device__ __forceinline__ float xhalf_sum(float v) { auto rr = __builtin_amdgcn_permlane32_swap(__float_as_uint(v), __float_as_uint(v), false, false); return __uint_as_float(rr[0]) + __uint_as_float(rr[1]); }
template <int ND> __device__ __forceinline__ void softmax_step(f32x16& p0, f32x16& p1, float& m, float& l, f32x16 (&o)[ND]) {
    float pmax = p0[0];
#pragma unroll
    for (int r = 1; r < 16; ++r) pmax = fmaxf(pmax, p0[r]);
#pragma unroll
    for (int r = 0; r < 16; ++r) pmax = fmaxf(pmax, p1[r]);
    pmax = xhalf_max(pmax);
    const float mn = fmaxf(m, pmax);
    const float alpha = __builtin_amdgcn_exp2f(m - mn);
    m = mn;
    float ps = 0.f;
#pragma unroll
    for (int r = 0; r < 16; ++r) { p0[r] = __builtin_amdgcn_exp2f(p0[r] - mn); ps += p0[r]; }
#pragma unroll
    for (int r = 0; r < 16; ++r) { p1[r] = __builtin_amdgcn_exp2f(p1[r] - mn); ps += p1[r]; }
    ps = xhalf_sum(ps);
    l = l * alpha + ps;
    if (__any(alpha != 1.f)) {
#pragma unroll
        for (int d = 0; d < ND; ++d)
#pragma unroll
            for (int r = 0; r < 16; ++r) o[d][r] *= alpha;
    }
}
typedef short v4i16_t __attribute__((ext_vector_type(4)));
__device__ __forceinline__ s16x4 vtr(const LAS char* p) { return __builtin_bit_cast(s16x4, __builtin_amdgcn_ds_read_tr16_b64_v4i16((LAS v4i16_t*)p)); }
template <int NCB, int D0> __device__ __forceinline__ void pv_one(f32x16& od, int vb, bf16x8 pa0, bf16x8 pa1, bf16x8 pa2, bf16x8 pa3) {
    constexpr int KS = NCB * 1024, HF = NCB * 512, B0 = D0 * 512;
    const LAS char* vp = (const LAS char*)(size_t)(unsigned)vb;
    const s16x4 l0 = vtr(vp + B0), h0 = vtr(vp + B0 + HF), l1 = vtr(vp + B0 + KS), h1 = vtr(vp + B0 + KS + HF);
    const s16x4 l2 = vtr(vp + B0 + 2 * KS), h2 = vtr(vp + B0 + 2 * KS + HF), l3 = vtr(vp + B0 + 3 * KS), h3 = vtr(vp + B0 + 3 * KS + HF);
#define PKV(L, H) (bf16x8){L[0], L[1], L[2], L[3], H[0], H[1], H[2], H[3]}
    od = __builtin_amdgcn_mfma_f32_32x32x16_bf16(PKV(l0, h0), pa0, od, 0, 0, 0);
    od = __builtin_amdgcn_mfma_f32_32x32x16_bf16(PKV(l1, h1), pa1, od, 0, 0, 0);
    od = __builtin_amdgcn_mfma_f32_32x32x16_bf16(PKV(l2, h2), pa2, od, 0, 0, 0);
    od = __builtin_amdgcn_mfma_f32_32x32x16_bf16(PKV(l3, h3), pa3, od, 0, 0, 0);
#undef PKV
}
template <int NCB> __device__ __forceinline__ void pv_all(f32x16 (&o)[NCB], int vb, bf16x8 pa0, bf16x8 pa1, bf16x8 pa2, bf16x8 pa3) {
    pv_one<NCB, 0>(o[0], vb, pa0, pa1, pa2, pa3); pv_one<NCB, 1>(o[1], vb, pa0, pa1, pa2, pa3); pv_one<NCB, 2>(o[2], vb, pa0, pa1, pa2, pa3); pv_one<NCB, 3>(o[3], vb, pa0, pa1, pa2, pa3);
    if constexpr (NCB == 6) { pv_one<NCB, 4>(o[4], vb, pa0, pa1, pa2, pa3); pv_one<NCB, 5>(o[5], vb, pa0, pa1, pa2, pa3); }
}
struct KReg { bf16x8 a, b; };
template <int NCB> struct VReg { bf16x8 v[NCB == 4 ? 2 : 3]; };
__device__ __forceinline__ void k_load(KReg& s, const bf16_t* kp, size_t ld, int tid) { const int sr = tid >> 4, sc = (tid & 15) * 8;
    s.a = *(const bf16x8*)(kp + (size_t)sr * ld + sc); s.b = *(const bf16x8*)(kp + (size_t)(32 + sr) * ld + sc); }
__device__ __forceinline__ void k_write(LAS char* Kl, const KReg& s, int tid) { const int sr = tid >> 4, kc = (tid & 15) * 16;
    *(LAS bf16x8*)(Kl + KSWZ(sr, kc)) = s.a; *(LAS bf16x8*)(Kl + KSWZ(32 + sr, kc)) = s.b; }
template <int NCB> __device__ __forceinline__ void v_load(VReg<NCB>& s, const bf16_t* vp, size_t ld, int tid) {
    if constexpr (NCB == 4) { const int sr = tid >> 4, sc = (tid & 15) * 8; s.v[0] = *(const bf16x8*)(vp + (size_t)sr * ld + sc); s.v[1] = *(const bf16x8*)(vp + (size_t)(32 + sr) * ld + sc); }
    else {
#pragma unroll
        for (int i = 0; i < 3; ++i) { const int id = tid + 512 * i, row = id / 24, c = (id % 24) * 8; s.v[i] = *(const bf16x8*)(vp + (size_t)row * ld + c); } }
}
template <int NCB> __device__ __forceinline__ void v_write(LAS char* Vl, const VReg<NCB>& s, int tid) {
    if constexpr (NCB == 4) { const int sr = tid >> 4, sc = (tid & 15) * 8; *(LAS bf16x8*)(Vl + v_st<4>(sr, sc)) = s.v[0]; *(LAS bf16x8*)(Vl + v_st<4>(32 + sr, sc)) = s.v[1]; }
    else {
#pragma unroll
        for (int i = 0; i < 3; ++i) { const int id = tid + 512 * i, row = id / 24, c = (id % 24) * 8; *(LAS bf16x8*)(Vl + v_st<6>(row, c)) = s.v[i]; } }
}
__device__ __forceinline__ void q_load(bf16x8 (&qr)[8], const bf16_t* qrow  , int hi) {
#pragma unroll
    for (int d0 = 0; d0 < 8; ++d0) qr[d0] = *(const bf16x8*)(qrow + d0 * 16 + hi * 8);
}
template <int ND> __device__ __forceinline__ void store_y(LAS char* scr, bf16_t* yrow0, size_t ld, const f32x16 (&o)[ND], float sc, const float* colscale, int lane, bool dry) {
    const int r32 = lane & 31, hi = lane >> 5;
    u32x4 gv[ND][2];
#pragma unroll
    for (int d0 = 0; d0 < ND; ++d0)
#pragma unroll
        for (int i = 0; i < 2; ++i) { const int id = lane + 64 * i, tok = id >> 2, c16 = id & 3; gv[d0][i] = *(const u32x4*)(yrow0 + (size_t)tok * ld + 32 * d0 + c16 * 8); }
#pragma unroll
    for (int d0 = 0; d0 < ND; ++d0) {
#pragma unroll
        for (int rg = 0; rg < 4; ++rg) *(LAS u32x2*)(scr + r32 * 80 + (8 * rg + 4 * hi) * 2) = (u32x2){cvt_pk_bf16(o[d0][4 * rg] * sc, o[d0][4 * rg + 1] * sc), cvt_pk_bf16(o[d0][4 * rg + 2] * sc, o[d0][4 * rg + 3] * sc)};
#pragma unroll
        for (int i = 0; i < 2; ++i) { const int id = lane + 64 * i, tok = id >> 2, c16 = id & 3;
            const u32x4 v = *(const LAS u32x4*)(scr + tok * 80 + c16 * 16);
            bf16_t* yp = yrow0 + (size_t)tok * ld + 32 * d0 + c16 * 8; const u32x4 g = gv[d0][i];
            float f[8] = {__builtin_bit_cast(float, v.x << 16), __builtin_bit_cast(float, v.x & 0xffff0000u), __builtin_bit_cast(float, v.y << 16), __builtin_bit_cast(float, v.y & 0xffff0000u),
                          __builtin_bit_cast(float, v.z << 16), __builtin_bit_cast(float, v.z & 0xffff0000u), __builtin_bit_cast(float, v.w << 16), __builtin_bit_cast(float, v.w & 0xffff0000u)};
            const float gg[8] = {__builtin_bit_cast(float, g.x << 16), __builtin_bit_cast(float, g.x & 0xffff0000u), __builtin_bit_cast(float, g.y << 16), __builtin_bit_cast(float, g.y & 0xffff0000u),
                          __builtin_bit_cast(float, g.z << 16), __builtin_bit_cast(float, g.z & 0xffff0000u), __builtin_bit_cast(float, g.w << 16), __builtin_bit_cast(float, g.w & 0xffff0000u)};
            if (colscale) { const f32x4 s0 = *(const f32x4*)(colscale + 32 * d0 + c16 * 8), s1 = *(const f32x4*)(colscale + 32 * d0 + c16 * 8 + 4);
                f[0] *= s0.x; f[1] *= s0.y; f[2] *= s0.z; f[3] *= s0.w; f[4] *= s1.x; f[5] *= s1.y; f[6] *= s1.z; f[7] *= s1.w; }
#pragma unroll
            for (int j = 0; j < 8; ++j) f[j] *= gg[j];
            if (!dry) *(u32x4*)yp = (u32x4){cvt_pk_bf16(f[0], f[1]), cvt_pk_bf16(f[2], f[3]), cvt_pk_bf16(f[4], f[5]), cvt_pk_bf16(f[6], f[7])}; }
        asm volatile("" ::: "memory");
    }
}

__device__ __forceinline__ void dma_k2(LAS char* Kslot, const bf16_t* kp, size_t ld, int wave, int lane);
__device__ __forceinline__ void dma_v2(LAS char* Vslot, const bf16_t* vp, size_t ld, int wave, int lane);
__device__ __forceinline__ void q_rows_regs(bf16x8 (&qr)[8], LAS char* scr, const bf16_t* q0, size_t ld, int lane) {
    u32x4 wq[4][2];
#pragma unroll
    for (int p = 0; p < 4; ++p)
#pragma unroll
        for (int k = 0; k < 2; ++k) { const int id = lane + 64 * k, T = id >> 2, c = 4 * p + (id & 3); wq[p][k] = *(const u32x4*)(q0 + (size_t)T * ld + c * 8); }
#pragma unroll
    for (int p = 0; p < 4; ++p) {
#pragma unroll
        for (int k = 0; k < 2; ++k) { const int id = lane + 64 * k, T = id >> 2, cc = id & 3; *(LAS u32x4*)(scr + (cc >> 1) * 1024 + ((cc & 1) * 32 + T) * 16) = wq[p][k]; }
        asm volatile("s_waitcnt lgkmcnt(0)" ::: "memory");
        qr[2 * p] = *(const LAS bf16x8*)(scr + lane * 16); qr[2 * p + 1] = *(const LAS bf16x8*)(scr + 1024 + lane * 16);
        asm volatile("s_waitcnt lgkmcnt(0)" ::: "memory");
    }
}
__device__ __forceinline__ void mem_attn_phase(const Frame& F, bf16_t* Z, int ldz, int xq_col, int y_col, const bf16_t* mkv, int widx, int nw) {
    int tid = F.tid; asm volatile("" : "+v"(tid));
    const int lane = tid & 63, r32 = lane & 31, hi = lane >> 5, wave = F.wave;
    LAS char* Kl = (LAS char*)F.lds; LAS char* Vl = Kl + 65536; LAS char* scr = Kl + 131072 + wave * 2560;
    constexpr float C = 0.08838834764831845f * LOG2E;
    const int per = nw >> 5, nun = 16 / per;
    const int bh = widx / per, b = bh >> 2, head = bh & 3, tb0 = (widx % per) * nun;
    const bf16_t* kp = mkv + (size_t)b * NMEM * DM + head * 128; const bf16_t* vp = kp + 512;
    __syncthreads();
#pragma unroll
    for (int j = 0; j < 4; ++j) { dma_k2(Kl + j * 16384, kp + (size_t)j * 64 * DM, DM, wave, lane); dma_v2(Vl + j * 16384, vp + (size_t)j * 64 * DM, DM, wave, lane); }
    __syncthreads();
    const int vb = lds_addr(Vl) + v_rd_base(lane);
    for (int ui = 0; ui < nun; ++ui) {
        const int tb = tb0 + ui;
        const size_t t0 = (size_t)b * SEQ + tb * 256 + wave * 32;
        bf16x8 qr[8]; q_rows_regs(qr, scr, Z + t0 * ldz + xq_col + head * 128, ldz, lane);
        float m = -1e30f, l = 0.f; f32x16 o[4] = {};
#pragma unroll
        for (int j = 0; j < 4; ++j) {
            f32x16 p0, p1; qkt(p0, p1, Kl + j * 16384, qr, r32, hi);
#pragma unroll
            for (int r = 0; r < 16; ++r) { p0[r] *= C; p1[r] *= C; }
            softmax_step<4>(p0, p1, m, l, o);
            bf16x8 pa0, pa1, pa2, pa3; pack_p(p0, p1, pa0, pa1, pa2, pa3);
            pv_all<4>(o, vb + j * 16384, pa0, pa1, pa2, pa3);
        }
        store_y<4>(scr, Z + t0 * ldz + y_col + head * 128, ldz, o, 1.f / l, nullptr, lane, F.dry != 0);
    }
    __syncthreads();
}

constexpr int POOL_W_BYTES = 192 * 400, POOL_ZROWS = 144;
__device__ __forceinline__ void pool_phase(const Frame& F, bf16_t* Z, const bf16_t* WP, const float* scale, int unit_lo, int unit_step) {
    int tid = F.tid; asm volatile("" : "+v"(tid));
    const int lane = tid & 63, r32 = lane & 31, hi = lane >> 5, wave = F.wave;
    LAS char* Wl = (LAS char*)F.lds;
    LAS char* Zl = Wl + POOL_W_BYTES;
    for (int u = unit_lo; u < BATCH * 32 * 4; u += unit_step) {
        const int g = (u + (u >> 8)) & 3, tb = (u >> 2) & 31, b = u >> 7, t0 = tb * 128;
        const int win = 2 << g;
        { const bf16_t* wsrc = WP + (size_t)g * 192 * 192; int ts = tid; asm volatile("" : "+v"(ts));
#pragma unroll
          for (int i = 0; i < 9; ++i) { const int id = ts + 512 * i, row = id / 24, c = id % 24; *(LAS bf16x8*)(Wl + row * 400 + c * 16) = *(const bf16x8*)(wsrc + row * 192 + c * 8); }
          const bf16_t* zsrc = Z + ((size_t)b * SEQ + t0 - 16) * EV_LD + EV_ZA + g * 192;
#pragma unroll
          for (int i = 0; i < 7; ++i) { const int id = ts + 512 * i, row = id / 24, c = id % 24;
              if (id < POOL_ZROWS * 24) { bf16x8 v = bf16x8{}; if (t0 - 16 + row >= 0) v = *(const bf16x8*)(zsrc + (size_t)row * EV_LD + c * 8); *(LAS bf16x8*)(Zl + row * 400 + c * 16) = v; } } }
        __syncthreads();
        const int tt = wave & 3, obh = wave >> 2, tloc = t0 + tt * 32 + r32;
        const int cnt = (tloc + 1 < win) ? tloc + 1 : win; const float icnt = 1.0f / (float)cnt;
        const LAS char* zr = Zl + (16 + tt * 32 + r32) * 400 + 16 * hi;
        f32x16 o[3] = {};
#define POOL_KSTEPS(WIN) do { _Pragma("unroll 1") for (int s = 0; s < 12; ++s) { bf16x8 wv[WIN]; \
            _Pragma("unroll") for (int i = 0; i < WIN; ++i) wv[i] = *(const LAS bf16x8*)(zr + 32 * s - i * 400); \
            float accv[8], cur[8]; \
            _Pragma("unroll") for (int j = 0; j < 8; ++j) { cur[j] = bf2f((unsigned short)wv[0][j]); accv[j] = cur[j]; } \
            _Pragma("unroll") for (int i = 1; i < WIN; ++i) { _Pragma("unroll") for (int j = 0; j < 8; ++j) accv[j] += bf2f((unsigned short)wv[i][j]); } \
            u32x4 w; w.x = cvt_pk_bf16(accv[0] * icnt - cur[0], accv[1] * icnt - cur[1]); w.y = cvt_pk_bf16(accv[2] * icnt - cur[2], accv[3] * icnt - cur[3]); \
            w.z = cvt_pk_bf16(accv[4] * icnt - cur[4], accv[5] * icnt - cur[5]); w.w = cvt_pk_bf16(accv[6] * icnt - cur[6], accv[7] * icnt - cur[7]); \
            const bf16x8 bfrag = __builtin_bit_cast(bf16x8, w); \
            _Pragma("unroll") for (int j = 0; j < 3; ++j) { const bf16x8 afrag = *(const LAS bf16x8*)(Wl + (32 * (3 * obh + j) + r32) * 400 + (16 * s + 8 * hi) * 2); \
                o[j] = __builtin_amdgcn_mfma_f32_32x32x16_bf16(afrag, bfrag, o[j], 0, 0, 0); } } } while (0)
        if (g == 0) POOL_KSTEPS(2); else if (g == 1) POOL_KSTEPS(4); else if (g == 2) POOL_KSTEPS(8); else POOL_KSTEPS(16);
#undef POOL_KSTEPS
        store_y<3>(Wl + POOL_W_BYTES + POOL_ZROWS * 400 + wave * 2560, Z + ((size_t)b * SEQ + t0 + tt * 32) * EV_LD + EV_G + g * 192 + 96 * obh, EV_LD, o, 1.f, scale + g * 192 + 96 * obh, lane, F.dry != 0);
        __syncthreads();
    }
}

__device__ __forceinline__ void unpack8(const u32x4 w, float (&f)[8]) {
    f[0] = __builtin_bit_cast(float, w.x << 16); f[1] = __builtin_bit_cast(float, w.x & 0xffff0000u); f[2] = __builtin_bit_cast(float, w.y << 16); f[3] = __builtin_bit_cast(float, w.y & 0xffff0000u);
    f[4] = __builtin_bit_cast(float, w.z << 16); f[5] = __builtin_bit_cast(float, w.z & 0xffff0000u); f[6] = __builtin_bit_cast(float, w.w << 16); f[7] = __builtin_bit_cast(float, w.w & 0xffff0000u);
}
constexpr int RET_KV_ELEMS = 192 * 128;
__device__ __forceinline__ float ret_log2_gamma(int h) { return log2f(1.0f - exp2f(-5.0f - (float)h)); }
struct RetAPre { bf16x8 x1[2], x2[2], v[6]; f32x4 ca[2], cb[2], sa[2], sb[2]; };
__device__ __forceinline__ void ret_a_load(RetAPre& P, const bf16_t* Z, const float* ropec, const float* ropes, int u, int tid) {
    asm volatile("" : "+v"(tid));
    const int b = u >> 7, h = (u >> 5) & 3, n = u & 31, c0 = n * 128;
#pragma unroll
    for (int i = 0; i < 2; ++i) {
        const int id = tid + 512 * i, m = id >> 3, c = id & 7, pos = c0 + m;
        const bf16_t* kp = Z + ((size_t)b * SEQ + pos) * EV_LD + EV_RK + h * 128 + 8 * c;
        P.x1[i] = *(const bf16x8*)kp; P.x2[i] = *(const bf16x8*)(kp + 64);
        P.ca[i] = *(const f32x4*)(ropec + pos * 64 + 8 * c); P.cb[i] = *(const f32x4*)(ropec + pos * 64 + 8 * c + 4);
        P.sa[i] = *(const f32x4*)(ropes + pos * 64 + 8 * c); P.sb[i] = *(const f32x4*)(ropes + pos * 64 + 8 * c + 4); }
#pragma unroll
    for (int i = 0; i < 6; ++i) { const int id = tid + 512 * i, m = id / 24, c = id % 24;
        P.v[i] = *(const bf16x8*)(Z + ((size_t)b * SEQ + c0 + m) * EV_LD + EV_RV + h * 192 + 8 * c); }
}
__device__ __forceinline__ void ret_a_phase(const Frame& F, const bf16_t* Z, const float* ropec, const float* ropes, bf16_t* kvT, int unit_lo, int unit_step) {
    int tid = F.tid; asm volatile("" : "+v"(tid));
    const int lane = tid & 63, wave = F.wave;
    LAS char* Kimg = (LAS char*)F.lds; LAS char* Vimg = Kimg + 32768;
    RetAPre P;
    if (unit_lo < BATCH * 4 * 32) ret_a_load(P, Z, ropec, ropes, unit_lo, tid);
    for (int u = unit_lo; u < BATCH * 4 * 32; u += unit_step) {
        const int h = (u >> 5) & 3;
        const float lgam = ret_log2_gamma(h);
#pragma unroll
        for (int i = 0; i < 2; ++i) {
            const int id = tid + 512 * i, m = id >> 3, c = id & 7;
            const f32x4 ca = P.ca[i], cb = P.cb[i], sa = P.sa[i], sb = P.sb[i];
            float cs[8] = {ca.x, ca.y, ca.z, ca.w, cb.x, cb.y, cb.z, cb.w}, sn[8] = {sa.x, sa.y, sa.z, sa.w, sb.x, sb.y, sb.z, sb.w};
            const float zeta = exp2f((float)(127 - m) * lgam);
            const bf16x8 x1 = P.x1[i], x2 = P.x2[i];
            float o1[8], o2[8];
#pragma unroll
            for (int j = 0; j < 8; ++j) { const float a = bf2f((unsigned short)x1[j]), bb = bf2f((unsigned short)x2[j]); o1[j] = (a * cs[j] - bb * sn[j]) * zeta; o2[j] = (a * sn[j] + bb * cs[j]) * zeta; }
            u32x4 z1 = {cvt_pk_bf16(o1[0], o1[1]), cvt_pk_bf16(o1[2], o1[3]), cvt_pk_bf16(o1[4], o1[5]), cvt_pk_bf16(o1[6], o1[7])};
            u32x4 z2 = {cvt_pk_bf16(o2[0], o2[1]), cvt_pk_bf16(o2[2], o2[3]), cvt_pk_bf16(o2[4], o2[5]), cvt_pk_bf16(o2[6], o2[7])};
            LAS char* img = Kimg + (m >> 6) * 16384;
            *(LAS u32x4*)(img + v_st<4>(m & 63, 8 * c)) = z1; *(LAS u32x4*)(img + v_st<4>(m & 63, 64 + 8 * c)) = z2;
        }
#pragma unroll
        for (int i = 0; i < 6; ++i) { const int id = tid + 512 * i, m = id / 24, c = id % 24;
            *(LAS bf16x8*)(Vimg + (m >> 6) * 24576 + v_st<6>(m & 63, 8 * c)) = P.v[i]; }
        __syncthreads();
        if (u + unit_step < BATCH * 4 * 32) ret_a_load(P, Z, ropec, ropes, u + unit_step, tid);
        const int kbk = wave & 3, dvb0 = (wave >> 2) * 3;
        const int vbK = lds_addr(Kimg) + v_rd_base(lane) + kbk * 512, vbV = lds_addr(Vimg) + v_rd_base(lane) + dvb0 * 512;
        f32x16 acc[3] = {};
#pragma unroll
        for (int T = 0; T < 2; ++T)
#pragma unroll
            for (int ks = 0; ks < 4; ++ks) {
                const s16x4 bl = tr_read<0>(vbK + T * 16384 + ks * 4096), bh = tr_read<0>(vbK + T * 16384 + ks * 4096 + 2048);
                s16x4 al[3], ah[3];
#pragma unroll
                for (int i = 0; i < 3; ++i) { al[i] = tr_read<0>(vbV + T * 24576 + ks * 6144 + i * 512); ah[i] = tr_read<0>(vbV + T * 24576 + ks * 6144 + 3072 + i * 512); }
                asm volatile("s_waitcnt lgkmcnt(0)" ::: "memory"); SBAR();
                const bf16x8 bf = (bf16x8){bl[0], bl[1], bl[2], bl[3], bh[0], bh[1], bh[2], bh[3]};
#pragma unroll
                for (int i = 0; i < 3; ++i) { const bf16x8 af = (bf16x8){al[i][0], al[i][1], al[i][2], al[i][3], ah[i][0], ah[i][1], ah[i][2], ah[i][3]};
                    acc[i] = __builtin_amdgcn_mfma_f32_32x32x16_bf16(bf, af, acc[i], 0, 0, 0); }
            }
        bf16_t* dst = kvT + (size_t)u * RET_KV_ELEMS;
        const int r32 = lane & 31, hi = lane >> 5;
        LAS char* tsc = Kimg + 81920 + wave * 7680;
#pragma unroll
        for (int i = 0; i < 3; ++i)
#pragma unroll
            for (int q = 0; q < 4; ++q) *(LAS u32x2*)(tsc + (32 * i + r32) * 80 + (8 * q + 4 * hi) * 2) = (u32x2){cvt_pk_bf16(acc[i][4 * q], acc[i][4 * q + 1]), cvt_pk_bf16(acc[i][4 * q + 2], acc[i][4 * q + 3])};
        asm volatile("s_waitcnt lgkmcnt(0)" ::: "memory");
        if (!F.dry)
#pragma unroll
        for (int k = 0; k < 6; ++k) { const int id = lane + 64 * k, row = id >> 2, part = id & 3;
            *(u32x4*)(dst + (size_t)(32 * dvb0 + row) * 128 + 32 * kbk + part * 8) = *(const LAS u32x4*)(tsc + row * 80 + part * 16); }
        __syncthreads();
    }
}
__device__ __forceinline__ void ret_scan_phase(const Frame& F, bf16_t* kvT) {
    for (int idx = F.bid * 512 + F.tid; idx < 32 * (RET_KV_ELEMS / 8); idx += F.G * 512) {
        const int bh = idx / (RET_KV_ELEMS / 8), e = idx % (RET_KV_ELEMS / 8), h = bh & 3;
        const float gch = exp2f(128.0f * ret_log2_gamma(h));
        u32x4* p = (u32x4*)(kvT + (size_t)bh * 32 * RET_KV_ELEMS) + e;
        float R[8];
#pragma unroll
        for (int j = 0; j < 8; ++j) R[j] = 0.f;
        u32x4 twv[32];
#pragma unroll
        for (int n = 0; n < 32; ++n) twv[n] = p[(size_t)n * (RET_KV_ELEMS / 8)];
#pragma unroll
        for (int n = 0; n < 32; ++n) { const u32x4 tw = twv[n]; float t[8]; unpack8(tw, t);
            if (!F.dry) p[(size_t)n * (RET_KV_ELEMS / 8)] = (u32x4){cvt_pk_bf16(R[0], R[1]), cvt_pk_bf16(R[2], R[3]), cvt_pk_bf16(R[4], R[5]), cvt_pk_bf16(R[6], R[7])};
#pragma unroll
            for (int j = 0; j < 8; ++j) R[j] = R[j] * gch + t[j]; }
    }
}
constexpr int RETC_SCR_OFF = 32768 + 49152 + 2048, RETC_R_OFF = RETC_SCR_OFF + 8 * 2560;
__device__ __forceinline__ void ret_c_phase(const Frame& F, bf16_t* Z, const float* ropec, const float* ropes, const bf16_t* kvT, int unit_lo, int unit_step) {
    int tid = F.tid; asm volatile("" : "+v"(tid));
    const int lane = tid & 63, wave = F.wave, r32 = lane & 31, hi = lane >> 5;
    LAS char* Kl = (LAS char*)F.lds; LAS char* Vl = Kl + 32768; LAS float* st = (LAS float*)(Kl + 32768 + 49152);
    LAS char* Rl = Kl + RETC_R_OFF;
    VReg<6> pv0, pv1; u32x4 pr[6];
#define RETC_PRE(U) do { int tp_ = tid; asm volatile("" : "+v"(tp_)); const int b_ = (U) >> 7, h_ = ((U) >> 5) & 3, n_ = (U) & 31; \
        const bf16_t* zv_ = Z + ((size_t)b_ * SEQ + n_ * 128) * EV_LD + EV_RV + h_ * 192; v_load<6>(pv0, zv_, EV_LD, tp_); v_load<6>(pv1, zv_ + (size_t)64 * EV_LD, EV_LD, tp_); \
        const u32x4* rp_ = (const u32x4*)(kvT + (size_t)(U) * RET_KV_ELEMS); _Pragma("unroll") for (int i_ = 0; i_ < 6; ++i_) pr[i_] = rp_[tp_ + 512 * i_]; } while (0)
    if (unit_lo < BATCH * 4 * 32) RETC_PRE(unit_lo);
    for (int u = unit_lo; u < BATCH * 4 * 32; u += unit_step) {
        const int b = u >> 7, h = (u >> 5) & 3, n = u & 31, c0 = n * 128;
        const float lgam = ret_log2_gamma(h);
        const bf16_t* zb = Z + ((size_t)b * SEQ + c0) * EV_LD;
        { const int sr = tid >> 4, cc = tid & 15, fq0 = 8 * (cc & 7);
#pragma unroll
          for (int i = 0; i < 4; ++i) { const int m = (i >> 1) * 64 + (i & 1) * 32 + sr, pos = c0 + m;
              const f32x4 ca = *(const f32x4*)(ropec + pos * 64 + fq0), cb = *(const f32x4*)(ropec + pos * 64 + fq0 + 4), sa = *(const f32x4*)(ropes + pos * 64 + fq0), sb = *(const f32x4*)(ropes + pos * 64 + fq0 + 4);
              const float cs[8] = {ca.x, ca.y, ca.z, ca.w, cb.x, cb.y, cb.z, cb.w}, sn[8] = {sa.x, sa.y, sa.z, sa.w, sb.x, sb.y, sb.z, sb.w};
#pragma unroll
              for (int qk = 0; qk < 2; ++qk) {
                  const bf16_t* kr = zb + (size_t)m * EV_LD + (qk ? EV_RK : EV_RQ) + h * 128;
                  const bf16x8 xo = *(const bf16x8*)(kr + 8 * cc), xp = *(const bf16x8*)(kr + 8 * (cc ^ 8));
                  const float sc = qk ? 1.0f : 0.08838834764831845f;
                  float o[8];
#pragma unroll
                  for (int j = 0; j < 8; ++j) { const float a = bf2f((unsigned short)xo[j]), p = bf2f((unsigned short)xp[j]); o[j] = ((cc < 8) ? a * cs[j] - p * sn[j] : p * sn[j] + a * cs[j]) * sc; }
                  *(LAS u32x4*)((qk ? Kl : Rl) + (i >> 1) * 16384 + KSWZ((i & 1) * 32 + sr, cc * 16)) = (u32x4){cvt_pk_bf16(o[0], o[1]), cvt_pk_bf16(o[2], o[3]), cvt_pk_bf16(o[4], o[5]), cvt_pk_bf16(o[6], o[7])}; } } }
        v_write<6>(Vl, pv0, tid); v_write<6>(Vl + 24576, pv1, tid);
        const int q4 = wave & 3, dvb0 = (wave >> 2) * 3, ti = 32 * q4 + r32;
        __syncthreads();
        bf16x8 qr[8];
#pragma unroll
        for (int s = 0; s < 8; ++s) qr[s] = *(const LAS bf16x8*)(Rl + (ti >> 6) * 16384 + KSWZ(ti & 63, (2 * s + hi) * 16));
        __syncthreads();
        { int ts = tid; asm volatile("" : "+v"(ts));
#pragma unroll
          for (int i = 0; i < 6; ++i) { const int id = ts + 512 * i, row = id >> 4, c8 = id & 15; *(LAS u32x4*)(Rl + row * 272 + c8 * 16) = pr[i]; } }
        if (u + unit_step < BATCH * 4 * 32) RETC_PRE(u + unit_step);
        f32x16 o[3] = {};
        const int ntile = (q4 >> 1) + 1;
        for (int j = 0; j < ntile; ++j) {
            f32x16 p0, p1; qkt(p0, p1, Kl + j * 16384, qr, r32, hi);
#pragma unroll
            for (int r = 0; r < 16; ++r) { const int d0 = ti - (64 * j + crow(r, hi)), d1 = d0 - 32;
                p0[r] = d0 >= 0 ? p0[r] * __builtin_amdgcn_exp2f((float)d0 * lgam) : 0.f; p1[r] = d1 >= 0 ? p1[r] * __builtin_amdgcn_exp2f((float)d1 * lgam) : 0.f; }
            bf16x8 pa0, pa1, pa2, pa3; pack_p(p0, p1, pa0, pa1, pa2, pa3);
            const int vb = lds_addr(Vl + j * 24576) + v_rd_base(lane) + dvb0 * 512;
            pv_one<6, 0>(o[0], vb, pa0, pa1, pa2, pa3); pv_one<6, 0>(o[1], vb + 512, pa0, pa1, pa2, pa3); pv_one<6, 0>(o[2], vb + 1024, pa0, pa1, pa2, pa3);
        }
        __syncthreads();
        { const float xi = exp2f((float)(ti + 1) * lgam);
#pragma unroll
          for (int s = 0; s < 8; ++s) { u32x4 w = __builtin_bit_cast(u32x4, qr[s]);
              w.x = cvt_pk_bf16(__builtin_bit_cast(float, w.x << 16) * xi, __builtin_bit_cast(float, w.x & 0xffff0000u) * xi); w.y = cvt_pk_bf16(__builtin_bit_cast(float, w.y << 16) * xi, __builtin_bit_cast(float, w.y & 0xffff0000u) * xi);
              w.z = cvt_pk_bf16(__builtin_bit_cast(float, w.z << 16) * xi, __builtin_bit_cast(float, w.z & 0xffff0000u) * xi); w.w = cvt_pk_bf16(__builtin_bit_cast(float, w.w << 16) * xi, __builtin_bit_cast(float, w.w & 0xffff0000u) * xi);
              qr[s] = __builtin_bit_cast(bf16x8, w); }
#pragma unroll
          for (int i = 0; i < 3; ++i)
#pragma unroll
              for (int s = 0; s < 8; ++s) { const bf16x8 af = *(const LAS bf16x8*)(Rl + (32 * (dvb0 + i) + r32) * 272 + (16 * s + 8 * hi) * 2);
                  o[i] = __builtin_amdgcn_mfma_f32_32x32x16_bf16(af, qr[s], o[i], 0, 0, 0); } }
        float s1 = 0.f, s2 = 0.f;
#pragma unroll
        for (int i = 0; i < 3; ++i)
#pragma unroll
            for (int r = 0; r < 16; ++r) { s1 += o[i][r]; s2 += o[i][r] * o[i][r]; }
        s1 = xhalf_sum(s1); s2 = xhalf_sum(s2);
        if (hi == 0) { st[(wave * 32 + r32) * 2] = s1; st[(wave * 32 + r32) * 2 + 1] = s2; }
        __syncthreads();
        const float t1 = s1 + st[((wave ^ 4) * 32 + r32) * 2], t2 = s2 + st[((wave ^ 4) * 32 + r32) * 2 + 1];
        const float mu = t1 * (1.f / 192.f), var = fmaxf(t2 * (1.f / 192.f) - mu * mu, 0.f), rs = 1.0f / sqrtf(var + EPS);
#pragma unroll
        for (int i = 0; i < 3; ++i)
#pragma unroll
            for (int r = 0; r < 16; ++r) o[i][r] = (o[i][r] - mu) * rs;
        store_y<3>(Kl + RETC_SCR_OFF + wave * 2560, Z + ((size_t)b * SEQ + c0 + 32 * q4) * EV_LD + EV_G + 768 + h * 192 + 32 * dvb0, EV_LD, o, 1.f, nullptr, lane, F.dry != 0);
        __syncthreads();
    }
}
#undef RETC_PRE

__device__ __forceinline__ void dma_k2(LAS char* Kslot, const bf16_t* kp, size_t ld, int wave, int lane);
__device__ __forceinline__ void compress_phase(const Frame& F, const bf16_t* Z, const bf16_t* W1t, const bf16_t* W2t, const float* b1, const float* b1part, bf16_t* kcmp, bf16_t* vcmp, int unit_lo, int unit_step) {
    const int tid = F.tid, lane = F.lane, wave = F.wave, r32 = lane & 31, hi = lane >> 5;
    LAS char* Wb = (LAS char*)F.lds; LAS char* Al = Wb + 131072; LAS char* Hs = Wb;
    volatile LAS unsigned* mw = (volatile LAS unsigned*)(F.lds + MISC_OFF); const unsigned sv0 = mw[0], sv1 = mw[1];
    for (int u = unit_lo; u < 128; u += unit_step) {
        const int kv = u >> 6, rt = u & 63;
        const bf16_t* w1 = W1t + (size_t)kv * 256 * 4096; const bf16_t* w2 = W2t + (size_t)kv * 128 * 256;
        bf16_t* dstc = kv ? vcmp : kcmp; const int zc = kv ? OD_VC : OD_KC;
        if (rt == 0 && tid < 256) { const int bg = tid >> 4, c = tid & 15; *(u32x4*)(dstc + ((size_t)bg * 256 + 255) * 128 + c * 8) = (u32x4){0u, 0u, 0u, 0u}; }
        const int sr = tid >> 4, sc = (tid & 15) * 8;
        const bf16_t* rp[2];
#pragma unroll
        for (int i = 0; i < 2; ++i) { int r = rt * 64 + sr + 32 * i; if (r > 4079) r = 4079; const int g = r & 1, bj = r >> 1, b = bj / 255, j = bj % 255;
            rp[i] = Z + ((size_t)b * SEQ + 16 * j) * OD_LD + zc + g * 128 + sc; }
        KReg a; a.a = *(const bf16x8*)rp[0]; a.b = *(const bf16x8*)rp[1];
#pragma unroll
        for (int q = 0; q < 4; ++q) dma_k2(Wb + q * 16384, w1 + (size_t)(64 * q) * 4096, 4096, wave, lane);
        k_write(Al, a, tid);
        f32x16 acc[2] = {};
#pragma unroll 1
        for (int l = 0; l < 32; ++l) {
            const LAS char* wt = Wb + (l & 1) * 65536 + (wave >> 1) * 16384;
            const LAS char* Ac = Al + (l & 1) * 16384;
            __syncthreads();
            if (l + 1 < 32) { a.a = *(const bf16x8*)(rp[0] + (size_t)(l + 1) * OD_LD); a.b = *(const bf16x8*)(rp[1] + (size_t)(l + 1) * OD_LD);
#pragma unroll
                for (int q = 0; q < 4; ++q) dma_k2(Wb + ((l + 1) & 1) * 65536 + q * 16384, w1 + (size_t)(64 * q) * 4096 + (l + 1) * 128, 4096, wave, lane); }
#pragma unroll
            for (int s = 0; s < 8; ++s) { const int cb = (16 * s + 8 * hi) * 2;
                const bf16x8 a0 = *(const LAS bf16x8*)(Ac + KSWZ(r32, cb)), a1 = *(const LAS bf16x8*)(Ac + KSWZ(32 + r32, cb));
                const bf16x8 bf = *(const LAS bf16x8*)(wt + KSWZ(32 * (wave & 1) + r32, cb));
                acc[0] = __builtin_amdgcn_mfma_f32_32x32x16_bf16(a0, bf, acc[0], 0, 0, 0);
                acc[1] = __builtin_amdgcn_mfma_f32_32x32x16_bf16(a1, bf, acc[1], 0, 0, 0); }
            if (l + 1 < 32) k_write(Al + ((l + 1) & 1) * 16384, a, tid);
        }
        { const int col = 32 * wave + r32; float bb = b1[kv * 256 + col];
          for (int j = 0; j < 32; ++j) bb += b1part[(kv * 32 + j) * 256 + col];
#pragma unroll
          for (int rb = 0; rb < 2; ++rb)
#pragma unroll
              for (int r = 0; r < 16; ++r) { const float v = acc[rb][r] + bb; const float sv = v * fast_sigmoid(v);
                  *(LAS unsigned short*)(Hs + (32 * rb + crow(r, hi)) * 528 + col * 2) = (unsigned short)f2bf(sv); } }
        __syncthreads();
        { const int rb = wave & 1, cbk = wave >> 1; f32x16 o2 = {};
#pragma unroll
          for (int s = 0; s < 16; ++s) { const bf16x8 af = *(const LAS bf16x8*)(Hs + (32 * rb + r32) * 528 + (16 * s + 8 * hi) * 2);
              const bf16x8 bf = *(const bf16x8*)(w2 + (size_t)(32 * cbk + r32) * 256 + 16 * s + 8 * hi);
              o2 = __builtin_amdgcn_mfma_f32_32x32x16_bf16(af, bf, o2, 0, 0, 0); }
#pragma unroll
          for (int r = 0; r < 16; ++r) { const int row = rt * 64 + 32 * rb + crow(r, hi);
              if (row < 4080) { const int g = row & 1, bj = row >> 1, b = bj / 255, j = bj % 255;
                  dstc[(((size_t)b * 2 + g) * 256 + j) * 128 + 32 * cbk + r32] = (bf16_t)f2bf(o2[r]); } } }
        __syncthreads();
    }
    if (tid == 0) { mw[0] = sv0; mw[1] = sv1; }
    __syncthreads();
}

__device__ __forceinline__ void nsa_post(f32x16& p0, f32x16& p1, int t, int kbase, int kstride, int limit, bool sel, int kvalid, const LAS float* tbl, int hi, bool fast) {
    constexpr float C = 0.08838834764831845f * LOG2E;
    const float NEGINF = -__builtin_inff();
    if (fast) { const float b128 = tbl[128];
#pragma unroll
        for (int r = 0; r < 16; ++r) { p0[r] = sel ? p0[r] * C + b128 : NEGINF; p1[r] = sel ? p1[r] * C + b128 : NEGINF; }
        return; }
    asm volatile("" : "+v"(hi), "+v"(t));
#pragma unroll
    for (int r = 0; r < 16; ++r) {
        { const int k = crow(r, hi); const int rel = t - (kbase + kstride * k); const bool ok = sel && rel >= 0 && rel < limit && k < kvalid; const int idx = rel < 0 ? 0 : (rel > 128 ? 128 : rel);
          p0[r] = ok ? p0[r] * C + tbl[idx] : NEGINF; }
        { const int k = 32 + crow(r, hi); const int rel = t - (kbase + kstride * k); const bool ok = sel && rel >= 0 && rel < limit && k < kvalid; const int idx = rel < 0 ? 0 : (rel > 128 ? 128 : rel);
          p1[r] = ok ? p1[r] * C + tbl[idx] : NEGINF; }
    }
}
__device__ __forceinline__ float fadd_s(float a, float b) { float r; asm("v_add_f32_e32 %0, %1, %2" : "=v"(r) : "v"(a), "v"(b)); return r; }
__device__ __forceinline__ float max3_s(float a, float b, float c) { float r; asm("v_max3_f32 %0, %1, %2, %3" : "=v"(r) : "v"(a), "v"(b), "v"(c)); return r; }
__device__ __forceinline__ void dma_k(LAS char* Kslot, const bf16_t* kp, size_t ld, int lw  , int lane) {
    asm volatile("" : "+v"(lane));
#pragma unroll
    for (int i = 0; i < 8; ++i) { const int pc = lw * 8 + i, row = pc * 4 + (lane >> 4), ch = (lane & 15) ^ (row & 15);
        __builtin_amdgcn_global_load_lds((const unsigned*)(kp + (size_t)row * ld + ch * 8), (LAS unsigned*)(Kslot + pc * 1024), 16, 0, 0); }
}
__device__ __forceinline__ void dma_v(LAS char* Vslot, const bf16_t* vp, size_t ld, int lw, int lane) {
    asm volatile("" : "+v"(lane));
#pragma unroll
    for (int i = 0; i < 8; ++i) { const int pc = lw * 8 + i, cblk = 2 * (pc & 1) + (lane >> 5), kk = (pc >> 1) * 8 + ((lane & 31) >> 2), k = (kk & ~0xC) | ((kk & 4) << 1) | ((kk & 8) >> 1), c = cblk * 32 + (lane & 3) * 8;
        __builtin_amdgcn_global_load_lds((const unsigned*)(vp + (size_t)k * ld + c), (LAS unsigned*)(Vslot + pc * 1024), 16, 0, 0); }
}
constexpr float NSA_THR = 24.0f;
template <int MODE>
__device__ __forceinline__ void acc_step(LAS char* scr, bf16_t* arow0, size_t ald, bf16_t* yrow0, size_t yld, const f32x16 (&o)[4], float sc, int lane, bool dry) {
    const int r32 = lane & 31, hi = lane >> 5;
    u32x4 av[4][2], yv[4][2];
    if (MODE >= 1) {
#pragma unroll
        for (int d0 = 0; d0 < 4; ++d0)
#pragma unroll
            for (int i = 0; i < 2; ++i) { const int id = lane + 64 * i, tok = id >> 2, c16 = id & 3; av[d0][i] = *(const u32x4*)(arow0 + (size_t)tok * ald + 32 * d0 + c16 * 8); } }
    if (MODE == 2) {
#pragma unroll
        for (int d0 = 0; d0 < 4; ++d0)
#pragma unroll
            for (int i = 0; i < 2; ++i) { const int id = lane + 64 * i, tok = id >> 2, c16 = id & 3; yv[d0][i] = *(const u32x4*)(yrow0 + (size_t)tok * yld + 32 * d0 + c16 * 8); } }
#pragma unroll
    for (int d0 = 0; d0 < 4; ++d0) {
#pragma unroll
        for (int rg = 0; rg < 4; ++rg) *(LAS u32x2*)(scr + r32 * 80 + (8 * rg + 4 * hi) * 2) = (u32x2){cvt_pk_bf16(o[d0][4 * rg] * sc, o[d0][4 * rg + 1] * sc), cvt_pk_bf16(o[d0][4 * rg + 2] * sc, o[d0][4 * rg + 3] * sc)};
#pragma unroll
        for (int i = 0; i < 2; ++i) { const int id = lane + 64 * i, tok = id >> 2, c16 = id & 3;
            float f[8]; unpack8(*(const LAS u32x4*)(scr + tok * 80 + c16 * 16), f);
            bf16_t* ap = arow0 + (size_t)tok * ald + 32 * d0 + c16 * 8;
            if (MODE >= 1) { float a[8]; unpack8(av[d0][i], a);
#pragma unroll
                for (int j = 0; j < 8; ++j) f[j] += a[j]; }
            if (MODE == 2) { bf16_t* yp = yrow0 + (size_t)tok * yld + 32 * d0 + c16 * 8; float g[8]; unpack8(yv[d0][i], g);
#pragma unroll
                for (int j = 0; j < 8; ++j) f[j] *= g[j];
                if (!dry) *(u32x4*)yp = (u32x4){cvt_pk_bf16(f[0], f[1]), cvt_pk_bf16(f[2], f[3]), cvt_pk_bf16(f[4], f[5]), cvt_pk_bf16(f[6], f[7])}; }
            else *(u32x4*)ap = (u32x4){cvt_pk_bf16(f[0], f[1]), cvt_pk_bf16(f[2], f[3]), cvt_pk_bf16(f[4], f[5]), cvt_pk_bf16(f[6], f[7])}; }
        asm volatile("" ::: "memory");
    }
}
#define NSA_PK4(P, BASE, OUT) do { unsigned a0_ = cvt_pk_bf16(P[BASE + 0], P[BASE + 1]), a1_ = cvt_pk_bf16(P[BASE + 2], P[BASE + 3]);   \
    unsigned b0_ = cvt_pk_bf16(P[BASE + 4], P[BASE + 5]), b1_ = cvt_pk_bf16(P[BASE + 6], P[BASE + 7]);                              \
    auto r0_ = __builtin_amdgcn_permlane32_swap(a0_, b0_, false, false); auto r1_ = __builtin_amdgcn_permlane32_swap(a1_, b1_, false, false); \
    u32x4 w_ = {r0_[0], r1_[0], r0_[1], r1_[1]}; OUT = __builtin_bit_cast(bf16x8, w_); } while (0)
struct TileInfo { int blk; bool far; };
template <int TYPE> __device__ __forceinline__ TileInfo tile_info(int blk, int s0) {
    TileInfo ti; ti.blk = blk; const int kb = 64 * blk;
    if (TYPE == 0) ti.far = s0 - (kb + 63) >= 128;
    else if (TYPE == 1) ti.far = (s0 - (kb + 63) >= 128) && (s0 + 31 - kb < 512);
    else ti.far = (blk < 3) && (s0 - (16 * (kb + 63) + 31) >= 128);
    return ti;
}
template <int TYPE> __device__ __forceinline__ void near_post(f32x16& P0, f32x16& P1, int blk, int t, float m, const LAS float* tbl, int hi) {
    const float NEGINF = -__builtin_inff();
    asm volatile("" : "+v"(hi), "+v"(t));
    const int rel0 = (TYPE >= 2) ? t - 31 - 16 * (64 * blk + 4 * hi) : t - 64 * blk - 4 * hi;
    const int jlim = 255 - 64 * blk - 4 * hi;
#pragma unroll
    for (int q = 0; q < 4; ++q) {
        float bv[8]; int rl[8];
#pragma unroll
        for (int e = 0; e < 8; ++e) { const int r = 4 * q + (e & 3), h = e >> 2, kc = 32 * h + (r & 3) + 8 * (r >> 2);
            rl[e] = (TYPE >= 2) ? rel0 - 16 * kc : rel0 - kc;
            const int idx = rl[e] < 0 ? 0 : (rl[e] > 128 ? 128 : rl[e]);
            bv[e] = tbl[idx]; }
#pragma unroll
        for (int e = 0; e < 8; ++e) { const int r = 4 * q + (e & 3), h = e >> 2, kc = 32 * h + (r & 3) + 8 * (r >> 2);
            bool ok = rl[e] >= 0; if (TYPE == 1) ok = ok && rl[e] < 512; if (TYPE >= 2) ok = ok && kc < jlim;
            if (h) { const float v = P1[r] + (bv[e] - m); P1[r] = ok ? v : NEGINF; } else { const float v = P0[r] + (bv[e] - m); P0[r] = ok ? v : NEGINF; } }
        SBAR();
    }
}
template <int TYPE>
__device__ __forceinline__ void nsa_step(f32x16& C0, f32x16& C1, bool csel, int cblk, f32x16& N0, f32x16& N1, const LAS char* Kn, int vbc, bool has_next, TileInfo tn, bool nsel,
                                         const LAS char* ql, float& m, float& alc, float& l, f32x16 (&o)[4], float b128, int t, const LAS float* tbl, LAS unsigned* impr, int r32, int hi, unsigned long long* tacc = nullptr) {
    bf16x8 pa0, pa1, pa2, pa3; float ps = 0.f, ps2 = 0.f;
    SBAR();
    unsigned long long tp_ = 0ull; if ((PROBE_SPIN >> 13) & 3) tp_ = __builtin_amdgcn_s_memrealtime();
#define IMP_ADD(P, gq, J) do { const float own_ = 2.f * (P[4 * gq] + P[4 * gq + 1] + P[4 * gq + 2]) + P[4 * gq + 3]; \
        __hip_atomic_fetch_add(impr + 16 * cblk + hi + (J), (unsigned)(own_ * 67108864.f + 0.5f), __ATOMIC_RELAXED, __HIP_MEMORY_SCOPE_WORKGROUP); \
        __hip_atomic_fetch_add(impr + 16 * cblk + hi + (J) + 1, (unsigned)(P[4 * gq + 3] * 67108864.f + 0.5f), __ATOMIC_RELAXED, __HIP_MEMORY_SCOPE_WORKGROUP); } while (0)
#define SM2_SLICE(d) do { C1[2 * d] = __builtin_amdgcn_exp2f(C1[2 * d]); C1[2 * d + 1] = __builtin_amdgcn_exp2f(C1[2 * d + 1]); \
        if (TYPE != 2) { ps = fadd_s(ps, C0[2 * d]); ps2 = fadd_s(ps2, C0[2 * d + 1]); ps = fadd_s(ps, C1[2 * d]); ps2 = fadd_s(ps2, C1[2 * d + 1]); } \
        if (TYPE != 3) { if (d == 2) NSA_PK4(C0, 0, pa0); if (d == 4) NSA_PK4(C0, 8, pa1); if (d == 6) NSA_PK4(C1, 0, pa2); } \
        if (TYPE == 2 && (d & 1)) { IMP_ADD(C0, (d >> 1), 2 * (d >> 1)); IMP_ADD(C1, (d >> 1), 8 + 2 * (d >> 1)); } } while (0)
    N0 = f32x16{}; N1 = f32x16{};
    if (has_next) {
        bf16x8 qf[8], kf0[8], kf1[8];
        qf[0] = *(const LAS bf16x8*)(ql); kf0[0] = *(const LAS bf16x8*)(Kn + KSWZ(r32, hi * 16)); kf1[0] = *(const LAS bf16x8*)(Kn + KSWZ(32 + r32, hi * 16));
#pragma unroll
        for (int d = 0; d < 8; ++d) {
            if (d + 1 < 8) { const int cb = ((d + 1) * 16 + hi * 8) * 2; qf[d + 1] = *(const LAS bf16x8*)(ql + (d + 1) * 1024); kf0[d + 1] = *(const LAS bf16x8*)(Kn + KSWZ(r32, cb)); kf1[d + 1] = *(const LAS bf16x8*)(Kn + KSWZ(32 + r32, cb)); }
            N0 = __builtin_amdgcn_mfma_f32_32x32x16_bf16(kf0[d], qf[d], N0, 0, 0, 0);
            N1 = __builtin_amdgcn_mfma_f32_32x32x16_bf16(kf1[d], qf[d], N1, 0, 0, 0);
            SM2_SLICE(d);
            SBAR();
        }
    } else {
#pragma unroll
        for (int d = 0; d < 8; ++d) SM2_SLICE(d);
    }
#undef SM2_SLICE
#undef IMP_ADD
    if (TYPE != 3) NSA_PK4(C1, 8, pa3);
    if (TYPE == 0 && !__all(csel)) {
        const unsigned km = csel ? 0xffffffffu : 0u; ps = csel ? ps : 0.f; ps2 = csel ? ps2 : 0.f;
        u32x4 w0 = __builtin_bit_cast(u32x4, pa0), w1 = __builtin_bit_cast(u32x4, pa1), w2 = __builtin_bit_cast(u32x4, pa2), w3 = __builtin_bit_cast(u32x4, pa3);
        w0 &= km; w1 &= km; w2 &= km; w3 &= km;
        pa0 = __builtin_bit_cast(bf16x8, w0); pa1 = __builtin_bit_cast(bf16x8, w1); pa2 = __builtin_bit_cast(bf16x8, w2); pa3 = __builtin_bit_cast(bf16x8, w3); }
    if (TYPE != 2) { ps = xhalf_sum(ps + ps2); l = l * alc + ps; }
    SBAR();
    if (tacc && ((PROBE_SPIN >> 13) & 3)) { const unsigned long long n_ = __builtin_amdgcn_s_memrealtime(); if ((PROBE_SPIN >> 13) & 1) *tacc += n_ - tp_; tp_ = n_; }
    float aln = 1.f;
    const LAS char* vp = (const LAS char*)(size_t)(unsigned)vbc;
    s16x4 va[8], vb2[8];
#define VRD(D0, A) do { A[0] = vtr(vp + D0 * 512); A[1] = vtr(vp + D0 * 512 + 2048); A[2] = vtr(vp + D0 * 512 + 4096); A[3] = vtr(vp + D0 * 512 + 6144); \
                        A[4] = vtr(vp + D0 * 512 + 8192); A[5] = vtr(vp + D0 * 512 + 10240); A[6] = vtr(vp + D0 * 512 + 12288); A[7] = vtr(vp + D0 * 512 + 14336); } while (0)
#define PVM(OD, A) do { OD = __builtin_amdgcn_mfma_f32_32x32x16_bf16((bf16x8){A[0][0], A[0][1], A[0][2], A[0][3], A[1][0], A[1][1], A[1][2], A[1][3]}, pa0, OD, 0, 0, 0); \
                        OD = __builtin_amdgcn_mfma_f32_32x32x16_bf16((bf16x8){A[2][0], A[2][1], A[2][2], A[2][3], A[3][0], A[3][1], A[3][2], A[3][3]}, pa1, OD, 0, 0, 0); \
                        OD = __builtin_amdgcn_mfma_f32_32x32x16_bf16((bf16x8){A[4][0], A[4][1], A[4][2], A[4][3], A[5][0], A[5][1], A[5][2], A[5][3]}, pa2, OD, 0, 0, 0); \
                        OD = __builtin_amdgcn_mfma_f32_32x32x16_bf16((bf16x8){A[6][0], A[6][1], A[6][2], A[6][3], A[7][0], A[7][1], A[7][2], A[7][3]}, pa3, OD, 0, 0, 0); } while (0)
    if (TYPE != 3) { VRD(0, va); SBAR(); VRD(1, vb2); PVM(o[0], va); }
    if (has_next) {
        if (!tn.far) near_post<TYPE>(N0, N1, tn.blk, t, m + b128, tbl, hi);
        else if (__any(m != 0.f)) {
#pragma unroll
            for (int r = 0; r < 16; ++r) { N0[r] -= m; N1[r] -= m; } } }
    SBAR();
    if (TYPE != 3) { VRD(2, va); PVM(o[1], vb2); }
    float pmax = -__builtin_inff();
    if (TYPE != 2 && has_next) {
        if (TYPE <= 1) {
            float a = max3_s(N0[0], N0[1], N1[0]), b2 = max3_s(N0[2], N0[3], N1[1]); a = max3_s(a, N1[2], N1[3]);
#pragma unroll
            for (int r = 4; r < 16; r += 4) { a = max3_s(a, N0[r], N0[r + 1]); b2 = max3_s(b2, N0[r + 2], N0[r + 3]); a = max3_s(a, N1[r], N1[r + 1]); b2 = max3_s(b2, N1[r + 2], N1[r + 3]); }
            pmax = fmaxf(a, b2);
        } else {
#pragma unroll
            for (int r = 0; r < 16; ++r) pmax = fmaxf(pmax, fmaxf(N0[r], N1[r])); }
        pmax = xhalf_max(pmax); if (TYPE == 0) pmax = nsel ? pmax : -__builtin_inff(); }
    SBAR();
    if (TYPE != 3) { VRD(3, vb2); PVM(o[2], va); }
    if (TYPE != 2 && has_next && __any(pmax > NSA_THR)) {
        const float dl = fmaxf(pmax, 0.f); m += dl; aln = __builtin_amdgcn_exp2f(-dl);
#pragma unroll
        for (int r = 0; r < 16; ++r) { N0[r] -= dl; N1[r] -= dl; } }
    SBAR();
    if (TYPE != 3) PVM(o[3], vb2);
    if (has_next) {
#pragma unroll
        for (int r = 0; r < 16; ++r) N0[r] = __builtin_amdgcn_exp2f(N0[r]); }
    SBAR();
#undef VRD
#undef PVM
    if (TYPE < 2 && __any(aln != 1.f)) {
#pragma unroll
        for (int d = 0; d < 4; ++d)
#pragma unroll
            for (int r = 0; r < 16; ++r) o[d][r] *= aln; }
    alc = aln;
    if (tacc && ((PROBE_SPIN >> 14) & 1)) *tacc += __builtin_amdgcn_s_memrealtime() - tp_;
}
template <int TYPE, bool NEAR>
__device__ __forceinline__ bool nsa_fast(f32x16& C0, f32x16& C1, bool csel, f32x16& N0, f32x16& N1, const LAS char* Kn, int vbc, const LAS char* ql, float& l, f32x16 (&o)[4], int r32, int hi,
                                         int nblk = 0, int t = 0, float b128 = 0.f, const LAS float* tbl = nullptr) {
    bf16x8 pa0, pa1, pa2, pa3; float ps = 0.f, ps2 = 0.f;
    asm volatile("" : "+v"(r32), "+v"(hi));
    SBAR();
    N0 = f32x16{}; N1 = f32x16{};
    {   bf16x8 qf[8], kf0[8], kf1[8];
        qf[0] = *(const LAS bf16x8*)(ql); kf0[0] = *(const LAS bf16x8*)(Kn + KSWZ(r32, hi * 16)); kf1[0] = *(const LAS bf16x8*)(Kn + KSWZ(32 + r32, hi * 16));
#pragma unroll
        for (int d = 0; d < 8; ++d) {
            if (d + 1 < 8) { const int cb = ((d + 1) * 16 + hi * 8) * 2; qf[d + 1] = *(const LAS bf16x8*)(ql + (d + 1) * 1024); kf0[d + 1] = *(const LAS bf16x8*)(Kn + KSWZ(r32, cb)); kf1[d + 1] = *(const LAS bf16x8*)(Kn + KSWZ(32 + r32, cb)); }
            N0 = __builtin_amdgcn_mfma_f32_32x32x16_bf16(kf0[d], qf[d], N0, 0, 0, 0);
            N1 = __builtin_amdgcn_mfma_f32_32x32x16_bf16(kf1[d], qf[d], N1, 0, 0, 0);
            C1[2 * d] = __builtin_amdgcn_exp2f(C1[2 * d]); C1[2 * d + 1] = __builtin_amdgcn_exp2f(C1[2 * d + 1]);
            ps = fadd_s(ps, C0[2 * d]); ps2 = fadd_s(ps2, C0[2 * d + 1]); ps = fadd_s(ps, C1[2 * d]); ps2 = fadd_s(ps2, C1[2 * d + 1]);
            if (d == 2) NSA_PK4(C0, 0, pa0); if (d == 4) NSA_PK4(C0, 8, pa1); if (d == 6) NSA_PK4(C1, 0, pa2);
            SBAR();
        } }
    NSA_PK4(C1, 8, pa3);
    if (TYPE == 0 && !__all(csel)) {
        const unsigned km = csel ? 0xffffffffu : 0u; ps = csel ? ps : 0.f; ps2 = csel ? ps2 : 0.f;
        u32x4 w0 = __builtin_bit_cast(u32x4, pa0), w1 = __builtin_bit_cast(u32x4, pa1), w2 = __builtin_bit_cast(u32x4, pa2), w3 = __builtin_bit_cast(u32x4, pa3);
        w0 &= km; w1 &= km; w2 &= km; w3 &= km;
        pa0 = __builtin_bit_cast(bf16x8, w0); pa1 = __builtin_bit_cast(bf16x8, w1); pa2 = __builtin_bit_cast(bf16x8, w2); pa3 = __builtin_bit_cast(bf16x8, w3); }
    ps = xhalf_sum(ps + ps2); l += ps;
    SBAR();
    const LAS char* vp = (const LAS char*)(size_t)(unsigned)vbc;
    s16x4 va[8], vb2[8];
#define VRD(D0, A) do { A[0] = vtr(vp + D0 * 512); A[1] = vtr(vp + D0 * 512 + 2048); A[2] = vtr(vp + D0 * 512 + 4096); A[3] = vtr(vp + D0 * 512 + 6144); \
                        A[4] = vtr(vp + D0 * 512 + 8192); A[5] = vtr(vp + D0 * 512 + 10240); A[6] = vtr(vp + D0 * 512 + 12288); A[7] = vtr(vp + D0 * 512 + 14336); } while (0)
#define PVM(OD, A) do { OD = __builtin_amdgcn_mfma_f32_32x32x16_bf16((bf16x8){A[0][0], A[0][1], A[0][2], A[0][3], A[1][0], A[1][1], A[1][2], A[1][3]}, pa0, OD, 0, 0, 0); \
                        OD = __builtin_amdgcn_mfma_f32_32x32x16_bf16((bf16x8){A[2][0], A[2][1], A[2][2], A[2][3], A[3][0], A[3][1], A[3][2], A[3][3]}, pa1, OD, 0, 0, 0); \
                        OD = __builtin_amdgcn_mfma_f32_32x32x16_bf16((bf16x8){A[4][0], A[4][1], A[4][2], A[4][3], A[5][0], A[5][1], A[5][2], A[5][3]}, pa2, OD, 0, 0, 0); \
                        OD = __builtin_amdgcn_mfma_f32_32x32x16_bf16((bf16x8){A[6][0], A[6][1], A[6][2], A[6][3], A[7][0], A[7][1], A[7][2], A[7][3]}, pa3, OD, 0, 0, 0); } while (0)
#define EXQ(R0) do { N0[R0] = __builtin_amdgcn_exp2f(N0[R0]); N0[R0 + 1] = __builtin_amdgcn_exp2f(N0[R0 + 1]); N0[R0 + 2] = __builtin_amdgcn_exp2f(N0[R0 + 2]); N0[R0 + 3] = __builtin_amdgcn_exp2f(N0[R0 + 3]); } while (0)
    if (!NEAR) {
        VRD(0, va); SBAR(); VRD(1, vb2); PVM(o[0], va); EXQ(0);
        SBAR();
        VRD(2, va); PVM(o[1], vb2); EXQ(4);
        SBAR();
        VRD(3, vb2); PVM(o[2], va); EXQ(8);
        SBAR();
        PVM(o[3], vb2); EXQ(12);
        SBAR();
    } else {
        VRD(0, va); SBAR(); VRD(1, vb2); PVM(o[0], va);
        near_post<TYPE>(N0, N1, nblk, t, b128, tbl, hi);
        SBAR();
        VRD(2, va); PVM(o[1], vb2); EXQ(0); EXQ(4);
        SBAR();
        VRD(3, vb2); PVM(o[2], va); EXQ(8);
        SBAR();
        PVM(o[3], vb2); EXQ(12);
        SBAR();
    }
#undef VRD
#undef PVM
#undef EXQ
    return __any(ps > 1.0e12f);
}
template <int TYPE>
__device__ __forceinline__ void nsa_branch_compute(const LAS char* Kl, int vb, const LAS int* tl, int n, const LAS char* ql, int t, int s0, unsigned long long mymask, const LAS float* tbl,
                                                   float& m, float& l, f32x16 (&o)[4], LAS unsigned* impr, int r32, int hi, bool nocompute) {
    float alc = 1.f; l = 0.f;
    if (TYPE != 3) {
#pragma unroll
        for (int d = 0; d < 4; ++d) o[d] = f32x16{}; }
    f32x16 pA0, pA1, pB0, pB1;
    if (nocompute) { l = 1.f; __syncthreads(); for (int i = 0; i < n; ++i) __syncthreads(); __syncthreads(); return; }
    const float b128 = tbl[128];
    __syncthreads();
    TileInfo ta = tile_info<TYPE>(tl[0], s0), tb_; bool sa = (TYPE == 0) ? ((mymask >> ta.blk) & 1ull) != 0ull : true, sb = true;
    {
        qkt_lq(pA0, pA1, Kl, ql, r32, hi);
        m = 0.f;
        if (!ta.far) near_post<TYPE>(pA0, pA1, ta.blk, t, b128, tbl, hi);
        float pmax = -__builtin_inff();
#pragma unroll
        for (int r = 0; r < 16; ++r) pmax = fmaxf(pmax, fmaxf(pA0[r], pA1[r]));
        pmax = xhalf_max(pmax); if (TYPE == 0) pmax = sa ? pmax : -__builtin_inff();
        if (__any(pmax > NSA_THR)) { m = fmaxf(pmax, 0.f);
#pragma unroll
            for (int r = 0; r < 16; ++r) { pA0[r] -= m; pA1[r] -= m; } }
#pragma unroll
        for (int r = 0; r < 16; ++r) pA0[r] = __builtin_amdgcn_exp2f(pA0[r]); }
    int kq = 16384, vq = 0;
#define NSA_ROT() do { kq = (kq == 32768) ? 0 : kq + 16384; vq = (vq == 32768) ? 0 : vq + 16384; } while (0)
    for (int i = 0; i < n; i += 2) {
        __syncthreads();
        { const bool hn = i + 1 < n; tb_ = tile_info<TYPE>(hn ? tl[i + 1] : 0, s0); sb = (TYPE == 0) ? ((mymask >> tb_.blk) & 1ull) != 0ull : true;
          nsa_step<TYPE>(pA0, pA1, sa, ta.blk, pB0, pB1, Kl + kq, vb + vq, hn, tb_, sb, ql, m, alc, l, o, b128, t, tbl, impr, r32, hi); }
        NSA_ROT();
        if (i + 1 >= n) break;
        __syncthreads();
        { const bool hn = i + 2 < n; ta = tile_info<TYPE>(hn ? tl[i + 2] : 0, s0); sa = (TYPE == 0) ? ((mymask >> ta.blk) & 1ull) != 0ull : true;
          nsa_step<TYPE>(pB0, pB1, sb, tb_.blk, pA0, pA1, Kl + kq, vb + vq, hn, ta, sa, ql, m, alc, l, o, b128, t, tbl, impr, r32, hi); }
        NSA_ROT();
    }
#undef NSA_ROT
    __syncthreads();
}
__device__ __forceinline__ void nsa_cmp_pass2(const LAS char* Kl, int vb, int n, const LAS char* ql, int t, int s0, const LAS float* tbl, float m2, f32x16 (&o)[4], LAS unsigned* impr, int r32, int hi) {
#pragma unroll
    for (int d = 0; d < 4; ++d) o[d] = f32x16{};
    bf16x8 pa0, pa1, pa2, pa3;
    const float b128 = tbl[128];
#define CMP_TILE(j, Kslot) do { f32x16 p0_, p1_; qkt_lq(p0_, p1_, Kslot, ql, r32, hi); const TileInfo ti_ = tile_info<2>(j, s0); \
        if (ti_.far) { _Pragma("unroll") for (int r = 0; r < 16; ++r) { p0_[r] = __builtin_amdgcn_exp2f(p0_[r] - m2); p1_[r] = __builtin_amdgcn_exp2f(p1_[r] - m2); } } \
        else { near_post<2>(p0_, p1_, j, t, m2 + b128, tbl, hi); _Pragma("unroll") for (int r = 0; r < 16; ++r) { p0_[r] = __builtin_amdgcn_exp2f(p0_[r]); p1_[r] = __builtin_amdgcn_exp2f(p1_[r]); } } \
        _Pragma("unroll") for (int gq = 0; gq < 4; ++gq) { \
            { const float own_ = 2.f * (p0_[4 * gq] + p0_[4 * gq + 1] + p0_[4 * gq + 2]) + p0_[4 * gq + 3]; \
              __hip_atomic_fetch_add(impr + 16 * (j) + hi + 2 * gq, (unsigned)(own_ * 67108864.f + 0.5f), __ATOMIC_RELAXED, __HIP_MEMORY_SCOPE_WORKGROUP); \
              __hip_atomic_fetch_add(impr + 16 * (j) + hi + 2 * gq + 1, (unsigned)(p0_[4 * gq + 3] * 67108864.f + 0.5f), __ATOMIC_RELAXED, __HIP_MEMORY_SCOPE_WORKGROUP); } \
            { const float own_ = 2.f * (p1_[4 * gq] + p1_[4 * gq + 1] + p1_[4 * gq + 2]) + p1_[4 * gq + 3]; \
              __hip_atomic_fetch_add(impr + 16 * (j) + hi + 8 + 2 * gq, (unsigned)(own_ * 67108864.f + 0.5f), __ATOMIC_RELAXED, __HIP_MEMORY_SCOPE_WORKGROUP); \
              __hip_atomic_fetch_add(impr + 16 * (j) + hi + 8 + 2 * gq + 1, (unsigned)(p1_[4 * gq + 3] * 67108864.f + 0.5f), __ATOMIC_RELAXED, __HIP_MEMORY_SCOPE_WORKGROUP); } } \
        pack_p(p0_, p1_, pa0, pa1, pa2, pa3); } while (0)
    __syncthreads();
    CMP_TILE(0, Kl);
    for (int i = 0; i < n; ++i) {
        __syncthreads();
        pv_all<4>(o, vb + (i % 3) * 16384, pa0, pa1, pa2, pa3);
        if (i + 1 < n) CMP_TILE(i + 1, Kl + ((i + 1) % 3) * 16384);
    }
    __syncthreads();
#undef CMP_TILE
}
__device__ __forceinline__ void dma_k2(LAS char* Kslot, const bf16_t* kp, size_t ld, int wave, int lane) {
    asm volatile("" : "+v"(lane));
#pragma unroll
    for (int i = 0; i < 2; ++i) { const int pc = wave * 2 + i, row = pc * 4 + (lane >> 4), ch = (lane & 15) ^ (row & 15);
        __builtin_amdgcn_global_load_lds((const unsigned*)(kp + (size_t)row * ld + ch * 8), (LAS unsigned*)(Kslot + pc * 1024), 16, 0, 0); }
}
__device__ __forceinline__ void dma_v2(LAS char* Vslot, const bf16_t* vp, size_t ld, int wave, int lane) {
    asm volatile("" : "+v"(lane));
#pragma unroll
    for (int i = 0; i < 2; ++i) { const int pc = wave * 2 + i, cblk = 2 * (pc & 1) + (lane >> 5), kk = (pc >> 1) * 8 + ((lane & 31) >> 2), k = (kk & ~0xC) | ((kk & 4) << 1) | ((kk & 8) >> 1), c = cblk * 32 + (lane & 3) * 8;
        __builtin_amdgcn_global_load_lds((const unsigned*)(vp + (size_t)k * ld + c), (LAS unsigned*)(Vslot + pc * 1024), 16, 0, 0); }
}
struct DmaOfs { unsigned k[2], v[2]; };
__device__ __forceinline__ DmaOfs dma_ofs(int wave, int lane) {
    DmaOfs d;
#pragma unroll
    for (int i = 0; i < 2; ++i) { const int pc = wave * 2 + i, row = pc * 4 + (lane >> 4), ch = (lane & 15) ^ (row & 15); d.k[i] = (unsigned)(row * OD_LD + ch * 8) * 2u;
        const int cblk = 2 * (pc & 1) + (lane >> 5), kk = (pc >> 1) * 8 + ((lane & 31) >> 2), k = (kk & ~0xC) | ((kk & 4) << 1) | ((kk & 8) >> 1), c = cblk * 32 + (lane & 3) * 8; d.v[i] = (unsigned)(k * OD_LD + c) * 2u; }
    return d;
}
__device__ __forceinline__ void dma_k2o(LAS char* Kslot, const bf16_t* kbase, int blk, const DmaOfs& d, int wave) {
    const char* tb = (const char*)(kbase + (size_t)__builtin_amdgcn_readfirstlane(blk) * 64 * OD_LD);
#pragma unroll
    for (int i = 0; i < 2; ++i) __builtin_amdgcn_global_load_lds((const unsigned*)(tb + d.k[i]), (LAS unsigned*)(Kslot + (wave * 2 + i) * 1024), 16, 0, 0);
}
__device__ __forceinline__ void dma_v2o(LAS char* Vslot, const bf16_t* vbase, int blk, const DmaOfs& d, int wave) {
    const char* tb = (const char*)(vbase + (size_t)__builtin_amdgcn_readfirstlane(blk) * 64 * OD_LD);
#pragma unroll
    for (int i = 0; i < 2; ++i) __builtin_amdgcn_global_load_lds((const unsigned*)(tb + d.v[i]), (LAS unsigned*)(Vslot + (wave * 2 + i) * 1024), 16, 0, 0);
}
template <int TYPE>
__device__ __forceinline__ void nsa_branch_all(LAS char* Kl, LAS char* Vl, const LAS int* tl, int n, const bf16_t* kbase, const bf16_t* vbase, const LAS char* ql, int t, int s0, unsigned long long mymask,
                                               const LAS float* tbl, float& l, f32x16 (&o)[4], int wave, int lane, unsigned long long* tacc = nullptr, bool k0_issued = false) {
    const int r32 = lane & 31, hi = lane >> 5;
    const DmaOfs dofs = dma_ofs(wave, lane);
    const int vb = lds_addr(Vl) + v_rd_base(lane);
    float m = 0.f, alc = 1.f; l = 0.f;
#pragma unroll
    for (int d = 0; d < 4; ++d) o[d] = f32x16{};
    f32x16 pA0, pA1, pB0, pB1;
    const float b128 = tbl[128];
    if (!k0_issued) dma_k2o(Kl, kbase, tl[0], dofs, wave);
    __syncthreads();
    if (n > 1) dma_k2o(Kl + 16384, kbase, tl[1], dofs, wave);
    dma_v2o(Vl, vbase, tl[0], dofs, wave);
    TileInfo ta = tile_info<TYPE>(tl[0], s0), tb_; bool sa = (TYPE == 0) ? ((mymask >> ta.blk) & 1ull) != 0ull : true, sb = true;
    {
        qkt_lq(pA0, pA1, Kl, ql, r32, hi);
        if (!ta.far) near_post<TYPE>(pA0, pA1, ta.blk, t, b128, tbl, hi);
        float pmax = -__builtin_inff();
#pragma unroll
        for (int r = 0; r < 16; ++r) pmax = fmaxf(pmax, fmaxf(pA0[r], pA1[r]));
        pmax = xhalf_max(pmax); if (TYPE == 0) pmax = sa ? pmax : -__builtin_inff();
        if (__any(pmax > NSA_THR)) { m = fmaxf(pmax, 0.f);
#pragma unroll
            for (int r = 0; r < 16; ++r) { pA0[r] -= m; pA1[r] -= m; } }
#pragma unroll
        for (int r = 0; r < 16; ++r) pA0[r] = __builtin_amdgcn_exp2f(pA0[r]); }
    bool plain = !__any(m != 0.f);
    int i = 0;
#define NSA_BAR() do { unsigned long long tq_ = 0ull; if ((PROBE_SPIN >> 12) & 1) tq_ = __builtin_amdgcn_s_memrealtime(); __syncthreads(); \
                       if (tacc && ((PROBE_SPIN >> 12) & 1)) *tacc += __builtin_amdgcn_s_memrealtime() - tq_; } while (0)
#define NSA_FARPAIR() (tile_info<TYPE>(tl[i + 1], s0).far && tile_info<TYPE>(tl[i + 2], s0).far)
#define NSA_GEN_PAIR() \
        NSA_BAR(); \
        if (i + 2 < n) dma_k2o(Kl, kbase, tl[i + 2], dofs, wave); \
        if (i + 1 < n) dma_v2o(Vl + 16384, vbase, tl[i + 1], dofs, wave); \
        { const bool hn = i + 1 < n; tb_ = tile_info<TYPE>(hn ? tl[i + 1] : 0, s0); sb = (TYPE == 0) ? ((mymask >> tb_.blk) & 1ull) != 0ull : true; \
          nsa_step<TYPE>(pA0, pA1, sa, ta.blk, pB0, pB1, Kl + 16384, vb, hn, tb_, sb, ql, m, alc, l, o, b128, t, tbl, nullptr, r32, hi, tacc); } \
        if (i + 1 >= n) { i = n; break; } \
        NSA_BAR(); \
        if (i + 3 < n) dma_k2o(Kl + 16384, kbase, tl[i + 3], dofs, wave); \
        if (i + 2 < n) dma_v2o(Vl, vbase, tl[i + 2], dofs, wave); \
        { const bool hn = i + 2 < n; ta = tile_info<TYPE>(hn ? tl[i + 2] : 0, s0); sa = (TYPE == 0) ? ((mymask >> ta.blk) & 1ull) != 0ull : true; \
          nsa_step<TYPE>(pB0, pB1, sb, tb_.blk, pA0, pA1, Kl, vb + 16384, hn, ta, sa, ql, m, alc, l, o, b128, t, tbl, nullptr, r32, hi, tacc); }
#define NSA_FAST_PAIR(NEARF) \
        NSA_BAR(); \
        dma_k2o(Kl, kbase, tl[i + 2], dofs, wave); \
        dma_v2o(Vl + 16384, vbase, tl[i + 1], dofs, wave); \
        sb = (TYPE == 0) ? ((mymask >> tl[i + 1]) & 1ull) != 0ull : true; \
        const bool f1 = nsa_fast<TYPE, NEARF>(pA0, pA1, sa, pB0, pB1, Kl + 16384, vb, ql, l, o, r32, hi, tl[i + 1], t, b128, tbl); \
        NSA_BAR(); \
        if (i + 3 < n) dma_k2o(Kl + 16384, kbase, tl[i + 3], dofs, wave); \
        dma_v2o(Vl, vbase, tl[i + 2], dofs, wave); \
        sa = (TYPE == 0) ? ((mymask >> tl[i + 2]) & 1ull) != 0ull : true; \
        const bool f2 = nsa_fast<TYPE, NEARF>(pB0, pB1, sb, pA0, pA1, Kl, vb + 16384, ql, l, o, r32, hi, tl[i + 2], t, b128, tbl); \
        plain = !(f1 || f2); \
        i += 2;
    if (TYPE == 1) {
#pragma unroll 1
        while (plain && i + 2 < n && i < 2 && !NSA_FARPAIR()) { NSA_FAST_PAIR(true) }
    }
#pragma unroll 1
    while (plain && i + 2 < n && NSA_FARPAIR()) { NSA_FAST_PAIR(false) }
#pragma unroll 1
    while (plain && i + 2 < n) { NSA_FAST_PAIR(true) }
#pragma unroll 1
    for (; i < n; i += 2) {
        NSA_GEN_PAIR()
    }
#undef NSA_FAST_PAIR
#undef NSA_FARPAIR
#undef NSA_GEN_PAIR
#undef NSA_BAR
    __syncthreads();
}
__device__ __forceinline__ void nsa_wait_vm(int n) {
    if (n >= 16) asm volatile("s_waitcnt vmcnt(16)" ::: "memory"); else if (n >= 8) asm volatile("s_waitcnt vmcnt(8)" ::: "memory"); else asm volatile("s_waitcnt vmcnt(0)" ::: "memory");
}
__device__ __forceinline__ void nsa_branch_load(LAS char* Kl, LAS char* Vl, const LAS int* tl, int n, const bf16_t* kbase, const bf16_t* vbase, size_t ld, bool with_v, int lw, int lane) {
    dma_k(Kl, kbase + (size_t)tl[0] * 64 * ld, ld, lw, lane);
    int c = 0;
    if (n > 1) { dma_k(Kl + 16384, kbase + (size_t)tl[1] * 64 * ld, ld, lw, lane); c += 8; }
    if (with_v) { dma_v(Vl, vbase + (size_t)tl[0] * 64 * ld, ld, lw, lane); c += 8; }
    nsa_wait_vm(c); __builtin_amdgcn_s_barrier();
    int ks = 32768, vs = 16384;
    for (int s = 0; s < n; ++s) {
        c = 0;
        if (s + 2 < n) { dma_k(Kl + ks, kbase + (size_t)tl[s + 2] * 64 * ld, ld, lw, lane); c += 8; }
        if (with_v && s + 1 < n) { dma_v(Vl + vs, vbase + (size_t)tl[s + 1] * 64 * ld, ld, lw, lane); c += 8; }
        nsa_wait_vm(c); __builtin_amdgcn_s_barrier();
        ks = (ks == 32768) ? 0 : ks + 16384; vs = (vs == 32768) ? 0 : vs + 16384;
    }
    asm volatile("s_waitcnt vmcnt(0)" ::: "memory"); __builtin_amdgcn_s_barrier();
}
__device__ __forceinline__ void nsa_topk(const LAS unsigned* imp, LAS unsigned long long* selm, int wave, int lane, int s0) {
    const int cur = s0 >> 6;
    unsigned v[4], thr[4];
#pragma unroll
    for (int i = 0; i < 4; ++i) { const int tt = wave * 4 + i, tq = s0 + tt;
        unsigned x = imp[tt * 65 + lane] + 1u;
        const bool forced = (lane == 0) || (lane == cur) || (lane == cur - 1), future = lane * 64 > tq;
        v[i] = forced ? 0xffffffffu : (future ? 0u : x); thr[i] = 0u; }
#pragma unroll
    for (int b = 31; b >= 0; --b)
#pragma unroll
        for (int i = 0; i < 4; ++i) { const unsigned cand = thr[i] | (1u << b); if (__builtin_popcountll(__ballot(v[i] >= cand)) >= 8) thr[i] = cand; }
#pragma unroll
    for (int i = 0; i < 4; ++i) { const int tt = wave * 4 + i;
        const unsigned long long gt = __ballot(v[i] > thr[i]), eq = __ballot(v[i] == thr[i]);
        const int need = 8 - __builtin_popcountll(gt);
        const int myord = __builtin_popcountll(eq & ((1ull << lane) - 1ull));
        unsigned long long msk = gt | __ballot(v[i] == thr[i] && myord < need);
        msk &= (2ull << cur) - 1ull;
        if (lane == 0) selm[tt] = msk; }
}
__device__ __forceinline__ unsigned long long nsa_union(unsigned long long mymask) {
    unsigned lo = (unsigned)mymask, hi32 = (unsigned)(mymask >> 32);
#pragma unroll
    for (int off = 1; off < 32; off <<= 1) { lo |= __shfl_xor(lo, off); hi32 |= __shfl_xor(hi32, off); }
    return ((unsigned long long)(unsigned)__builtin_amdgcn_readfirstlane(hi32) << 32) | (unsigned)__builtin_amdgcn_readfirstlane(lo);
}
constexpr int NSA_V_OFF = 49152, NSA_Q_OFF = 98304, NSA_IMP_OFF = NSA_Q_OFF + 6 * 8192, NSA_LIST_OFF = NSA_IMP_OFF + 32 * 65 * 4, NSA_SEL_OFF = NSA_LIST_OFF + 96 * 4, NSA_TB_OFF = NSA_SEL_OFF + 1024;
constexpr int NSA2_V_OFF = 32768, NSA2_Q_OFF = 65536, NSA2_SCR_OFF = 131072;
static_assert(NSA_TB_OFF + 12 * 132 * 4 <= MISC_OFF && NSA2_SCR_OFF + 8 * 2560 <= NSA_LIST_OFF, "nsa lds");
constexpr int ACC_LD = 1536;
__device__ __forceinline__ void q_park(LAS char* qdst  , const bf16_t* q0  , int lane) {
    constexpr float C = 0.08838834764831845f * LOG2E;
#pragma unroll
    for (int i = 0; i < 8; ++i) { const int T = 4 * i + (lane >> 4), c = lane & 15;
        u32x4 w = *(const u32x4*)(q0 + (size_t)T * OD_LD + c * 8);
        w.x = cvt_pk_bf16(__builtin_bit_cast(float, w.x << 16) * C, __builtin_bit_cast(float, w.x & 0xffff0000u) * C); w.y = cvt_pk_bf16(__builtin_bit_cast(float, w.y << 16) * C, __builtin_bit_cast(float, w.y & 0xffff0000u) * C);
        w.z = cvt_pk_bf16(__builtin_bit_cast(float, w.z << 16) * C, __builtin_bit_cast(float, w.z & 0xffff0000u) * C); w.w = cvt_pk_bf16(__builtin_bit_cast(float, w.w << 16) * C, __builtin_bit_cast(float, w.w & 0xffff0000u) * C);
        *(LAS u32x4*)(qdst + (c >> 1) * 1024 + ((c & 1) * 32 + T) * 16) = w; }
}
__device__ __forceinline__ void q_pieces(u32x4 (&wq)[4][2], const bf16_t* q0, int lane) {
#pragma unroll
    for (int p = 0; p < 4; ++p)
#pragma unroll
        for (int k = 0; k < 2; ++k) { const int id = lane + 64 * k, T = id >> 2, c = 4 * p + (id & 3); wq[p][k] = *(const u32x4*)(q0 + (size_t)T * OD_LD + c * 8); }
}
__device__ __forceinline__ void q_regs(bf16x8 (&qr)[8], LAS char* scr, const u32x4 (&wq)[4][2], int lane) {
    constexpr float C = 0.08838834764831845f * LOG2E;
#pragma unroll
    for (int p = 0; p < 4; ++p) {
#pragma unroll
        for (int k = 0; k < 2; ++k) { const int id = lane + 64 * k, T = id >> 2, cc = id & 3;
            u32x4 w = wq[p][k];
            w.x = cvt_pk_bf16(__builtin_bit_cast(float, w.x << 16) * C, __builtin_bit_cast(float, w.x & 0xffff0000u) * C); w.y = cvt_pk_bf16(__builtin_bit_cast(float, w.y << 16) * C, __builtin_bit_cast(float, w.y & 0xffff0000u) * C);
            w.z = cvt_pk_bf16(__builtin_bit_cast(float, w.z << 16) * C, __builtin_bit_cast(float, w.z & 0xffff0000u) * C); w.w = cvt_pk_bf16(__builtin_bit_cast(float, w.w << 16) * C, __builtin_bit_cast(float, w.w & 0xffff0000u) * C);
            *(LAS u32x4*)(scr + (cc >> 1) * 1024 + ((cc & 1) * 32 + T) * 16) = w; }
        asm volatile("s_waitcnt lgkmcnt(0)" ::: "memory");
        qr[2 * p] = *(const LAS bf16x8*)(scr + lane * 16); qr[2 * p + 1] = *(const LAS bf16x8*)(scr + 1024 + lane * 16);
        asm volatile("s_waitcnt lgkmcnt(0)" ::: "memory");
    }
}
__device__ __forceinline__ void cmp_pass1_res(const LAS char* Kres, int n, const bf16x8 (&qr)[8], int t, int s0, const LAS float* tbl, float& m, float& l, int r32, int hi) {
    const float b128 = tbl[128], NEGINF = -__builtin_inff();
    m = NEGINF; l = 0.f;
    for (int j = 0; j < n; ++j) {
        f32x16 p0, p1; qkt(p0, p1, Kres + j * 16384, qr, r32, hi);
        const TileInfo ti = tile_info<3>(j, s0);
        if (!ti.far) near_post<3>(p0, p1, j, t, b128, tbl, hi);
        float pmax = NEGINF;
#pragma unroll
        for (int r = 0; r < 16; ++r) pmax = fmaxf(pmax, fmaxf(p0[r], p1[r]));
        pmax = xhalf_max(pmax);
        const float mn = fmaxf(m, pmax), mref = (mn == NEGINF) ? 0.f : mn;
        float ps = 0.f, ps2 = 0.f;
#pragma unroll
        for (int r = 0; r < 16; ++r) { ps += __builtin_amdgcn_exp2f(p0[r] - mref); ps2 += __builtin_amdgcn_exp2f(p1[r] - mref); }
        l = l * __builtin_amdgcn_exp2f(m - mref) + xhalf_sum(ps + ps2); m = mn;
    }
}
__device__ __forceinline__ void cmp_pass2_res(const LAS char* Kres, int vb, int n, const bf16x8 (&qr)[8], int t, int s0, const LAS float* tbl, float m2, f32x16 (&o)[4], LAS unsigned* impr, int r32, int hi) {
#pragma unroll
    for (int d = 0; d < 4; ++d) o[d] = f32x16{};
    const float b128 = tbl[128];
    for (int j = 0; j < n; ++j) {
        f32x16 p0_, p1_; qkt(p0_, p1_, Kres + j * 16384, qr, r32, hi);
        const TileInfo ti_ = tile_info<2>(j, s0);
        if (ti_.far) {
#pragma unroll
            for (int r = 0; r < 16; ++r) { p0_[r] = __builtin_amdgcn_exp2f(p0_[r] - m2); p1_[r] = __builtin_amdgcn_exp2f(p1_[r] - m2); } }
        else { near_post<2>(p0_, p1_, j, t, m2 + b128, tbl, hi);
#pragma unroll
            for (int r = 0; r < 16; ++r) { p0_[r] = __builtin_amdgcn_exp2f(p0_[r]); p1_[r] = __builtin_amdgcn_exp2f(p1_[r]); } }
#pragma unroll
        for (int gq = 0; gq < 4; ++gq) {
            { const float own_ = 2.f * (p0_[4 * gq] + p0_[4 * gq + 1] + p0_[4 * gq + 2]) + p0_[4 * gq + 3];
              __hip_atomic_fetch_add(impr + 16 * j + hi + 2 * gq, (unsigned)(own_ * 67108864.f + 0.5f), __ATOMIC_RELAXED, __HIP_MEMORY_SCOPE_WORKGROUP);
              __hip_atomic_fetch_add(impr + 16 * j + hi + 2 * gq + 1, (unsigned)(p0_[4 * gq + 3] * 67108864.f + 0.5f), __ATOMIC_RELAXED, __HIP_MEMORY_SCOPE_WORKGROUP); }
            { const float own_ = 2.f * (p1_[4 * gq] + p1_[4 * gq + 1] + p1_[4 * gq + 2]) + p1_[4 * gq + 3];
              __hip_atomic_fetch_add(impr + 16 * j + hi + 8 + 2 * gq, (unsigned)(own_ * 67108864.f + 0.5f), __ATOMIC_RELAXED, __HIP_MEMORY_SCOPE_WORKGROUP);
              __hip_atomic_fetch_add(impr + 16 * j + hi + 8 + 2 * gq + 1, (unsigned)(p1_[4 * gq + 3] * 67108864.f + 0.5f), __ATOMIC_RELAXED, __HIP_MEMORY_SCOPE_WORKGROUP); } }
        bf16x8 pa0, pa1, pa2, pa3; pack_p(p0_, p1_, pa0, pa1, pa2, pa3);
        pv_all<4>(o, vb + j * 16384, pa0, pa1, pa2, pa3);
    }
}
__device__ __forceinline__ float cmp_single_res(const LAS char* Kres, int vb, int n, const bf16x8 (&qr)[8], int t, int s0, const LAS float* tbl, f32x16 (&o)[4], LAS unsigned* impr, int r32, int hi) {
    const float b128 = tbl[128], NEGINF = -__builtin_inff();
    f32x16 sa[4], sb[4];
    float m = NEGINF;
#pragma unroll
    for (int j = 0; j < 4; ++j) if (j < n) {
        qkt(sa[j], sb[j], Kres + j * 16384, qr, r32, hi);
        const TileInfo ti = tile_info<3>(j, s0);
        if (!ti.far) near_post<3>(sa[j], sb[j], j, t, b128, tbl, hi);
        float pmax = NEGINF;
#pragma unroll
        for (int r = 0; r < 16; ++r) pmax = fmaxf(pmax, fmaxf(sa[j][r], sb[j][r]));
        m = fmaxf(m, pmax); }
    m = xhalf_max(m);
    const float mref = (m == NEGINF) ? 0.f : m;
    float ps = 0.f, ps2 = 0.f;
#pragma unroll
    for (int j = 0; j < 4; ++j) if (j < n) {
#pragma unroll
        for (int r = 0; r < 16; ++r) { sa[j][r] = __builtin_amdgcn_exp2f(sa[j][r] - mref); sb[j][r] = __builtin_amdgcn_exp2f(sb[j][r] - mref); ps += sa[j][r]; ps2 += sb[j][r]; } }
    const float l = xhalf_sum(ps + ps2);
    const float inv = (l > 0.f && t >= 31) ? 1.0f / l : 0.f;
    const float fx = inv * 67108864.f;
#pragma unroll
    for (int d = 0; d < 4; ++d) o[d] = f32x16{};
#pragma unroll
    for (int j = 0; j < 4; ++j) if (j < n) {
#pragma unroll
        for (int gq = 0; gq < 4; ++gq) {
            { const float own_ = 2.f * (sa[j][4 * gq] + sa[j][4 * gq + 1] + sa[j][4 * gq + 2]) + sa[j][4 * gq + 3];
              __hip_atomic_fetch_add(impr + 16 * j + hi + 2 * gq, (unsigned)(own_ * fx + 0.5f), __ATOMIC_RELAXED, __HIP_MEMORY_SCOPE_WORKGROUP);
              __hip_atomic_fetch_add(impr + 16 * j + hi + 2 * gq + 1, (unsigned)(sa[j][4 * gq + 3] * fx + 0.5f), __ATOMIC_RELAXED, __HIP_MEMORY_SCOPE_WORKGROUP); }
            { const float own_ = 2.f * (sb[j][4 * gq] + sb[j][4 * gq + 1] + sb[j][4 * gq + 2]) + sb[j][4 * gq + 3];
              __hip_atomic_fetch_add(impr + 16 * j + hi + 8 + 2 * gq, (unsigned)(own_ * fx + 0.5f), __ATOMIC_RELAXED, __HIP_MEMORY_SCOPE_WORKGROUP);
              __hip_atomic_fetch_add(impr + 16 * j + hi + 8 + 2 * gq + 1, (unsigned)(sb[j][4 * gq + 3] * fx + 0.5f), __ATOMIC_RELAXED, __HIP_MEMORY_SCOPE_WORKGROUP); } }
        bf16x8 pa0, pa1, pa2, pa3; pack_p(sa[j], sb[j], pa0, pa1, pa2, pa3);
        pv_all<4>(o, vb + j * 16384, pa0, pa1, pa2, pa3); }
    return inv;
}
__device__ __forceinline__ void nsa_phase(const Frame& F, bf16_t* Z, const float* gates, const bf16_t* kcmp, const bf16_t* vcmp, const float* tbias, bf16_t* ACC, unsigned long long& tacc) {
    const int wave = F.wave;
    LAS char* Kl = (LAS char*)F.lds; LAS char* Vl = Kl + NSA_V_OFF;
    LAS unsigned* imp = (LAS unsigned*)(Kl + NSA_IMP_OFF); LAS unsigned long long* selm = (LAS unsigned long long*)(Kl + NSA_SEL_OFF); LAS float* tb = (LAS float*)(Kl + NSA_TB_OFF);
    LAS int* tls = (LAS int*)(Kl + NSA_LIST_OFF); LAS int* tlw = tls + 72; LAS int* tlc = tls + 88;
    const bool cw = wave < 6;
    for (int i = F.tid; i < 12 * 132; i += 512) tb[i] = tbias[i];
    if (F.tid < 4) tlc[F.tid] = F.tid;
    for (int round = 0; round < 2; ++round) {
        const int rank = round * 256 + ((round & 1) ? (255 - F.bid) : F.bid);
        if (F.bid >= 256) break;
        const int bg = rank & 15, b = bg >> 1, g = bg & 1, T0 = (31 - (rank >> 4)) * 128;
        bf16_t* zb = Z + (size_t)b * SEQ * OD_LD;
        const bf16_t* kc = kcmp + (size_t)bg * 256 * 128; const bf16_t* vc = vcmp + (size_t)bg * 256 * 128;
        unsigned long long tp1_ = 0ull; if ((PROBE_SPIN >> 15) & 1) tp1_ = __builtin_amdgcn_s_memrealtime();
        { const int ntc_su = ((((T0 + 96) >> 4) > 254 ? 254 : ((T0 + 96) >> 4)) >> 6) + 1;
          int ld_ = F.tid & 63;
          for (int j = 0; j < ntc_su; ++j) { dma_k2(Kl + j * 16384, kc + (size_t)j * 64 * 128, 128, wave, ld_); dma_v2(Kl + 65536 + j * 16384, vc + (size_t)j * 64 * 128, 128, wave, ld_); } }
        for (int sub = 0; sub < 4; ++sub) {
            int tid = F.tid; asm volatile("" : "+v"(tid));
            const int lane = tid & 63, r32 = lane & 31, hi = lane >> 5;
            const int s0 = T0 + 32 * sub, t = s0 + r32;
            const int jmax = (s0 >> 4) > 254 ? 254 : (s0 >> 4), ntc = (jmax >> 6) + 1;
            for (int i = tid; i < 32 * 65; i += 512) imp[i] = 0u;
            __syncthreads();
            if (cw) {
                const int head = wave, hg = g * 6 + head;
                const int vb = lds_addr(Kl + 65536) + v_rd_base(lane);
                const LAS float* tbl = tb + hg * 132;
                LAS unsigned* impr = imp + r32 * 65;
                LAS char* scr = Kl + 131072 + wave * 2560;
                bf16x8 qr[8]; { u32x4 wq[4][2]; q_pieces(wq, zb + (size_t)s0 * OD_LD + OD_Q + hg * 128, lane); q_regs(qr, scr, wq, lane); }
                f32x16 o[4];
                const float inv = cmp_single_res(Kl, vb, ntc, qr, t, s0, tbl, o, impr, r32, hi);
                { int tv = t; asm volatile("" : "+v"(tv));
                  acc_step<0>(scr, ACC + ((size_t)b * SEQ + s0) * ACC_LD + hg * 128, ACC_LD, nullptr, 0, o, gates[((size_t)b * SEQ + tv) * GATE_LD + hg] * inv, (tv & 31) | (hi << 5), false); }
            }
            __syncthreads();
            nsa_topk(imp, selm + sub * 32, wave, lane, s0);
            __syncthreads();
        }
        if ((PROBE_SPIN >> 15) & 1) tacc += __builtin_amdgcn_s_memrealtime() - tp1_;
        for (int rr = 0; rr < 3; ++rr) {
            int tid = F.tid; asm volatile("" : "+v"(tid));
            const int lane = tid & 63, r32 = lane & 31, hi = lane >> 5;
            const int task = 8 * rr + wave, sub = task / 6, head = task - 6 * sub, hg = g * 6 + head, s0 = T0 + 32 * sub, t = s0 + r32;
            const LAS float* tbl = tb + hg * 132;
            LAS char* K2 = Kl; LAS char* V2 = Kl + NSA2_V_OFF;
            const LAS char* ql = Kl + NSA2_Q_OFF + wave * 8192 + lane * 16;
            q_park(Kl + NSA2_Q_OFF + wave * 8192, zb + (size_t)s0 * OD_LD + OD_Q + hg * 128, lane);
            const unsigned long long mymask = selm[sub * 32 + r32];
            const int s_lo = T0 + 32 * rr, s_hi = s_lo + 32, cur_hi = s_hi >> 6;
            const int jt0 = (s_lo - 511) < 0 ? 0 : (s_lo - 511) >> 6, ntw = cur_hi - jt0 + 1;
            unsigned long long uni;
            { const unsigned long long mk = selm[rr * 32 + lane]; unsigned lo = (unsigned)mk, h32 = (unsigned)(mk >> 32);
#pragma unroll
              for (int off = 1; off < 64; off <<= 1) { lo |= __shfl_xor(lo, off); h32 |= __shfl_xor(h32, off); }
              uni = ((unsigned long long)(unsigned)__builtin_amdgcn_readfirstlane(h32) << 32) | (unsigned)__builtin_amdgcn_readfirstlane(lo); }
            const int ns = __builtin_popcountll(uni);
            if (wave == 7) {
                if ((uni >> lane) & 1ull) tls[__builtin_popcountll(uni & ((1ull << lane) - 1ull))] = lane;
                if (lane < ntw) tlw[lane] = jt0 + lane; }
            dma_k2(K2, zb + OD_KS + g * 128 + (size_t)__builtin_ctzll(uni) * 64 * OD_LD, OD_LD, wave, lane);
            __syncthreads();
            f32x16 o[4]; float lb;
            bf16_t* arow0 = ACC + ((size_t)b * SEQ + s0) * ACC_LD + hg * 128;
            nsa_branch_all<0>(K2, V2, tls, ns, zb + OD_KS + g * 128, zb + OD_VS + g * 128, ql, t, s0, mymask, tbl, lb, o, wave, lane, &tacc, true);
            dma_k2(K2, zb + OD_KW + g * 128 + (size_t)jt0 * 64 * OD_LD, OD_LD, wave, lane);
            { int tv = t; asm volatile("" : "+v"(tv));
              acc_step<1>(Kl + NSA2_SCR_OFF + wave * 2560, arow0, ACC_LD, nullptr, 0, o, gates[((size_t)b * SEQ + tv) * GATE_LD + hg + 12] / lb, (tv & 31) | (hi << 5), false); }
            nsa_branch_all<1>(K2, V2, tlw, ntw, zb + OD_KW + g * 128, zb + OD_VW + g * 128, ql, t, s0, mymask, tbl, lb, o, wave, lane, &tacc, true);
            { int tv = t; asm volatile("" : "+v"(tv));
              acc_step<2>(Kl + NSA2_SCR_OFF + wave * 2560, arow0, ACC_LD, Z + ((size_t)b * SEQ + s0) * OD_LD + OD_G + hg * 128, OD_LD, o, gates[((size_t)b * SEQ + tv) * GATE_LD + hg + 24] / lb, (tv & 31) | (hi << 5), F.dry != 0); }
            __syncthreads();
        }
    }
}

template <int MAP>
__device__ __forceinline__ void transpose_item(const float* W, int K, int N, bf16_t* WT, const float* kscale, LAS float* scr, int item, int lane) {
    const int nblk = (N + 31) / 32, kb = item / nblk, nb = item % nblk, k0 = 64 * kb, n0 = 32 * nb;
    const int nl = n0 + (lane & 31);
    float tv[32];
#pragma unroll
    for (int i = 0; i < 32; ++i) { const int kk = 2 * i + (lane >> 5); tv[i] = 0.f; if (nl < N) tv[i] = W[(size_t)(k0 + kk) * N + nl]; }
#pragma unroll
    for (int i = 0; i < 32; ++i) { const int kk = 2 * i + (lane >> 5); float v = tv[i]; if (kscale) v *= kscale[k0 + kk]; scr[kk * 33 + (lane & 31)] = v; }
    LDS_WAIT(); asm volatile("" ::: "memory");
    const int c = lane & 7;
#pragma unroll
    for (int j = 0; j < 4; ++j) { const int n = (lane >> 3) + 8 * j; const LAS float* s = scr + (8 * c) * 33 + n;
        u32x4 o; o.x = pk2(s[0 * 33], s[1 * 33]); o.y = pk2(s[2 * 33], s[3 * 33]); o.z = pk2(s[4 * 33], s[5 * 33]); o.w = pk2(s[6 * 33], s[7 * 33]);
        const int ncol = n0 + n;
        if (ncol < N) {
            int drow = ncol;
            if (MAP == 1) { if (ncol >= 3620) drow = OD_G + (ncol - 3620); else if (ncol >= 3108) drow = OD_XQ + (ncol - 3108); else if (ncol >= 3072) drow = OD_LD + (ncol - 3072); }
            *(u32x4*)(WT + (size_t)drow * K + k0 + 8 * c) = o; } }
    LDS_WAIT(); asm volatile("" ::: "memory");
}
__device__ __forceinline__ int t5_bucket(int n) {
    if (n < 16) return n;
    int l = 16 + (int)(__logf((float)n * (1.f / 16.f)) / 2.0794415416798357f * 16.f);
    return l < 31 ? l : 31;
}
__device__ __forceinline__ void prologue(const Frame& F, const Args& a) {
    LAS float* scr = (LAS float*)(F.lds + F.wave * 16384);
    const int gw = F.bid * 8 + F.wave, NGW = F.G * 8, lane = F.lane;
    unsigned char* ws = F.ws;
    const float* norm_g = a.in[2];
    constexpr int I0 = 16 * 160, I1 = 16 * 178, IO = 32 * 32, IM = 16 * 32, IC1 = 64 * 8, IC2 = 4 * 4, IP = 3 * 6;
    constexpr int NITEMS = I0 + I1 + 2 * IO + 2 * IM + 2 * IC1 + 2 * IC2 + 4 * IP;
    for (int it = gw; it < NITEMS; it += NGW) {
        int r = it;
        if (r < I0) { transpose_item<0>(a.in[6], DM, EV_LD, (bf16_t*)(ws + WS_W0), norm_g, scr, r, lane); continue; } r -= I0;
        if (r < I1) { transpose_item<1>(a.in[11], DM, OD_COLS, (bf16_t*)(ws + WS_W1), norm_g + DM, scr, r, lane); continue; } r -= I1;
        if (r < IO) { transpose_item<0>(a.in[10], DIN, DM, (bf16_t*)(ws + WS_WO0), nullptr, scr, r, lane); continue; } r -= IO;
        if (r < IO) { transpose_item<0>(a.in[17], DIN, DM, (bf16_t*)(ws + WS_WO1), nullptr, scr, r, lane); continue; } r -= IO;
        if (r < IM) { transpose_item<0>(a.in[9], DM, DM, (bf16_t*)(ws + WS_WM0), nullptr, scr, r, lane); continue; } r -= IM;
        if (r < IM) { transpose_item<0>(a.in[16], DM, DM, (bf16_t*)(ws + WS_WM1), nullptr, scr, r, lane); continue; } r -= IM;
        if (r < 2 * IC1) { const int kv = r / IC1; transpose_item<0>(a.in[13] + (size_t)kv * 4096 * 256, 4096, 256, (bf16_t*)(ws + WS_WC1) + (size_t)kv * 256 * 4096, nullptr, scr, r % IC1, lane); continue; } r -= 2 * IC1;
        if (r < 2 * IC2) { const int kv = r / IC2; transpose_item<0>(a.in[15] + (size_t)kv * 256 * 128, 256, 128, (bf16_t*)(ws + WS_WC2) + (size_t)kv * 128 * 256, nullptr, scr, r % IC2, lane); continue; } r -= 2 * IC2;
        { const int gi = r / IP; transpose_item<0>(a.in[7] + (size_t)gi * 192 * 192, 192, 192, (bf16_t*)(ws + WS_WP) + (size_t)gi * 192 * 192, nullptr, scr, r % IP, lane); }
    }
    { u32x4* p = (u32x4*)((bf16_t*)(ws + WS_W1) + (size_t)OD_COLS * DM); const int n16 = (OD_N - OD_COLS) * DM * 2 / 16;
      for (int i = F.bid * 512 + F.tid; i < n16; i += F.G * 512) p[i] = (u32x4){0u, 0u, 0u, 0u}; }
    { const float* x = a.in[0]; bf16_t* xb = (bf16_t*)(ws + WS_R); float* part = (float*)(ws + WS_PART);
      for (int m = gw; m < MTOK; m += 4 * NGW) {
          f32x4 v[4][4]; float s[4]; bool ok[4]; int mr[4];
#pragma unroll
          for (int q = 0; q < 4; ++q) { ok[q] = m + q * NGW < MTOK; mr[q] = ok[q] ? m + q * NGW : m; const f32x4* xr = (const f32x4*)(x + (size_t)mr[q] * DM) + lane;
#pragma unroll
              for (int j = 0; j < 4; ++j) v[q][j] = xr[64 * j]; }
#pragma unroll
          for (int q = 0; q < 4; ++q) { s[q] = 0.f;
#pragma unroll
              for (int j = 0; j < 4; ++j) s[q] += (v[q][j].x * v[q][j].x + v[q][j].y * v[q][j].y) + (v[q][j].z * v[q][j].z + v[q][j].w * v[q][j].w);
              s[q] = wave_sum(s[q]); }
#pragma unroll
          for (int q = 0; q < 4; ++q) if (ok[q]) { u32x2* o8 = (u32x2*)(xb + (size_t)mr[q] * DM) + lane;
#pragma unroll
              for (int j = 0; j < 4; ++j) o8[64 * j] = (u32x2){pk2(v[q][j].x, v[q][j].y), pk2(v[q][j].z, v[q][j].w)};
              if (lane < 16) part[(size_t)mr[q] * 16 + lane] = (lane == 0) ? s[q] : 0.f; }
      } }
    { const float* mem = a.in[1]; const float* mg = a.in[4]; bf16_t* mn = (bf16_t*)(ws + WS_MEMN);
      for (int m = gw; m < BATCH * NMEM; m += NGW) {
          const f32x4* xr = (const f32x4*)(mem + (size_t)m * DM) + lane; const f32x4* gr = (const f32x4*)mg + lane; f32x4 v[4]; float s = 0.f;
#pragma unroll
          for (int j = 0; j < 4; ++j) { v[j] = xr[64 * j]; s += (v[j].x * v[j].x + v[j].y * v[j].y) + (v[j].z * v[j].z + v[j].w * v[j].w); }
          const float rs = 1.0f / sqrtf(wave_sum(s) * (1.f / DM) + EPS);
          u32x2* o8 = (u32x2*)(mn + (size_t)m * DM) + lane;
#pragma unroll
          for (int j = 0; j < 4; ++j) { const f32x4 g = gr[64 * j]; o8[64 * j] = (u32x2){pk2(v[j].x * rs * g.x, v[j].y * rs * g.y), pk2(v[j].z * rs * g.z, v[j].w * rs * g.w)}; }
      } }
    { float* ct = (float*)(ws + WS_ROPE); float* st = ct + SEQ * 64;
      for (int i = F.bid * 512 + F.tid; i < SEQ * 64; i += F.G * 512) {
          const int s = i >> 6, f = i & 63;
          const float inv = exp2f(-((float)f * (1.f / 64.f)) * 13.287712379549449f);
          const float ang = (float)s * inv;
          const double x = (double)ang; const double kq = rint(x * 0.6366197723675814);
          double r = fma(-kq, 1.5707963267948966, x); r = fma(-kq, 6.123233995736766e-17, r);
          const double r2 = r * r;
          const double sn = r * (1.0 + r2 * (-1.0 / 6 + r2 * (1.0 / 120 + r2 * (-1.0 / 5040 + r2 * (1.0 / 362880 - r2 * (1.0 / 39916800))))));
          const double cs = 1.0 + r2 * (-0.5 + r2 * (1.0 / 24 + r2 * (-1.0 / 720 + r2 * (1.0 / 40320 - r2 * (1.0 / 3628800)))));
          const int q = ((int)kq) & 3;
          double c_, s_;
          if (q == 0) { c_ = cs; s_ = sn; } else if (q == 1) { c_ = -sn; s_ = cs; } else if (q == 2) { c_ = -cs; s_ = -sn; } else { c_ = sn; s_ = -cs; }
          ct[i] = (float)c_; st[i] = (float)s_;
      } }
    if (F.bid == 0) { float* tb = (float*)(ws + WS_MISC); const float* rb = a.in[5];
        for (int i = F.tid; i < 12 * 132; i += 512) { const int h = i / 132, r = i % 132; const int bk = r >= 128 ? 31 : t5_bucket(r); tb[i] = rb[bk * 12 + h] * LOG2E; } }
    for (int w = F.bid; w < 256; w += F.G) { const int kv = w >> 7, j = (w >> 2) & 31, cl = F.tid & 63, c = (w & 3) * 64 + cl, kg = F.tid >> 6;
        const float* pe = a.in[12] + (size_t)kv * 4096 + 128 * j + 16 * kg; const float* w1 = a.in[13] + (size_t)kv * 4096 * 256 + (size_t)(128 * j + 16 * kg) * 256 + c;
        float pv[16], wv[16];
#pragma unroll
        for (int i = 0; i < 16; ++i) { pv[i] = pe[i]; wv[i] = w1[(size_t)i * 256]; }
        float s = 0.f;
#pragma unroll
        for (int i = 0; i < 16; ++i) s += pv[i] * wv[i];
        LAS float* red = (LAS float*)(F.lds + RSTD_OFF);
        red[kg * 64 + cl] = s;
        __syncthreads();
        if (kg == 0) { float tot = 0.f;
#pragma unroll
            for (int q = 0; q < 8; ++q) tot += red[q * 64 + cl];
            ((float*)(ws + WS_MISC + 65536))[(kv * 32 + j) * 256 + c] = tot; }
        __syncthreads(); }
}

__device__ __forceinline__ void final_norm(const Frame& F, float* out, const bf16_t* hb, const float* part, const float* fg) {
    const int gw = F.bid * 8 + F.wave, NGW = F.G * 8, lane = F.lane;
    for (int m = gw; m < MTOK; m += NGW) {
        float ps = (lane < 16) ? part[(size_t)m * 16 + lane] : 0.f;
        float tot = 0.f;
#pragma unroll
        for (int j = 0; j < 16; ++j) tot += __shfl(ps, j);
        const float rs = 1.0f / sqrtf(tot * (1.f / DM) + EPS);
        const u32x4* hr = (const u32x4*)(hb + (size_t)m * DM) + lane; f32x4* xr = (f32x4*)(out + (size_t)m * DM) + 2 * lane; const f32x4* gr = (const f32x4*)fg + 2 * lane;
#pragma unroll
        for (int j = 0; j < 2; ++j) { const u32x4 hw = hr[64 * j]; const f32x4 g0 = gr[128 * j], g1 = gr[128 * j + 1];
            f32x4 v0 = {__builtin_bit_cast(float, hw.x << 16), __builtin_bit_cast(float, hw.x & 0xffff0000u), __builtin_bit_cast(float, hw.y << 16), __builtin_bit_cast(float, hw.y & 0xffff0000u)};
            f32x4 v1 = {__builtin_bit_cast(float, hw.z << 16), __builtin_bit_cast(float, hw.z & 0xffff0000u), __builtin_bit_cast(float, hw.w << 16), __builtin_bit_cast(float, hw.w & 0xffff0000u)};
            v0 = v0 * rs * g0; v1 = v1 * rs * g1;
            if (!F.dry) { xr[128 * j] = v0; xr[128 * j + 1] = v1; } }
    }
}
__device__ __forceinline__ void fill_rstd(const Frame& F, const pg8::StaticOrder& S, const float* part) {
    LAS float* rl = (LAS float*)(F.lds + RSTD_OFF);
    f32x4 pv[6][4]; bool ok[6];
#pragma unroll
    for (int j = 0; j < 6; ++j) { const int en = F.tid + 512 * j, i = en >> 8, r = en & 255; pg8::Unit u; ok[j] = S.next(i, u);
        const f32x4* p = (const f32x4*)(part + ((size_t)(ok[j] ? u.pm : 0) * 256 + r) * 16);
#pragma unroll
        for (int q = 0; q < 4; ++q) pv[j][q] = p[q]; }
#pragma unroll
    for (int j = 0; j < 6; ++j) { const int en = F.tid + 512 * j;
        float tot = 0.f;
#pragma unroll
        for (int q = 0; q < 4; ++q) { tot += pv[j][q].x; tot += pv[j][q].y; tot += pv[j][q].z; tot += pv[j][q].w; }
        if (ok[j]) rl[en] = 1.0f / sqrtf(tot * (1.f / DM) + EPS); }
    __syncthreads();
}

constexpr int NPHASE = 12;
__global__ void __launch_bounds__(512, 2) fwd_kernel(Args args) {
    extern __shared__ __attribute__((aligned(16))) unsigned char lds_raw[];
    Frame F; F.lds = (LAS unsigned char*)lds_raw; F.tid = threadIdx.x; F.lane = F.tid & 63; F.wave = __builtin_amdgcn_readfirstlane(F.tid >> 6);
    F.G = gridDim.x; F.bid = blockIdx.x; F.ws = args.ws; F.dry = 0;
    unsigned char* ws = args.ws;
    const int lo = args.ph_lo, hi = args.ph_hi;
#define IN(k) (lo <= (k) && (k) < hi)
    { volatile LAS unsigned* mw = (volatile LAS unsigned*)(F.lds + MISC_OFF); if (F.tid < 16) mw[F.tid] = 0u; }
    __syncthreads();
    const XcdBarrier xbar = xcd_barrier_post((unsigned*)(ws + WS_CTL) + 4096, (volatile LAS unsigned*)(F.lds + MISC_OFF));
    unsigned long long ts_prev = 0ull, ts_acc = 0ull;
    if (PROBE_SPIN) ts_prev = __builtin_amdgcn_s_memrealtime();
#define SEAM(k) do { if (IN(k) && IN((k) + 1)) xcd_barrier(xbar); if (PROBE_SPIN) { const unsigned long long now_ = __builtin_amdgcn_s_memrealtime(); if ((PROBE_SPIN >> (k)) & 1) ts_acc += now_ - ts_prev; ts_prev = now_; } } while (0)
    float* part = (float*)(ws + WS_PART);
    bf16_t* Z = (bf16_t*)(ws + WS_Z);
    bf16_t* HB = (bf16_t*)(ws + WS_R);

#define PHASE(k, ...) if (IN(k)) { { F.dry = 0; __VA_ARGS__ } if ((PROBE_REP >> (k)) & 1) { xcd_barrier(xbar); F.dry = 1; __VA_ARGS__ } }
    PHASE(0, prologue(F, args);)
    SEAM(0);
    PHASE(1,
        { pg8::StaticOrder S; S.init(MTOK, EV_LD, F.G, F.bid); fill_rstd(F, S, part);
          pg8::Gemm g{HB, (const bf16_t*)(ws + WS_W0), MTOK, EV_LD, DM, DM};
          EpiIn E{Z, EV_LD, (const LAS float*)(F.lds + RSTD_OFF), EV_G / 256, -1, nullptr, 0, 0};
          pg8::gemm_phase(F.lds, g, S, E); }
        { pg8::StaticOrder S; S.init(BATCH * NMEM, DM, F.G, F.bid);
          pg8::Gemm g{(const bf16_t*)(ws + WS_MEMN), (const bf16_t*)(ws + WS_WM0), BATCH * NMEM, DM, DM, DM};
          EpiBf E{(bf16_t*)(ws + WS_MKV0), DM};
          pg8::gemm_phase(F.lds, g, S, E); }
    )
    SEAM(1);
    PHASE(2,
        ret_a_phase(F, Z, (const float*)(ws + WS_ROPE), (const float*)(ws + WS_ROPE) + SEQ * 64, (bf16_t*)(ws + WS_R), F.bid, F.G);
        pool_phase(F, Z, (const bf16_t*)(ws + WS_WP), args.in[8], F.bid, F.G);
        mem_attn_phase(F, Z, EV_LD, EV_XQ, EV_G + 1536, (const bf16_t*)(ws + WS_MKV0), F.bid, 256);
    )
    SEAM(2);
    PHASE(3, ret_scan_phase(F, (bf16_t*)(ws + WS_R));)
    SEAM(3);
    PHASE(4, ret_c_phase(F, Z, (const float*)(ws + WS_ROPE), (const float*)(ws + WS_ROPE) + SEQ * 64, (const bf16_t*)(ws + WS_R), F.bid, F.G);)
    SEAM(4);
    PHASE(5,
        pg8::StaticOrder S; S.init(MTOK, DM, F.G, F.bid);
        pg8::Gemm g{Z + EV_G, (const bf16_t*)(ws + WS_WO0), MTOK, DM, DIN, EV_LD};
        EpiOut<true> E{args.in[0], HB, part, F.dry};
        pg8::gemm_phase(F.lds, g, S, E);
    )
    SEAM(5);
    PHASE(6,
        pg8::StaticOrder S; S.init(MTOK, OD_N, F.G, F.bid); fill_rstd(F, S, part);
        pg8::Gemm g{HB, (const bf16_t*)(ws + WS_W1), MTOK, OD_N, DM, DM};
        EpiIn E{Z, OD_LD, (const LAS float*)(F.lds + RSTD_OFF), OD_G / 256, OD_LD / 256, (float*)(ws + WS_GATES), 0, 0};
        pg8::gemm_phase(F.lds, g, S, E);
        { pg8::StaticOrder S2; S2.init(BATCH * NMEM, DM, F.G, (F.bid + 128) % F.G);
          pg8::Gemm g2{(const bf16_t*)(ws + WS_MEMN), (const bf16_t*)(ws + WS_WM1), BATCH * NMEM, DM, DM, DM};
          EpiBf E2{(bf16_t*)(ws + WS_MKV1), DM};
          pg8::gemm_phase(F.lds, g2, S2, E2); }
    )
    SEAM(6);
    PHASE(7,
        if (F.bid < 128) compress_phase(F, Z, (const bf16_t*)(ws + WS_WC1), (const bf16_t*)(ws + WS_WC2), args.in[14], (const float*)(ws + WS_MISC + 65536), (bf16_t*)(ws + WS_KCMP), (bf16_t*)(ws + WS_VCMP), F.bid, 128);
        else mem_attn_phase(F, Z, OD_LD, OD_XQ, OD_G + 1536, (const bf16_t*)(ws + WS_MKV1), F.bid - 128, 128);
    )
    SEAM(7);
    PHASE(8, nsa_phase(F, Z, (const float*)(ws + WS_GATES), (const bf16_t*)(ws + WS_KCMP), (const bf16_t*)(ws + WS_VCMP), (const float*)(ws + WS_MISC), (bf16_t*)args.out, ts_acc);)
    SEAM(8);
    PHASE(10,
        pg8::StaticOrder S; S.init(MTOK, DM, F.G, F.bid);
        pg8::Gemm g{Z + OD_G, (const bf16_t*)(ws + WS_WO1), MTOK, DM, DIN, OD_LD};
        EpiFinal E{HB, args.out, part, args.in[3], (unsigned*)(ws + WS_CTL) + 16384, xbar.bar};
        pg8::gemm_phase(F.lds, g, S, E);
    )
#undef PHASE
    if (PROBE_SPIN) { const unsigned long long now_ = __builtin_amdgcn_s_memrealtime(); if ((PROBE_SPIN >> 11) & 1) ts_acc += now_ - ts_prev;
        if (F.bid == 0) { const unsigned long long t0_ = __builtin_amdgcn_s_memrealtime(); while (__builtin_amdgcn_s_memrealtime() - t0_ < ts_acc) __builtin_amdgcn_s_sleep(8); } }
#undef IN
#undef SEAM
}

extern "C" void kernel_launch(void* const* d_in, const int* in_sizes, int n_in, void* d_out, int out_size, void* d_ws, size_t ws_size, hipStream_t stream) {
    static int grid = 0;
    if (grid == 0) {
        if (n_in != 18 || out_size != MTOK * DM || ws_size < WS_END) { fprintf(stderr, "kernel_launch: unexpected shapes: n_in %d out %d ws %zu (need %zu)\n", n_in, out_size, ws_size, (size_t)WS_END); grid = -1; return; }
        int dev = 0, cus = 0, per_cu = 0;
        hipGetDevice(&dev); hipDeviceGetAttribute(&cus, hipDeviceAttributeMultiprocessorCount, dev);
        if (hipFuncSetAttribute((const void*)fwd_kernel, hipFuncAttributeMaxDynamicSharedMemorySize, LDS_BYTES) != hipSuccess) { fprintf(stderr, "kernel_launch: hipFuncSetAttribute failed\n"); grid = -1; return; }
        if (hipOccupancyMaxActiveBlocksPerMultiprocessor(&per_cu, (const void*)fwd_kernel, 512, LDS_BYTES) != hipSuccess || per_cu < 1) { fprintf(stderr, "kernel_launch: occupancy query says %d\n", per_cu); per_cu = 1; }
        (void)hipGetLastError();
        grid = cus;
    }
    if (grid < 0) return;
    if (hipMemsetAsync((char*)d_ws + WS_CTL, 0, CTL_BYTES, stream) != hipSuccess) { fprintf(stderr, "kernel_launch: memset failed\n"); return; }
    Args a{};
    for (int i = 0; i < 18; ++i) a.in[i] = (const float*)d_in[i];
    a.out = (float*)d_out; a.ws = (unsigned char*)d_ws; a.ph_lo = 0; a.ph_hi = NPHASE;
    void* kargs[] = {&a};
    hipError_t e = hipLaunchCooperativeKernel((const void*)fwd_kernel, dim3(grid), dim3(512), kargs, LDS_BYTES, stream);
    if (e != hipSuccess) fprintf(stderr, "kernel_launch: cooperative launch failed: %s (grid %d)\n", hipGetErrorString(e), grid);
}
```
